# Optimizing an MI355X kernel written in HIP

```python
import math
import jax
import jax.numpy as jnp
from jax import lax
import numpy as np

D_MODEL = 2048
BATCH = 1
SEQ = 16384
DEPTH = 4

F32 = jnp.float32
MIX_WIDTH = D_MODEL
N_MIXERS = 4
GROUP_WIDTH = MIX_WIDTH // N_MIXERS
SWA_HEADS = 8
SWA_KV_HEADS = 2
SWA_HEAD_DIM = GROUP_WIDTH // SWA_HEADS
WINDOW = 128
SWA_BLOCK = 128
CONV_CH = GROUP_WIDTH
CONV_WIDTH = 31
MLA_HEADS = 4
MLA_Q_LORA = 512
MLA_KV_LORA = 256
MLA_NOPE = 128
MLA_ROPE = 64
MLA_V = GROUP_WIDTH // MLA_HEADS
MLA_QBLK = 128
ROPE_THETA = 10000.0
SSM_CH = GROUP_WIDTH
SSM_GROUP_IN = 16
SSM_GROUPS = SSM_CH // SSM_GROUP_IN
SSM_STATE = 64
DT_MIN = 0.001
DT_MAX = 0.1
REL_BUCKETS = 32
REL_MAX_DIST = 128
MEM_TOKENS = 256
XA_HEADS = 4
XA_HEAD_DIM = 128
N_EXPERT_GROUPS = 4
EXPERTS_PER_GROUP = 8
N_EXPERTS = N_EXPERT_GROUPS * EXPERTS_PER_GROUP
EXPERT_TOPK = 2
EXPERT_FF = 512
EXPERT_BLOCK = 256
NORM_EPS = 1e-6
NEG_INF = -1e30
IN_SPLITS = (SWA_HEADS * SWA_HEAD_DIM, SWA_KV_HEADS * SWA_HEAD_DIM, SWA_KV_HEADS * SWA_HEAD_DIM,
             CONV_CH, CONV_CH, MLA_Q_LORA, MLA_KV_LORA, MLA_ROPE, SSM_CH)
IN_WIDTH = sum(IN_SPLITS)

kernel_name = 'hybrid_parallel_heads_hmoe_trunk'


def rms_norm(x, g):
    x32 = x.astype(F32)
    y = x32 * lax.rsqrt(jnp.mean(x32 * x32, axis=-1, keepdims=True) + NORM_EPS)
    return (y * g.astype(F32)).astype(x.dtype)


def layer_norm(x, g, b):
    x32 = x.astype(F32)
    xc = x32 - jnp.mean(x32, axis=-1, keepdims=True)
    y = xc * lax.rsqrt(jnp.mean(xc * xc, axis=-1, keepdims=True) + NORM_EPS)
    return (y * g.astype(F32) + b.astype(F32)).astype(x.dtype)


def rope_tables(seq_len):
    inv = 1.0 / (ROPE_THETA ** (jnp.arange(0, MLA_ROPE, 2, dtype=F32) / MLA_ROPE))
    ang = jnp.arange(seq_len, dtype=F32)[:, None] * inv[None, :]
    return jnp.cos(ang), jnp.sin(ang)


def apply_rope(x, cos, sin):
    x32 = x.astype(F32)
    x1, x2 = jnp.split(x32, 2, axis=-1)
    return jnp.concatenate([x1 * cos - x2 * sin, x1 * sin + x2 * cos], axis=-1).astype(x.dtype)


def t5_band_buckets():
    qi = np.arange(SWA_BLOCK)[:, None]
    kj = np.arange(2 * SWA_BLOCK)[None, :]
    dist = SWA_BLOCK + qi - kj
    valid = (dist >= 0) & (dist < WINDOW)
    max_exact = REL_BUCKETS // 2
    d0 = np.maximum(dist, 0)
    dl = np.maximum(dist, 1).astype(np.float32)
    large = max_exact + (np.log(dl / max_exact) / np.log(REL_MAX_DIST / max_exact)
                         * (REL_BUCKETS - max_exact)).astype(np.int32)
    large = np.minimum(large, REL_BUCKETS - 1)
    bucket = np.where(d0 < max_exact, d0, large).astype(np.int32)
    return bucket, valid


def swa_sink_attention(q, k, v, sinks, rel_bias):
    b, s, _, dh = q.shape
    nb = s // SWA_BLOCK
    grp = SWA_HEADS // SWA_KV_HEADS
    qb = q.reshape(b, nb, SWA_BLOCK, SWA_KV_HEADS, grp, dh)

    def band(t):
        tb = t.reshape(b, nb, SWA_BLOCK, SWA_KV_HEADS, dh)
        prev = jnp.concatenate([jnp.zeros_like(tb[:, :1]), tb[:, :-1]], axis=1)
        return jnp.concatenate([prev, tb], axis=2)

    kb, vb = band(k), band(v)
    bucket, valid = t5_band_buckets()
    bias = rel_bias.astype(F32)[bucket]
    bias = bias.reshape(SWA_BLOCK, 2 * SWA_BLOCK, SWA_KV_HEADS, grp).transpose(2, 3, 0, 1)
    not_first = (np.arange(nb)[:, None, None] > 0) | (np.arange(2 * SWA_BLOCK)[None, None, :] >= SWA_BLOCK)
    mask = jnp.asarray(valid[None] & not_first)[None, :, None, None]
    logits = jnp.einsum('bnqkgd,bnjkd->bnkgqj', qb, kb).astype(F32) * (dh ** -0.5) + bias
    logits = jnp.where(mask, logits, NEG_INF)
    sink = sinks.astype(F32).reshape(SWA_KV_HEADS, grp)[None, None, :, :, None, None]
    m = jnp.maximum(jnp.max(logits, axis=-1, keepdims=True), sink)
    p = jnp.exp(logits - m)
    probs = p / (jnp.sum(p, axis=-1, keepdims=True) + jnp.exp(sink - m))
    out = jnp.einsum('bnkgqj,bnjkd->bnqkgd', probs.astype(v.dtype), vb)
    return out.reshape(b, s, SWA_HEADS * dh)


def conformer_conv(a, g, dw_w, dw_b, ln_g, ln_b, pw_w, pw_b):
    z = a * jax.nn.sigmoid(g)
    z = lax.conv_general_dilated(z, dw_w[:, None, :].astype(z.dtype), window_strides=(1,),
                                 padding=[(CONV_WIDTH - 1, 0)],
                                 dimension_numbers=('NWC', 'WIO', 'NWC'),
                                 feature_group_count=CONV_CH) + dw_b
    z = jax.nn.silu(layer_norm(z, ln_g, ln_b))
    return z @ pw_w + pw_b


def mla_attention(q_lat, kv_lat, k_rope_in, qa_g, kva_g, wq_b, wkv_b,
                  qn_nope_g, qn_rope_g, kn_nope_g, kn_rope_g, cos, sin):
    b, s, _ = q_lat.shape
    q = (rms_norm(q_lat, qa_g) @ wq_b).reshape(b, s, MLA_HEADS, MLA_NOPE + MLA_ROPE)
    kv = (rms_norm(kv_lat, kva_g) @ wkv_b).reshape(b, s, MLA_HEADS, MLA_NOPE + MLA_V)
    q_nope = rms_norm(q[..., :MLA_NOPE], qn_nope_g)
    q_rope = apply_rope(rms_norm(q[..., MLA_NOPE:], qn_rope_g), cos[:, None, :], sin[:, None, :])
    k_nope = rms_norm(kv[..., :MLA_NOPE], kn_nope_g)
    v = kv[..., MLA_NOPE:]
    k_rope = apply_rope(rms_norm(k_rope_in, kn_rope_g), cos, sin)
    nb = s // MLA_QBLK

    def to_blocks(t):
        return jnp.moveaxis(t.reshape(b, nb, MLA_QBLK, *t.shape[2:]), 1, 0)

    q_pos = jnp.arange(s, dtype=jnp.int32).reshape(nb, MLA_QBLK)
    k_pos = jnp.arange(s, dtype=jnp.int32)
    scale = (MLA_NOPE + MLA_ROPE) ** -0.5

    def one_block(args):
        qn, qr, qp = args
        logits = (jnp.einsum('bqhd,bkhd->bhqk', qn, k_nope)
                  + jnp.einsum('bqhr,bkr->bhqk', qr, k_rope)).astype(F32) * scale
        logits = jnp.where(k_pos[None, :] <= qp[:, None], logits, NEG_INF)
        probs = jax.nn.softmax(logits, axis=-1)
        return jnp.einsum('bhqk,bkhd->bqhd', probs.astype(v.dtype), v)

    out = lax.map(one_block, (to_blocks(q_nope), to_blocks(q_rope), q_pos))
    return jnp.moveaxis(out, 0, 1).reshape(b, s, MLA_HEADS * MLA_V)


def s5_mixer(u, a_re, a_im, log_dt, b_re, b_im, c_re, c_im, d_skip, glu_w, glu_b):
    b, s, _ = u.shape
    u32 = u.astype(F32).reshape(b, s, SSM_GROUPS, SSM_GROUP_IN)
    lam = lax.complex(a_re.astype(F32), a_im.astype(F32))
    dt = jnp.exp(log_dt.astype(F32))[:, None]
    lam_bar = jnp.exp(lam * dt)
    b_bar = ((lam_bar - 1.0) / lam)[..., None] * lax.complex(b_re.astype(F32), b_im.astype(F32))
    bu = jnp.einsum('bsgi,gpi->bsgp', u32.astype(jnp.complex64), b_bar)
    a_seq = jnp.broadcast_to(lam_bar, bu.shape)

    def combine(left, right):
        a_l, x_l = left
        a_r, x_r = right
        return a_r * a_l, a_r * x_l + x_r

    _, states = lax.associative_scan(combine, (a_seq, bu), axis=1)
    c = lax.complex(c_re.astype(F32), c_im.astype(F32))
    y = (jnp.einsum('gop,bsgp->bsgo', c, states).real
         + d_skip.astype(F32).reshape(SSM_GROUPS, SSM_GROUP_IN) * u32)
    y = jax.nn.gelu(y.reshape(b, s, SSM_CH))
    out = y * jax.nn.sigmoid(y @ glu_w.astype(F32) + glu_b.astype(F32))
    return out.astype(u.dtype)


def memory_cross_attention(h, mem_n, wq, wk, wv, qn_g, kn_g, wo):
    b, s, _ = h.shape
    m = mem_n.shape[1]
    q = rms_norm((h @ wq).reshape(b, s, XA_HEADS, XA_HEAD_DIM), qn_g)
    k = rms_norm((mem_n @ wk).reshape(b, m, XA_HEADS, XA_HEAD_DIM), kn_g)
    v = (mem_n @ wv).reshape(b, m, XA_HEADS, XA_HEAD_DIM)
    logits = jnp.einsum('bshd,bmhd->bhsm', q, k).astype(F32) * (XA_HEAD_DIM ** -0.5)
    probs = jax.nn.softmax(logits, axis=-1)
    o = jnp.einsum('bhsm,bmhd->bshd', probs.astype(v.dtype), v).reshape(b, s, XA_HEADS * XA_HEAD_DIM)
    return o @ wo


def dispatch_experts(ht, expert_flat, w_flat, w_gate, w_up, w_down):
    n_tok, d = ht.shape
    n_assign = expert_flat.shape[0]
    n_blocks = -(-(n_assign + N_EXPERTS * (EXPERT_BLOCK - 1)) // EXPERT_BLOCK)
    padded_len = n_blocks * EXPERT_BLOCK
    tok_flat = jnp.repeat(jnp.arange(n_tok, dtype=jnp.int32), EXPERT_TOPK)
    order = jnp.argsort(expert_flat)
    e_sorted = expert_flat[order]
    tok_sorted = tok_flat[order]
    w_sorted = w_flat[order]
    counts = jnp.bincount(expert_flat, length=N_EXPERTS)
    starts = jnp.cumsum(counts) - counts
    padded = (counts + EXPERT_BLOCK - 1) // EXPERT_BLOCK * EXPERT_BLOCK
    pad_ends = jnp.cumsum(padded)
    pad_starts = pad_ends - padded
    dest = pad_starts[e_sorted] + jnp.arange(n_assign, dtype=jnp.int32) - starts[e_sorted]
    tok_buf = jnp.full((padded_len,), n_tok, jnp.int32).at[dest].set(tok_sorted)
    w_buf = jnp.zeros((padded_len,), ht.dtype).at[dest].set(w_sorted.astype(ht.dtype))
    block_starts = jnp.arange(n_blocks, dtype=jnp.int32) * EXPERT_BLOCK
    block_expert = jnp.minimum(jnp.searchsorted(pad_ends, block_starts, side='right'),
                               N_EXPERTS - 1).astype(jnp.int32)
    x_pad = jnp.concatenate([ht, jnp.zeros((1, d), ht.dtype)], axis=0)
    xb = x_pad[tok_buf].reshape(n_blocks, EXPERT_BLOCK, d)

    def expert_block(args):
        xblk, e = args
        hid = jax.nn.silu(xblk @ w_gate[e]) * (xblk @ w_up[e])
        return hid @ w_down[e]

    out = lax.map(expert_block, (xb, block_expert)).reshape(padded_len, d)
    y = jnp.zeros((n_tok + 1, d), ht.dtype).at[tok_buf].add(out * w_buf[:, None])
    return y[:n_tok]


def hier_moe(h, w_group, b_group, w_expert, b_expert, w_gate, w_up, w_down):
    b, s, d = h.shape
    n_tok = b * s
    ht = h.reshape(n_tok, d)
    tok = jnp.arange(n_tok)
    g_logits = (ht @ w_group).astype(F32) + b_group.astype(F32)
    g_idx = jnp.argmax(g_logits, axis=-1)
    g_w = jax.nn.softmax(g_logits, axis=-1)[tok, g_idx]
    e_logits = ((ht @ w_expert).astype(F32) + b_expert.astype(F32)).reshape(
        n_tok, N_EXPERT_GROUPS, EXPERTS_PER_GROUP)[tok, g_idx]
    top_val, top_idx = lax.top_k(e_logits, EXPERT_TOPK)
    gate = jax.nn.softmax(top_val, axis=-1) * g_w[:, None]
    expert_id = (g_idx[:, None] * EXPERTS_PER_GROUP + top_idx).astype(jnp.int32)
    y = dispatch_experts(ht, expert_id.reshape(-1), gate.reshape(-1), w_gate, w_up, w_down)
    return y.reshape(b, s, d)


def setup_inputs(seed: int = 0) -> dict:
    key = jax.random.key(seed)
    keys = list(jax.random.split(key, 64))
    L = DEPTH

    def nk():
        return keys.pop()

    def nrm(shape, scale):
        return scale * jax.random.normal(nk(), shape, F32)

    def gain(shape):
        return 1.0 + 0.02 * jax.random.normal(nk(), shape, F32)

    a_im = jnp.pi * jnp.arange(SSM_STATE, dtype=F32)[None, None, :] + nrm((L, SSM_GROUPS, SSM_STATE), 0.01)
    return {
        'x': nrm((BATCH, SEQ, D_MODEL), 1.0),
        'mem': nrm((BATCH, MEM_TOKENS, D_MODEL), 1.0),
        'rel_bias': nrm((REL_BUCKETS, SWA_HEADS), 0.5),
        'ln_mix_g': gain((L, D_MODEL)),
        'w_in': nrm((L, D_MODEL, IN_WIDTH), D_MODEL ** -0.5),
        'swa_qn_g': gain((L, SWA_HEAD_DIM)),
        'swa_kn_g': gain((L, SWA_HEAD_DIM)),
        'swa_sinks': nrm((L, SWA_HEADS), 0.5),
        'conv_dw_w': nrm((L, CONV_WIDTH, CONV_CH), CONV_WIDTH ** -0.5),
        'conv_dw_b': nrm((L, CONV_CH), 0.02),
        'conv_ln_g': gain((L, CONV_CH)),
        'conv_ln_b': nrm((L, CONV_CH), 0.02),
        'conv_pw_w': nrm((L, CONV_CH, CONV_CH), CONV_CH ** -0.5),
        'conv_pw_b': nrm((L, CONV_CH), 0.02),
        'mla_qa_g': gain((L, MLA_Q_LORA)),
        'mla_kva_g': gain((L, MLA_KV_LORA)),
        'mla_wq_b': nrm((L, MLA_Q_LORA, MLA_HEADS * (MLA_NOPE + MLA_ROPE)), MLA_Q_LORA ** -0.5),
        'mla_wkv_b': nrm((L, MLA_KV_LORA, MLA_HEADS * (MLA_NOPE + MLA_V)), MLA_KV_LORA ** -0.5),
        'mla_qn_nope_g': gain((L, MLA_NOPE)),
        'mla_qn_rope_g': gain((L, MLA_ROPE)),
        'mla_kn_nope_g': gain((L, MLA_NOPE)),
        'mla_kn_rope_g': gain((L, MLA_ROPE)),
        'ssm_a_re': -0.5 + nrm((L, SSM_GROUPS, SSM_STATE), 0.01),
        'ssm_a_im': a_im,
        'ssm_log_dt': jax.random.uniform(nk(), (L, SSM_GROUPS), F32, math.log(DT_MIN), math.log(DT_MAX)),
        'ssm_b_re': nrm((L, SSM_GROUPS, SSM_STATE, SSM_GROUP_IN), (2 * SSM_GROUP_IN) ** -0.5),
        'ssm_b_im': nrm((L, SSM_GROUPS, SSM_STATE, SSM_GROUP_IN), (2 * SSM_GROUP_IN) ** -0.5),
        'ssm_c_re': nrm((L, SSM_GROUPS, SSM_GROUP_IN, SSM_STATE), SSM_STATE ** -0.5),
        'ssm_c_im': nrm((L, SSM_GROUPS, SSM_GROUP_IN, SSM_STATE), SSM_STATE ** -0.5),
        'ssm_d': nrm((L, SSM_CH), 1.0),
        'ssm_glu_w': nrm((L, SSM_CH, SSM_CH), SSM_CH ** -0.5),
        'ssm_glu_b': nrm((L, SSM_CH), 0.02),
        'mix_out_g': gain((L, MIX_WIDTH)),
        'w_out': nrm((L, MIX_WIDTH, D_MODEL), MIX_WIDTH ** -0.5),
        'ln_cross_g': gain((L, D_MODEL)),
        'mem_ln_g': gain((L, D_MODEL)),
        'xa_wq': nrm((L, D_MODEL, XA_HEADS * XA_HEAD_DIM), D_MODEL ** -0.5),
        'xa_wk': nrm((L, D_MODEL, XA_HEADS * XA_HEAD_DIM), D_MODEL ** -0.5),
        'xa_wv': nrm((L, D_MODEL, XA_HEADS * XA_HEAD_DIM), D_MODEL ** -0.5),
        'xa_qn_g': gain((L, XA_HEAD_DIM)),
        'xa_kn_g': gain((L, XA_HEAD_DIM)),
        'xa_wo': nrm((L, XA_HEADS * XA_HEAD_DIM, D_MODEL), (XA_HEADS * XA_HEAD_DIM) ** -0.5),
        'ln_moe_g': gain((L, D_MODEL)),
        'moe_w_group': nrm((L, D_MODEL, N_EXPERT_GROUPS), D_MODEL ** -0.5),
        'moe_b_group': nrm((L, N_EXPERT_GROUPS), 0.01),
        'moe_w_expert': nrm((L, D_MODEL, N_EXPERTS), D_MODEL ** -0.5),
        'moe_b_expert': nrm((L, N_EXPERTS), 0.01),
        'moe_w_gate': nrm((L, N_EXPERTS, D_MODEL, EXPERT_FF), D_MODEL ** -0.5),
        'moe_w_up': nrm((L, N_EXPERTS, D_MODEL, EXPERT_FF), D_MODEL ** -0.5),
        'moe_w_down': nrm((L, N_EXPERTS, EXPERT_FF, D_MODEL), EXPERT_FF ** -0.5),
    }


def reference(x, mem, rel_bias, ln_mix_g, w_in, swa_qn_g, swa_kn_g, swa_sinks,
              conv_dw_w, conv_dw_b, conv_ln_g, conv_ln_b, conv_pw_w, conv_pw_b,
              mla_qa_g, mla_kva_g, mla_wq_b, mla_wkv_b, mla_qn_nope_g, mla_qn_rope_g,
              mla_kn_nope_g, mla_kn_rope_g,
              ssm_a_re, ssm_a_im, ssm_log_dt, ssm_b_re, ssm_b_im, ssm_c_re, ssm_c_im,
              ssm_d, ssm_glu_w, ssm_glu_b,
              mix_out_g, w_out,
              ln_cross_g, mem_ln_g, xa_wq, xa_wk, xa_wv, xa_qn_g, xa_kn_g, xa_wo,
              ln_moe_g, moe_w_group, moe_b_group, moe_w_expert, moe_b_expert,
              moe_w_gate, moe_w_up, moe_w_down):
    b, s, _ = x.shape
    cos, sin = rope_tables(s)
    split_at = [int(i) for i in np.cumsum(IN_SPLITS)[:-1]]
    for l in range(DEPTH):
        h = rms_norm(x, ln_mix_g[l])
        a_q, a_k, a_v, b_a, b_g, c_q, c_kv, c_kr, d_u = jnp.split(h @ w_in[l], split_at, axis=-1)
        q = rms_norm(a_q.reshape(b, s, SWA_HEADS, SWA_HEAD_DIM), swa_qn_g[l])
        k = rms_norm(a_k.reshape(b, s, SWA_KV_HEADS, SWA_HEAD_DIM), swa_kn_g[l])
        v = a_v.reshape(b, s, SWA_KV_HEADS, SWA_HEAD_DIM)
        o_a = swa_sink_attention(q, k, v, swa_sinks[l], rel_bias)
        o_b = conformer_conv(b_a, b_g, conv_dw_w[l], conv_dw_b[l], conv_ln_g[l], conv_ln_b[l],
                             conv_pw_w[l], conv_pw_b[l])
        o_c = mla_attention(c_q, c_kv, c_kr, mla_qa_g[l], mla_kva_g[l], mla_wq_b[l], mla_wkv_b[l],
                            mla_qn_nope_g[l], mla_qn_rope_g[l], mla_kn_nope_g[l], mla_kn_rope_g[l],
                            cos, sin)
        o_d = s5_mixer(d_u, ssm_a_re[l], ssm_a_im[l], ssm_log_dt[l], ssm_b_re[l], ssm_b_im[l],
                       ssm_c_re[l], ssm_c_im[l], ssm_d[l], ssm_glu_w[l], ssm_glu_b[l])
        o = jnp.concatenate([o_a, o_b, o_c, o_d], axis=-1).reshape(b, s, N_MIXERS, GROUP_WIDTH)
        o = rms_norm(o, mix_out_g[l].reshape(N_MIXERS, GROUP_WIDTH)).reshape(b, s, MIX_WIDTH)
        x = x + o @ w_out[l]
        x = x + memory_cross_attention(rms_norm(x, ln_cross_g[l]), rms_norm(mem, mem_ln_g[l]),
                                       xa_wq[l], xa_wk[l], xa_wv[l], xa_qn_g[l], xa_kn_g[l], xa_wo[l])
        x = x + hier_moe(rms_norm(x, ln_moe_g[l]), moe_w_group[l], moe_b_group[l],
                         moe_w_expert[l], moe_b_expert[l], moe_w_gate[l], moe_w_up[l], moe_w_down[l])
    return x
```

```cpp
#include <hip/hip_runtime.h>
#include <cstdio>
#include <cstdint>

#ifndef MK_MULTI
#define MK_MULTI 0
#endif

#define LAS __attribute__((address_space(3)))
#define GAS __attribute__((address_space(1)))
typedef unsigned short bf16_t;
typedef short bf16x8 __attribute__((ext_vector_type(8)));
typedef float f32x4 __attribute__((ext_vector_type(4)));
typedef float f32x2 __attribute__((ext_vector_type(2)));
typedef float f32x16 __attribute__((ext_vector_type(16)));
typedef unsigned u32x4 __attribute__((ext_vector_type(4)));
typedef unsigned u32x2 __attribute__((ext_vector_type(2)));

constexpr int S = 16384, D = 2048, NL = 4, INW = 3136, INWP = 3200, WINR = 3328;
constexpr int MEMT = 256;
constexpr int NSLOT = 40960;
constexpr float EPS = 1e-6f;
constexpr float LOG2E = 1.4426950408889634f;
constexpr int P_AQ = 0, P_AK = 448, P_AV = 576, P_BA = 704, P_BG = 1216, P_CQ = 1728, P_CKV = 2240, P_CKR = 2496, P_DU = 2560;

constexpr size_t MiB = 1u << 20;
constexpr size_t WS_CTL = 0, CTL_ZERO_BYTES = 1 * MiB;
constexpr size_t WS_ROPE = 1 * MiB;
constexpr size_t WS_H = WS_ROPE + 4 * MiB;
constexpr size_t WS_P = WS_H + 65 * MiB;
constexpr size_t WS_O = WS_P + 104 * MiB;
constexpr size_t WS_QRAW = WS_O + 64 * MiB;
constexpr size_t WS_KVRAW = WS_QRAW + 24 * MiB;
constexpr size_t WS_Q = WS_KVRAW + 32 * MiB;
constexpr size_t WS_KIMG = WS_Q + 24 * MiB;
constexpr size_t WS_VIMG = WS_KIMG + 24 * MiB;
constexpr size_t WS_SWAK = WS_VIMG + 16 * MiB;
constexpr size_t WS_SWAV = WS_SWAK + 4 * MiB;
constexpr size_t WS_ZC = WS_SWAV + 4 * MiB;
constexpr size_t WS_UA = WS_ZC + 16 * MiB;
constexpr size_t WS_EBUF = WS_UA + 20 * MiB;
constexpr size_t WS_YG = WS_EBUF + 4 * MiB;
constexpr size_t WS_QX = WS_YG + 16 * MiB;
constexpr size_t WS_OX = WS_QX + 16 * MiB;
constexpr size_t WS_MEMN = WS_OX + 16 * MiB;
constexpr size_t WS_KMEM = WS_MEMN + 1 * MiB;
constexpr size_t WS_VMEM = WS_KMEM + 1 * MiB;
constexpr size_t WS_XKIMG = WS_VMEM + 1 * MiB;
constexpr size_t WS_XVIMG = WS_XKIMG + 1 * MiB;
constexpr size_t WS_LOG = WS_XVIMG + 1 * MiB;
constexpr size_t WS_REC = WS_LOG + 4 * MiB;
constexpr size_t WS_TOK = WS_REC + 1 * MiB;
constexpr size_t WS_WSLOT = WS_TOK + 1 * MiB;
constexpr size_t WS_HID = WS_WSLOT + 1 * MiB;
constexpr size_t WS_YS = WS_HID + 40 * MiB;
constexpr size_t WS_WIN = WS_YS + 160 * MiB;
constexpr size_t WS_WOUT = WS_WIN + 13 * MiB;
constexpr size_t WS_XWQ = WS_WOUT + 8 * MiB;
constexpr size_t WS_XWK = WS_XWQ + 2 * MiB;
constexpr size_t WS_XWV = WS_XWK + 2 * MiB;
constexpr size_t WS_XWO = WS_XWV + 2 * MiB;
constexpr size_t WS_PW = WS_XWO + 2 * MiB;
constexpr size_t WS_WQB = WS_PW + 1 * MiB;
constexpr size_t WS_WKVB = WS_WQB + 1 * MiB;
constexpr size_t WS_GLU = WS_WKVB + 1 * MiB;
constexpr size_t WS_ROUT = WS_GLU + 1 * MiB;
constexpr size_t WS_MOE1 = WS_ROUT + 1 * MiB;
constexpr size_t WS_MOE2 = WS_MOE1 + 128 * MiB;
constexpr size_t WS_W1G = WS_MOE2 + 64 * MiB;
constexpr size_t WS_BTY = WS_W1G + 16 * MiB;
constexpr size_t WS_PARTO = WS_BTY + 80 * MiB;
constexpr size_t WS_PARTML = WS_PARTO + 32 * MiB;
constexpr size_t WS_XB = WS_PARTML + 1 * MiB;
constexpr size_t WS_QXP = WS_XB + 65 * MiB;
constexpr size_t WS_LOGP = WS_QXP + 64 * MiB;
constexpr size_t WS_SSP = WS_LOGP + 16 * MiB;
constexpr size_t WS_RMSV = WS_SSP + 2 * MiB;
constexpr size_t WS_RMS1 = WS_RMSV + 1 * MiB;
constexpr size_t WS_XF8 = WS_RMS1 + 1 * MiB;
constexpr size_t WS_END = WS_XF8 + 33 * MiB;
constexpr int CW_BAR = 4096;
constexpr int CW_SS = 32768;
constexpr int CW_CNT = 16384;

constexpr int RING_BYTES = 131072;
constexpr int LDSCTL_OFF = RING_BYTES;
constexpr int LDS_BYTES = 147456;
constexpr int NWAVES = 8, NTHR = 512;

__device__ __forceinline__ float bf2f(unsigned b) { return __uint_as_float(b << 16); }
typedef __bf16 bf16x2_t __attribute__((ext_vector_type(2)));
__device__ __forceinline__ unsigned cvt_pk_bf16(float lo, float hi) { const f32x2 v = {lo, hi}; const bf16x2_t b = __builtin_convertvector(v, bf16x2_t); return __builtin_bit_cast(unsigned, b); }
__device__ __forceinline__ float wave_sum(float v) {
#pragma unroll
    for (int o = 1; o < 64; o <<= 1) v += __shfl_xor(v, o);
    return v;
}
__device__ __forceinline__ float fast_exp2(float x) { return __builtin_amdgcn_exp2f(x); }
__device__ __forceinline__ float fast_rcp(float x) { return __builtin_amdgcn_rcpf(x); }
__device__ __forceinline__ float sigmoidf_(float x) { return fast_rcp(1.f + fast_exp2(-x * LOG2E)); }
__device__ __forceinline__ void unpack8(const u32x4 w, float (&f)[8]) {
    f[0] = bf2f(w.x & 0xffffu); f[1] = bf2f(w.x >> 16); f[2] = bf2f(w.y & 0xffffu); f[3] = bf2f(w.y >> 16);
    f[4] = bf2f(w.z & 0xffffu); f[5] = bf2f(w.z >> 16); f[6] = bf2f(w.w & 0xffffu); f[7] = bf2f(w.w >> 16);
}
__device__ __forceinline__ u32x4 pack8(const float (&f)[8]) { u32x4 w; w.x = cvt_pk_bf16(f[0], f[1]); w.y = cvt_pk_bf16(f[2], f[3]); w.z = cvt_pk_bf16(f[4], f[5]); w.w = cvt_pk_bf16(f[6], f[7]); return w; }
__device__ __forceinline__ unsigned pk4_fp8(float a, float b, float c, float d) { int w = __builtin_amdgcn_cvt_pk_fp8_f32(a, b, 0, false); w = __builtin_amdgcn_cvt_pk_fp8_f32(c, d, w, true); return (unsigned)w; }
__device__ __forceinline__ void unpack8_fp8(const u32x2 w, float (&f)[8]) { const f32x2 a = __builtin_amdgcn_cvt_pk_f32_fp8(w.x, false), b = __builtin_amdgcn_cvt_pk_f32_fp8(w.x, true), c = __builtin_amdgcn_cvt_pk_f32_fp8(w.y, false), d = __builtin_amdgcn_cvt_pk_f32_fp8(w.y, true);
    f[0] = a.x; f[1] = a.y; f[2] = b.x; f[3] = b.y; f[4] = c.x; f[5] = c.y; f[6] = d.x; f[7] = d.y; }
#define LDS_WAIT() asm volatile("s_waitcnt lgkmcnt(0)" ::: "memory")
#define VM_WAIT() asm volatile("s_waitcnt vmcnt(0)" ::: "memory")

namespace pg8 {
constexpr int BM = 256, BK = 64, HALF = 128, HTB = HALF * BK * 2, STAGE_BYTES = 8 * HTB, NXCD = 8, WGM = 8;
__host__ __device__ __forceinline__ int lds_byte(int r, int c) { const int st = (r >> 4) * 2 + (c >> 5), rr = r & 15, cc = c & 31, ob = rr * 64 + cc * 2; return st * 1024 + (ob ^ (((ob >> 9) & 1) << 5)); }
__host__ __device__ __forceinline__ void stage_rc(int b, int& R, int& C) { const int st = b / 1024, sb = b % 1024, swz = sb ^ (((sb >> 9) & 1) << 5); R = (st >> 1) * 16 + swz / 64; C = (st & 1) * 32 + (swz % 64) / 2; }
__host__ __device__ __forceinline__ int perm32(int rho) { const int n = rho >> 4, i = rho & 15; return 8 * (i >> 2) + 4 * n + (i & 3); }

struct Unit { int pm, pn, z; const char* a; const char* b; const int* rows; };

struct GSched {
    const char* A; const char* B; size_t aTile, bTile, aZ, bZ; int nM, nN, nZ, G, c;
    __device__ __forceinline__ bool next(int i, Unit& u) const {
        const int nwg = nM * nN; const long L = (long)i * G + c; if (L >= (long)nwg * nZ) return false;
        const int z = (int)(L / nwg); int wgid = (int)(L - (long)z * nwg);
        { const int q = nwg / NXCD, r = nwg % NXCD, xcd = wgid % NXCD, off = wgid / NXCD; wgid = (xcd < r ? xcd * (q + 1) : r * (q + 1) + (xcd - r) * q) + off; }
        const int nig = WGM * nN, gid = wgid / nig, fm = gid * WGM, gsz = (nM - fm) < WGM ? (nM - fm) : WGM;
        u.pm = fm + ((wgid % nig) % gsz); u.pn = (wgid % nig) / gsz; u.z = z;
        u.a = A + (size_t)z * aZ + (size_t)u.pm * aTile; u.b = B + (size_t)z * bZ + (size_t)u.pn * bTile; u.rows = nullptr; return true;
    }
};

template <class Epi, class Sched, bool GATHER = false, bool F8 = false>
__device__ __forceinline__ void gemm_phase(const int tid_in, LAS unsigned char* lds, const int K, const int lda, const int ldb, const char* Abase, const Sched& S, const Epi& E) {
    int tid = tid_in; asm volatile("" : "+v"(tid));
    const int wid = __builtin_amdgcn_readfirstlane(tid >> 6), lane = tid & 63, wr = wid >> 2, wc = wid & 3, fr = lane & 15, fq = lane >> 4;
    const int nt = K / BK;
    unsigned voffA[2], voffB[2]; int rA[2], cA2[2];
#pragma unroll
    for (int i = 0; i < 2; ++i) { int R, C; stage_rc(tid * 16 + i * 8192, R, C); const int Rb = Epi::PERM ? ((R & ~31) + perm32(R & 31)) : R;
        voffA[i] = (unsigned)(R * lda + C) * 2u; voffB[i] = (unsigned)(Rb * ldb + C) * 2u; rA[i] = R; cA2[i] = C * 2; }
    const size_t kstep = (size_t)(BK * 2);
    const size_t hstepA = (size_t)HALF * lda * 2, hstepB = (size_t)HALF * ldb * 2;
    const unsigned ldsw = (unsigned)wid * 1024u;
    const int aoff = lds_byte(wr * 64 + fr, fq * 8), boff = lds_byte(wc * 32 + fr, fq * 8);
#define PG8_SA(b, h) (((b) * 2 + (h)) * HTB)
#define PG8_SB(b, h) ((4 + (b) * 2 + (h)) * HTB)
#define PG8_STAGE(bufoff, gbase, voff) do { _Pragma("unroll") for (int _i = 0; _i < 2; ++_i) \
        __builtin_amdgcn_global_load_lds((const unsigned*)((const char*)(gbase) + (voff)[_i]), (LAS unsigned*)(lds + (bufoff) + ldsw + _i * 8192), 16, 0, 0); } while (0)
#define PG8_LDA(dst, b, h) do { _Pragma("unroll") for (int m = 0; m < 4; ++m) _Pragma("unroll") for (int k = 0; k < 2; ++k) dst[m][k] = *(const LAS bf16x8*)(lds + PG8_SA(b, h) + aoff + m * 2048 + k * 1024); } while (0)
#define PG8_LDB(dst, b, h) do { _Pragma("unroll") for (int n = 0; n < 2; ++n) _Pragma("unroll") for (int k = 0; k < 2; ++k) dst[n][k] = *(const LAS bf16x8*)(lds + PG8_SB(b, h) + boff + n * 2048 + k * 1024); } while (0)
typedef long pg8_i64x2 __attribute__((ext_vector_type(2)));
#define PG8_MMA(ai, bj, At, Bt) do { __builtin_amdgcn_s_setprio(1); _Pragma("unroll") for (int m = 0; m < 4; ++m) _Pragma("unroll") for (int n = 0; n < 2; ++n) _Pragma("unroll") for (int k = 0; k < 2; ++k) { \
        if constexpr (F8) {   \
            const pg8_i64x2 a_ = __builtin_bit_cast(pg8_i64x2, At[m][k]), b_ = __builtin_bit_cast(pg8_i64x2, Bt[n][k]); \
            acc[ai][bj][m][n] = __builtin_amdgcn_mfma_f32_16x16x32_fp8_fp8(b_.x, a_.x, acc[ai][bj][m][n], 0, 0, 0); \
            acc[ai][bj][m][n] = __builtin_amdgcn_mfma_f32_16x16x32_fp8_fp8(b_.y, a_.y, acc[ai][bj][m][n], 0, 0, 0); \
        } else acc[ai][bj][m][n] = __builtin_amdgcn_mfma_f32_16x16x32_bf16(Bt[n][k], At[m][k], acc[ai][bj][m][n], 0, 0, 0); } \
        __builtin_amdgcn_s_setprio(0); } while (0)
#define PG8_WAIT_V(n) asm volatile("s_waitcnt vmcnt(" #n ")" ::: "memory")
#define PG8_WAIT_L(n) asm volatile("s_waitcnt lgkmcnt(" #n ")" ::: "memory")
#define PG8_BAR __builtin_amdgcn_s_barrier()
#define PG8_SCHED __builtin_amdgcn_sched_barrier(0)
    Unit cur, nxt; int ui = 0;
    if (!S.next(0, cur)) return;
    f32x4 acc[2][2][4][2];
#pragma unroll
    for (int a = 0; a < 2; ++a)
#pragma unroll
        for (int b = 0; b < 2; ++b)
#pragma unroll
            for (int m = 0; m < 4; ++m)
#pragma unroll
                for (int n = 0; n < 2; ++n) acc[a][b][m][n] = (f32x4){0.f, 0.f, 0.f, 0.f};
    bf16x8 At[4][2], B0[2][2], B1[2][2];
    unsigned gc0[2], gc1[2], gn0[2], gn1[2];
    const char* cA = GATHER ? Abase : cur.a; const char* cB = cur.b;
    if constexpr (GATHER) {
#pragma unroll
        for (int i = 0; i < 2; ++i) { gc0[i] = (unsigned)cur.rows[rA[i]] * (unsigned)(lda * 2) + (unsigned)cA2[i]; gc1[i] = (unsigned)cur.rows[HALF + rA[i]] * (unsigned)(lda * 2) + (unsigned)cA2[i]; gn0[i] = gc0[i]; gn1[i] = gc1[i]; }
    }
#define PG8_STAGE_A(bufoff, h, ptr, usenext) do { if constexpr (GATHER) { if (usenext) { if ((h) == 0) PG8_STAGE(bufoff, ptr, gn0); else PG8_STAGE(bufoff, ptr, gn1); } else { if ((h) == 0) PG8_STAGE(bufoff, ptr, gc0); else PG8_STAGE(bufoff, ptr, gc1); } } \
        else { PG8_STAGE(bufoff, (ptr) + ((h) ? hstepA : 0), voffA); } } while (0)
    PG8_STAGE(PG8_SB(0, 0), cB, voffB); PG8_STAGE(PG8_SB(0, 1), cB + hstepB, voffB); PG8_STAGE_A(PG8_SA(0, 0), 0, cA, false); PG8_STAGE_A(PG8_SA(0, 1), 1, cA, false);
    if (wr == 1) PG8_BAR;
    PG8_WAIT_V(2); PG8_BAR;
    PG8_STAGE(PG8_SB(1, 0), cB + kstep, voffB); PG8_STAGE_A(PG8_SA(1, 0), 0, cA + kstep, false); PG8_STAGE(PG8_SB(1, 1), cB + hstepB + kstep, voffB);
    PG8_WAIT_V(6); PG8_BAR;
    for (;;) {
        const bool has_next = S.next(ui + 1, nxt);
        const char* nA = GATHER ? Abase : (has_next ? nxt.a : cA); const char* nB = has_next ? nxt.b : cB;
        if constexpr (GATHER) {
            if (has_next) {
#pragma unroll
                for (int i = 0; i < 2; ++i) { gn0[i] = (unsigned)nxt.rows[rA[i]] * (unsigned)(lda * 2) + (unsigned)cA2[i]; gn1[i] = (unsigned)nxt.rows[HALF + rA[i]] * (unsigned)(lda * 2) + (unsigned)cA2[i]; }
            } else {
#pragma unroll
                for (int i = 0; i < 2; ++i) { gn0[i] = gc0[i]; gn1[i] = gc1[i]; }
            }
        }
#pragma unroll 1
        for (int t = 0; t < nt; t += 2) {
            const bool last = (t == nt - 2);
            const char* a1 = cA + (size_t)(t + 1) * kstep;
            const char* a2 = last ? nA : cA + (size_t)(t + 2) * kstep; const char* b2 = last ? nB : cB + (size_t)(t + 2) * kstep;
            const char* a3 = a2 + kstep; const char* b3 = b2 + kstep;
            PG8_LDB(B0, 0, 0); PG8_LDB(B1, 0, 1); PG8_SCHED; PG8_LDA(At, 0, 0); PG8_STAGE_A(PG8_SA(1, 1), 1, a1, false);
            PG8_WAIT_V(8); PG8_WAIT_L(0); PG8_BAR; PG8_MMA(0, 0, At, B0); PG8_MMA(0, 1, At, B1); PG8_BAR; PG8_SCHED;
            PG8_LDA(At, 0, 1); PG8_STAGE(PG8_SB(0, 0), b2, voffB); PG8_STAGE(PG8_SB(0, 1), b2 + hstepB, voffB); PG8_STAGE_A(PG8_SA(0, 0), 0, a2, last);
            PG8_WAIT_V(8); PG8_WAIT_L(0); PG8_BAR; PG8_MMA(1, 0, At, B0); PG8_MMA(1, 1, At, B1); PG8_BAR; PG8_SCHED;
            PG8_LDB(B0, 1, 0); PG8_LDB(B1, 1, 1); PG8_SCHED; PG8_LDA(At, 1, 0); PG8_STAGE_A(PG8_SA(0, 1), 1, a2, last);
            PG8_WAIT_V(8); PG8_WAIT_L(0); PG8_BAR; PG8_MMA(0, 0, At, B0); PG8_MMA(0, 1, At, B1); PG8_BAR; PG8_SCHED;
            PG8_LDA(At, 1, 1); PG8_STAGE(PG8_SB(1, 0), b3, voffB); PG8_STAGE(PG8_SB(1, 1), b3 + hstepB, voffB); PG8_STAGE_A(PG8_SA(1, 0), 0, a3, last);
            PG8_WAIT_V(8); PG8_WAIT_L(0); PG8_BAR; PG8_MMA(1, 0, At, B0); PG8_MMA(1, 1, At, B1); PG8_BAR; PG8_SCHED;
        }
        if (wr == 0) PG8_BAR;
        E(acc, cur, wr, wc, fr, fq);
        if (!has_next) break;
#pragma unroll
        for (int a = 0; a < 2; ++a)
#pragma unroll
            for (int b = 0; b < 2; ++b)
#pragma unroll
                for (int m = 0; m < 4; ++m)
#pragma unroll
                    for (int n = 0; n < 2; ++n) acc[a][b][m][n] = (f32x4){0.f, 0.f, 0.f, 0.f};
        cur = nxt; cA = nA; cB = nB; ++ui;
        if constexpr (GATHER) {
#pragma unroll
            for (int i = 0; i < 2; ++i) { gc0[i] = gn0[i]; gc1[i] = gn1[i]; }
        }
        if (wr == 1) PG8_BAR;
    }
    PG8_WAIT_V(0);
    PG8_BAR;
#undef PG8_STAGE_A
#undef PG8_SA
#undef PG8_SB
#undef PG8_STAGE
#undef PG8_LDA
#undef PG8_LDB
#undef PG8_MMA
#undef PG8_WAIT_V
#undef PG8_WAIT_L
#undef PG8_BAR
#undef PG8_SCHED
}

struct EpiBf16 {
    static constexpr bool PERM = true;
    bf16_t* O; int ldc; int col_off; const float* bias; const float* rowscale;
    __device__ __forceinline__ void operator()(const f32x4 (&acc)[2][2][4][2], const Unit& u, int wr, int wc, int fr, int fq) const {
        const int row0 = u.pm * BM + wr * 64 + fr, c0 = u.pn * BM + wc * 32 + 8 * fq;
        f32x4 bv[2][2];
#pragma unroll
        for (int bj = 0; bj < 2; ++bj)
#pragma unroll
            for (int n = 0; n < 2; ++n) bv[bj][n] = bias ? *(const f32x4*)(bias + c0 + bj * HALF + 4 * n) : (f32x4){0.f, 0.f, 0.f, 0.f};
#pragma unroll
        for (int ai = 0; ai < 2; ++ai)
#pragma unroll
            for (int m = 0; m < 4; ++m) { const int row = row0 + ai * HALF + m * 16; bf16_t* rowp = O + (size_t)row * ldc + col_off + c0; const float rs = rowscale ? rowscale[row] : 1.f;
#pragma unroll
                for (int bj = 0; bj < 2; ++bj) { const f32x4 v0 = acc[ai][bj][m][0] * rs + bv[bj][0], v1 = acc[ai][bj][m][1] * rs + bv[bj][1];
                    u32x4 w; w.x = cvt_pk_bf16(v0[0], v0[1]); w.y = cvt_pk_bf16(v0[2], v0[3]); w.z = cvt_pk_bf16(v1[0], v1[1]); w.w = cvt_pk_bf16(v1[2], v1[3]);
                    *(u32x4*)(rowp + bj * HALF) = w; } }
    }
};
struct EpiResid {
    static constexpr bool PERM = true;
    bf16_t* XBp; int ldc; float* SS; bool dry; unsigned char* XF8p;
    __device__ __forceinline__ void operator()(const f32x4 (&acc)[2][2][4][2], const Unit& u, int wr, int wc, int fr, int fq) const {
        const int row0 = u.pm * BM + wr * 64 + fr, c0 = u.pn * BM + wc * 32 + 8 * fq;
#pragma unroll
        for (int ai = 0; ai < 2; ++ai)
#pragma unroll
            for (int m = 0; m < 4; ++m) { const int row = row0 + ai * HALF + m * 16; bf16_t* rowb = XBp + (size_t)row * ldc + c0; float ss = 0.f;
                u32x4 old[2];
#pragma unroll
                for (int bj = 0; bj < 2; ++bj) old[bj] = *(const u32x4*)(rowb + bj * HALF);
#pragma unroll
                for (int bj = 0; bj < 2; ++bj) { float x[8]; unpack8(old[bj], x);
#pragma unroll
                    for (int j = 0; j < 4; ++j) { x[j] += acc[ai][bj][m][0][j]; x[4 + j] += acc[ai][bj][m][1][j]; }
#pragma unroll
                    for (int j = 0; j < 8; ++j) ss += x[j] * x[j];
                    if (!dry) *(u32x4*)(rowb + bj * HALF) = pack8(x);
                    if (XF8p) *(u32x2*)(XF8p + (size_t)row * ldc + c0 + bj * HALF) = (u32x2){pk4_fp8(x[0], x[1], x[2], x[3]), pk4_fp8(x[4], x[5], x[6], x[7])}; }
                if (SS) { ss += __shfl_xor(ss, 16); ss += __shfl_xor(ss, 32); if (fq == 0) SS[(size_t)row * 32 + u.pn * 4 + wc] = ss; } }
    }
};
struct EpiF32Z {
    static constexpr bool PERM = false;
    float* C; int ldc; size_t zstride;
    __device__ __forceinline__ void operator()(const f32x4 (&acc)[2][2][4][2], const Unit& u, int wr, int wc, int fr, int fq) const {
        const int row0 = u.pm * BM + wr * 64 + fr, col0 = u.pn * BM + wc * 32 + 4 * fq;
#pragma unroll
        for (int ai = 0; ai < 2; ++ai)
#pragma unroll
            for (int m = 0; m < 4; ++m) { float* rowp = C + (size_t)u.z * zstride + (size_t)(row0 + ai * HALF + m * 16) * ldc + col0;
#pragma unroll
                for (int bj = 0; bj < 2; ++bj)
#pragma unroll
                    for (int n = 0; n < 2; ++n) *(f32x4*)(rowp + bj * HALF + n * 16) = acc[ai][bj][m][n]; }
    }
};
template <int NVALID> struct EpiF32Part {
    static constexpr bool PERM = false;
    float* C; int ldc; size_t zstride;
    __device__ __forceinline__ void operator()(const f32x4 (&acc)[2][2][4][2], const Unit& u, int wr, int wc, int fr, int fq) const {
        if (u.pn != 0) return;
        if (NVALID == 64 && wc >= 2) return;
        const int row0 = u.pm * BM + wr * 64 + fr, col0 = wc * 32 + 4 * fq;
#pragma unroll
        for (int ai = 0; ai < 2; ++ai)
#pragma unroll
            for (int m = 0; m < 4; ++m) { float* rowp = C + (size_t)u.z * zstride + (size_t)(row0 + ai * HALF + m * 16) * ldc + col0;
#pragma unroll
                for (int n = 0; n < 2; ++n) *(f32x4*)(rowp + n * 16) = acc[ai][0][m][n]; }
    }
};
struct EpiSsmY {
    static constexpr bool PERM = true;
    bf16_t* YG;
    __device__ __forceinline__ void operator()(const f32x4 (&acc)[2][2][4][2], const Unit& u, int wr, int wc, int fr, int fq) const {
        const int row0 = wr * 64 + fr, c0 = u.pn * BM + wc * 32 + 8 * fq;
#pragma unroll
        for (int ai = 0; ai < 2; ++ai)
#pragma unroll
            for (int m = 0; m < 4; ++m) { const int chunk = row0 + ai * HALF + m * 16;
#pragma unroll
                for (int bj = 0; bj < 2; ++bj) { const int col = c0 + bj * HALF, t = col >> 4, o0 = col & 15;
                    float v[8];
#pragma unroll
                    for (int j = 0; j < 4; ++j) { v[j] = acc[ai][bj][m][0][j]; v[4 + j] = acc[ai][bj][m][1][j]; }
#pragma unroll
                    for (int j = 0; j < 8; ++j) { const float x = v[j], y = 1.5957691216f * (x + 0.044715f * x * x * x); v[j] = x * fast_rcp(1.f + fast_exp2(-y * LOG2E)); }
                    *(u32x4*)(YG + (size_t)(chunk * 64 + t) * 512 + u.z * 16 + o0) = pack8(v); } }
    }
};
struct EpiGlu {
    static constexpr bool PERM = true;
    const bf16_t* YG; const float* bias; bf16_t* O;
    __device__ __forceinline__ void operator()(const f32x4 (&acc)[2][2][4][2], const Unit& u, int wr, int wc, int fr, int fq) const {
        const int row0 = u.pm * BM + wr * 64 + fr, c0 = u.pn * BM + wc * 32 + 8 * fq;
#pragma unroll
        for (int ai = 0; ai < 2; ++ai)
#pragma unroll
            for (int m = 0; m < 4; ++m) { const int row = row0 + ai * HALF + m * 16;
#pragma unroll
                for (int bj = 0; bj < 2; ++bj) { const int col = c0 + bj * HALF;
                    const u32x4 yw = *(const u32x4*)(YG + (size_t)row * 512 + col); float y[8]; unpack8(yw, y);
                    const f32x4 b0 = *(const f32x4*)(bias + col), b1 = *(const f32x4*)(bias + col + 4);
                    float v[8];
#pragma unroll
                    for (int j = 0; j < 4; ++j) { v[j] = y[j] * sigmoidf_(acc[ai][bj][m][0][j] + b0[j]); v[4 + j] = y[4 + j] * sigmoidf_(acc[ai][bj][m][1][j] + b1[j]); }
                    *(u32x4*)(O + (size_t)row * D + 1536 + col) = pack8(v); } }
    }
};
struct EpiMoe1 {
    static constexpr bool PERM = true;
    unsigned char* HID8; const int* TOKp; const float* SS;
    __device__ __forceinline__ void operator()(const f32x4 (&acc)[2][2][4][2], const Unit& u, int wr, int wc, int fr, int fq) const {
        const int row0 = u.z * BM + wr * 64 + fr, c0 = u.pn * HALF + wc * 32 + 8 * fq;
#pragma unroll
        for (int ai = 0; ai < 2; ++ai)
#pragma unroll
            for (int m = 0; m < 4; ++m) { const int row = row0 + ai * HALF + m * 16; float v[8];
                const float rs = SS[TOKp[row]] * (1.0f / 32.0f);
#pragma unroll
                for (int j = 0; j < 4; ++j) { const float g0 = acc[ai][0][m][0][j] * rs, g1 = acc[ai][0][m][1][j] * rs; v[j] = g0 * sigmoidf_(g0) * (acc[ai][1][m][0][j] * rs); v[4 + j] = g1 * sigmoidf_(g1) * (acc[ai][1][m][1][j] * rs); }
                *(u32x2*)(HID8 + (size_t)row * 512 + c0) = (u32x2){pk4_fp8(v[0], v[1], v[2], v[3]), pk4_fp8(v[4], v[5], v[6], v[7])}; }
    }
};
struct EpiMoe2 {
    static constexpr bool PERM = true;
    unsigned char* YS8; const float* W;
    __device__ __forceinline__ void operator()(const f32x4 (&acc)[2][2][4][2], const Unit& u, int wr, int wc, int fr, int fq) const {
        const int row0 = u.z * BM + wr * 64 + fr, c0 = u.pn * BM + wc * 32 + 8 * fq;
#pragma unroll
        for (int ai = 0; ai < 2; ++ai)
#pragma unroll
            for (int m = 0; m < 4; ++m) { const int row = row0 + ai * HALF + m * 16; const float w = W[row] * (16.0f / 32.0f);
#pragma unroll
                for (int bj = 0; bj < 2; ++bj) { const f32x4 v0 = acc[ai][bj][m][0] * w, v1 = acc[ai][bj][m][1] * w;
                    *(u32x2*)(YS8 + (size_t)row * D + c0 + bj * HALF) = (u32x2){pk4_fp8(v0[0], v0[1], v0[2], v0[3]), pk4_fp8(v1[0], v1[1], v1[2], v1[3])}; } }
    }
};
struct EpiBf16Part64 {
    static constexpr bool PERM = true;
    bf16_t* O; size_t zstride; const float* rowscale;
    __device__ __forceinline__ void operator()(const f32x4 (&acc)[2][2][4][2], const Unit& u, int wr, int wc, int fr, int fq) const {
        if (wc >= 2) return;
        const int row0 = u.pm * BM + wr * 64 + fr, c0 = wc * 32 + 8 * fq;
#pragma unroll
        for (int ai = 0; ai < 2; ++ai)
#pragma unroll
            for (int m = 0; m < 4; ++m) { const int row = row0 + ai * HALF + m * 16; const float rs = rowscale[row]; const f32x4 v0 = acc[ai][0][m][0] * rs, v1 = acc[ai][0][m][1] * rs;
                u32x4 w; w.x = cvt_pk_bf16(v0[0], v0[1]); w.y = cvt_pk_bf16(v0[2], v0[3]); w.z = cvt_pk_bf16(v1[0], v1[1]); w.w = cvt_pk_bf16(v1[2], v1[3]);
                *(u32x4*)(O + (size_t)u.z * zstride + (size_t)row * 64 + c0) = w; }
    }
};
struct EpiBf16Z { static constexpr bool PERM = true; bf16_t* O0; int ldc; size_t zstride;
    __device__ __forceinline__ void operator()(const f32x4 (&acc)[2][2][4][2], const Unit& u, int wr, int wc, int fr, int fq) const { EpiBf16 e{O0 + (size_t)u.z * zstride, ldc, 0, nullptr, nullptr}; e(acc, u, wr, wc, fr, fq); } };
struct EpiMem { static constexpr bool PERM = true; bf16_t* K0; bf16_t* V0;
    __device__ __forceinline__ void operator()(const f32x4 (&acc)[2][2][4][2], const Unit& u, int wr, int wc, int fr, int fq) const { EpiBf16 e{((u.z >> 2) ? V0 : K0) + (size_t)(u.z & 3) * 256 * 512, 512, 0, nullptr, nullptr}; e(acc, u, wr, wc, fr, fq); } };
struct MemSched { const char* A; const char* B; int G, c;
    __device__ __forceinline__ bool next(int i, Unit& u) const {
        const long L = (long)i * G + c; if (L >= 16) return false;
        const int pn = (int)L & 1, ks = ((int)L >> 1) & 3, kv = (int)L >> 3;
        u.pm = 0; u.pn = pn; u.z = kv * 4 + ks; u.a = A + (size_t)ks * 1024; u.b = B + (size_t)kv * 512 * D * 2 + (size_t)pn * 256 * D * 2 + (size_t)ks * 1024; u.rows = nullptr; return true; } };
struct MoeSched { const LAS int* pst; const char* B; const int* tok; size_t bE, bTile; int nN, G, c, mode;
    __device__ __forceinline__ bool next(int i, Unit& u) const {
        const int nb = __builtin_amdgcn_readfirstlane(pst[32]) >> 8; const int n1 = nb * nN, n1a = (n1 / G) * G;
        const int cv = (G % NXCD == 0) ? (c % NXCD) * (G / NXCD) + c / NXCD : c;
        const long L = (long)(mode == 2 ? n1a : 0) + (long)i * G + cv; if (L >= (long)(mode == 1 ? n1a : n1)) return false;
        const int b = (int)(L / nN), pn = (int)(L % nN); const int e = __builtin_amdgcn_readfirstlane(pst[240 + b]);
        u.pm = 0; u.pn = pn; u.z = b; u.a = nullptr; u.rows = tok + b * 256; u.b = B + (size_t)e * bE + (size_t)pn * bTile; return true; } };
struct MoeSched2 { const LAS int* pst; const char* A; const char* B; size_t bE, bTile; int nN, G, c, mode;
    __device__ __forceinline__ bool next(int i, Unit& u) const {
        const int nb = __builtin_amdgcn_readfirstlane(pst[32]) >> 8; const int n1 = nb * 4, r1 = n1 % G, bdone = ((n1 / G) * G) / 4, n2a = bdone * nN, n2 = nb * nN;
        const int cv = (G % NXCD == 0) ? (c % NXCD) * (G / NXCD) + c / NXCD : c;
        long L;
        if (mode == 1) { const int nfree = r1 ? G - r1 : 0; const long E = 3L * nfree;
            if (r1 && cv >= r1) L = (i < 3) ? (long)i * nfree + (cv - r1) : E + (long)(i - 3) * G + cv; else L = E + (long)i * G + cv;
            if (L >= n2a) return false; }
        else { L = (long)n2a + (long)i * G + cv; if (L >= n2) return false; }
        const int b = (int)(L / nN), pn = (int)(L % nN); const int e = __builtin_amdgcn_readfirstlane(pst[240 + b]);
        u.pm = 0; u.pn = pn; u.z = b; u.a = A + (size_t)b * 256 * 512; u.rows = nullptr; u.b = B + (size_t)e * bE + (size_t)pn * bTile; return true; } };
}

#define XB_TMO      128
#define XB_XCNT(j)  (256  + 64 * (j))
#define XB_XSUB(j)  (1280 + 64 * (j))
#define XB_XGEN(j)  (2304 + 64 * (j))
#define XB_TOP      3328
#define XB_TOPGEN   3392
#define XCD_BAR_WORDS 3456
#define XB_SPIN_CAP (1u << 22)
__device__ __forceinline__ unsigned xb_ld(unsigned* p)              { return __hip_atomic_load(p, __ATOMIC_RELAXED, __HIP_MEMORY_SCOPE_AGENT); }
__device__ __forceinline__ unsigned xb_add(unsigned* p, unsigned v) { return __hip_atomic_fetch_add(p, v, __ATOMIC_RELAXED, __HIP_MEMORY_SCOPE_AGENT); }
__device__ __forceinline__ unsigned xb_xcc_id() { return (unsigned)__builtin_amdgcn_s_getreg((3 << 11) | 20) & 0xFu; }
#define XB_SPIN(cond, bar) do { unsigned _sp = 0; while (cond) { __builtin_amdgcn_s_sleep(1); \
    if ((++_sp & 255u) == 0u) { if (xb_ld(&(bar)[XB_TMO])) break; if (_sp > XB_SPIN_CAP) { atomicAdd(&(bar)[XB_TMO], 1u); break; } } } } while (0)
struct XcdBarrier { unsigned* bar; unsigned x; volatile LAS unsigned* st; };
__device__ __forceinline__ XcdBarrier xcd_barrier_post(unsigned* bar, volatile LAS unsigned* st) {
    XcdBarrier b; b.bar = bar; b.x = xb_xcc_id(); b.st = st;
    if (threadIdx.x == 0) (void)xb_add(&bar[XB_XCNT(b.x)], 1u);
    return b;
}
__device__ __forceinline__ void xcd_barrier_complete(unsigned* bar, unsigned x, unsigned& nloc, unsigned& nx) {
    const unsigned G = gridDim.x * gridDim.y * gridDim.z;
    unsigned sum, cnt, mine, sp = 0u;
    for (;;) {
        sum = 0u; cnt = 0u; mine = 0u;
#pragma unroll
        for (unsigned j = 0; j < 16; ++j) { const unsigned c = xb_ld(&bar[XB_XCNT(j)]); sum += c; cnt += (c > 0u) ? 1u : 0u; mine = (j == x) ? c : mine; }
        if (sum == G) break;
        __builtin_amdgcn_s_sleep(1);
        if ((++sp & 255u) == 0u) { if (xb_ld(&bar[XB_TMO])) break; if (sp > XB_SPIN_CAP) { atomicAdd(&bar[XB_TMO], 1u); break; } }
    }
    nloc = mine > 0u ? mine : 1u; nx = cnt > 0u ? cnt : 1u;
}
__device__ __forceinline__ void xcd_barrier(const XcdBarrier& b, const int tid_) {
    asm volatile("s_waitcnt vmcnt(0)" ::: "memory");
    __syncthreads();
    if (tid_ == 0) {
        unsigned* bar = b.bar;
        __builtin_amdgcn_s_waitcnt(0);
        unsigned nloc = b.st[0], nx = b.st[1];
        if (nloc == 0u) { xcd_barrier_complete(bar, b.x, nloc, nx); b.st[0] = nloc; b.st[1] = nx; }
        const unsigned old = xb_add(&bar[XB_XSUB(b.x)], 1u);
        const unsigned gen = old / nloc;
        if (old + 1u == (gen + 1u) * nloc) {
            __builtin_amdgcn_fence(__ATOMIC_RELEASE, "agent");
            asm volatile("s_waitcnt vmcnt(0)" ::: "memory");
            const unsigned og = xb_add(&bar[XB_TOP], 1u);
            const unsigned tg = og / nx;
            if (og + 1u == (tg + 1u) * nx) xb_add(&bar[XB_TOPGEN], 1u);
            else XB_SPIN(xb_ld(&bar[XB_TOPGEN]) == tg, bar);
            __builtin_amdgcn_fence(__ATOMIC_ACQUIRE, "agent");
            xb_add(&bar[XB_XGEN(b.x)], 1u);
            asm volatile("s_waitcnt vmcnt(0)" ::: "memory");
        } else {
            XB_SPIN(xb_ld(&bar[XB_XGEN(b.x)]) == gen, bar);
            __builtin_amdgcn_fence(__ATOMIC_ACQUIRE, "agent");
            asm volatile("s_waitcnt vmcnt(0)" ::: "memory");
        }
    }
    __syncthreads();
}

template <int RB> __device__ __forceinline__ int kswz(int row, int c) { return (RB == 256) ? (c ^ (row & 15)) : (c ^ ((row >> 1) & 7)); }
__device__ __forceinline__ int vswz(int d, int c) { return c ^ ((d >> 1) & 7); }
template <int BYTES> __device__ __forceinline__ void dma_tile(const unsigned char* src, LAS unsigned char* dst, int tid, int wid) {
#pragma unroll
    for (int i = 0; i < BYTES / 8192; ++i)
        __builtin_amdgcn_global_load_lds((const unsigned*)(src + (unsigned)(i * 8192 + tid * 16)), (LAS unsigned*)(dst + i * 8192 + wid * 1024), 16, 0, 0);
}
template <int DQK, int DV, int MODE>
__device__ __forceinline__ void attn_tile_compute(const LAS unsigned char* kb, const LAS unsigned char* vb, const int k0, const bool domask, const bf16x8 (&qf)[DQK / 16],
                                                  const int qpos, const LAS float* biasrow, const int lr, const int hi, f32x16 (&o)[DV / 32], float& m_run, float& l_run) {
    constexpr int RB = DQK * 2, NKS = DQK / 16, NDB = DV / 32;
            f32x16 p0, p1;
#pragma unroll
            for (int r = 0; r < 16; ++r) { p0[r] = 0.f; p1[r] = 0.f; }
#pragma unroll
            for (int ks = 0; ks < NKS; ++ks) {
                const int c = 2 * ks + hi;
                const bf16x8 kf0 = *(const LAS bf16x8*)(kb + lr * RB + kswz<RB>(lr, c) * 16);
                const bf16x8 kf1 = *(const LAS bf16x8*)(kb + (lr + 32) * RB + kswz<RB>(lr + 32, c) * 16);
                p0 = __builtin_amdgcn_mfma_f32_32x32x16_bf16(kf0, qf[ks], p0, 0, 0, 0);
                p1 = __builtin_amdgcn_mfma_f32_32x32x16_bf16(kf1, qf[ks], p1, 0, 0, 0);
            }
            if (domask) {
                const float NEG = -__builtin_inff();
#pragma unroll
                for (int r = 0; r < 16; ++r) {
                    const int key0 = k0 + (r & 3) + 8 * (r >> 2) + 4 * hi, key1 = key0 + 32;
                    if (MODE == 0) { if (key0 > qpos) p0[r] = NEG; if (key1 > qpos) p1[r] = NEG; }
                    if (MODE == 1) { const int d0 = qpos - key0, d1 = qpos - key1;
                        p0[r] = ((unsigned)d0 < 128u) ? p0[r] + biasrow[d0 & 127] : NEG;
                        p1[r] = ((unsigned)d1 < 128u) ? p1[r] + biasrow[d1 & 127] : NEG; }
                }
            }
            float mx = p0[0];
#pragma unroll
            for (int r = 1; r < 16; ++r) mx = fmaxf(mx, p0[r]);
#pragma unroll
            for (int r = 0; r < 16; ++r) mx = fmaxf(mx, p1[r]);
            { auto rr = __builtin_amdgcn_permlane32_swap(__float_as_uint(mx), __float_as_uint(mx), false, false); mx = fmaxf(__uint_as_float(rr[0]), __uint_as_float(rr[1])); }
            const float mn = fmaxf(m_run, mx), alpha = fast_exp2(m_run - mn);
            m_run = mn;
            float ps = 0.f;
#pragma unroll
            for (int r = 0; r < 16; ++r) { p0[r] = fast_exp2(p0[r] - mn); p1[r] = fast_exp2(p1[r] - mn); ps += p0[r] + p1[r]; }
            l_run = l_run * alpha + ps;
            if (!__all(alpha == 1.f)) {
#pragma unroll
                for (int db = 0; db < NDB; ++db)
#pragma unroll
                    for (int r = 0; r < 16; ++r) o[db][r] *= alpha;
            }
            bf16x8 pf[4];
#pragma unroll
            for (int s = 0; s < 4; ++s) {
                const int r0 = 8 * (s & 1);
                unsigned a01, a23, b45, b67;
                if (s < 2) { a01 = cvt_pk_bf16(p0[r0 + 0], p0[r0 + 1]); a23 = cvt_pk_bf16(p0[r0 + 2], p0[r0 + 3]); b45 = cvt_pk_bf16(p0[r0 + 4], p0[r0 + 5]); b67 = cvt_pk_bf16(p0[r0 + 6], p0[r0 + 7]); }
                else       { a01 = cvt_pk_bf16(p1[r0 + 0], p1[r0 + 1]); a23 = cvt_pk_bf16(p1[r0 + 2], p1[r0 + 3]); b45 = cvt_pk_bf16(p1[r0 + 4], p1[r0 + 5]); b67 = cvt_pk_bf16(p1[r0 + 6], p1[r0 + 7]); }
                auto s0 = __builtin_amdgcn_permlane32_swap(a01, b45, false, false);
                auto s1 = __builtin_amdgcn_permlane32_swap(a23, b67, false, false);
                u32x4 w; w.x = s0[0]; w.y = s1[0]; w.z = s0[1]; w.w = s1[1];
                pf[s] = __builtin_bit_cast(bf16x8, w);
            }
#pragma unroll
            for (int db = 0; db < NDB; ++db) {
                const int d = 32 * db + lr;
#pragma unroll
                for (int s = 0; s < 4; ++s) {
                    const bf16x8 vf = *(const LAS bf16x8*)(vb + d * 128 + vswz(d, 2 * s + hi) * 16);
                    o[db] = __builtin_amdgcn_mfma_f32_32x32x16_bf16(vf, pf[s], o[db], 0, 0, 0);
                }
            }
        }
template <int DQK, int DV, int MODE>
__device__ __forceinline__ void attn_tiles(const int tid_in, LAS unsigned char* lds, const unsigned char* gK, const unsigned char* gV, int t_lo, int t_hi,
                                           const bf16x8 (&qf)[DQK / 16], int qpos, int wave_q0, const LAS float* biasrow,
                                           f32x16 (&o)[DV / 32], float& m_run, float& l_run) {
    constexpr int KT = 64 * DQK * 2, VT = DV * 128, BUF = KT + VT;
    int tid = tid_in; asm volatile("" : "+v"(tid));
    const int wid = __builtin_amdgcn_readfirstlane(tid >> 6), lane = tid & 63, lr = lane & 31, hi = lane >> 5;
    dma_tile<KT>(gK + (size_t)t_lo * KT, lds, tid, wid); dma_tile<VT>(gV + (size_t)t_lo * VT, lds + KT, tid, wid);
    VM_WAIT(); __syncthreads();
#pragma unroll 1
    for (int t = t_lo; t < t_hi; ++t) {
        const int cur = (t - t_lo) & 1;
        LAS unsigned char* kb = lds + cur * BUF; LAS unsigned char* vb = kb + KT;
        if (t + 1 < t_hi) { LAS unsigned char* nb = lds + (cur ^ 1) * BUF; dma_tile<KT>(gK + (size_t)(t + 1) * KT, nb, tid, wid); dma_tile<VT>(gV + (size_t)(t + 1) * VT, nb + KT, tid, wid); }
        const int k0 = t * 64;
        bool need = true, domask = false;
        if (MODE == 0) { need = (k0 <= wave_q0 + 31); domask = (k0 + 63 > wave_q0); }
        if (MODE == 1) { need = (k0 <= wave_q0 + 31) && (k0 + 63 >= wave_q0 - 127); domask = true; }
        if (need) attn_tile_compute<DQK, DV, MODE>(kb, vb, k0, domask, qf, qpos, biasrow, lr, hi, o, m_run, l_run);
        VM_WAIT(); __syncthreads();
    }
}
#define MLA_KLD(KB, ks, F0, F1) do { const int c_ = 2 * (ks) + hi; \
        F0 = *(const LAS bf16x8*)((KB) + lr * 384 + kswz<384>(lr, c_) * 16); \
        F1 = *(const LAS bf16x8*)((KB) + (lr + 32) * 384 + kswz<384>(lr + 32, c_) * 16); } while (0)
#define MLA_QK(KB, P0, P1) do { _Pragma("unroll") for (int r = 0; r < 16; ++r) { P0[r] = 0.f; P1[r] = 0.f; } \
    bf16x8 ka_[3], kb_[3]; MLA_KLD(KB, 0, ka_[0], kb_[0]); MLA_KLD(KB, 1, ka_[1], kb_[1]); \
    _Pragma("unroll") for (int ks = 0; ks < 12; ++ks) { \
        if (ks + 2 < 12) MLA_KLD(KB, ks + 2, ka_[(ks + 2) % 3], kb_[(ks + 2) % 3]); \
        __builtin_amdgcn_sched_barrier(0); \
        P0 = __builtin_amdgcn_mfma_f32_32x32x16_bf16(ka_[ks % 3], qf[ks], P0, 0, 0, 0); \
        P1 = __builtin_amdgcn_mfma_f32_32x32x16_bf16(kb_[ks % 3], qf[ks], P1, 0, 0, 0); } } while (0)
__device__ __forceinline__ void mla_softmax(f32x16& p0, f32x16& p1, const bool domask, const int k0, const int qpos, const int hi, f32x16 (&o)[4], float& m_run, float& l_run, bf16x8 (&pf)[4]) {
    if (domask) {
        const float NEG = -__builtin_inff();
#pragma unroll
        for (int r = 0; r < 16; ++r) { const int key0 = k0 + (r & 3) + 8 * (r >> 2) + 4 * hi; if (key0 > qpos) p0[r] = NEG; if (key0 + 32 > qpos) p1[r] = NEG; }
    }
    float mx = p0[0];
#pragma unroll
    for (int r = 1; r < 16; ++r) mx = fmaxf(mx, p0[r]);
#pragma unroll
    for (int r = 0; r < 16; ++r) mx = fmaxf(mx, p1[r]);
    { auto rr = __builtin_amdgcn_permlane32_swap(__float_as_uint(mx), __float_as_uint(mx), false, false); mx = fmaxf(__uint_as_float(rr[0]), __uint_as_float(rr[1])); }
    float mn = m_run, alpha = 1.f;
    if (!__all(mx - m_run <= 8.f)) { mn = fmaxf(m_run, mx); alpha = fast_exp2(m_run - mn); m_run = mn;
#pragma unroll
        for (int db = 0; db < 4; ++db)
#pragma unroll
            for (int r = 0; r < 16; ++r) o[db][r] *= alpha; }
    float ps = 0.f;
#pragma unroll
    for (int r = 0; r < 16; ++r) { p0[r] = fast_exp2(p0[r] - mn); p1[r] = fast_exp2(p1[r] - mn); ps += p0[r] + p1[r]; }
    l_run = l_run * alpha + ps;
#pragma unroll
    for (int s = 0; s < 4; ++s) {
        const int r0 = 8 * (s & 1);
        unsigned a01, a23, b45, b67;
        if (s < 2) { a01 = cvt_pk_bf16(p0[r0 + 0], p0[r0 + 1]); a23 = cvt_pk_bf16(p0[r0 + 2], p0[r0 + 3]); b45 = cvt_pk_bf16(p0[r0 + 4], p0[r0 + 5]); b67 = cvt_pk_bf16(p0[r0 + 6], p0[r0 + 7]); }
        else       { a01 = cvt_pk_bf16(p1[r0 + 0], p1[r0 + 1]); a23 = cvt_pk_bf16(p1[r0 + 2], p1[r0 + 3]); b45 = cvt_pk_bf16(p1[r0 + 4], p1[r0 + 5]); b67 = cvt_pk_bf16(p1[r0 + 6], p1[r0 + 7]); }
        auto s0 = __builtin_amdgcn_permlane32_swap(a01, b45, false, false);
        auto s1 = __builtin_amdgcn_permlane32_swap(a23, b67, false, false);
        u32x4 w; w.x = s0[0]; w.y = s1[0]; w.z = s0[1]; w.w = s1[1];
        pf[s] = __builtin_bit_cast(bf16x8, w);
    }
}
__device__ __forceinline__ void mla_pv(const bf16x8 (&pf)[4], const LAS unsigned char* vb, const int lr, const int hi, f32x16 (&o)[4]) {
    bf16x8 vf[2][4];
#pragma unroll
    for (int s = 0; s < 4; ++s) vf[0][s] = *(const LAS bf16x8*)(vb + lr * 128 + vswz(lr, 2 * s + hi) * 16);
#pragma unroll
    for (int db = 0; db < 4; ++db) {
        if (db + 1 < 4) { const int d = 32 * (db + 1) + lr;
#pragma unroll
            for (int s = 0; s < 4; ++s) vf[(db + 1) & 1][s] = *(const LAS bf16x8*)(vb + d * 128 + vswz(d, 2 * s + hi) * 16); }
        __builtin_amdgcn_sched_barrier(0);
#pragma unroll
        for (int s = 0; s < 4; ++s) o[db] = __builtin_amdgcn_mfma_f32_32x32x16_bf16(vf[db & 1][s], pf[s], o[db], 0, 0, 0);
    }
}
typedef long i64x2 __attribute__((ext_vector_type(2)));
__host__ __device__ __forceinline__ int f8pos(int k) { return (k & ~31) | (((k >> 3) & 1) << 4) | (((k >> 4) & 1) << 3) | (k & 7); }
#define F8_KLD(KB, m, F0, F1) do { const int c_ = (2 * (m) + hi) ^ ((lr >> 2) & 3); \
        F0 = *(const LAS i64x2*)((KB) + lr * 192 + c_ * 16); F1 = *(const LAS i64x2*)((KB) + (lr + 32) * 192 + c_ * 16); } while (0)
#define F8_QK(KB, P0, P1) do { _Pragma("unroll") for (int r = 0; r < 16; ++r) { P0[r] = 0.f; P1[r] = 0.f; } \
    i64x2 ka_[3], kb_[3]; F8_KLD(KB, 0, ka_[0], kb_[0]); F8_KLD(KB, 1, ka_[1], kb_[1]); \
    _Pragma("unroll") for (int m = 0; m < 6; ++m) { \
        if (m + 2 < 6) F8_KLD(KB, m + 2, ka_[(m + 2) % 3], kb_[(m + 2) % 3]); \
        __builtin_amdgcn_sched_barrier(0); \
        P0 = __builtin_amdgcn_mfma_f32_32x32x16_fp8_fp8(ka_[m % 3].x, qf[m].x, P0, 0, 0, 0); \
        P1 = __builtin_amdgcn_mfma_f32_32x32x16_fp8_fp8(kb_[m % 3].x, qf[m].x, P1, 0, 0, 0); \
        P0 = __builtin_amdgcn_mfma_f32_32x32x16_fp8_fp8(ka_[m % 3].y, qf[m].y, P0, 0, 0, 0); \
        P1 = __builtin_amdgcn_mfma_f32_32x32x16_fp8_fp8(kb_[m % 3].y, qf[m].y, P1, 0, 0, 0); } } while (0)
__device__ __forceinline__ void f8_softmax(f32x16& p0, f32x16& p1, const bool domask, const int k0, const int qpos, const int hi, f32x16 (&o)[4], float& m_run, float& l_run, long (&pf)[4]) {
    constexpr float C = 0.07216878364870322f * LOG2E;
    if (domask) {
        const float NEG = -__builtin_inff();
#pragma unroll
        for (int r = 0; r < 16; ++r) { const int key0 = k0 + (r & 3) + 8 * (r >> 2) + 4 * hi; if (key0 > qpos) p0[r] = NEG; if (key0 + 32 > qpos) p1[r] = NEG; }
    }
    float mx = p0[0];
#pragma unroll
    for (int r = 1; r < 16; ++r) mx = fmaxf(mx, p0[r]);
#pragma unroll
    for (int r = 0; r < 16; ++r) mx = fmaxf(mx, p1[r]);
    { auto rr = __builtin_amdgcn_permlane32_swap(__float_as_uint(mx), __float_as_uint(mx), false, false); mx = fmaxf(__uint_as_float(rr[0]), __uint_as_float(rr[1])); }
    mx *= C;
    float mn = m_run, alpha = 1.f;
    if (!__all(mx - m_run <= 8.f)) { mn = fmaxf(m_run, mx); alpha = fast_exp2(m_run - mn); m_run = mn;
#pragma unroll
        for (int db = 0; db < 4; ++db)
#pragma unroll
            for (int r = 0; r < 16; ++r) o[db][r] *= alpha; }
    float ps = 0.f;
#pragma unroll
    for (int r = 0; r < 16; ++r) { p0[r] = fast_exp2(p0[r] * C - mn); p1[r] = fast_exp2(p1[r] * C - mn); ps += p0[r] + p1[r]; }
    l_run = l_run * alpha + ps;
#pragma unroll
    for (int s = 0; s < 4; ++s) {
        const int r0 = 8 * (s & 1);
        unsigned a, b;
        if (s < 2) { a = pk4_fp8(p0[r0 + 0], p0[r0 + 1], p0[r0 + 2], p0[r0 + 3]); b = pk4_fp8(p0[r0 + 4], p0[r0 + 5], p0[r0 + 6], p0[r0 + 7]); }
        else       { a = pk4_fp8(p1[r0 + 0], p1[r0 + 1], p1[r0 + 2], p1[r0 + 3]); b = pk4_fp8(p1[r0 + 4], p1[r0 + 5], p1[r0 + 6], p1[r0 + 7]); }
        auto sw = __builtin_amdgcn_permlane32_swap(a, b, false, false);
        pf[s] = (long)(((unsigned long long)sw[1] << 32) | (unsigned long long)sw[0]);
    }
}
__device__ __forceinline__ void f8_pv(const long (&pf)[4], const LAS unsigned char* vb, const int lr, const int hi, f32x16 (&o)[4]) {
    i64x2 vf[2][2];
#pragma unroll
    for (int m = 0; m < 2; ++m) vf[0][m] = *(const LAS i64x2*)(vb + lr * 64 + (((2 * m + hi) ^ ((lr >> 2) & 3)) << 4));
#pragma unroll
    for (int db = 0; db < 4; ++db) {
        if (db + 1 < 4) { const int d = 32 * (db + 1) + lr;
#pragma unroll
            for (int m = 0; m < 2; ++m) vf[(db + 1) & 1][m] = *(const LAS i64x2*)(vb + d * 64 + (((2 * m + hi) ^ ((d >> 2) & 3)) << 4)); }
        __builtin_amdgcn_sched_barrier(0);
#pragma unroll
        for (int m = 0; m < 2; ++m) { o[db] = __builtin_amdgcn_mfma_f32_32x32x16_fp8_fp8(vf[db & 1][m].x, pf[2 * m], o[db], 0, 0, 0);
                                      o[db] = __builtin_amdgcn_mfma_f32_32x32x16_fp8_fp8(vf[db & 1][m].y, pf[2 * m + 1], o[db], 0, 0, 0); }
    }
}
__device__ __forceinline__ void attn_mla_f8(const int tid_in, LAS unsigned char* lds, const unsigned char* gK, const unsigned char* gV, const int t_lo, const int t_hi,
                                            const i64x2 (&qf)[6], const int qpos, const int wave_q0, f32x16 (&o)[4], float& m_run, float& l_run) {
    constexpr int KT = 12288, VT = 8192;
    int tid = tid_in; asm volatile("" : "+v"(tid));
    const int wid = __builtin_amdgcn_readfirstlane(tid >> 6), lane = tid & 63, lr0 = lane & 31, hi = lane >> 5;
    const bool halfB = wid >= 4;
    LAS unsigned char* KB0 = lds; LAS unsigned char* VB0 = lds + 2 * KT;
#define F8_DMA(T, KDST, VDST) do { const unsigned char* ks_ = gK + (size_t)(T) * KT; \
        __builtin_amdgcn_global_load_lds((const unsigned*)(ks_ + (unsigned)(tid * 16)), (LAS unsigned*)((KDST) + wid * 1024), 16, 0, 0); \
        if (wid < 4) __builtin_amdgcn_global_load_lds((const unsigned*)(ks_ + 8192 + (unsigned)(tid * 16)), (LAS unsigned*)((KDST) + 8192 + wid * 1024), 16, 0, 0); \
        __builtin_amdgcn_global_load_lds((const unsigned*)(gV + (size_t)(T) * VT + (unsigned)(tid * 16)), (LAS unsigned*)((VDST) + wid * 1024), 16, 0, 0); } while (0)
    F8_DMA(t_lo, KB0, VB0);
    VM_WAIT(); __syncthreads();
    if (!halfB) {
        int vcur = 0;
#pragma unroll 1
        for (int t = t_lo; t <= t_hi; ++t) {
            const int j = t - t_lo, vnext = (vcur == 2) ? 0 : vcur + 1;
            if (t + 1 < t_hi) F8_DMA(t + 1, KB0 + ((j + 1) & 1) * KT, VB0 + vnext * VT);
            const int k0 = t * 64;
            int lr = lr0; asm volatile("" : "+v"(lr));
            if ((t < t_hi) && (k0 <= wave_q0 + 31)) { f32x16 p0, p1; long pf[4]; const LAS unsigned char* kb = KB0 + (j & 1) * KT;
                F8_QK(kb, p0, p1); f8_softmax(p0, p1, k0 + 63 > wave_q0, k0, qpos, hi, o, m_run, l_run, pf); f8_pv(pf, VB0 + vcur * VT, lr, hi, o); }
            vcur = vnext;
            VM_WAIT(); __syncthreads();
        }
    } else {
        long pf[4] = {0, 0, 0, 0};
        int vcur = 0, vprev = 2;
#pragma unroll 1
        for (int t = t_lo; t <= t_hi; ++t) {
            const int j = t - t_lo, vnext = (vcur == 2) ? 0 : vcur + 1;
            if (t + 1 < t_hi) F8_DMA(t + 1, KB0 + ((j + 1) & 1) * KT, VB0 + vnext * VT);
            const int k0 = t * 64;
            int lr = lr0; asm volatile("" : "+v"(lr));
            if ((j > 0) && (k0 - 64 <= wave_q0 + 31)) f8_pv(pf, VB0 + vprev * VT, lr, hi, o);
            if ((t < t_hi) && (k0 <= wave_q0 + 31)) { f32x16 p0, p1; const LAS unsigned char* kb = KB0 + (j & 1) * KT;
                F8_QK(kb, p0, p1); f8_softmax(p0, p1, k0 + 63 > wave_q0, k0, qpos, hi, o, m_run, l_run, pf); }
            vprev = vcur; vcur = vnext;
            VM_WAIT(); __syncthreads();
        }
    }
#undef F8_DMA
}
__device__ __forceinline__ void attn_mla_stag(const int tid_in, LAS unsigned char* lds, const unsigned char* gK, const unsigned char* gV, const int t_lo, const int t_hi,
                                              const bf16x8 (&qf)[12], const int qpos, const int wave_q0, f32x16 (&o)[4], float& m_run, float& l_run) {
    constexpr int KT = 24576, VT = 16384;
    int tid = tid_in; asm volatile("" : "+v"(tid));
    const int wid = __builtin_amdgcn_readfirstlane(tid >> 6), lane = tid & 63, lr0 = lane & 31, hi = lane >> 5;
    const bool halfB = wid >= 4;
    LAS unsigned char* KB0 = lds; LAS unsigned char* VB0 = lds + 2 * KT;
    dma_tile<KT>(gK + (size_t)t_lo * KT, KB0, tid, wid); dma_tile<VT>(gV + (size_t)t_lo * VT, VB0, tid, wid);
    VM_WAIT(); __syncthreads();
    if (!halfB) {
        int vcur = 0;
#pragma unroll 1
        for (int t = t_lo; t <= t_hi; ++t) {
            const int j = t - t_lo, vnext = (vcur == 2) ? 0 : vcur + 1;
            if (t + 1 < t_hi) { dma_tile<KT>(gK + (size_t)(t + 1) * KT, KB0 + ((j + 1) & 1) * KT, tid, wid); dma_tile<VT>(gV + (size_t)(t + 1) * VT, VB0 + vnext * VT, tid, wid); }
            const int k0 = t * 64;
            int lr = lr0; asm volatile("" : "+v"(lr));
            if ((t < t_hi) && (k0 <= wave_q0 + 31)) { f32x16 p0, p1; bf16x8 pf[4]; const LAS unsigned char* kb = KB0 + (j & 1) * KT;
                MLA_QK(kb, p0, p1); mla_softmax(p0, p1, k0 + 63 > wave_q0, k0, qpos, hi, o, m_run, l_run, pf); mla_pv(pf, VB0 + vcur * VT, lr, hi, o); }
            vcur = vnext;
            VM_WAIT(); __syncthreads();
        }
    } else {
        bf16x8 pf[4];
#pragma unroll
        for (int s = 0; s < 4; ++s) pf[s] = (bf16x8){0, 0, 0, 0, 0, 0, 0, 0};
        int vcur = 0, vprev = 2;
#pragma unroll 1
        for (int t = t_lo; t <= t_hi; ++t) {
            const int j = t - t_lo, vnext = (vcur == 2) ? 0 : vcur + 1;
            if (t + 1 < t_hi) { dma_tile<KT>(gK + (size_t)(t + 1) * KT, KB0 + ((j + 1) & 1) * KT, tid, wid); dma_tile<VT>(gV + (size_t)(t + 1) * VT, VB0 + vnext * VT, tid, wid); }
            const int k0 = t * 64;
            int lr = lr0; asm volatile("" : "+v"(lr));
            if ((j > 0) && (k0 - 64 <= wave_q0 + 31)) mla_pv(pf, VB0 + vprev * VT, lr, hi, o);
            if ((t < t_hi) && (k0 <= wave_q0 + 31)) { f32x16 p0, p1; const LAS unsigned char* kb = KB0 + (j & 1) * KT;
                MLA_QK(kb, p0, p1); mla_softmax(p0, p1, k0 + 63 > wave_q0, k0, qpos, hi, o, m_run, l_run, pf); }
            vprev = vcur; vcur = vnext;
            VM_WAIT(); __syncthreads();
        }
    }
}
template <int DQK> __device__ __forceinline__ void load_q_norm(const bf16_t* qrow, const float* gain, float scale, int hi, bf16x8 (&qf)[DQK / 16]) {
    float x[DQK / 16][8]; float ss = 0.f;
#pragma unroll
    for (int ks = 0; ks < DQK / 16; ++ks) { const u32x4 w = *(const u32x4*)(qrow + 16 * ks + 8 * hi); unpack8(w, x[ks]);
#pragma unroll
        for (int j = 0; j < 8; ++j) ss += x[ks][j] * x[ks][j]; }
    { auto rr = __builtin_amdgcn_permlane32_swap(__float_as_uint(ss), __float_as_uint(ss), false, false); ss = __uint_as_float(rr[0]) + __uint_as_float(rr[1]); }
    const float rs = rsqrtf(ss * (1.0f / DQK) + EPS) * scale;
#pragma unroll
    for (int ks = 0; ks < DQK / 16; ++ks) { float y[8];
#pragma unroll
        for (int j = 0; j < 8; ++j) y[j] = x[ks][j] * rs * gain[16 * ks + 8 * hi + j];
        qf[ks] = __builtin_bit_cast(bf16x8, pack8(y)); }
}
template <int DQK> __device__ __forceinline__ void load_q_norm_bf16x2(const bf16_t* qa, const bf16_t* qb_, const float* gain, float scale, int hi, bf16x8 (&qf)[DQK / 16]) {
    float x[DQK / 16][8]; float ss = 0.f;
#pragma unroll
    for (int ks = 0; ks < DQK / 16; ++ks) { float a[8], b[8]; unpack8(*(const u32x4*)(qa + 16 * ks + 8 * hi), a); unpack8(*(const u32x4*)(qb_ + 16 * ks + 8 * hi), b);
#pragma unroll
        for (int j = 0; j < 8; ++j) { x[ks][j] = a[j] + b[j]; ss += x[ks][j] * x[ks][j]; } }
    { auto rr = __builtin_amdgcn_permlane32_swap(__float_as_uint(ss), __float_as_uint(ss), false, false); ss = __uint_as_float(rr[0]) + __uint_as_float(rr[1]); }
    const float rs = rsqrtf(ss * (1.0f / DQK) + EPS) * scale;
#pragma unroll
    for (int ks = 0; ks < DQK / 16; ++ks) { float y[8];
#pragma unroll
        for (int j = 0; j < 8; ++j) y[j] = x[ks][j] * rs * gain[16 * ks + 8 * hi + j];
        qf[ks] = __builtin_bit_cast(bf16x8, pack8(y)); }
}
template <int DQK> __device__ __forceinline__ void load_q_norm_bf16x4(const bf16_t* q0, const size_t zs, const float* gain, float scale, int hi, bf16x8 (&qf)[DQK / 16]) {
    float x[DQK / 16][8]; float ss = 0.f;
#pragma unroll
    for (int ks = 0; ks < DQK / 16; ++ks) {
#pragma unroll
        for (int j = 0; j < 8; ++j) x[ks][j] = 0.f;
#pragma unroll
        for (int z = 0; z < 4; ++z) { float a[8]; unpack8(*(const u32x4*)(q0 + z * zs + 16 * ks + 8 * hi), a);
#pragma unroll
            for (int j = 0; j < 8; ++j) x[ks][j] += a[j]; }
#pragma unroll
        for (int j = 0; j < 8; ++j) ss += x[ks][j] * x[ks][j]; }
    { auto rr = __builtin_amdgcn_permlane32_swap(__float_as_uint(ss), __float_as_uint(ss), false, false); ss = __uint_as_float(rr[0]) + __uint_as_float(rr[1]); }
    const float rs = rsqrtf(ss * (1.0f / DQK) + EPS) * scale;
#pragma unroll
    for (int ks = 0; ks < DQK / 16; ++ks) { float y[8];
#pragma unroll
        for (int j = 0; j < 8; ++j) y[j] = x[ks][j] * rs * gain[16 * ks + 8 * hi + j];
        qf[ks] = __builtin_bit_cast(bf16x8, pack8(y)); }
}
template <int DV> __device__ __forceinline__ void store_o(bf16_t* orow, const f32x16 (&o)[DV / 32], float inv_l, int hi) {
#pragma unroll
    for (int db = 0; db < DV / 32; ++db)
#pragma unroll
        for (int r4 = 0; r4 < 4; ++r4) { u32x2 w; w.x = cvt_pk_bf16(o[db][4 * r4] * inv_l, o[db][4 * r4 + 1] * inv_l); w.y = cvt_pk_bf16(o[db][4 * r4 + 2] * inv_l, o[db][4 * r4 + 3] * inv_l);
            *(u32x2*)(orow + 32 * db + 8 * r4 + 4 * hi) = w; }
}

struct Args { const float* in[50]; float* out; unsigned char* ws; int l_lo, l_hi, ph_lo, ph_hi; };
enum { I_X = 0, I_MEM, I_RELB, I_LNMIX, I_WIN, I_SWAQG, I_SWAKG, I_SINK, I_DWW, I_DWB, I_CLNG, I_CLNB, I_PWW, I_PWB, I_QAG, I_KVAG, I_WQB, I_WKVB, I_QNN, I_QNR, I_KNN, I_KNR,
       I_ARE, I_AIM, I_LOGDT, I_BRE, I_BIM, I_CRE, I_CIM, I_SSMD, I_GLUW, I_GLUB, I_MIXG, I_WOUT, I_LNX, I_MEMG, I_XWQ, I_XWK, I_XWV, I_XQG, I_XKG, I_XWO, I_LNMOE, I_WG, I_BG, I_WE, I_BE, I_MG, I_MU, I_MD };
constexpr int NPH = 19;

__constant__ unsigned char T5_BUCKET[128] = {0,1,2,3,4,5,6,7,8,9,10,11,12,13,14,15,16,16,16,17,17,18,18,18,19,19,19,20,20,20,20,21,21,21,21,22,22,22,22,22,23,23,23,23,23,23,24,24,24,24,24,24,25,25,25,25,25,25,25,26,26,26,26,26,26,26,26,27,27,27,27,27,27,27,27,27,27,28,28,28,28,28,28,28,28,28,28,29,29,29,29,29,29,29,29,29,29,29,29,30,30,30,30,30,30,30,30,30,30,30,30,30,30,31,31,31,31,31,31,31,31,31,31,31,31,31,31,31};

__device__ __forceinline__ void tr_item(const float* W, int ldw, int k0, int n0, bf16_t* WT, int ldt, int drow0, const float* kgain, LAS float* scr, int lane) {
    float tv[32];
#pragma unroll
    for (int i = 0; i < 32; ++i) { const int kk = 2 * i + (lane >> 5); tv[i] = W[(size_t)(k0 + kk) * ldw + n0 + (lane & 31)]; }
#pragma unroll
    for (int i = 0; i < 32; ++i) { const int kk = 2 * i + (lane >> 5); float v = tv[i]; if (kgain) v *= kgain[k0 + kk]; scr[kk * 33 + (lane & 31)] = v; }
    LDS_WAIT();
    const int c = lane & 7;
#pragma unroll
    for (int j = 0; j < 4; ++j) { const int n = (lane >> 3) + 8 * j; const LAS float* s = scr + (8 * c) * 33 + n;
        u32x4 o; o.x = cvt_pk_bf16(s[0 * 33], s[1 * 33]); o.y = cvt_pk_bf16(s[2 * 33], s[3 * 33]); o.z = cvt_pk_bf16(s[4 * 33], s[5 * 33]); o.w = cvt_pk_bf16(s[6 * 33], s[7 * 33]);
        *(u32x4*)(WT + (size_t)(drow0 + n) * ldt + k0 + 8 * c) = o; }
    LDS_WAIT();
}
__device__ __forceinline__ void tr_item8(const float* W, int ldw, int k0, int n0, unsigned char* WT8, int ldt, int drow0, const float* kgain, LAS float* scr, int lane) {
    float tv[32];
#pragma unroll
    for (int i = 0; i < 32; ++i) { const int kk = 2 * i + (lane >> 5); tv[i] = W[(size_t)(k0 + kk) * ldw + n0 + (lane & 31)]; }
#pragma unroll
    for (int i = 0; i < 32; ++i) { const int kk = 2 * i + (lane >> 5); float v = tv[i] * 32.0f; if (kgain) v *= kgain[k0 + kk]; scr[kk * 33 + (lane & 31)] = v; }
    LDS_WAIT();
    const int c = lane & 7;
#pragma unroll
    for (int j = 0; j < 4; ++j) { const int n = (lane >> 3) + 8 * j; const LAS float* s = scr + (8 * c) * 33 + n;
        *(u32x2*)(WT8 + (size_t)(drow0 + n) * ldt + k0 + 8 * c) = (u32x2){pk4_fp8(s[0 * 33], s[1 * 33], s[2 * 33], s[3 * 33]), pk4_fp8(s[4 * 33], s[5 * 33], s[6 * 33], s[7 * 33])}; }
    LDS_WAIT();
}
__device__ __forceinline__ void rms_row_store(const f32x4 (&v)[8], const float* gain, bf16_t* orow, int lane) {
    float ss = 0.f;
#pragma unroll
    for (int j = 0; j < 8; ++j) ss += (v[j].x * v[j].x + v[j].y * v[j].y) + (v[j].z * v[j].z + v[j].w * v[j].w);
    const float rs = rsqrtf(wave_sum(ss) * (1.0f / D) + EPS);
#pragma unroll
    for (int j = 0; j < 8; ++j) { const f32x4 g = *(const f32x4*)(gain + 4 * lane + 256 * j); u32x2 w; w.x = cvt_pk_bf16(v[j].x * rs * g.x, v[j].y * rs * g.y); w.y = cvt_pk_bf16(v[j].z * rs * g.z, v[j].w * rs * g.w);
        *(u32x2*)(orow + 4 * lane + 256 * j) = w; }
}
__device__ __forceinline__ f32x2 cmul(f32x2 a, f32x2 b) { return (f32x2){a.x * b.x - a.y * b.y, a.x * b.y + a.y * b.x}; }
__device__ __forceinline__ void sincos_rev(float x, float& s, float& c) { float r = x * 0.15915494309189535f; r -= rintf(r); s = __builtin_amdgcn_sinf(r); c = __builtin_amdgcn_cosf(r); }

#define X ((float*)out_)
#define ROPE ((float*)(ws + WS_ROPE))
#define H ((bf16_t*)(ws + WS_H))
#define P ((bf16_t*)(ws + WS_P))
#define O ((bf16_t*)(ws + WS_O))
#define QRAW ((bf16_t*)(ws + WS_QRAW))
#define KVRAW ((bf16_t*)(ws + WS_KVRAW))
#define Q ((bf16_t*)(ws + WS_Q))
#define KIMG ((unsigned char*)(ws + WS_KIMG))
#define VIMG ((unsigned char*)(ws + WS_VIMG))
#define SWAK ((unsigned char*)(ws + WS_SWAK))
#define SWAV ((unsigned char*)(ws + WS_SWAV))
#define ZC ((bf16_t*)(ws + WS_ZC))
#define UA ((bf16_t*)(ws + WS_UA))
#define EBUF ((float*)(ws + WS_EBUF))
#define YG ((bf16_t*)(ws + WS_YG))
#define QX ((bf16_t*)(ws + WS_QX))
#define OX ((bf16_t*)(ws + WS_OX))
#define MEMN ((bf16_t*)(ws + WS_MEMN))
#define KMEM ((bf16_t*)(ws + WS_KMEM))
#define VMEM ((bf16_t*)(ws + WS_VMEM))
#define XKIMG ((unsigned char*)(ws + WS_XKIMG))
#define XVIMG ((unsigned char*)(ws + WS_XVIMG))
#define LOGI ((float*)(ws + WS_LOG))
#define TOK ((int*)(ws + WS_TOK))
#define WSLOT ((float*)(ws + WS_WSLOT))
#define HID ((bf16_t*)(ws + WS_HID))
#define YS8 ((unsigned char*)(ws + WS_YS))
#define WIN ((bf16_t*)(ws + WS_WIN))
#define WOUT ((bf16_t*)(ws + WS_WOUT))
#define XWQ ((bf16_t*)(ws + WS_XWQ))
#define XWK ((bf16_t*)(ws + WS_XWK))
#define XWV ((bf16_t*)(ws + WS_XWV))
#define XWO ((bf16_t*)(ws + WS_XWO))
#define PW ((bf16_t*)(ws + WS_PW))
#define WQB ((bf16_t*)(ws + WS_WQB))
#define WKVB ((bf16_t*)(ws + WS_WKVB))
#define GLU ((bf16_t*)(ws + WS_GLU))
#define ROUT ((bf16_t*)(ws + WS_ROUT))
#define MOE1 ((bf16_t*)(ws + WS_MOE1))
#define MOE2 ((bf16_t*)(ws + WS_MOE2))
#define W1G ((bf16_t*)(ws + WS_W1G))
#define BTY ((bf16_t*)(ws + WS_BTY))
#define PARTO ((float*)(ws + WS_PARTO))
#define XB ((bf16_t*)(ws + WS_XB))
#define QXP ((float*)(ws + WS_QXP))
#define LOGP ((float*)(ws + WS_LOGP))
#define SSP ((float*)(ws + WS_SSP))
#define RMSV ((float*)(ws + WS_RMSV))
#define RMS1 ((float*)(ws + WS_RMS1))
#define XF8 ((unsigned char*)(ws + WS_XF8))
#define PQ7 ((bf16_t*)(ws + WS_H))
#define HID8 ((unsigned char*)(ws + WS_HID))
#define MOE1F ((unsigned char*)(ws + WS_MOE1))
#define MOE2F ((unsigned char*)(ws + WS_MOE2))
#define PARTML ((float*)(ws + WS_PARTML))
#define REC_E ((int*)(ws + WS_REC))
#define REC_R (REC_E + 2 * S)
#define REC_W ((float*)(REC_E + 4 * S))
#define REC_S (REC_E + 6 * S)
__device__ __forceinline__ unsigned long long ldp(const LAS unsigned* pt, int i) { unsigned lo = pt[2 * i], hi = pt[2 * i + 1]; lo = __builtin_amdgcn_readfirstlane(lo); hi = __builtin_amdgcn_readfirstlane(hi); return ((unsigned long long)hi << 32) | lo; }
#define INP(i) ((const float*)(const GAS float*)ldp(PT, (i)))
#define FRESH() int tid = (wave_s << 6) + (int)__builtin_amdgcn_mbcnt_hi(~0u, __builtin_amdgcn_mbcnt_lo(~0u, 0u)), G = gridDim.x, bid = blockIdx.x; unsigned lo_ = 0u; asm volatile("" : "+v"(tid), "+s"(G), "+s"(bid), "+s"(lo_)); LAS unsigned char* lds = lds0; const LAS unsigned* PT = (const LAS unsigned*)(lds0 + lo_ + LDSCTL_OFF + 512); volatile LAS unsigned* CTLW = (volatile LAS unsigned*)(lds0 + lo_ + LDSCTL_OFF); (void)CTLW; const int NGW = G * NWAVES; (void)NGW; const int lane = tid & 63, wave = __builtin_amdgcn_readfirstlane(tid >> 6), gw = bid * NWAVES + wave; unsigned char* ws = (unsigned char*)(GAS unsigned char*)ldp(PT, 50); float* out_ = (float*)(GAS float*)ldp(PT, 51); unsigned* ctl = (unsigned*)ws; (void)lane; (void)wave; (void)gw; (void)ws; (void)out_; (void)ctl
#if !MK_MULTI
#define GRID_BAR() do { XcdBarrier bar_; bar_.bar = ctl + CW_BAR; bar_.x = xb_xcc_id(); bar_.st = CTLW; xcd_barrier(bar_, tid); } while (0)
#else
#define GRID_BAR() do { } while (0)
#endif

#ifndef PROBE_REP
#define PROBE_REP 0u
#endif
#ifndef PHASE_MASK
#define PHASE_MASK 0xFFFFFFFFu
#endif
#define IN(k) ((((PHASE_MASK) >> (k)) & 1u) && ({ int a_ = ph_lo, b_ = ph_hi; asm volatile("" : "+s"(a_), "+s"(b_)); (a_ <= (k) && (k) < b_); }))
#define SEAM(k) do { if (IN((k) + 1) || ((k) == NPH - 1 && IN(0) && IN(NPH - 1))) GRID_BAR(); } while (0)


__device__ __forceinline__ void norm_groups(const LAS unsigned* PT, unsigned char* ws, const int l, const int s0, const int sstride, const int glo, const int ghi, const int lane) {
    const float* mg = INP(I_MIXG) + l * D;
    for (int s = s0; s < S; s += sstride) {
#pragma unroll
        for (int grp = 0; grp < 4; ++grp) { if (grp < glo || grp >= ghi) continue; bf16_t* p = O + (size_t)s * D + grp * 512 + 8 * lane; float x[8];
                    if (grp == 2 && s >= S / 2) {
                        const int h = lane >> 4, d0 = (lane & 15) * 8, qb = s >> 8, row = s & 255;
                        const size_t sa = ((size_t)(h * 32 + (qb - 32)) * 2 + 0) * 256 + row, sb = sa + 256;
                        const f32x2 mla = *(const f32x2*)(PARTML + sa * 2), mlb = *(const f32x2*)(PARTML + sb * 2);
                        const float mm = fmaxf(mla.x, mlb.x), fa = fast_exp2(mla.x - mm), fb = fast_exp2(mlb.x - mm), inv = fast_rcp(mla.y * fa + mlb.y * fb);
                        const f32x4 a0 = *(const f32x4*)(PARTO + sa * 128 + d0), a1 = *(const f32x4*)(PARTO + sa * 128 + d0 + 4), b0 = *(const f32x4*)(PARTO + sb * 128 + d0), b1 = *(const f32x4*)(PARTO + sb * 128 + d0 + 4);
#pragma unroll
                        for (int j = 0; j < 4; ++j) { x[j] = (a0[j] * fa + b0[j] * fb) * inv; x[4 + j] = (a1[j] * fa + b1[j] * fb) * inv; }
                    } else unpack8(*(const u32x4*)p, x);
                    float ss = 0.f;
#pragma unroll
                    for (int j = 0; j < 8; ++j) ss += x[j] * x[j];
                    const float rs = rsqrtf(wave_sum(ss) * (1.f / 512.f) + EPS); const float* gn = mg + grp * 512 + 8 * lane;
#pragma unroll
                    for (int j = 0; j < 8; ++j) x[j] = x[j] * rs * gn[j];
                    *(u32x4*)p = pack8(x); }
            }
}

template <int DUMMY> __device__ __forceinline__ void layer_body(const int l, const int wave_s, LAS unsigned char* lds0, const int ph_lo, const int ph_hi) {
        if (IN(0)) {
            FRESH();
            LAS float* scr = (LAS float*)(lds + wave * 16384);
            for (int rep_ = 0; rep_ < (int)(PROBE_REP & 1u) + 1; ++rep_) {
                const float* w_in = INP(I_WIN) + (size_t)l * D * INW; const float* w_out = INP(I_WOUT) + (size_t)l * D * D;
                const float* xwq = INP(I_XWQ) + (size_t)l * D * 512; const float* xwk = INP(I_XWK) + (size_t)l * D * 512; const float* xwv = INP(I_XWV) + (size_t)l * D * 512;
                const float* xwo = INP(I_XWO) + (size_t)l * 512 * D; const float* pww = INP(I_PWW) + (size_t)l * 512 * 512;
                const float* wqb = INP(I_WQB) + (size_t)l * 512 * 768; const float* wkvb = INP(I_WKVB) + (size_t)l * 256 * 1024; const float* gluw = INP(I_GLUW) + (size_t)l * 512 * 512;
                const float* mg = INP(I_MG) + (size_t)l * 32 * D * 512; const float* mu = INP(I_MU) + (size_t)l * 32 * D * 512; const float* md = INP(I_MD) + (size_t)l * 32 * 512 * D;
                const float* qag = INP(I_QAG) + l * 512; const float* kvag = INP(I_KVAG) + l * 256; const float* lnx = INP(I_LNX) + l * D; const float* lnmix = INP(I_LNMIX) + l * D; const float* lnm = INP(I_LNMOE) + l * D;
                constexpr int N_IN = 32 * 98, N_OUT = 32 * 64, N_XQ = 32 * 16, N_XO = 8 * 64, N_PW = 8 * 16, N_QB = 8 * 24, N_KVB = 4 * 32, N_GLU = 8 * 16, N_MG = 32 * 512, N_MD = 32 * 512;
                constexpr int NITEMS = N_IN + N_OUT + 3 * N_XQ + N_XO + N_PW + N_QB + N_KVB + N_GLU + 2 * N_MG + N_MD;
                for (int it = gw; it < NITEMS; it += NGW) {
                    int r = it;
                    if (r < N_MG) { const int e = r >> 9, rr = r & 511, kb = rr >> 4, nb = rr & 15, n0 = 32 * nb; tr_item8(mg + (size_t)e * D * 512, 512, 64 * kb, n0, MOE1F + (size_t)e * 1024 * D, D, (n0 >> 7) * 256 + (n0 & 127), lnm, scr, lane); continue; } r -= N_MG;
                    if (r < N_MG) { const int e = r >> 9, rr = r & 511, kb = rr >> 4, nb = rr & 15, n0 = 32 * nb; tr_item8(mu + (size_t)e * D * 512, 512, 64 * kb, n0, MOE1F + (size_t)e * 1024 * D, D, (n0 >> 7) * 256 + 128 + (n0 & 127), lnm, scr, lane); continue; } r -= N_MG;
                    if (r < N_MD) { const int e = r >> 9, rr = r & 511, kb = rr >> 6, nb = rr & 63; tr_item8(md + (size_t)e * 512 * D, D, 64 * kb, 32 * nb, MOE2F + (size_t)e * D * 512, 512, 32 * nb, nullptr, scr, lane); continue; } r -= N_MD;
                    if (r < N_IN) { const int kb = r / 98, nb = r % 98, n0 = 32 * nb, dr = (n0 < 448) ? n0 : (n0 < 512 ? 3072 + (n0 - 448) : n0 - 64); tr_item(w_in, INW, 64 * kb, n0, WIN, D, dr, lnmix, scr, lane); continue; } r -= N_IN;
                    if (r < N_OUT) { const int kb = r >> 6, nb = r & 63; tr_item(w_out, D, 64 * kb, 32 * nb, WOUT, D, 32 * nb, nullptr, scr, lane); continue; } r -= N_OUT;
                    if (r < N_XQ) { const int kb = r >> 4, nb = r & 15; tr_item(xwq, 512, 64 * kb, 32 * nb, XWQ, D, 32 * nb, lnx, scr, lane); continue; } r -= N_XQ;
                    if (r < N_XQ) { const int kb = r >> 4, nb = r & 15; tr_item(xwk, 512, 64 * kb, 32 * nb, XWK, D, 32 * nb, nullptr, scr, lane); continue; } r -= N_XQ;
                    if (r < N_XQ) { const int kb = r >> 4, nb = r & 15; tr_item(xwv, 512, 64 * kb, 32 * nb, XWV, D, 32 * nb, nullptr, scr, lane); continue; } r -= N_XQ;
                    if (r < N_XO) { const int kb = r >> 6, nb = r & 63; tr_item(xwo, D, 64 * kb, 32 * nb, XWO, 512, 32 * nb, nullptr, scr, lane); continue; } r -= N_XO;
                    if (r < N_PW) { const int kb = r >> 4, nb = r & 15; tr_item(pww, 512, 64 * kb, 32 * nb, PW, 512, 32 * nb, nullptr, scr, lane); continue; } r -= N_PW;
                    if (r < N_QB) { const int kb = r / 24, nb = r % 24; tr_item(wqb, 768, 64 * kb, 32 * nb, WQB, 512, 32 * nb, qag, scr, lane); continue; } r -= N_QB;
                    if (r < N_KVB) { const int kb = r >> 5, nb = r & 31; tr_item(wkvb, 1024, 64 * kb, 32 * nb, WKVB, 256, 32 * nb, kvag, scr, lane); continue; } r -= N_KVB;
                    { const int kb = r >> 4, nb = r & 15; tr_item(gluw, 512, 64 * kb, 32 * nb, GLU, 512, 32 * nb, nullptr, scr, lane); }
                }
                if (bid == 0 && tid < 256) { *(u32x4*)(XB + (size_t)S * D + 8 * tid) = (u32x4){0u, 0u, 0u, 0u}; *(u32x2*)(XF8 + (size_t)S * D + 8 * tid) = (u32x2){0u, 0u}; }
                for (int i = bid * NTHR + tid; i < (WINR - INW) * D / 8; i += G * NTHR) *(u32x4*)(WIN + (size_t)INW * D + (size_t)i * 8) = (u32x4){0u, 0u, 0u, 0u};
                const float* wgp = INP(I_WG) + (size_t)l * D * 4; const float* wep = INP(I_WE) + (size_t)l * D * 32;
                for (int i = bid * NTHR + tid; i < 256 * D / 2; i += G * NTHR) { const int n = i / (D / 2), k = (i % (D / 2)) * 2; float a = 0.f, b = 0.f;
                    if (n < 4) { a = wgp[(size_t)k * 4 + n] * lnm[k]; b = wgp[(size_t)(k + 1) * 4 + n] * lnm[k + 1]; } else if (n < 36) { a = wep[(size_t)k * 32 + n - 4] * lnm[k]; b = wep[(size_t)(k + 1) * 32 + n - 4] * lnm[k + 1]; }
                    *(unsigned*)(ROUT + (size_t)n * D + k) = cvt_pk_bf16(a, b); }
            }
            __syncthreads();
            for (int rep_ = 0; rep_ < (int)((PROBE_REP >> 19) & 1u) + 1; ++rep_)
            for (int task = bid; task < 256; task += G) {
                FRESH();
                const int g = task >> 3, part = task & 7;
                LAS f32x2* LP = (LAS f32x2*)lds;
                LAS f32x2* BB = (LAS f32x2*)(lds + 36864);
                LAS f32x2* CC = (LAS f32x2*)(lds + 45056);
                LAS float* KC = (LAS float*)(lds + 53248);
                const float* are = INP(I_ARE) + (size_t)(l * 32 + g) * 64; const float* aim = INP(I_AIM) + (size_t)(l * 32 + g) * 64;
                const float dt = __expf(INP(I_LOGDT)[l * 32 + g]);
                const float* bre = INP(I_BRE) + (size_t)(l * 32 + g) * 1024; const float* bim = INP(I_BIM) + (size_t)(l * 32 + g) * 1024;
                const float* cre = INP(I_CRE) + (size_t)(l * 32 + g) * 1024; const float* cim = INP(I_CIM) + (size_t)(l * 32 + g) * 1024;
                const float* dsk = INP(I_SSMD) + l * 512 + g * 16;
                if (tid < 64) { const int p = tid; float s, c; sincos_rev(aim[p] * dt, s, c); const float mag = fast_exp2(are[p] * dt * LOG2E); const f32x2 lb = (f32x2){mag * c, mag * s};
                    f32x2 cur = (f32x2){1.f, 0.f}; for (int j = 0; j <= 64; ++j) { LP[p * 65 + j] = cur; cur = cmul(cur, lb); } }
                for (int i = tid; i < 1024; i += NTHR) { const int p = i >> 4, ii = i & 15; float s, c; sincos_rev(aim[p] * dt, s, c); const float mag = fast_exp2(are[p] * dt * LOG2E);
                    const float nr = mag * c - 1.f, ni = mag * s, lr_ = are[p], li = aim[p], den = fast_rcp(lr_ * lr_ + li * li);
                    const f32x2 coef = (f32x2){(nr * lr_ + ni * li) * den, (ni * lr_ - nr * li) * den};
                    BB[p * 16 + ii] = cmul(coef, (f32x2){bre[p * 16 + ii], bim[p * 16 + ii]});
                    CC[i] = (f32x2){cre[i], cim[i]}; }
                __syncthreads();
                for (int task = tid; task < 1024; task += NTHR) {
                    const int j = task >> 4, o0 = ((task >> 2) & 3) * 4, i0 = (task & 3) * 4; float acc[4][4];
#pragma unroll
                    for (int k = 0; k < 4; ++k)
#pragma unroll
                        for (int m = 0; m < 4; ++m) acc[k][m] = 0.f;
                    for (int p = 0; p < 64; ++p) { const f32x2 lp = LP[p * 65 + j]; f32x2 bb[4];
#pragma unroll
                        for (int m = 0; m < 4; ++m) bb[m] = BB[p * 16 + i0 + m];
#pragma unroll
                        for (int k = 0; k < 4; ++k) { const f32x2 u = cmul(CC[(o0 + k) * 64 + p], lp);
#pragma unroll
                            for (int m = 0; m < 4; ++m) acc[k][m] += u.x * bb[m].x - u.y * bb[m].y; } }
#pragma unroll
                    for (int k = 0; k < 4; ++k)
#pragma unroll
                        for (int m = 0; m < 4; ++m) KC[(j * 16 + o0 + k) * 16 + i0 + m] = acc[k][m] + ((j == 0 && o0 + k == i0 + m) ? dsk[o0 + k] : 0.f); }
                __syncthreads();
                for (int ch = tid; ch < 128 * 160; ch += NTHR) { const int rr = part * 128 + ch / 160, kc = (ch % 160) * 8, t = rr >> 4, o = rr & 15; float v[8];
                    if (kc < 1024) { const int tau = kc >> 4, i0 = kc & 15;
#pragma unroll
                        for (int j = 0; j < 8; ++j) v[j] = (tau <= t) ? KC[((t - tau) * 16 + o) * 16 + i0 + j] : 0.f; }
                    else if (kc < 1152) { const bool im = kc >= 1088; const int p0 = (kc - (im ? 1088 : 1024));
#pragma unroll
                        for (int j = 0; j < 8; ++j) { const f32x2 t2 = cmul(CC[o * 64 + p0 + j], LP[(p0 + j) * 65 + t + 1]); v[j] = im ? -t2.y : t2.x; } }
                    else {
#pragma unroll
                        for (int j = 0; j < 8; ++j) v[j] = 0.f; }
                    *(u32x4*)(BTY + ((size_t)g * 1024 + rr) * 1280 + kc) = pack8(v); }
                for (int ch = tid; ch < 32 * 128; ch += NTHR) { const int n = part * 32 + ch / 128, kc = (ch % 128) * 8, tau = kc >> 4, i0 = kc & 15; float v[8];
                    if (n < 128) { const int p = n & 63; const f32x2 lp = LP[p * 65 + 63 - tau];
#pragma unroll
                        for (int j = 0; j < 8; ++j) { const f32x2 t2 = cmul(lp, BB[p * 16 + i0 + j]); v[j] = (n < 64) ? t2.x : t2.y; } }
                    else {
#pragma unroll
                        for (int j = 0; j < 8; ++j) v[j] = 0.f; }
                    *(u32x4*)(W1G + ((size_t)g * 256 + n) * 1024 + kc) = pack8(v); }
                __syncthreads();
            }
            if (l == 0) { FRESH(); for (int i = bid * NTHR + tid; i < S * 32; i += G * NTHR) { const int pos = i >> 5, f = i & 31; const float inv = fast_exp2(-(float)f * (13.287712379549449f / 32.0f));
                    double tr = (double)pos * (double)inv * 0.15915494309189535; tr -= rint(tr); const float rf = (float)tr;
                    ROPE[2 * i] = __builtin_amdgcn_cosf(rf); ROPE[2 * i + 1] = __builtin_amdgcn_sinf(rf); } }
            for (int rep3_ = (int)((PROBE_REP >> 21) & 1u); rep3_ >= 0; --rep3_)
            {   FRESH(); const float* xin = INP(I_X);
                for (int s = gw; s < S; s += NGW) { float x[4][8];
                    if (l == 0) {
#pragma unroll
                        for (int j = 0; j < 4; ++j) { const f32x4 a = *(const f32x4*)(xin + (size_t)s * D + 8 * lane + 512 * j), b = *(const f32x4*)(xin + (size_t)s * D + 8 * lane + 512 * j + 4);
                            x[j][0] = a[0]; x[j][1] = a[1]; x[j][2] = a[2]; x[j][3] = a[3]; x[j][4] = b[0]; x[j][5] = b[1]; x[j][6] = b[2]; x[j][7] = b[3]; } }
                    else { const int s0 = REC_S[2 * s], s1 = REC_S[2 * s + 1];
#pragma unroll
                        for (int j = 0; j < 4; ++j) { float ya[8], yb[8]; unpack8(*(const u32x4*)(XB + (size_t)s * D + 8 * lane + 512 * j), x[j]);
                            unpack8_fp8(*(const u32x2*)(YS8 + (size_t)s0 * D + 8 * lane + 512 * j), ya); unpack8_fp8(*(const u32x2*)(YS8 + (size_t)s1 * D + 8 * lane + 512 * j), yb);
#pragma unroll
                            for (int e = 0; e < 8; ++e) x[j][e] += (ya[e] + yb[e]) * 0.0625f; } }
                    float ss = 0.f;
#pragma unroll
                    for (int j = 0; j < 4; ++j)
#pragma unroll
                        for (int e = 0; e < 8; ++e) ss += x[j][e] * x[j][e];
                    ss = wave_sum(ss);
                    if (rep3_ == 0) {
#pragma unroll
                        for (int j = 0; j < 4; ++j) *(u32x4*)(XB + (size_t)s * D + 8 * lane + 512 * j) = pack8(x[j]);
                        if (lane == 0) RMS1[s] = rsqrtf(ss * (1.0f / D) + EPS); } }
                const float* mgain = INP(I_MEMG) + l * D; const float* mem = INP(I_MEM);
                for (int s = gw; s < MEMT; s += NGW) { f32x4 v[8];
#pragma unroll
                    for (int j = 0; j < 8; ++j) v[j] = *(const f32x4*)(mem + (size_t)s * D + 4 * lane + 256 * j);
                    rms_row_store(v, mgain, MEMN + (size_t)s * D, lane); }
            }
            SEAM(0);
        }
        if (IN(1)) for (int rep_ = 0; rep_ < (int)((PROBE_REP >> 1) & 1u) + 1; ++rep_) {
            FRESH();
            pg8::GSched Sd{(const char*)XB, (const char*)WIN, (size_t)256 * D * 2, (size_t)256 * D * 2, 0, 0, S / 256, 12, 1, G, bid};
            pg8::EpiBf16 E{P, INWP, 0, nullptr, RMS1};
            for (int r2_ = 0; r2_ < (int)((PROBE_REP >> 23) & 1u) + 1; ++r2_)
            pg8::gemm_phase<pg8::EpiBf16, pg8::GSched>(tid, lds, D, D, D, nullptr, Sd, E);
            for (int r3_ = 0; r3_ < (int)((PROBE_REP >> 22) & 1u) * 4 + 1; ++r3_)
            {
                pg8::GSched St{(const char*)XB, (const char*)(WIN + (size_t)3072 * D), (size_t)256 * D * 2, 0, (size_t)512 * 2, (size_t)512 * 2, S / 256, 1, 4, G, bid};
                pg8::EpiBf16Part64 Et{PQ7, (size_t)S * 64, RMS1};
                pg8::gemm_phase<pg8::EpiBf16Part64, pg8::GSched>(tid, lds, 512, D, D, nullptr, St, Et); }
            SEAM(1);
        }
        if (IN(2)) for (int rep_ = 0; rep_ < (int)((PROBE_REP >> 2) & 1u) + 1; ++rep_) {
            FRESH();
            {   pg8::GSched Sd{(const char*)(P + P_CQ), (const char*)WQB, (size_t)256 * INWP * 2, (size_t)256 * 512 * 2, 0, 0, S / 256, 3, 1, G, bid};
                pg8::EpiBf16 E{QRAW, 768, 0, nullptr, nullptr};
                pg8::gemm_phase<pg8::EpiBf16, pg8::GSched>(tid, lds, 512, INWP, 512, nullptr, Sd, E); }
            {   FRESH(); pg8::GSched Sd{(const char*)(P + P_CKV), (const char*)WKVB, (size_t)256 * INWP * 2, (size_t)256 * 256 * 2, 0, 0, S / 256, 4, 1, G, bid};
                pg8::EpiBf16 E{KVRAW, 1024, 0, nullptr, nullptr};
                pg8::gemm_phase<pg8::EpiBf16, pg8::GSched>(tid, lds, 256, INWP, 256, nullptr, Sd, E); }
            __syncthreads();
            for (int rep2_ = 0; rep2_ < (int)((PROBE_REP >> 20) & 1u) + 1; ++rep2_)
            for (int tile = bid; tile < S / 64; tile += G) {
                FRESH();
                const int t0 = tile * 64;
                LAS bf16_t* Z = (LAS bf16_t*)lds;
                LAS bf16_t* DW = (LAS bf16_t*)(lds + 98304);
                const float* dww = INP(I_DWW) + (size_t)l * 31 * 512;
#pragma unroll
                for (int i0_ = 0; i0_ < 12; ++i0_) { const int i = tid + i0_ * NTHR; if (i >= 94 * 64) break; const int rr = i >> 6, c8 = (i & 63) * 8, s = t0 - 30 + rr; float z[8];
                    if (s >= 0) { const u32x4 aw = *(const u32x4*)(P + (size_t)s * INWP + P_BA + c8), gw4 = *(const u32x4*)(P + (size_t)s * INWP + P_BG + c8); float a[8], g[8]; unpack8(aw, a); unpack8(gw4, g);
#pragma unroll
                        for (int j = 0; j < 8; ++j) z[j] = a[j] * sigmoidf_(g[j]); }
                    else {
#pragma unroll
                        for (int j = 0; j < 8; ++j) z[j] = 0.f; }
                    *(LAS u32x4*)(Z + rr * 512 + c8) = pack8(z); }
                for (int i = tid; i < 31 * 64; i += NTHR) { const int w = i >> 6, c8 = (i & 63) * 8; float v[8];
#pragma unroll
                    for (int j = 0; j < 8; ++j) v[j] = dww[w * 512 + c8 + j];
                    *(LAS u32x4*)(DW + w * 512 + c8) = pack8(v); }
                __syncthreads();
                {   const int c8 = lane * 8; const float* dwb = INP(I_DWB) + l * 512 + c8; const float* lg = INP(I_CLNG) + l * 512 + c8; const float* lb = INP(I_CLNB) + l * 512 + c8;
                    for (int j8 = 0; j8 < 8; ++j8) { const int tau = wave * 8 + j8; float acc[8];
#pragma unroll
                        for (int j = 0; j < 8; ++j) acc[j] = dwb[j];
                        for (int w = 0; w < 31; ++w) { float z[8], k[8]; unpack8(*(const LAS u32x4*)(Z + (tau + w) * 512 + c8), z); unpack8(*(const LAS u32x4*)(DW + w * 512 + c8), k);
#pragma unroll
                            for (int j = 0; j < 8; ++j) acc[j] += z[j] * k[j]; }
                        float sm = 0.f;
#pragma unroll
                        for (int j = 0; j < 8; ++j) sm += acc[j];
                        const float mean = wave_sum(sm) * (1.f / 512.f); float sq = 0.f;
#pragma unroll
                        for (int j = 0; j < 8; ++j) { acc[j] -= mean; sq += acc[j] * acc[j]; }
                        const float rstd = rsqrtf(wave_sum(sq) * (1.f / 512.f) + EPS); float y[8];
#pragma unroll
                        for (int j = 0; j < 8; ++j) { const float v = acc[j] * rstd * lg[j] + lb[j]; y[j] = v * sigmoidf_(v); }
                        *(u32x4*)(ZC + (size_t)(t0 + tau) * 512 + c8) = pack8(y); } }
                __syncthreads();
                { u32x4 tmp_[8];
#pragma unroll
                for (int k_ = 0; k_ < 8; ++k_) { const int i = tid + k_ * NTHR; const int half = i & 1, g = (i >> 1) & 31, tau = i >> 6; tmp_[k_] = *(const u32x4*)(P + (size_t)(t0 + tau) * INWP + P_DU + g * 16 + 8 * half); }
#pragma unroll
                for (int k_ = 0; k_ < 8; ++k_) { const int i = tid + k_ * NTHR; const int half = i & 1, g = (i >> 1) & 31, tau = i >> 6;
                    *(u32x4*)(UA + ((size_t)g * 256 + tile) * 1280 + tau * 16 + 8 * half) = tmp_[k_]; } }
                { const int g = tid >> 4, c = tid & 15; *(u32x4*)(UA + ((size_t)g * 256 + tile) * 1280 + 1152 + 8 * c) = (u32x4){0u, 0u, 0u, 0u}; }
                {   LAS bf16_t* vt = (LAS bf16_t*)(lds + wave * 1024);
                    const int j = lane >> 3, c = lane & 7, r = wave * 8 + j, s = t0 + r; const float* kg = INP(I_SWAKG) + l * 64 + 8 * c;
                    for (int kh = 0; kh < 2; ++kh) {
                        float x[8]; unpack8(*(const u32x4*)(P + (size_t)s * INWP + P_AK + kh * 64 + 8 * c), x); float ss = 0.f;
#pragma unroll
                        for (int e = 0; e < 8; ++e) ss += x[e] * x[e];
                        ss += __shfl_xor(ss, 1); ss += __shfl_xor(ss, 2); ss += __shfl_xor(ss, 4);
                        const float rs = rsqrtf(ss * (1.f / 64.f) + EPS);
#pragma unroll
                        for (int e = 0; e < 8; ++e) x[e] = x[e] * rs * kg[e];
                        *(u32x4*)(SWAK + ((size_t)kh * 256 + tile) * 8192 + r * 128 + kswz<128>(r, c) * 16) = pack8(x);
                        *(LAS u32x4*)(vt + j * 64 + 8 * c) = *(const u32x4*)(P + (size_t)s * INWP + P_AV + kh * 64 + 8 * c);
                        LDS_WAIT();
                        { const int d = lane; float v[8];
#pragma unroll
                            for (int jj = 0; jj < 8; ++jj) v[jj] = bf2f(vt[jj * 64 + d]);
                            *(u32x4*)(SWAV + ((size_t)kh * 256 + tile) * 8192 + d * 128 + vswz(d, wave) * 16) = pack8(v); }
                        LDS_WAIT();
                    } }
                __syncthreads();
            }
            SEAM(2);
        }
        if (IN(3)) for (int rep_ = 0; rep_ < (int)((PROBE_REP >> 3) & 1u) + 1; ++rep_) {
            FRESH();
            {   pg8::GSched Sd{(const char*)ZC, (const char*)PW, (size_t)256 * 512 * 2, (size_t)256 * 512 * 2, 0, 0, S / 256, 2, 1, G, (bid + G / 2) % G};
                pg8::EpiBf16 E{O, D, 512, INP(I_PWB) + l * 512, nullptr};
                pg8::gemm_phase<pg8::EpiBf16, pg8::GSched>(tid, lds, 512, 512, 512, nullptr, Sd, E); }
            {   pg8::GSched Sd{(const char*)UA, (const char*)W1G, 0, 0, (size_t)256 * 1280 * 2, (size_t)256 * 1024 * 2, 1, 1, 32, G, (bid + 128) % G};
                pg8::EpiF32Part<128> E{EBUF, 128, (size_t)256 * 128};
                pg8::gemm_phase<pg8::EpiF32Part<128>, pg8::GSched>(tid, lds, 1024, 1280, 1024, nullptr, Sd, E); }
            {   FRESH(); pg8::MemSched Sm{(const char*)MEMN, (const char*)XWK, G, (bid + G - 160) % G};
                pg8::EpiMem Em{KMEM, VMEM};
                pg8::gemm_phase<pg8::EpiMem, pg8::MemSched>(tid, lds, 512, D, D, nullptr, Sm, Em); }
            __syncthreads();
            for (int tile = bid; tile < S / 64; tile += G) {
                FRESH();
                const int t0 = tile * 64; constexpr float QSCALE = 0.07216878364870322f * LOG2E;
                LAS bf16_t* vt = (LAS bf16_t*)(lds + wave * 8192);
                const float* qnn = INP(I_QNN) + l * 128; const float* qnr = INP(I_QNR) + l * 64; const float* knn = INP(I_KNN) + l * 128; const float* knr = INP(I_KNR) + l * 64;
                for (int j2 = 0; j2 < 8; j2 += 2) {
                    u32x2 wkv_[2]; float xkr_[2], cs_[2], sn_[2]; unsigned wqn_[2][4], wkn_[2][4], wv_[2][4]; float xqr_[2][4];
#pragma unroll
                    for (int u = 0; u < 2; ++u) { const int s = t0 + wave * 8 + j2 + u;
                        wkv_[u] = *(const u32x2*)(P + (size_t)s * INWP + P_CKV + 4 * lane);
                        xkr_[u] = bf2f(P[(size_t)s * INWP + P_CKR + lane]);
                        cs_[u] = ROPE[((size_t)s * 32 + (lane & 31)) * 2]; sn_[u] = ROPE[((size_t)s * 32 + (lane & 31)) * 2 + 1];
#pragma unroll
                        for (int h = 0; h < 4; ++h) { wqn_[u][h] = *(const unsigned*)(QRAW + (size_t)s * 768 + h * 192 + 2 * lane); xqr_[u][h] = bf2f(QRAW[(size_t)s * 768 + h * 192 + 128 + lane]);
                            wkn_[u][h] = *(const unsigned*)(KVRAW + (size_t)s * 1024 + h * 256 + 2 * lane); wv_[u][h] = *(const unsigned*)(KVRAW + (size_t)s * 1024 + h * 256 + 128 + 2 * lane); } }
#pragma unroll
                    for (int u = 0; u < 2; ++u) {
                    const int j = j2 + u, r = wave * 8 + j, s = t0 + r;
                    const u32x2 wkv = wkv_[u]; const float xkr = xkr_[u], cs = cs_[u], sn = sn_[u];
                    unsigned wqn[4], wkn[4], wv[4]; float xqr[4];
#pragma unroll
                    for (int h = 0; h < 4; ++h) { wqn[h] = wqn_[u][h]; wkn[h] = wkn_[u][h]; wv[h] = wv_[u][h]; xqr[h] = xqr_[u][h]; }
                    float ps[14];
                    { const float a = bf2f(wkv.x & 0xffffu), b = bf2f(wkv.x >> 16), c = bf2f(wkv.y & 0xffffu), d = bf2f(wkv.y >> 16); ps[0] = a * a + b * b + c * c + d * d; }
                    ps[1] = xkr * xkr;
#pragma unroll
                    for (int h = 0; h < 4; ++h) { const float a = bf2f(wqn[h] & 0xffffu), b = bf2f(wqn[h] >> 16), c = bf2f(wkn[h] & 0xffffu), d = bf2f(wkn[h] >> 16);
                        ps[2 + 3 * h] = a * a + b * b; ps[3 + 3 * h] = xqr[h] * xqr[h]; ps[4 + 3 * h] = c * c + d * d; }
#pragma unroll
                    for (int o = 1; o < 64; o <<= 1)
#pragma unroll
                        for (int k = 0; k < 14; ++k) ps[k] += __shfl_xor(ps[k], o);
                    const float rkv = rsqrtf(ps[0] * (1.f / 256.f) + EPS);
                    float kr; { const float y = xkr * rsqrtf(ps[1] * (1.f / 64.f) + EPS) * knr[lane]; const float pr = __shfl_xor(y, 32);
                        kr = (lane < 32) ? (y * cs - pr * sn) : (pr * sn + y * cs); }
#pragma unroll
                    for (int h = 0; h < 4; ++h) {
                        { const float a = bf2f(wqn[h] & 0xffffu), b = bf2f(wqn[h] >> 16);
                          const float rs = rsqrtf(ps[2 + 3 * h] * (1.f / 128.f) + EPS);
                          *(unsigned short*)((unsigned char*)Q + ((size_t)h * S + s) * 192 + f8pos(2 * lane)) = (unsigned short)(pk4_fp8(a * rs * qnn[2 * lane], b * rs * qnn[2 * lane + 1], 0.f, 0.f) & 0xffffu); }
                        { const float y = xqr[h] * rsqrtf(ps[3 + 3 * h] * (1.f / 64.f) + EPS) * qnr[lane]; const float pr = __shfl_xor(y, 32);
                          const float qr = ((lane < 32) ? (y * cs - pr * sn) : (pr * sn + y * cs));
                          ((unsigned char*)Q)[((size_t)h * S + s) * 192 + f8pos(128 + lane)] = (unsigned char)(pk4_fp8(qr, 0.f, 0.f, 0.f) & 0xffu); }
                        { const float a = bf2f(wkn[h] & 0xffffu), b = bf2f(wkn[h] >> 16);
                          const float rs = rsqrtf(ps[4 + 3 * h] * (1.f / 128.f) + EPS);
                          unsigned char* kimg = KIMG + ((size_t)h * 256 + tile) * 12288 + r * 192; const int pn_ = f8pos(2 * lane), pr_ = f8pos(128 + lane), sw_ = (r >> 2) & 3;
                          *(unsigned short*)(kimg + (((pn_ >> 4) ^ sw_) << 4) + (pn_ & 15)) = (unsigned short)(pk4_fp8(a * rs * knn[2 * lane], b * rs * knn[2 * lane + 1], 0.f, 0.f) & 0xffffu);
                          kimg[(((pr_ >> 4) ^ sw_) << 4) + (pr_ & 15)] = (unsigned char)(pk4_fp8(kr, 0.f, 0.f, 0.f) & 0xffu); }
                        *(LAS unsigned short*)((LAS unsigned char*)vt + (h * 8 + j) * 128 + 2 * lane) = (unsigned short)(pk4_fp8(bf2f(wv[h] & 0xffffu) * rkv, bf2f(wv[h] >> 16) * rkv, 0.f, 0.f) & 0xffffu);
                    }
                                    }
                }
                LDS_WAIT();
                for (int h = 0; h < 4; ++h)
                    for (int dd = 0; dd < 2; ++dd) { const int d = lane + 64 * dd; const LAS unsigned char* v8 = (const LAS unsigned char*)vt; unsigned lo = 0u, hi4 = 0u;
#pragma unroll
                        for (int jj = 0; jj < 4; ++jj) { lo |= (unsigned)v8[(h * 8 + jj) * 128 + d] << (8 * jj); hi4 |= (unsigned)v8[(h * 8 + 4 + jj) * 128 + d] << (8 * jj); }
                        const int off_ = 32 * (wave >> 2) + 8 * (((wave & 1) << 1) | ((wave >> 1) & 1));
                        *(u32x2*)(VIMG + ((size_t)h * 256 + tile) * 8192 + d * 64 + ((((off_ >> 4) ^ ((d >> 2) & 3))) << 4) + (off_ & 15)) = (u32x2){lo, hi4}; }
                LDS_WAIT();
            }
            __syncthreads();
            {   FRESH(); LAS float* tab = (LAS float*)(lds + 98304);
                const float* relb = INP(I_RELB);
                for (int i = tid; i < 1024; i += NTHR) { const int h = i >> 7, dist = i & 127; tab[i] = relb[T5_BUCKET[dist] * 8 + h] * LOG2E; }
                __syncthreads();
                const int lr = lane & 31, hi = lane >> 5;
                for (int it = bid; it < 128; it += G) {
                    const int kh = it & 1, qb = it >> 1, q0 = qb * 256, wq0 = q0 + 32 * wave, qpos = wq0 + lr;
                    const int t_lo = (4 * qb - 2) < 0 ? 0 : (4 * qb - 2), t_hi = 4 * qb + 4;
                    __syncthreads();
                    for (int t = t_lo; t < t_hi; ++t) { dma_tile<8192>(SWAK + ((size_t)kh * 256 + t) * 8192, lds + (t - t_lo) * 16384, tid, wave); dma_tile<8192>(SWAV + ((size_t)kh * 256 + t) * 8192, lds + (t - t_lo) * 16384 + 8192, tid, wave); }
                    VM_WAIT(); __syncthreads();
#pragma unroll 1
                    for (int g = 0; g < 4; ++g) { const int h = 4 * kh + g;
                        bf16x8 qf[4];
                        if (h < 7) load_q_norm<64>(P + (size_t)qpos * INWP + P_AQ + h * 64, INP(I_SWAQG) + l * 64, 0.125f * LOG2E, hi, qf);
                        else load_q_norm_bf16x4<64>(PQ7 + (size_t)qpos * 64, (size_t)S * 64, INP(I_SWAQG) + l * 64, 0.125f * LOG2E, hi, qf);
                        f32x16 o[2];
#pragma unroll
                        for (int db = 0; db < 2; ++db)
#pragma unroll
                            for (int r = 0; r < 16; ++r) o[db][r] = 0.f;
                        float m_run = -1e30f, l_run = 0.f;
#pragma unroll 1
                        for (int t = t_lo; t < t_hi; ++t) { const int k0 = t * 64;
                            if ((k0 <= wq0 + 31) && (k0 + 63 >= wq0 - 127)) attn_tile_compute<64, 64, 1>(lds + (t - t_lo) * 16384, lds + (t - t_lo) * 16384 + 8192, k0, true, qf, qpos, tab + h * 128, lr, hi, o, m_run, l_run); }
                        { auto rr = __builtin_amdgcn_permlane32_swap(__float_as_uint(l_run), __float_as_uint(l_run), false, false); l_run = __uint_as_float(rr[0]) + __uint_as_float(rr[1]); }
                        l_run += fast_exp2(INP(I_SINK)[l * 8 + h] * LOG2E - m_run);
                        store_o<64>(O + (size_t)qpos * D + h * 64, o, fast_rcp(l_run), hi);
                    }
                }
            }
            SEAM(3);
        }
        if (IN(4)) for (int rep_ = 0; rep_ < (int)((PROBE_REP >> 4) & 1u) + 1; ++rep_) {
            FRESH();
            for (int task = bid; task < 64; task += G) {
                FRESH();
                LAS f32x2* SE = (LAS f32x2*)lds;
                const int sl = tid & 31, seg = tid >> 5, st = task * 32 + sl, g = st >> 6, p = st & 63;
                const float dt = __expf(INP(I_LOGDT)[l * 32 + g]); const float are = INP(I_ARE)[(size_t)(l * 32 + g) * 64 + p], aim = INP(I_AIM)[(size_t)(l * 32 + g) * 64 + p];
                float s_, c_; sincos_rev(aim * dt, s_, c_); const float mag = fast_exp2(are * dt * LOG2E); f32x2 lt = (f32x2){mag * c_, mag * s_};
#pragma unroll
                for (int k = 0; k < 6; ++k) lt = cmul(lt, lt);
                f32x2 e[16];
#pragma unroll
                for (int k = 0; k < 16; ++k) { const size_t off = ((size_t)g * 256 + seg * 16 + k) * 128 + p; e[k] = (f32x2){EBUF[off], EBUF[off + 64]}; }
                f32x2 acc = (f32x2){0.f, 0.f};
#pragma unroll
                for (int k = 0; k < 16; ++k) { const f32x2 t = cmul(lt, acc); acc = (f32x2){t.x + e[k].x, t.y + e[k].y}; }
                SE[sl * 16 + seg] = acc;
                f32x2 l16 = lt;
#pragma unroll
                for (int k = 0; k < 4; ++k) l16 = cmul(l16, l16);
                __syncthreads();
                f32x2 carry = (f32x2){0.f, 0.f};
                for (int k = 0; k < seg; ++k) { const f32x2 t = cmul(l16, carry); const f32x2 se = SE[sl * 16 + k]; carry = (f32x2){t.x + se.x, t.y + se.y}; }
#pragma unroll
                for (int k = 0; k < 16; ++k) { const int c = seg * 16 + k; bf16_t* dst = UA + ((size_t)g * 256 + c) * 1280 + 1024 + p;
                    dst[0] = (bf16_t)(cvt_pk_bf16(carry.x, 0.f) & 0xffffu); dst[64] = (bf16_t)(cvt_pk_bf16(carry.y, 0.f) & 0xffffu);
                    const f32x2 t = cmul(lt, carry); carry = (f32x2){t.x + e[k].x, t.y + e[k].y}; }
                __syncthreads();
            }
            {   FRESH(); const int lr = lane & 31, hi = lane >> 5;
                for (int it = bid; it < 256; it += G) {
                    const int xcd_ = it & 7, il_ = ((xcd_ & 1) << 5) | (it >> 3), h = xcd_ >> 1, j = il_ >> 1, part = il_ & 1;
                    for (int sub = 0; sub <= part; ++sub) {
                        const bool fin = (sub == 1);
                        const int qb = fin ? j : 63 - j;
                        const int t_lo = fin ? 0 : (part ? 130 : 0), t_hi = fin ? 4 * j + 4 : (part ? 4 * (64 - j) : 130);
                        const int q0 = qb * 256, wq0 = q0 + 32 * wave, qpos = wq0 + lr;
                        i64x2 qf[6];
#pragma unroll
                        for (int m = 0; m < 6; ++m) qf[m] = *(const i64x2*)((const unsigned char*)Q + ((size_t)h * S + qpos) * 192 + 32 * m + 16 * hi);
                        f32x16 o[4];
#pragma unroll
                        for (int db = 0; db < 4; ++db)
#pragma unroll
                            for (int r = 0; r < 16; ++r) o[db][r] = 0.f;
                        float m_run = -1e30f, l_run = 0.f;
                        attn_mla_f8(tid, lds, KIMG + (size_t)h * 256 * 12288, VIMG + (size_t)h * 256 * 8192, t_lo, t_hi, qf, qpos, wq0, o, m_run, l_run);
                        { auto rr = __builtin_amdgcn_permlane32_swap(__float_as_uint(l_run), __float_as_uint(l_run), false, false); l_run = __uint_as_float(rr[0]) + __uint_as_float(rr[1]); }
                        int tz = tid; asm volatile("" : "+v"(tz));
                        const int lr2 = tz & 31, hi2 = (tz >> 5) & 1, row2 = q0 + (tz >> 6) * 32 + lr2;
                        if (fin) store_o<128>(O + (size_t)row2 * D + 1024 + h * 128, o, fast_rcp(l_run), hi2);
                        else {
                            const size_t slot = ((size_t)(h * 32 + (qb - 32)) * 2 + part) * 256 + (tz >> 6) * 32 + lr2;
                            float* po = PARTO + slot * 128;
#pragma unroll
                            for (int db = 0; db < 4; ++db)
#pragma unroll
                                for (int r4 = 0; r4 < 4; ++r4) *(f32x4*)(po + 32 * db + 8 * r4 + 4 * hi2) = (f32x4){o[db][4 * r4], o[db][4 * r4 + 1], o[db][4 * r4 + 2], o[db][4 * r4 + 3]};
                            if (hi2 == 0) *(f32x2*)(PARTML + slot * 2) = (f32x2){m_run, l_run};
                        }
                    }
                }
            }
            SEAM(4);
        }
        if (IN(5)) for (int rep_ = 0; rep_ < (int)((PROBE_REP >> 5) & 1u) + 1; ++rep_) {
            FRESH();
            pg8::GSched Sd{(const char*)UA, (const char*)BTY, 0, (size_t)256 * 1280 * 2, (size_t)256 * 1280 * 2, (size_t)1024 * 1280 * 2, 1, 4, 32, G, bid};
            pg8::EpiSsmY E{YG};
            pg8::gemm_phase<pg8::EpiSsmY, pg8::GSched>(tid, lds, 1280, 1280, 1280, nullptr, Sd, E);
            if (G == 256 && bid >= 128) { FRESH(); norm_groups(PT, ws, l, (bid - 128) * NWAVES + wave, 128 * NWAVES, 0, 3, lane); }
            SEAM(5);
        }
        if (IN(6)) for (int rep_ = 0; rep_ < (int)((PROBE_REP >> 6) & 1u) + 1; ++rep_) {
            FRESH();
            pg8::GSched Sd{(const char*)YG, (const char*)GLU, (size_t)256 * 512 * 2, (size_t)256 * 512 * 2, 0, 0, S / 256, 2, 1, G, bid};
            pg8::EpiGlu E{YG, INP(I_GLUB) + l * 512, O};
            pg8::gemm_phase<pg8::EpiGlu, pg8::GSched>(tid, lds, 512, 512, 512, nullptr, Sd, E);
            __syncthreads();
            for (int it = (bid + 32) % G; it < 32; it += G) {
                FRESH();
                const int tile = it >> 3, w8 = it & 7, r = w8 * 8 + wave, mrow = tile * 64 + r;
                LAS bf16_t* vt = (LAS bf16_t*)lds; const float* kg = INP(I_XKG) + l * 128;
                unsigned wk[4]; float ps[4];
#pragma unroll
                for (int h = 0; h < 4; ++h) { float a = 0.f, b = 0.f, va = 0.f, vb = 0.f;
#pragma unroll
                    for (int z = 0; z < 4; ++z) { const unsigned k2 = *(const unsigned*)(KMEM + (size_t)z * 256 * 512 + (size_t)mrow * 512 + h * 128 + 2 * lane), v2 = *(const unsigned*)(VMEM + (size_t)z * 256 * 512 + (size_t)mrow * 512 + h * 128 + 2 * lane);
                        a += bf2f(k2 & 0xffffu); b += bf2f(k2 >> 16); va += bf2f(v2 & 0xffffu); vb += bf2f(v2 >> 16); }
                    wk[h] = cvt_pk_bf16(a, b); a = bf2f(wk[h] & 0xffffu); b = bf2f(wk[h] >> 16); ps[h] = a * a + b * b;
                    *(LAS unsigned*)(vt + (h * 8 + wave) * 128 + 2 * lane) = cvt_pk_bf16(va, vb); }
#pragma unroll
                for (int o = 1; o < 64; o <<= 1)
#pragma unroll
                    for (int h = 0; h < 4; ++h) ps[h] += __shfl_xor(ps[h], o);
#pragma unroll
                for (int h = 0; h < 4; ++h) { const float a = bf2f(wk[h] & 0xffffu), b = bf2f(wk[h] >> 16), rs = rsqrtf(ps[h] * (1.f / 128.f) + EPS);
                    *(unsigned*)(XKIMG + ((size_t)h * 4 + tile) * 16384 + r * 256 + kswz<256>(r, lane >> 2) * 16 + (lane & 3) * 4) = cvt_pk_bf16(a * rs * kg[2 * lane], b * rs * kg[2 * lane + 1]); }
                __syncthreads();
                {   const int h = tid >> 7, d = tid & 127; float v[8];
#pragma unroll
                    for (int jj = 0; jj < 8; ++jj) v[jj] = bf2f(vt[(h * 8 + jj) * 128 + d]);
                    *(u32x4*)(XVIMG + ((size_t)h * 4 + tile) * 16384 + d * 128 + vswz(d, w8) * 16) = pack8(v); }
                __syncthreads();
            }
            SEAM(6);
        }
        if (IN(7)) for (int rep_ = 0; rep_ < (int)((PROBE_REP >> 7) & 1u) + 1; ++rep_) {
            FRESH();
            norm_groups(PT, ws, l, gw, NGW, (G == 256) ? 3 : 0, 4, lane);
            SEAM(7);
        }
        if (IN(8)) for (int rep_ = 0; rep_ < (int)((PROBE_REP >> 8) & 1u) + 1; ++rep_) {
            FRESH();
            pg8::GSched Sd{(const char*)O, (const char*)WOUT, (size_t)256 * D * 2, (size_t)256 * D * 2, 0, 0, S / 256, D / 256, 1, G, bid};
            pg8::EpiResid E{XB, D, nullptr, (((PROBE_REP >> 8) & 1u) != 0u) && rep_ == 0, nullptr};
            pg8::gemm_phase<pg8::EpiResid, pg8::GSched>(tid, lds, D, D, D, nullptr, Sd, E);
            SEAM(8);
        }
        if (IN(10)) for (int rep_ = 0; rep_ < (int)((PROBE_REP >> 10) & 1u) + 1; ++rep_) {
            FRESH();
            pg8::GSched Sd{(const char*)XB, (const char*)XWQ, (size_t)256 * D * 2, (size_t)256 * D * 2, (size_t)1024 * 2, (size_t)1024 * 2, S / 256, 2, 2, G, bid};
            pg8::EpiBf16Z E{(bf16_t*)QXP, 512, (size_t)S * 512};
            pg8::gemm_phase<pg8::EpiBf16Z, pg8::GSched>(tid, lds, 1024, D, D, nullptr, Sd, E);
            SEAM(10);
        }
        if (IN(11)) for (int rep_ = 0; rep_ < (int)((PROBE_REP >> 11) & 1u) + 1; ++rep_) {
            FRESH();
            const int lr = lane & 31, hi = lane >> 5;
            for (int it = bid; it < 256; it += G) {
                const int h = it & 3, qb = it >> 2, wq0 = qb * 256 + 32 * wave, qpos = wq0 + lr;
                bf16x8 qf[8]; load_q_norm_bf16x2<128>((const bf16_t*)QXP + (size_t)qpos * 512 + h * 128, (const bf16_t*)QXP + (size_t)S * 512 + (size_t)qpos * 512 + h * 128, INP(I_XQG) + l * 128, 0.08838834764831845f * LOG2E, hi, qf);
                f32x16 o[4];
#pragma unroll
                for (int db = 0; db < 4; ++db)
#pragma unroll
                    for (int r = 0; r < 16; ++r) o[db][r] = 0.f;
                float m_run = -1e30f, l_run = 0.f;
                attn_tiles<128, 128, 2>(tid, lds, XKIMG + (size_t)h * 4 * 16384, XVIMG + (size_t)h * 4 * 16384, 0, 4, qf, qpos, wq0, nullptr, o, m_run, l_run);
                { auto rr = __builtin_amdgcn_permlane32_swap(__float_as_uint(l_run), __float_as_uint(l_run), false, false); l_run = __uint_as_float(rr[0]) + __uint_as_float(rr[1]); }
                store_o<128>(OX + (size_t)qpos * 512 + h * 128, o, fast_rcp(l_run), hi);
            }
            SEAM(11);
        }
        if (IN(12)) for (int rep_ = 0; rep_ < (int)((PROBE_REP >> 12) & 1u) + 1; ++rep_) {
            FRESH();
            pg8::GSched Sd{(const char*)OX, (const char*)XWO, (size_t)256 * 512 * 2, (size_t)256 * 512 * 2, 0, 0, S / 256, D / 256, 1, G, bid};
            pg8::EpiResid E{XB, D, SSP, (((PROBE_REP >> 12) & 1u) != 0u) && rep_ == 0, XF8};
            pg8::gemm_phase<pg8::EpiResid, pg8::GSched>(tid, lds, 512, 512, 512, nullptr, Sd, E);
            SEAM(12);
        }
        if (IN(14)) for (int rep_ = 0; rep_ < (int)((PROBE_REP >> 14) & 1u) + 1; ++rep_) {
            FRESH();
            pg8::GSched Sd{(const char*)XB, (const char*)ROUT, (size_t)256 * D * 2, 0, (size_t)512 * 2, (size_t)512 * 2, S / 256, 1, 4, G, bid};
            pg8::EpiF32Part<64> E{LOGP, 64, (size_t)S * 64};
            pg8::gemm_phase<pg8::EpiF32Part<64>, pg8::GSched>(tid, lds, 512, D, D, nullptr, Sd, E);
            SEAM(14);
        }
        if (IN(15)) for (int rep_ = 0; rep_ < (int)((PROBE_REP >> 15) & 1u) + 1; ++rep_) {
            FRESH();
            for (int i = bid * NTHR + tid; i < NSLOT; i += G * NTHR) { TOK[i] = S; WSLOT[i] = 0.f; }
            if (bid == 0 && tid == 0) RMSV[S] = 0.f;
            LAS unsigned* hist = (LAS unsigned*)lds; LAS unsigned* base = hist + 32;
            const float* bg = INP(I_BG) + l * 4; const float* be = INP(I_BE) + l * 32;
            for (int blk = bid; blk < S / 64; blk += G) {
                if (tid < 64) hist[tid] = 0u;
                __syncthreads();
                int e0 = 0, e1 = 0; unsigned r0 = 0, r1 = 0; float w0 = 0.f, w1 = 0.f; const int s = blk * 64 + tid;
                if (tid < 64) {
                    float ssq = 0.f;
#pragma unroll
                    for (int j4 = 0; j4 < 8; ++j4) { const f32x4 a = *(const f32x4*)(SSP + (size_t)s * 32 + 4 * j4); ssq += (a[0] + a[1]) + (a[2] + a[3]); }
                    const float rms = rsqrtf(ssq * (1.0f / D) + EPS); RMSV[s] = rms;
                    float lg[36];
#pragma unroll
                    for (int j4 = 0; j4 < 9; ++j4) { f32x4 a = *(const f32x4*)(LOGP + (size_t)s * 64 + 4 * j4);
#pragma unroll
                        for (int z = 1; z < 4; ++z) a += *(const f32x4*)(LOGP + (size_t)z * S * 64 + (size_t)s * 64 + 4 * j4);
                        lg[4 * j4] = a[0] * rms; lg[4 * j4 + 1] = a[1] * rms; lg[4 * j4 + 2] = a[2] * rms; lg[4 * j4 + 3] = a[3] * rms; }
                    float gl[4]; int gi = 0; float gm;
#pragma unroll
                    for (int j = 0; j < 4; ++j) gl[j] = lg[j] + bg[j];
                    gm = gl[0];
#pragma unroll
                    for (int j = 1; j < 4; ++j) if (gl[j] > gm) { gm = gl[j]; gi = j; }
                    float gs = 0.f;
#pragma unroll
                    for (int j = 0; j < 4; ++j) gs += __expf(gl[j] - gm);
                    const float gwt = 1.f / gs;
                    float v0 = -__builtin_inff(), v1 = -__builtin_inff(); int i0 = 0, i1 = 0;
#pragma unroll
                    for (int j = 0; j < 8; ++j) { const float lv = (gi == 0) ? lg[4 + j] : (gi == 1) ? lg[12 + j] : (gi == 2) ? lg[20 + j] : lg[28 + j]; const float v = lv + be[gi * 8 + j];
                        if (v > v0) { v1 = v0; i1 = i0; v0 = v; i0 = j; } else if (v > v1) { v1 = v; i1 = j; } }
                    const float ee = __expf(v1 - v0), den = 1.f / (1.f + ee);
                    w0 = gwt * den; w1 = gwt * ee * den; e0 = gi * 8 + i0; e1 = gi * 8 + i1;
                    r0 = __hip_atomic_fetch_add(&hist[e0], 1u, __ATOMIC_RELAXED, __HIP_MEMORY_SCOPE_WORKGROUP); r1 = __hip_atomic_fetch_add(&hist[e1], 1u, __ATOMIC_RELAXED, __HIP_MEMORY_SCOPE_WORKGROUP);
                }
                __syncthreads();
                if (tid < 32) { const unsigned c = hist[tid]; base[tid] = c ? __hip_atomic_fetch_add(ctl + CW_CNT + 64 * l + tid, c, __ATOMIC_RELAXED, __HIP_MEMORY_SCOPE_AGENT) : 0u; }
                __syncthreads();
                if (tid < 64) { REC_E[2 * s] = e0; REC_E[2 * s + 1] = e1; REC_R[2 * s] = (int)(base[e0] + r0); REC_R[2 * s + 1] = (int)(base[e1] + r1); REC_W[2 * s] = w0; REC_W[2 * s + 1] = w1; }
                __syncthreads();
            }
            SEAM(15);
        }
        if (IN(16) || IN(17) || IN(18)) {
            FRESH();
            LAS int* pst = (LAS int*)(CTLW + 16);
            if (tid == 0) { int acc = 0; for (int e = 0; e < 32; ++e) { pst[e] = acc; const int c = (int)__hip_atomic_load(ctl + CW_CNT + 64 * l + e, __ATOMIC_RELAXED, __HIP_MEMORY_SCOPE_AGENT); acc += (c + 255) & ~255; } pst[32] = acc; }
            __syncthreads();
            if (tid < 160) { int e = 0; for (int k = 1; k < 32; ++k) if (pst[k] <= tid * 256) e = k; ((LAS int*)(CTLW + 256))[tid] = e; }
            __syncthreads();
        }
        if (IN(16)) for (int rep_ = 0; rep_ < (int)((PROBE_REP >> 16) & 1u) + 1; ++rep_) {
            FRESH();
            const LAS int* pst = (const LAS int*)(CTLW + 16);
            for (int i = bid * NTHR + tid; i < 2 * S; i += G * NTHR) { const int slot = pst[REC_E[i]] + REC_R[i]; TOK[slot] = i >> 1; WSLOT[slot] = REC_W[i]; REC_S[i] = slot; }
            SEAM(16);
        }
        if (IN(17)) for (int rep_ = 0; rep_ < (int)((PROBE_REP >> 17) & 1u) + 1; ++rep_) {
            FRESH();
            pg8::MoeSched Sd{(const LAS int*)(CTLW + 16), (const char*)MOE1F, TOK, (size_t)1024 * D, (size_t)256 * D, 4, G, bid, 1};
            pg8::EpiMoe1 E{HID8, TOK, RMSV};
            pg8::gemm_phase<pg8::EpiMoe1, pg8::MoeSched, true, true>(tid, lds, D / 2, D / 2, D / 2, (const char*)XF8, Sd, E);
            SEAM(17);
        }
        if (IN(18)) for (int rep_ = 0; rep_ < (int)((PROBE_REP >> 18) & 1u) + 1; ++rep_) {
            {   FRESH();
                pg8::MoeSched Sd{(const LAS int*)(CTLW + 16), (const char*)MOE1F, TOK, (size_t)1024 * D, (size_t)256 * D, 4, G, bid, 2};
                pg8::EpiMoe1 E{HID8, TOK, RMSV};
                pg8::gemm_phase<pg8::EpiMoe1, pg8::MoeSched, true, true>(tid, lds, D / 2, D / 2, D / 2, (const char*)XF8, Sd, E); }
            {   FRESH();
                pg8::MoeSched2 Sd{(const LAS int*)(CTLW + 16), (const char*)HID8, (const char*)MOE2F, (size_t)D * 512, (size_t)256 * 512, 8, G, bid, 1};
                pg8::EpiMoe2 E{YS8, WSLOT};
                pg8::gemm_phase<pg8::EpiMoe2, pg8::MoeSched2, false, true>(tid, lds, 256, 256, 256, nullptr, Sd, E); }
            {   FRESH(); GRID_BAR(); }
            {   FRESH();
                pg8::MoeSched2 Sd{(const LAS int*)(CTLW + 16), (const char*)HID8, (const char*)MOE2F, (size_t)D * 512, (size_t)256 * 512, 8, G, bid, 2};
                pg8::EpiMoe2 E{YS8, WSLOT};
                pg8::gemm_phase<pg8::EpiMoe2, pg8::MoeSched2, false, true>(tid, lds, 256, 256, 256, nullptr, Sd, E); }
            {   FRESH(); SEAM(18); }
        }
}

__global__ void __launch_bounds__(NTHR, 2) fwd_kernel(Args args) {
    extern __shared__ __attribute__((aligned(16))) unsigned char lds_raw[];
    LAS unsigned char* lds0 = (LAS unsigned char*)lds_raw;
    {   int t0 = threadIdx.x; asm volatile("" : "+v"(t0));
        for (int u = t0; u < (LDS_BYTES - LDSCTL_OFF) / 4; u += NTHR) ((LAS unsigned*)(lds0 + LDSCTL_OFF))[u] = 0u;
        __syncthreads();
        if (t0 == 0) { LAS unsigned long long* pw = (LAS unsigned long long*)(lds0 + LDSCTL_OFF + 512);
#pragma unroll
            for (int i = 0; i < 50; ++i) pw[i] = (unsigned long long)args.in[i];
            pw[50] = (unsigned long long)args.ws; pw[51] = (unsigned long long)args.out; }
        __syncthreads();
#if !MK_MULTI
        if (t0 == 0) (void)xb_add(&((unsigned*)args.ws)[CW_BAR + XB_XCNT(xb_xcc_id())], 1u);
#endif
    }
    const int ph_lo = args.ph_lo, ph_hi = args.ph_hi;
    int wave_s = __builtin_amdgcn_readfirstlane(threadIdx.x >> 6); asm volatile("" : "+s"(wave_s));
#if MK_MULTI
    if (args.l_lo < NL) layer_body<0>(args.l_lo, wave_s, lds0, ph_lo, ph_hi);
#else
    layer_body<0>(0, wave_s, lds0, ph_lo, ph_hi);
    layer_body<1>(1, wave_s, lds0, ph_lo, ph_hi);
    layer_body<2>(2, wave_s, lds0, ph_lo, ph_hi);
    layer_body<3>(3, wave_s, lds0, ph_lo, ph_hi);
#endif
    if (args.l_hi > NL) {
        FRESH();
        for (int s = gw; s < S; s += NGW) { const int s0 = REC_S[2 * s], s1 = REC_S[2 * s + 1];
#pragma unroll
            for (int j = 0; j < 4; ++j) { float x[8], ya[8], yb[8]; unpack8(*(const u32x4*)(XB + (size_t)s * D + 8 * lane + 512 * j), x);
                unpack8_fp8(*(const u32x2*)(YS8 + (size_t)s0 * D + 8 * lane + 512 * j), ya); unpack8_fp8(*(const u32x2*)(YS8 + (size_t)s1 * D + 8 * lane + 512 * j), yb);
#pragma unroll
                for (int e = 0; e < 8; ++e) x[e] += (ya[e] + yb[e]) * 0.0625f;
                *(f32x4*)(X + (size_t)s * D + 8 * lane + 512 * j) = (f32x4){x[0], x[1], x[2], x[3]};
                *(f32x4*)(X + (size_t)s * D + 8 * lane + 512 * j + 4) = (f32x4){x[4], x[5], x[6], x[7]}; } }
    }
}

extern "C" void kernel_launch(void* const* d_in, const int* in_sizes, int n_in, void* d_out, int out_size, void* d_ws, size_t ws_size, hipStream_t stream) {
    static int grid = 0;
    if (grid == 0) {
        if (n_in != 50 || out_size != S * D || ws_size < WS_END) { fprintf(stderr, "kernel_launch: unexpected shapes (n_in %d, out %d, ws %zu < %zu)\n", n_in, out_size, ws_size, (size_t)WS_END); grid = -1; return; }
        int dev = 0, cus = 0, per_cu = 0;
        if (hipGetDevice(&dev) != hipSuccess || hipDeviceGetAttribute(&cus, hipDeviceAttributeMultiprocessorCount, dev) != hipSuccess) { grid = -1; return; }
        if (hipFuncSetAttribute((const void*)fwd_kernel, hipFuncAttributeMaxDynamicSharedMemorySize, LDS_BYTES) != hipSuccess) { fprintf(stderr, "kernel_launch: hipFuncSetAttribute failed\n"); grid = -1; return; }
        if (hipOccupancyMaxActiveBlocksPerMultiprocessor(&per_cu, (const void*)fwd_kernel, NTHR, LDS_BYTES) != hipSuccess || per_cu < 1) { fprintf(stderr, "kernel_launch: occupancy query says %d\n", per_cu); }
        (void)hipGetLastError();
        grid = cus;
    }
    if (grid < 0) return;
    (void)in_sizes;
    if (hipMemsetAsync((char*)d_ws + WS_CTL, 0, CTL_ZERO_BYTES, stream) != hipSuccess) return;
    Args a{};
    for (int i = 0; i < 50; ++i) a.in[i] = (const float*)d_in[i];
    a.out = (float*)d_out; a.ws = (unsigned char*)d_ws;
#if MK_MULTI
    for (int l = 0; l < NL; ++l)
        for (int ph = 0; ph < NPH; ++ph) { a.l_lo = l; a.l_hi = l + 1; a.ph_lo = ph; a.ph_hi = ph + 1; hipLaunchKernelGGL(fwd_kernel, dim3(grid), dim3(NTHR), LDS_BYTES, stream, a); }
    a.l_lo = NL; a.l_hi = NL + 1; a.ph_lo = 0; a.ph_hi = 0; hipLaunchKernelGGL(fwd_kernel, dim3(grid), dim3(NTHR), LDS_BYTES, stream, a);
#else
    a.l_lo = 0; a.l_hi = NL + 1; a.ph_lo = 0; a.ph_hi = NPH;
    hipLaunchKernelGGL(fwd_kernel, dim3(grid), dim3(NTHR), LDS_BYTES, stream, a);
#endif
    const hipError_t le = hipPeekAtLastError();
    if (le != hipSuccess) fprintf(stderr, "kernel_launch: launch failed: %s\n", hipGetErrorName(le));
}
```

```cpp
#include <hip/hip_runtime.h>
#include <cstdio>
#include <cstdint>

#ifndef MK_MULTI
#define MK_MULTI 0
#endif

#define LAS __attribute__((address_space(3)))
#define GAS __attribute__((address_space(1)))
typedef unsigned short bf16_t;
typedef short bf16x8 __attribute__((ext_vector_type(8)));
typedef float f32x4 __attribute__((ext_vector_type(4)));
typedef float f32x2 __attribute__((ext_vector_type(2)));
typedef float f32x16 __attribute__((ext_vector_type(16)));
typedef unsigned u32x4 __attribute__((ext_vector_type(4)));
typedef unsigned u32x2 __attribute__((ext_vector_type(2)));

constexpr int S = 16384, D = 2048, NL = 4, INW = 3136, INWP = 3200, WINR = 3328;
constexpr int MEMT = 256;
constexpr int NSLOT = 40960;
constexpr float EPS = 1e-6f;
constexpr float LOG2E = 1.4426950408889634f;
constexpr int P_AQ = 0, P_AK = 448, P_AV = 576, P_BA = 704, P_BG = 1216, P_CQ = 1728, P_CKV = 2240, P_CKR = 2496, P_DU = 2560;

constexpr size_t MiB = 1u << 20;
constexpr size_t WS_CTL = 0, CTL_ZERO_BYTES = 1 * MiB;
constexpr size_t WS_ROPE = 1 * MiB;
constexpr size_t WS_H = WS_ROPE + 4 * MiB;
constexpr size_t WS_P = WS_H + 65 * MiB;
constexpr size_t WS_O = WS_P + 104 * MiB;
constexpr size_t WS_QRAW = WS_O + 64 * MiB;
constexpr size_t WS_KVRAW = WS_QRAW + 24 * MiB;
constexpr size_t WS_Q = WS_KVRAW + 32 * MiB;
constexpr size_t WS_KIMG = WS_Q + 24 * MiB;
constexpr size_t WS_VIMG = WS_KIMG + 24 * MiB;
constexpr size_t WS_SWAK = WS_VIMG + 16 * MiB;
constexpr size_t WS_SWAV = WS_SWAK + 4 * MiB;
constexpr size_t WS_ZC = WS_SWAV + 4 * MiB;
constexpr size_t WS_UA = WS_ZC + 16 * MiB;
constexpr size_t WS_EBUF = WS_UA + 20 * MiB;
constexpr size_t WS_YG = WS_EBUF + 4 * MiB;
constexpr size_t WS_QX = WS_YG + 16 * MiB;
constexpr size_t WS_OX = WS_QX + 16 * MiB;
constexpr size_t WS_MEMN = WS_OX + 16 * MiB;
constexpr size_t WS_KMEM = WS_MEMN + 1 * MiB;
constexpr size_t WS_VMEM = WS_KMEM + 1 * MiB;
constexpr size_t WS_XKIMG = WS_VMEM + 1 * MiB;
constexpr size_t WS_XVIMG = WS_XKIMG + 1 * MiB;
constexpr size_t WS_LOG = WS_XVIMG + 1 * MiB;
constexpr size_t WS_REC = WS_LOG + 4 * MiB;
constexpr size_t WS_TOK = WS_REC + 1 * MiB;
constexpr size_t WS_WSLOT = WS_TOK + 1 * MiB;
constexpr size_t WS_HID = WS_WSLOT + 1 * MiB;
constexpr size_t WS_YS = WS_HID + 40 * MiB;
constexpr size_t WS_WIN = WS_YS + 160 * MiB;
constexpr size_t WS_WOUT = WS_WIN + 13 * MiB;
constexpr size_t WS_XWQ = WS_WOUT + 8 * MiB;
constexpr size_t WS_XWK = WS_XWQ + 2 * MiB;
constexpr size_t WS_XWV = WS_XWK + 2 * MiB;
constexpr size_t WS_XWO = WS_XWV + 2 * MiB;
constexpr size_t WS_PW = WS_XWO + 2 * MiB;
constexpr size_t WS_WQB = WS_PW + 1 * MiB;
constexpr size_t WS_WKVB = WS_WQB + 1 * MiB;
constexpr size_t WS_GLU = WS_WKVB + 1 * MiB;
constexpr size_t WS_ROUT = WS_GLU + 1 * MiB;
constexpr size_t WS_MOE1 = WS_ROUT + 1 * MiB;
constexpr size_t WS_MOE2 = WS_MOE1 + 128 * MiB;
constexpr size_t WS_W1G = WS_MOE2 + 64 * MiB;
constexpr size_t WS_BTY = WS_W1G + 16 * MiB;
constexpr size_t WS_PARTO = WS_BTY + 80 * MiB;
constexpr size_t WS_PARTML = WS_PARTO + 32 * MiB;
constexpr size_t WS_XB = WS_PARTML + 1 * MiB;
constexpr size_t WS_QXP = WS_XB + 65 * MiB;
constexpr size_t WS_LOGP = WS_QXP + 64 * MiB;
constexpr size_t WS_SSP = WS_LOGP + 16 * MiB;
constexpr size_t WS_RMSV = WS_SSP + 2 * MiB;
constexpr size_t WS_RMS1 = WS_RMSV + 1 * MiB;
constexpr size_t WS_XF8 = WS_RMS1 + 1 * MiB;
constexpr size_t WS_END = WS_XF8 + 33 * MiB;
constexpr int CW_BAR = 4096;
constexpr int CW_SS = 32768;
constexpr int CW_CNT = 16384;

constexpr int RING_BYTES = 131072;
constexpr int LDSCTL_OFF = RING_BYTES;
constexpr int LDS_BYTES = 147456;
constexpr int NWAVES = 8, NTHR = 512;

__device__ __forceinline__ float bf2f(unsigned b) { return __uint_as_float(b << 16); }
typedef __bf16 bf16x2_t __attribute__((ext_vector_type(2)));
__device__ __forceinline__ unsigned cvt_pk_bf16(float lo, float hi) { const f32x2 v = {lo, hi}; const bf16x2_t b = __builtin_convertvector(v, bf16x2_t); return __builtin_bit_cast(unsigned, b); }
__device__ __forceinline__ float wave_sum(float v) {
#pragma unroll
    for (int o = 1; o < 64; o <<= 1) v += __shfl_xor(v, o);
    return v;
}
__device__ __forceinline__ float fast_exp2(float x) { return __builtin_amdgcn_exp2f(x); }
__device__ __forceinline__ float fast_rcp(float x) { return __builtin_amdgcn_rcpf(x); }
__device__ __forceinline__ float sigmoidf_(float x) { return fast_rcp(1.f + fast_exp2(-x * LOG2E)); }
__device__ __forceinline__ void unpack8(const u32x4 w, float (&f)[8]) {
    f[0] = bf2f(w.x & 0xffffu); f[1] = bf2f(w.x >> 16); f[2] = bf2f(w.y & 0xffffu); f[3] = bf2f(w.y >> 16);
    f[4] = bf2f(w.z & 0xffffu); f[5] = bf2f(w.z >> 16); f[6] = bf2f(w.w & 0xffffu); f[7] = bf2f(w.w >> 16);
}
__device__ __forceinline__ u32x4 pack8(const float (&f)[8]) { u32x4 w; w.x = cvt_pk_bf16(f[0], f[1]); w.y = cvt_pk_bf16(f[2], f[3]); w.z = cvt_pk_bf16(f[4], f[5]); w.w = cvt_pk_bf16(f[6], f[7]); return w; }
__device__ __forceinline__ unsigned pk4_fp8(float a, float b, float c, float d) { int w = __builtin_amdgcn_cvt_pk_fp8_f32(a, b, 0, false); w = __builtin_amdgcn_cvt_pk_fp8_f32(c, d, w, true); return (unsigned)w; }
__device__ __forceinline__ void unpack8_fp8(const u32x2 w, float (&f)[8]) { const f32x2 a = __builtin_amdgcn_cvt_pk_f32_fp8(w.x, false), b = __builtin_amdgcn_cvt_pk_f32_fp8(w.x, true), c = __builtin_amdgcn_cvt_pk_f32_fp8(w.y, false), d = __builtin_amdgcn_cvt_pk_f32_fp8(w.y, true);
    f[0] = a.x; f[1] = a.y; f[2] = b.x; f[3] = b.y; f[4] = c.x; f[5] = c.y; f[6] = d.x; f[7] = d.y; }
#define LDS_WAIT() asm volatile("s_waitcnt lgkmcnt(0)" ::: "memory")
#define VM_WAIT() asm volatile("s_waitcnt vmcnt(0)" ::: "memory")

namespace pg8 {
constexpr int BM = 256, BK = 64, HALF = 128, HTB = HALF * BK * 2, STAGE_BYTES = 8 * HTB, NXCD = 8, WGM = 8;
__host__ __device__ __forceinline__ int lds_byte(int r, int c) { const int st = (r >> 4) * 2 + (c >> 5), rr = r & 15, cc = c & 31, ob = rr * 64 + cc * 2; return st * 1024 + (ob ^ (((ob >> 9) & 1) << 5)); }
__host__ __device__ __forceinline__ void stage_rc(int b, int& R, int& C) { const int st = b / 1024, sb = b % 1024, swz = sb ^ (((sb >> 9) & 1) << 5); R = (st >> 1) * 16 + swz / 64; C = (st & 1) * 32 + (swz % 64) / 2; }
__host__ __device__ __forceinline__ int perm32(int rho) { const int n = rho >> 4, i = rho & 15; return 8 * (i >> 2) + 4 * n + (i & 3); }

struct Unit { int pm, pn, z; const char* a; const char* b; const int* rows; };

struct GSched {
    const char* A; const char* B; size_t aTile, bTile, aZ, bZ; int nM, nN, nZ, G, c;
    __device__ __forceinline__ bool next(int i, Unit& u) const {
        const int nwg = nM * nN; const long L = (long)i * G + c; if (L >= (long)nwg * nZ) return false;
        const int z = (int)(L / nwg); int wgid = (int)(L - (long)z * nwg);
        { const int q = nwg / NXCD, r = nwg % NXCD, xcd = wgid % NXCD, off = wgid / NXCD; wgid = (xcd < r ? xcd * (q + 1) : r * (q + 1) + (xcd - r) * q) + off; }
        const int nig = WGM * nN, gid = wgid / nig, fm = gid * WGM, gsz = (nM - fm) < WGM ? (nM - fm) : WGM;
        u.pm = fm + ((wgid % nig) % gsz); u.pn = (wgid % nig) / gsz; u.z = z;
        u.a = A + (size_t)z * aZ + (size_t)u.pm * aTile; u.b = B + (size_t)z * bZ + (size_t)u.pn * bTile; u.rows = nullptr; return true;
    }
};

template <class Epi, class Sched, bool GATHER = false, bool F8 = false>
__device__ __forceinline__ void gemm_phase(const int tid_in, LAS unsigned char* lds, const int K, const int lda, const int ldb, const char* Abase, const Sched& S, const Epi& E) {
    int tid = tid_in; asm volatile("" : "+v"(tid));
    const int wid = __builtin_amdgcn_readfirstlane(tid >> 6), lane = tid & 63, wr = wid >> 2, wc = wid & 3, fr = lane & 15, fq = lane >> 4;
    const int nt = K / BK;
    unsigned voffA[2], voffB[2]; int rA[2], cA2[2];
#pragma unroll
    for (int i = 0; i < 2; ++i) { int R, C; stage_rc(tid * 16 + i * 8192, R, C); const int Rb = Epi::PERM ? ((R & ~31) + perm32(R & 31)) : R;
        voffA[i] = (unsigned)(R * lda + C) * 2u; voffB[i] = (unsigned)(Rb * ldb + C) * 2u; rA[i] = R; cA2[i] = C * 2; }
    const size_t kstep = (size_t)(BK * 2);
    const size_t hstepA = (size_t)HALF * lda * 2, hstepB = (size_t)HALF * ldb * 2;
    const unsigned ldsw = (unsigned)wid * 1024u;
    const int aoff = lds_byte(wr * 64 + fr, fq * 8), boff = lds_byte(wc * 32 + fr, fq * 8);
#define PG8_SA(b, h) (((b) * 2 + (h)) * HTB)
#define PG8_SB(b, h) ((4 + (b) * 2 + (h)) * HTB)
#define PG8_STAGE(bufoff, gbase, voff) do { _Pragma("unroll") for (int _i = 0; _i < 2; ++_i) \
        __builtin_amdgcn_global_load_lds((const unsigned*)((const char*)(gbase) + (voff)[_i]), (LAS unsigned*)(lds + (bufoff) + ldsw + _i * 8192), 16, 0, 0); } while (0)
#define PG8_LDA(dst, b, h) do { _Pragma("unroll") for (int m = 0; m < 4; ++m) _Pragma("unroll") for (int k = 0; k < 2; ++k) dst[m][k] = *(const LAS bf16x8*)(lds + PG8_SA(b, h) + aoff + m * 2048 + k * 1024); } while (0)
#define PG8_LDB(dst, b, h) do { _Pragma("unroll") for (int n = 0; n < 2; ++n) _Pragma("unroll") for (int k = 0; k < 2; ++k) dst[n][k] = *(const LAS bf16x8*)(lds + PG8_SB(b, h) + boff + n * 2048 + k * 1024); } while (0)
typedef long pg8_i64x2 __attribute__((ext_vector_type(2)));
#define PG8_MMA(ai, bj, At, Bt) do { __builtin_amdgcn_s_setprio(1); _Pragma("unroll") for (int m = 0; m < 4; ++m) _Pragma("unroll") for (int n = 0; n < 2; ++n) _Pragma("unroll") for (int k = 0; k < 2; ++k) { \
        if constexpr (F8) {   \
            const pg8_i64x2 a_ = __builtin_bit_cast(pg8_i64x2, At[m][k]), b_ = __builtin_bit_cast(pg8_i64x2, Bt[n][k]); \
            acc[ai][bj][m][n] = __builtin_amdgcn_mfma_f32_16x16x32_fp8_fp8(b_.x, a_.x, acc[ai][bj][m][n], 0, 0, 0); \
            acc[ai][bj][m][n] = __builtin_amdgcn_mfma_f32_16x16x32_fp8_fp8(b_.y, a_.y, acc[ai][bj][m][n], 0, 0, 0); \
        } else acc[ai][bj][m][n] = __builtin_amdgcn_mfma_f32_16x16x32_bf16(Bt[n][k], At[m][k], acc[ai][bj][m][n], 0, 0, 0); } \
        __builtin_amdgcn_s_setprio(0); } while (0)
#define PG8_WAIT_V(n) asm volatile("s_waitcnt vmcnt(" #n ")" ::: "memory")
#define PG8_WAIT_L(n) asm volatile("s_waitcnt lgkmcnt(" #n ")" ::: "memory")
#define PG8_BAR __builtin_amdgcn_s_barrier()
#define PG8_SCHED __builtin_amdgcn_sched_barrier(0)
    Unit cur, nxt; int ui = 0;
    if (!S.next(0, cur)) return;
    f32x4 acc[2][2][4][2];
#pragma unroll
    for (int a = 0; a < 2; ++a)
#pragma unroll
        for (int b = 0; b < 2; ++b)
#pragma unroll
            for (int m = 0; m < 4; ++m)
#pragma unroll
                for (int n = 0; n < 2; ++n) acc[a][b][m][n] = (f32x4){0.f, 0.f, 0.f, 0.f};
    bf16x8 At[4][2], B0[2][2], B1[2][2];
    unsigned gc0[2], gc1[2], gn0[2], gn1[2];
    const char* cA = GATHER ? Abase : cur.a; const char* cB = cur.b;
    if constexpr (GATHER) {
#pragma unroll
        for (int i = 0; i < 2; ++i) { gc0[i] = (unsigned)cur.rows[rA[i]] * (unsigned)(lda * 2) + (unsigned)cA2[i]; gc1[i] = (unsigned)cur.rows[HALF + rA[i]] * (unsigned)(lda * 2) + (unsigned)cA2[i]; gn0[i] = gc0[i]; gn1[i] = gc1[i]; }
    }
#define PG8_STAGE_A(bufoff, h, ptr, usenext) do { if constexpr (GATHER) { if (usenext) { if ((h) == 0) PG8_STAGE(bufoff, ptr, gn0); else PG8_STAGE(bufoff, ptr, gn1); } else { if ((h) == 0) PG8_STAGE(bufoff, ptr, gc0); else PG8_STAGE(bufoff, ptr, gc1); } } \
        else { PG8_STAGE(bufoff, (ptr) + ((h) ? hstepA : 0), voffA); } } while (0)
    PG8_STAGE(PG8_SB(0, 0), cB, voffB); PG8_STAGE(PG8_SB(0, 1), cB + hstepB, voffB); PG8_STAGE_A(PG8_SA(0, 0), 0, cA, false); PG8_STAGE_A(PG8_SA(0, 1), 1, cA, false);
    if (wr == 1) PG8_BAR;
    PG8_WAIT_V(2); PG8_BAR;
    PG8_STAGE(PG8_SB(1, 0), cB + kstep, voffB); PG8_STAGE_A(PG8_SA(1, 0), 0, cA + kstep, false); PG8_STAGE(PG8_SB(1, 1), cB + hstepB + kstep, voffB);
    PG8_WAIT_V(6); PG8_BAR;
    for (;;) {
        const bool has_next = S.next(ui + 1, nxt);
        const char* nA = GATHER ? Abase : (has_next ? nxt.a : cA); const char* nB = has_next ? nxt.b : cB;
        if constexpr (GATHER) {
            if (has_next) {
#pragma unroll
                for (int i = 0; i < 2; ++i) { gn0[i] = (unsigned)nxt.rows[rA[i]] * (unsigned)(lda * 2) + (unsigned)cA2[i]; gn1[i] = (unsigned)nxt.rows[HALF + rA[i]] * (unsigned)(lda * 2) + (unsigned)cA2[i]; }
            } else {
#pragma unroll
                for (int i = 0; i < 2; ++i) { gn0[i] = gc0[i]; gn1[i] = gc1[i]; }
            }
        }
#pragma unroll 1
        for (int t = 0; t < nt; t += 2) {
            const bool last = (t == nt - 2);
            const char* a1 = cA + (size_t)(t + 1) * kstep;
            const char* a2 = last ? nA : cA + (size_t)(t + 2) * kstep; const char* b2 = last ? nB : cB + (size_t)(t + 2) * kstep;
            const char* a3 = a2 + kstep; const char* b3 = b2 + kstep;
            PG8_LDB(B0, 0, 0); PG8_LDB(B1, 0, 1); PG8_SCHED; PG8_LDA(At, 0, 0); PG8_STAGE_A(PG8_SA(1, 1), 1, a1, false);
            PG8_WAIT_V(8); PG8_WAIT_L(0); PG8_BAR; PG8_MMA(0, 0, At, B0); PG8_MMA(0, 1, At, B1); PG8_BAR; PG8_SCHED;
            PG8_LDA(At, 0, 1); PG8_STAGE(PG8_SB(0, 0), b2, voffB); PG8_STAGE(PG8_SB(0, 1), b2 + hstepB, voffB); PG8_STAGE_A(PG8_SA(0, 0), 0, a2, last);
            PG8_WAIT_V(8); PG8_WAIT_L(0); PG8_BAR; PG8_MMA(1, 0, At, B0); PG8_MMA(1, 1, At, B1); PG8_BAR; PG8_SCHED;
            PG8_LDB(B0, 1, 0); PG8_LDB(B1, 1, 1); PG8_SCHED; PG8_LDA(At, 1, 0); PG8_STAGE_A(PG8_SA(0, 1), 1, a2, last);
            PG8_WAIT_V(8); PG8_WAIT_L(0); PG8_BAR; PG8_MMA(0, 0, At, B0); PG8_MMA(0, 1, At, B1); PG8_BAR; PG8_SCHED;
            PG8_LDA(At, 1, 1); PG8_STAGE(PG8_SB(1, 0), b3, voffB); PG8_STAGE(PG8_SB(1, 1), b3 + hstepB, voffB); PG8_STAGE_A(PG8_SA(1, 0), 0, a3, last);
            PG8_WAIT_V(8); PG8_WAIT_L(0); PG8_BAR; PG8_MMA(1, 0, At, B0); PG8_MMA(1, 1, At, B1); PG8_BAR; PG8_SCHED;
        }
        if (wr == 0) PG8_BAR;
        E(acc, cur, wr, wc, fr, fq);
        if (!has_next) break;
#pragma unroll
        for (int a = 0; a < 2; ++a)
#pragma unroll
            for (int b = 0; b < 2; ++b)
#pragma unroll
                for (int m = 0; m < 4; ++m)
#pragma unroll
                    for (int n = 0; n < 2; ++n) acc[a][b][m][n] = (f32x4){0.f, 0.f, 0.f, 0.f};
        cur = nxt; cA = nA; cB = nB; ++ui;
        if constexpr (GATHER) {
#pragma unroll
            for (int i = 0; i < 2; ++i) { gc0[i] = gn0[i]; gc1[i] = gn1[i]; }
        }
        if (wr == 1) PG8_BAR;
    }
    PG8_WAIT_V(0);
    PG8_BAR;
#undef PG8_STAGE_A
#undef PG8_SA
#undef PG8_SB
#undef PG8_STAGE
#undef PG8_LDA
#undef PG8_LDB
#undef PG8_MMA
#undef PG8_WAIT_V
#undef PG8_WAIT_L
#undef PG8_BAR
#undef PG8_SCHED
}

struct EpiBf16 {
    static constexpr bool PERM = true;
    bf16_t* O; int ldc; int col_off; const float* bias; const float* rowscale;
    __device__ __forceinline__ void operator()(const f32x4 (&acc)[2][2][4][2], const Unit& u, int wr, int wc, int fr, int fq) const {
        const int row0 = u.pm * BM + wr * 64 + fr, c0 = u.pn * BM + wc * 32 + 8 * fq;
        f32x4 bv[2][2];
#pragma unroll
        for (int bj = 0; bj < 2; ++bj)
#pragma unroll
            for (int n = 0; n < 2; ++n) bv[bj][n] = bias ? *(const f32x4*)(bias + c0 + bj * HALF + 4 * n) : (f32x4){0.f, 0.f, 0.f, 0.f};
#pragma unroll
        for (int ai = 0; ai < 2; ++ai)
#pragma unroll
            for (int m = 0; m < 4; ++m) { const int row = row0 + ai * HALF + m * 16; bf16_t* rowp = O + (size_t)row * ldc + col_off + c0; const float rs = rowscale ? rowscale[row] : 1.f;
#pragma unroll
                for (int bj = 0; bj < 2; ++bj) { const f32x4 v0 = acc[ai][bj][m][0] * rs + bv[bj][0], v1 = acc[ai][bj][m][1] * rs + bv[bj][1];
                    u32x4 w; w.x = cvt_pk_bf16(v0[0], v0[1]); w.y = cvt_pk_bf16(v0[2], v0[3]); w.z = cvt_pk_bf16(v1[0], v1[1]); w.w = cvt_pk_bf16(v1[2], v1[3]);
                    *(u32x4*)(rowp + bj * HALF) = w; } }
    }
};
struct EpiResid {
    static constexpr bool PERM = true;
    bf16_t* XBp; int ldc; float* SS; bool dry; unsigned char* XF8p;
    __device__ __forceinline__ void operator()(const f32x4 (&acc)[2][2][4][2], const Unit& u, int wr, int wc, int fr, int fq) const {
        const int row0 = u.pm * BM + wr * 64 + fr, c0 = u.pn * BM + wc * 32 + 8 * fq;
#pragma unroll
        for (int ai = 0; ai < 2; ++ai)
#pragma unroll
            for (int m = 0; m < 4; ++m) { const int row = row0 + ai * HALF + m * 16; bf16_t* rowb = XBp + (size_t)row * ldc + c0; float ss = 0.f;
                u32x4 old[2];
#pragma unroll
                for (int bj = 0; bj < 2; ++bj) old[bj] = *(const u32x4*)(rowb + bj * HALF);
#pragma unroll
                for (int bj = 0; bj < 2; ++bj) { float x[8]; unpack8(old[bj], x);
#pragma unroll
                    for (int j = 0; j < 4; ++j) { x[j] += acc[ai][bj][m][0][j]; x[4 + j] += acc[ai][bj][m][1][j]; }
#pragma unroll
                    for (int j = 0; j < 8; ++j) ss += x[j] * x[j];
                    if (!dry) *(u32x4*)(rowb + bj * HALF) = pack8(x);
                    if (XF8p) *(u32x2*)(XF8p + (size_t)row * ldc + c0 + bj * HALF) = (u32x2){pk4_fp8(x[0], x[1], x[2], x[3]), pk4_fp8(x[4], x[5], x[6], x[7])}; }
                if (SS) { ss += __shfl_xor(ss, 16); ss += __shfl_xor(ss, 32); if (fq == 0) SS[(size_t)row * 32 + u.pn * 4 + wc] = ss; } }
    }
};
struct EpiF32Z {
    static constexpr bool PERM = false;
    float* C; int ldc; size_t zstride;
    __device__ __forceinline__ void operator()(const f32x4 (&acc)[2][2][4][2], const Unit& u, int wr, int wc, int fr, int fq) const {
        const int row0 = u.pm * BM + wr * 64 + fr, col0 = u.pn * BM + wc * 32 + 4 * fq;
#pragma unroll
        for (int ai = 0; ai < 2; ++ai)
#pragma unroll
            for (int m = 0; m < 4; ++m) { float* rowp = C + (size_t)u.z * zstride + (size_t)(row0 + ai * HALF + m * 16) * ldc + col0;
#pragma unroll
                for (int bj = 0; bj < 2; ++bj)
#pragma unroll
                    for (int n = 0; n < 2; ++n) *(f32x4*)(rowp + bj * HALF + n * 16) = acc[ai][bj][m][n]; }
    }
};
template <int NVALID> struct EpiF32Part {
    static constexpr bool PERM = false;
    float* C; int ldc; size_t zstride;
    __device__ __forceinline__ void operator()(const f32x4 (&acc)[2][2][4][2], const Unit& u, int wr, int wc, int fr, int fq) const {
        if (u.pn != 0) return;
        if (NVALID == 64 && wc >= 2) return;
        const int row0 = u.pm * BM + wr * 64 + fr, col0 = wc * 32 + 4 * fq;
#pragma unroll
        for (int ai = 0; ai < 2; ++ai)
#pragma unroll
            for (int m = 0; m < 4; ++m) { float* rowp = C + (size_t)u.z * zstride + (size_t)(row0 + ai * HALF + m * 16) * ldc + col0;
#pragma unroll
                for (int n = 0; n < 2; ++n) *(f32x4*)(rowp + n * 16) = acc[ai][0][m][n]; }
    }
};
struct EpiSsmY {
    static constexpr bool PERM = true;
    bf16_t* YG;
    __device__ __forceinline__ void operator()(const f32x4 (&acc)[2][2][4][2], const Unit& u, int wr, int wc, int fr, int fq) const {
        const int row0 = wr * 64 + fr, c0 = u.pn * BM + wc * 32 + 8 * fq;
#pragma unroll
        for (int ai = 0; ai < 2; ++ai)
#pragma unroll
            for (int m = 0; m < 4; ++m) { const int chunk = row0 + ai * HALF + m * 16;
#pragma unroll
                for (int bj = 0; bj < 2; ++bj) { const int col = c0 + bj * HALF, t = col >> 4, o0 = col & 15;
                    float v[8];
#pragma unroll
                    for (int j = 0; j < 4; ++j) { v[j] = acc[ai][bj][m][0][j]; v[4 + j] = acc[ai][bj][m][1][j]; }
#pragma unroll
                    for (int j = 0; j < 8; ++j) { const float x = v[j], y = 1.5957691216f * (x + 0.044715f * x * x * x); v[j] = x * fast_rcp(1.f + fast_exp2(-y * LOG2E)); }
                    *(u32x4*)(YG + (size_t)(chunk * 64 + t) * 512 + u.z * 16 + o0) = pack8(v); } }
    }
};
struct EpiGlu {
    static constexpr bool PERM = true;
    const bf16_t* YG; const float* bias; bf16_t* O;
    __device__ __forceinline__ void operator()(const f32x4 (&acc)[2][2][4][2], const Unit& u, int wr, int wc, int fr, int fq) const {
        const int row0 = u.pm * BM + wr * 64 + fr, c0 = u.pn * BM + wc * 32 + 8 * fq;
#pragma unroll
        for (int ai = 0; ai < 2; ++ai)
#pragma unroll
            for (int m = 0; m < 4; ++m) { const int row = row0 + ai * HALF + m * 16;
#pragma unroll
                for (int bj = 0; bj < 2; ++bj) { const int col = c0 + bj * HALF;
                    const u32x4 yw = *(const u32x4*)(YG + (size_t)row * 512 + col); float y[8]; unpack8(yw, y);
                    const f32x4 b0 = *(const f32x4*)(bias + col), b1 = *(const f32x4*)(bias + col + 4);
                    float v[8];
#pragma unroll
                    for (int j = 0; j < 4; ++j) { v[j] = y[j] * sigmoidf_(acc[ai][bj][m][0][j] + b0[j]); v[4 + j] = y[4 + j] * sigmoidf_(acc[ai][bj][m][1][j] + b1[j]); }
                    *(u32x4*)(O + (size_t)row * D + 1536 + col) = pack8(v); } }
    }
};
struct EpiMoe1 {
    static constexpr bool PERM = true;
    unsigned char* HID8; const int* TOKp; const float* SS;
    __device__ __forceinline__ void operator()(const f32x4 (&acc)[2][2][4][2], const Unit& u, int wr, int wc, int fr, int fq) const {
        const int row0 = u.z * BM + wr * 64 + fr, c0 = u.pn * HALF + wc * 32 + 8 * fq;
#pragma unroll
        for (int ai = 0; ai < 2; ++ai)
#pragma unroll
            for (int m = 0; m < 4; ++m) { const int row = row0 + ai * HALF + m * 16; float v[8];
                const float rs = SS[TOKp[row]] * (1.0f / 32.0f);
#pragma unroll
                for (int j = 0; j < 4; ++j) { const float g0 = acc[ai][0][m][0][j] * rs, g1 = acc[ai][0][m][1][j] * rs; v[j] = g0 * sigmoidf_(g0) * (acc[ai][1][m][0][j] * rs); v[4 + j] = g1 * sigmoidf_(g1) * (acc[ai][1][m][1][j] * rs); }
                *(u32x2*)(HID8 + (size_t)row * 512 + c0) = (u32x2){pk4_fp8(v[0], v[1], v[2], v[3]), pk4_fp8(v[4], v[5], v[6], v[7])}; }
    }
};
struct EpiMoe2 {
    static constexpr bool PERM = true;
    unsigned char* YS8; const float* W;
    __device__ __forceinline__ void operator()(const f32x4 (&acc)[2][2][4][2], const Unit& u, int wr, int wc, int fr, int fq) const {
        const int row0 = u.z * BM + wr * 64 + fr, c0 = u.pn * BM + wc * 32 + 8 * fq;
#pragma unroll
        for (int ai = 0; ai < 2; ++ai)
#pragma unroll
            for (int m = 0; m < 4; ++m) { const int row = row0 + ai * HALF + m * 16; const float w = W[row] * (16.0f / 32.0f);
#pragma unroll
                for (int bj = 0; bj < 2; ++bj) { const f32x4 v0 = acc[ai][bj][m][0] * w, v1 = acc[ai][bj][m][1] * w;
                    *(u32x2*)(YS8 + (size_t)row * D + c0 + bj * HALF) = (u32x2){pk4_fp8(v0[0], v0[1], v0[2], v0[3]), pk4_fp8(v1[0], v1[1], v1[2], v1[3])}; } }
    }
};
struct EpiBf16Part64 {
    static constexpr bool PERM = true;
    bf16_t* O; size_t zstride; const float* rowscale;
    __device__ __forceinline__ void operator()(const f32x4 (&acc)[2][2][4][2], const Unit& u, int wr, int wc, int fr, int fq) const {
        if (wc >= 2) return;
        const int row0 = u.pm * BM + wr * 64 + fr, c0 = wc * 32 + 8 * fq;
#pragma unroll
        for (int ai = 0; ai < 2; ++ai)
#pragma unroll
            for (int m = 0; m < 4; ++m) { const int row = row0 + ai * HALF + m * 16; const float rs = rowscale[row]; const f32x4 v0 = acc[ai][0][m][0] * rs, v1 = acc[ai][0][m][1] * rs;
                u32x4 w; w.x = cvt_pk_bf16(v0[0], v0[1]); w.y = cvt_pk_bf16(v0[2], v0[3]); w.z = cvt_pk_bf16(v1[0], v1[1]); w.w = cvt_pk_bf16(v1[2], v1[3]);
                *(u32x4*)(O + (size_t)u.z * zstride + (size_t)row * 64 + c0) = w; }
    }
};
struct EpiBf16Z { static constexpr bool PERM = true; bf16_t* O0; int ldc; size_t zstride;
    __device__ __forceinline__ void operator()(const f32x4 (&acc)[2][2][4][2], const Unit& u, int wr, int wc, int fr, int fq) const { EpiBf16 e{O0 + (size_t)u.z * zstride, ldc, 0, nullptr, nullptr}; e(acc, u, wr, wc, fr, fq); } };
struct EpiMem { static constexpr bool PERM = true; bf16_t* K0; bf16_t* V0;
    __device__ __forceinline__ void operator()(const f32x4 (&acc)[2][2][4][2], const Unit& u, int wr, int wc, int fr, int fq) const { EpiBf16 e{((u.z >> 2) ? V0 : K0) + (size_t)(u.z & 3) * 256 * 512, 512, 0, nullptr, nullptr}; e(acc, u, wr, wc, fr, fq); } };
struct MemSched { const char* A; const char* B; int G, c;
    __device__ __forceinline__ bool next(int i, Unit& u) const {
        const long L = (long)i * G + c; if (L >= 16) return false;
        const int pn = (int)L & 1, ks = ((int)L >> 1) & 3, kv = (int)L >> 3;
        u.pm = 0; u.pn = pn; u.z = kv * 4 + ks; u.a = A + (size_t)ks * 1024; u.b = B + (size_t)kv * 512 * D * 2 + (size_t)pn * 256 * D * 2 + (size_t)ks * 1024; u.rows = nullptr; return true; } };
struct MoeSched { const LAS int* pst; const char* B; const int* tok; size_t bE, bTile; int nN, G, c, mode;
    __device__ __forceinline__ bool next(int i, Unit& u) const {
        const int nb = __builtin_amdgcn_readfirstlane(pst[32]) >> 8; const int n1 = nb * nN, n1a = (n1 / G) * G;
        const int cv = (G % NXCD == 0) ? (c % NXCD) * (G / NXCD) + c / NXCD : c;
        const long L = (long)(mode == 2 ? n1a : 0) + (long)i * G + cv; if (L >= (long)(mode == 1 ? n1a : n1)) return false;
        const int b = (int)(L / nN), pn = (int)(L % nN); const int e = __builtin_amdgcn_readfirstlane(pst[240 + b]);
        u.pm = 0; u.pn = pn; u.z = b; u.a = nullptr; u.rows = tok + b * 256; u.b = B + (size_t)e * bE + (size_t)pn * bTile; return true; } };
struct MoeSched2 { const LAS int* pst; const char* A; const char* B; size_t bE, bTile; int nN, G, c, mode;
    __device__ __forceinline__ bool next(int i, Unit& u) const {
        const int nb = __builtin_amdgcn_readfirstlane(pst[32]) >> 8; const int n1 = nb * 4, r1 = n1 % G, bdone = ((n1 / G) * G) / 4, n2a = bdone * nN, n2 = nb * nN;
        const int cv = (G % NXCD == 0) ? (c % NXCD) * (G / NXCD) + c / NXCD : c;
        long L;
        if (mode == 1) { const int nfree = r1 ? G - r1 : 0; const long E = 3L * nfree;
            if (r1 && cv >= r1) L = (i < 3) ? (long)i * nfree + (cv - r1) : E + (long)(i - 3) * G + cv; else L = E + (long)i * G + cv;
            if (L >= n2a) return false; }
        else { L = (long)n2a + (long)i * G + cv; if (L >= n2) return false; }
        const int b = (int)(L / nN), pn = (int)(L % nN); const int e = __builtin_amdgcn_readfirstlane(pst[240 + b]);
        u.pm = 0; u.pn = pn; u.z = b; u.a = A + (size_t)b * 256 * 512; u.rows = nullptr; u.b = B + (size_t)e * bE + (size_t)pn * bTile; return true; } };
}

#define XB_TMO      128
#define XB_XCNT(j)  (256  + 64 * (j))
#define XB_XSUB(j)  (1280 + 64 * (j))
#define XB_XGEN(j)  (2304 + 64 * (j))
#define XB_TOP      3328
#define XB_TOPGEN   3392
#define XCD_BAR_WORDS 3456
#define XB_SPIN_CAP (1u << 22)
__device__ __forceinline__ unsigned xb_ld(unsigned* p)              { return __hip_atomic_load(p, __ATOMIC_RELAXED, __HIP_MEMORY_SCOPE_AGENT); }
__device__ __forceinline__ unsigned xb_add(unsigned* p, unsigned v) { return __hip_atomic_fetch_add(p, v, __ATOMIC_RELAXED, __HIP_MEMORY_SCOPE_AGENT); }
__device__ __forceinline__ unsigned xb_xcc_id() { return (unsigned)__builtin_amdgcn_s_getreg((3 << 11) | 20) & 0xFu; }
#define XB_SPIN(cond, bar) do { unsigned _sp = 0; while (cond) { __builtin_amdgcn_s_sleep(1); \
    if ((++_sp & 255u) == 0u) { if (xb_ld(&(bar)[XB_TMO])) break; if (_sp > XB_SPIN_CAP) { atomicAdd(&(bar)[XB_TMO], 1u); break; } } } } while (0)
struct XcdBarrier { unsigned* bar; unsigned x; volatile LAS unsigned* st; };
__device__ __forceinline__ XcdBarrier xcd_barrier_post(unsigned* bar, volatile LAS unsigned* st) {
    XcdBarrier b; b.bar = bar; b.x = xb_xcc_id(); b.st = st;
    if (threadIdx.x == 0) (void)xb_add(&bar[XB_XCNT(b.x)], 1u);
    return b;
}
__device__ __forceinline__ void xcd_barrier_complete(unsigned* bar, unsigned x, unsigned& nloc, unsigned& nx) {
    const unsigned G = gridDim.x * gridDim.y * gridDim.z;
    unsigned sum, cnt, mine, sp = 0u;
    for (;;) {
        sum = 0u; cnt = 0u; mine = 0u;
#pragma unroll
        for (unsigned j = 0; j < 16; ++j) { const unsigned c = xb_ld(&bar[XB_XCNT(j)]); sum += c; cnt += (c > 0u) ? 1u : 0u; mine = (j == x) ? c : mine; }
        if (sum == G) break;
        __builtin_amdgcn_s_sleep(1);
        if ((++sp & 255u) == 0u) { if (xb_ld(&bar[XB_TMO])) break; if (sp > XB_SPIN_CAP) { atomicAdd(&bar[XB_TMO], 1u); break; } }
    }
    nloc = mine > 0u ? mine : 1u; nx = cnt > 0u ? cnt : 1u;
}
__device__ __forceinline__ void xcd_barrier(const XcdBarrier& b, const int tid_) {
    asm volatile("s_waitcnt vmcnt(0)" ::: "memory");
    __syncthreads();
    if (tid_ == 0) {
        unsigned* bar = b.bar;
        __builtin_amdgcn_s_waitcnt(0);
        unsigned nloc = b.st[0], nx = b.st[1];
        if (nloc == 0u) { xcd_barrier_complete(bar, b.x, nloc, nx); b.st[0] = nloc; b.st[1] = nx; }
        const unsigned old = xb_add(&bar[XB_XSUB(b.x)], 1u);
        const unsigned gen = old / nloc;
        if (old + 1u == (gen + 1u) * nloc) {
            __builtin_amdgcn_fence(__ATOMIC_RELEASE, "agent");
            asm volatile("s_waitcnt vmcnt(0)" ::: "memory");
            const unsigned og = xb_add(&bar[XB_TOP], 1u);
            const unsigned tg = og / nx;
            if (og + 1u == (tg + 1u) * nx) xb_add(&bar[XB_TOPGEN], 1u);
            else XB_SPIN(xb_ld(&bar[XB_TOPGEN]) == tg, bar);
            __builtin_amdgcn_fence(__ATOMIC_ACQUIRE, "agent");
            xb_add(&bar[XB_XGEN(b.x)], 1u);
            asm volatile("s_waitcnt vmcnt(0)" ::: "memory");
        } else {
            XB_SPIN(xb_ld(&bar[XB_XGEN(b.x)]) == gen, bar);
            __builtin_amdgcn_fence(__ATOMIC_ACQUIRE, "agent");
            asm volatile("s_waitcnt vmcnt(0)" ::: "memory");
        }
    }
    __syncthreads();
}

template <int RB> __device__ __forceinline__ int kswz(int row, int c) { return (RB == 256) ? (c ^ (row & 15)) : (c ^ ((row >> 1) & 7)); }
__device__ __forceinline__ int vswz(int d, int c) { return c ^ ((d >> 1) & 7); }
template <int BYTES> __device__ __forceinline__ void dma_tile(const unsigned char* src, LAS unsigned char* dst, int tid, int wid) {
#pragma unroll
    for (int i = 0; i < BYTES / 8192; ++i)
        __builtin_amdgcn_global_load_lds((const unsigned*)(src + (unsigned)(i * 8192 + tid * 16)), (LAS unsigned*)(dst + i * 8192 + wid * 1024), 16, 0, 0);
}
template <int DQK, int DV, int MODE>
__device__ __forceinline__ void attn_tile_compute(const LAS unsigned char* kb, const LAS unsigned char* vb, const int k0, const bool domask, const bf16x8 (&qf)[DQK / 16],
                                                  const int qpos, const LAS float* biasrow, const int lr, const int hi, f32x16 (&o)[DV / 32], float& m_run, float& l_run) {
    constexpr int RB = DQK * 2, NKS = DQK / 16, NDB = DV / 32;
            f32x16 p0, p1;
#pragma unroll
            for (int r = 0; r < 16; ++r) { p0[r] = 0.f; p1[r] = 0.f; }
#pragma unroll
            for (int ks = 0; ks < NKS; ++ks) {
                const int c = 2 * ks + hi;
                const bf16x8 kf0 = *(const LAS bf16x8*)(kb + lr * RB + kswz<RB>(lr, c) * 16);
                const bf16x8 kf1 = *(const LAS bf16x8*)(kb + (lr + 32) * RB + kswz<RB>(lr + 32, c) * 16);
                p0 = __builtin_amdgcn_mfma_f32_32x32x16_bf16(kf0, qf[ks], p0, 0, 0, 0);
                p1 = __builtin_amdgcn_mfma_f32_32x32x16_bf16(kf1, qf[ks], p1, 0, 0, 0);
            }
            if (domask) {
                const float NEG = -__builtin_inff();
#pragma unroll
                for (int r = 0; r < 16; ++r) {
                    const int key0 = k0 + (r & 3) + 8 * (r >> 2) + 4 * hi, key1 = key0 + 32;
                    if (MODE == 0) { if (key0 > qpos) p0[r] = NEG; if (key1 > qpos) p1[r] = NEG; }
                    if (MODE == 1) { const int d0 = qpos - key0, d1 = qpos - key1;
                        p0[r] = ((unsigned)d0 < 128u) ? p0[r] + biasrow[d0 & 127] : NEG;
                        p1[r] = ((unsigned)d1 < 128u) ? p1[r] + biasrow[d1 & 127] : NEG; }
                }
            }
            float mx = p0[0];
#pragma unroll
            for (int r = 1; r < 16; ++r) mx = fmaxf(mx, p0[r]);
#pragma unroll
            for (int r = 0; r < 16; ++r) mx = fmaxf(mx, p1[r]);
            { auto rr = __builtin_amdgcn_permlane32_swap(__float_as_uint(mx), __float_as_uint(mx), false, false); mx = fmaxf(__uint_as_float(rr[0]), __uint_as_float(rr[1])); }
            const float mn = fmaxf(m_run, mx), alpha = fast_exp2(m_run - mn);
            m_run = mn;
            float ps = 0.f;
#pragma unroll
            for (int r = 0; r < 16; ++r) { p0[r] = fast_exp2(p0[r] - mn); p1[r] = fast_exp2(p1[r] - mn); ps += p0[r] + p1[r]; }
            l_run = l_run * alpha + ps;
            if (!__all(alpha == 1.f)) {
#pragma unroll
                for (int db = 0; db < NDB; ++db)
#pragma unroll
                    for (int r = 0; r < 16; ++r) o[db][r] *= alpha;
            }
            bf16x8 pf[4];
#pragma unroll
            for (int s = 0; s < 4; ++s) {
                const int r0 = 8 * (s & 1);
                unsigned a01, a23, b45, b67;
                if (s < 2) { a01 = cvt_pk_bf16(p0[r0 + 0], p0[r0 + 1]); a23 = cvt_pk_bf16(p0[r0 + 2], p0[r0 + 3]); b45 = cvt_pk_bf16(p0[r0 + 4], p0[r0 + 5]); b67 = cvt_pk_bf16(p0[r0 + 6], p0[r0 + 7]); }
                else       { a01 = cvt_pk_bf16(p1[r0 + 0], p1[r0 + 1]); a23 = cvt_pk_bf16(p1[r0 + 2], p1[r0 + 3]); b45 = cvt_pk_bf16(p1[r0 + 4], p1[r0 + 5]); b67 = cvt_pk_bf16(p1[r0 + 6], p1[r0 + 7]); }
                auto s0 = __builtin_amdgcn_permlane32_swap(a01, b45, false, false);
                auto s1 = __builtin_amdgcn_permlane32_swap(a23, b67, false, false);
                u32x4 w; w.x = s0[0]; w.y = s1[0]; w.z = s0[1]; w.w = s1[1];
                pf[s] = __builtin_bit_cast(bf16x8, w);
            }
#pragma unroll
            for (int db = 0; db < NDB; ++db) {
                const int d = 32 * db + lr;
#pragma unroll
                for (int s = 0; s < 4; ++s) {
                    const bf16x8 vf = *(const LAS bf16x8*)(vb + d * 128 + vswz(d, 2 * s + hi) * 16);
                    o[db] = __builtin_amdgcn_mfma_f32_32x32x16_bf16(vf, pf[s], o[db], 0, 0, 0);
                }
            }
        }
template <int DQK, int DV, int MODE>
__device__ __forceinline__ void attn_tiles(const int tid_in, LAS unsigned char* lds, const unsigned char* gK, const unsigned char* gV, int t_lo, int t_hi,
                                           const bf16x8 (&qf)[DQK / 16], int qpos, int wave_q0, const LAS float* biasrow,
                                           f32x16 (&o)[DV / 32], float& m_run, float& l_run) {
    constexpr int KT = 64 * DQK * 2, VT = DV * 128, BUF = KT + VT;
    int tid = tid_in; asm volatile("" : "+v"(tid));
    const int wid = __builtin_amdgcn_readfirstlane(tid >> 6), lane = tid & 63, lr = lane & 31, hi = lane >> 5;
    dma_tile<KT>(gK + (size_t)t_lo * KT, lds, tid, wid); dma_tile<VT>(gV + (size_t)t_lo * VT, lds + KT, tid, wid);
    VM_WAIT(); __syncthreads();
#pragma unroll 1
    for (int t = t_lo; t < t_hi; ++t) {
        const int cur = (t - t_lo) & 1;
        LAS unsigned char* kb = lds + cur * BUF; LAS unsigned char* vb = kb + KT;
        if (t + 1 < t_hi) { LAS unsigned char* nb = lds + (cur ^ 1) * BUF; dma_tile<KT>(gK + (size_t)(t + 1) * KT, nb, tid, wid); dma_tile<VT>(gV + (size_t)(t + 1) * VT, nb + KT, tid, wid); }
        const int k0 = t * 64;
        bool need = true, domask = false;
        if (MODE == 0) { need = (k0 <= wave_q0 + 31); domask = (k0 + 63 > wave_q0); }
        if (MODE == 1) { need = (k0 <= wave_q0 + 31) && (k0 + 63 >= wave_q0 - 127); domask = true; }
        if (need) attn_tile_compute<DQK, DV, MODE>(kb, vb, k0, domask, qf, qpos, biasrow, lr, hi, o, m_run, l_run);
        VM_WAIT(); __syncthreads();
    }
}
#define MLA_KLD(KB, ks, F0, F1) do { const int c_ = 2 * (ks) + hi; \
        F0 = *(const LAS bf16x8*)((KB) + lr * 384 + kswz<384>(lr, c_) * 16); \
        F1 = *(const LAS bf16x8*)((KB) + (lr + 32) * 384 + kswz<384>(lr + 32, c_) * 16); } while (0)
#define MLA_QK(KB, P0, P1) do { _Pragma("unroll") for (int r = 0; r < 16; ++r) { P0[r] = 0.f; P1[r] = 0.f; } \
    bf16x8 ka_[3], kb_[3]; MLA_KLD(KB, 0, ka_[0], kb_[0]); MLA_KLD(KB, 1, ka_[1], kb_[1]); \
    _Pragma("unroll") for (int ks = 0; ks < 12; ++ks) { \
        if (ks + 2 < 12) MLA_KLD(KB, ks + 2, ka_[(ks + 2) % 3], kb_[(ks + 2) % 3]); \
        __builtin_amdgcn_sched_barrier(0); \
        P0 = __builtin_amdgcn_mfma_f32_32x32x16_bf16(ka_[ks % 3], qf[ks], P0, 0, 0, 0); \
        P1 = __builtin_amdgcn_mfma_f32_32x32x16_bf16(kb_[ks % 3], qf[ks], P1, 0, 0, 0); } } while (0)
__device__ __forceinline__ void mla_softmax(f32x16& p0, f32x16& p1, const bool domask, const int k0, const int qpos, const int hi, f32x16 (&o)[4], float& m_run, float& l_run, bf16x8 (&pf)[4]) {
    if (domask) {
        const float NEG = -__builtin_inff();
#pragma unroll
        for (int r = 0; r < 16; ++r) { const int key0 = k0 + (r & 3) + 8 * (r >> 2) + 4 * hi; if (key0 > qpos) p0[r] = NEG; if (key0 + 32 > qpos) p1[r] = NEG; }
    }
    float mx = p0[0];
#pragma unroll
    for (int r = 1; r < 16; ++r) mx = fmaxf(mx, p0[r]);
#pragma unroll
    for (int r = 0; r < 16; ++r) mx = fmaxf(mx, p1[r]);
    { auto rr = __builtin_amdgcn_permlane32_swap(__float_as_uint(mx), __float_as_uint(mx), false, false); mx = fmaxf(__uint_as_float(rr[0]), __uint_as_float(rr[1])); }
    float mn = m_run, alpha = 1.f;
    if (!__all(mx - m_run <= 8.f)) { mn = fmaxf(m_run, mx); alpha = fast_exp2(m_run - mn); m_run = mn;
#pragma unroll
        for (int db = 0; db < 4; ++db)
#pragma unroll
            for (int r = 0; r < 16; ++r) o[db][r] *= alpha; }
    float ps = 0.f;
#pragma unroll
    for (int r = 0; r < 16; ++r) { p0[r] = fast_exp2(p0[r] - mn); p1[r] = fast_exp2(p1[r] - mn); ps += p0[r] + p1[r]; }
    l_run = l_run * alpha + ps;
#pragma unroll
    for (int s = 0; s < 4; ++s) {
        const int r0 = 8 * (s & 1);
        unsigned a01, a23, b45, b67;
        if (s < 2) { a01 = cvt_pk_bf16(p0[r0 + 0], p0[r0 + 1]); a23 = cvt_pk_bf16(p0[r0 + 2], p0[r0 + 3]); b45 = cvt_pk_bf16(p0[r0 + 4], p0[r0 + 5]); b67 = cvt_pk_bf16(p0[r0 + 6], p0[r0 + 7]); }
        else       { a01 = cvt_pk_bf16(p1[r0 + 0], p1[r0 + 1]); a23 = cvt_pk_bf16(p1[r0 + 2], p1[r0 + 3]); b45 = cvt_pk_bf16(p1[r0 + 4], p1[r0 + 5]); b67 = cvt_pk_bf16(p1[r0 + 6], p1[r0 + 7]); }
        auto s0 = __builtin_amdgcn_permlane32_swap(a01, b45, false, false);
        auto s1 = __builtin_amdgcn_permlane32_swap(a23, b67, false, false);
        u32x4 w; w.x = s0[0]; w.y = s1[0]; w.z = s0[1]; w.w = s1[1];
        pf[s] = __builtin_bit_cast(bf16x8, w);
    }
}
__device__ __forceinline__ void mla_pv(const bf16x8 (&pf)[4], const LAS unsigned char* vb, const int lr, const int hi, f32x16 (&o)[4]) {
    bf16x8 vf[2][4];
#pragma unroll
    for (int s = 0; s < 4; ++s) vf[0][s] = *(const LAS bf16x8*)(vb + lr * 128 + vswz(lr, 2 * s + hi) * 16);
#pragma unroll
    for (int db = 0; db < 4; ++db) {
        if (db + 1 < 4) { const int d = 32 * (db + 1) + lr;
#pragma unroll
            for (int s = 0; s < 4; ++s) vf[(db + 1) & 1][s] = *(const LAS bf16x8*)(vb + d * 128 + vswz(d, 2 * s + hi) * 16); }
        __builtin_amdgcn_sched_barrier(0);
#pragma unroll
        for (int s = 0; s < 4; ++s) o[db] = __builtin_amdgcn_mfma_f32_32x32x16_bf16(vf[db & 1][s], pf[s], o[db], 0, 0, 0);
    }
}
typedef long i64x2 __attribute__((ext_vector_type(2)));
__host__ __device__ __forceinline__ int f8pos(int k) { return (k & ~31) | (((k >> 3) & 1) << 4) | (((k >> 4) & 1) << 3) | (k & 7); }
#define F8_KLD(KB, m, F0, F1) do { const int c_ = (2 * (m) + hi) ^ ((lr >> 2) & 3); \
        F0 = *(const LAS i64x2*)((KB) + lr * 192 + c_ * 16); F1 = *(const LAS i64x2*)((KB) + (lr + 32) * 192 + c_ * 16); } while (0)
#define F8_QK(KB, P0, P1) do { _Pragma("unroll") for (int r = 0; r < 16; ++r) { P0[r] = 0.f; P1[r] = 0.f; } \
    i64x2 ka_[3], kb_[3]; F8_KLD(KB, 0, ka_[0], kb_[0]); F8_KLD(KB, 1, ka_[1], kb_[1]); \
    _Pragma("unroll") for (int m = 0; m < 6; ++m) { \
        if (m + 2 < 6) F8_KLD(KB, m + 2, ka_[(m + 2) % 3], kb_[(m + 2) % 3]); \
        __builtin_amdgcn_sched_barrier(0); \
        P0 = __builtin_amdgcn_mfma_f32_32x32x16_fp8_fp8(ka_[m % 3].x, qf[m].x, P0, 0, 0, 0); \
        P1 = __builtin_amdgcn_mfma_f32_32x32x16_fp8_fp8(kb_[m % 3].x, qf[m].x, P1, 0, 0, 0); \
        P0 = __builtin_amdgcn_mfma_f32_32x32x16_fp8_fp8(ka_[m % 3].y, qf[m].y, P0, 0, 0, 0); \
        P1 = __builtin_amdgcn_mfma_f32_32x32x16_fp8_fp8(kb_[m % 3].y, qf[m].y, P1, 0, 0, 0); } } while (0)
__device__ __forceinline__ void f8_softmax(f32x16& p0, f32x16& p1, const bool domask, const int k0, const int qpos, const int hi, f32x16 (&o)[4], float& m_run, float& l_run, long (&pf)[4]) {
    constexpr float C = 0.07216878364870322f * LOG2E;
    if (domask) {
        const float NEG = -__builtin_inff();
#pragma unroll
        for (int r = 0; r < 16; ++r) { const int key0 = k0 + (r & 3) + 8 * (r >> 2) + 4 * hi; if (key0 > qpos) p0[r] = NEG; if (key0 + 32 > qpos) p1[r] = NEG; }
    }
    float mx = p0[0];
#pragma unroll
    for (int r = 1; r < 16; ++r) mx = fmaxf(mx, p0[r]);
#pragma unroll
    for (int r = 0; r < 16; ++r) mx = fmaxf(mx, p1[r]);
    { auto rr = __builtin_amdgcn_permlane32_swap(__float_as_uint(mx), __float_as_uint(mx), false, false); mx = fmaxf(__uint_as_float(rr[0]), __uint_as_float(rr[1])); }
    mx *= C;
    float mn = m_run, alpha = 1.f;
    if (!__all(mx - m_run <= 8.f)) { mn = fmaxf(m_run, mx); alpha = fast_exp2(m_run - mn); m_run = mn;
#pragma unroll
        for (int db = 0; db < 4; ++db)
#pragma unroll
            for (int r = 0; r < 16; ++r) o[db][r] *= alpha; }
    float ps = 0.f;
#pragma unroll
    for (int r = 0; r < 16; ++r) { p0[r] = fast_exp2(p0[r] * C - mn); p1[r] = fast_exp2(p1[r] * C - mn); ps += p0[r] + p1[r]; }
    l_run = l_run * alpha + ps;
#pragma unroll
    for (int s = 0; s < 4; ++s) {
        const int r0 = 8 * (s & 1);
        unsigned a, b;
        if (s < 2) { a = pk4_fp8(p0[r0 + 0], p0[r0 + 1], p0[r0 + 2], p0[r0 + 3]); b = pk4_fp8(p0[r0 + 4], p0[r0 + 5], p0[r0 + 6], p0[r0 + 7]); }
        else       { a = pk4_fp8(p1[r0 + 0], p1[r0 + 1], p1[r0 + 2], p1[r0 + 3]); b = pk4_fp8(p1[r0 + 4], p1[r0 + 5], p1[r0 + 6], p1[r0 + 7]); }
        auto sw = __builtin_amdgcn_permlane32_swap(a, b, false, false);
        pf[s] = (long)(((unsigned long long)sw[1] << 32) | (unsigned long long)sw[0]);
    }
}
__device__ __forceinline__ void f8_pv(const long (&pf)[4], const LAS unsigned char* vb, const int lr, const int hi, f32x16 (&o)[4]) {
    i64x2 vf[2][2];
#pragma unroll
    for (int m = 0; m < 2; ++m) vf[0][m] = *(const LAS i64x2*)(vb + lr * 64 + (((2 * m + hi) ^ ((lr >> 2) & 3)) << 4));
#pragma unroll
    for (int db = 0; db < 4; ++db) {
        if (db + 1 < 4) { const int d = 32 * (db + 1) + lr;
#pragma unroll
            for (int m = 0; m < 2; ++m) vf[(db + 1) & 1][m] = *(const LAS i64x2*)(vb + d * 64 + (((2 * m + hi) ^ ((d >> 2) & 3)) << 4)); }
        __builtin_amdgcn_sched_barrier(0);
#pragma unroll
        for (int m = 0; m < 2; ++m) { o[db] = __builtin_amdgcn_mfma_f32_32x32x16_fp8_fp8(vf[db & 1][m].x, pf[2 * m], o[db], 0, 0, 0);
                                      o[db] = __builtin_amdgcn_mfma_f32_32x32x16_fp8_fp8(vf[db & 1][m].y, pf[2 * m + 1], o[db], 0, 0, 0); }
    }
}
__device__ __forceinline__ void attn_mla_f8(const int tid_in, LAS unsigned char* lds, const unsigned char* gK, const unsigned char* gV, const int t_lo, const int t_hi,
                                            const i64x2 (&qf)[6], const int qpos, const int wave_q0, f32x16 (&o)[4], float& m_run, float& l_run) {
    constexpr int KT = 12288, VT = 8192;
    int tid = tid_in; asm volatile("" : "+v"(tid));
    const int wid = __builtin_amdgcn_readfirstlane(tid >> 6), lane = tid & 63, lr0 = lane & 31, hi = lane >> 5;
    const bool halfB = wid >= 4;
    LAS unsigned char* KB0 = lds; LAS unsigned char* VB0 = lds + 2 * KT;
#define F8_DMA(T, KDST, VDST) do { const unsigned char* ks_ = gK + (size_t)(T) * KT; \
        __builtin_amdgcn_global_load_lds((const unsigned*)(ks_ + (unsigned)(tid * 16)), (LAS unsigned*)((KDST) + wid * 1024), 16, 0, 0); \
        if (wid < 4) __builtin_amdgcn_global_load_lds((const unsigned*)(ks_ + 8192 + (unsigned)(tid * 16)), (LAS unsigned*)((KDST) + 8192 + wid * 1024), 16, 0, 0); \
        __builtin_amdgcn_global_load_lds((const unsigned*)(gV + (size_t)(T) * VT + (unsigned)(tid * 16)), (LAS unsigned*)((VDST) + wid * 1024), 16, 0, 0); } while (0)
    F8_DMA(t_lo, KB0, VB0);
    VM_WAIT(); __syncthreads();
    if (!halfB) {
        int vcur = 0;
#pragma unroll 1
        for (int t = t_lo; t <= t_hi; ++t) {
            const int j = t - t_lo, vnext = (vcur == 2) ? 0 : vcur + 1;
            if (t + 1 < t_hi) F8_DMA(t + 1, KB0 + ((j + 1) & 1) * KT, VB0 + vnext * VT);
            const int k0 = t * 64;
            int lr = lr0; asm volatile("" : "+v"(lr));
            if ((t < t_hi) && (k0 <= wave_q0 + 31)) { f32x16 p0, p1; long pf[4]; const LAS unsigned char* kb = KB0 + (j & 1) * KT;
                F8_QK(kb, p0, p1); f8_softmax(p0, p1, k0 + 63 > wave_q0, k0, qpos, hi, o, m_run, l_run, pf); f8_pv(pf, VB0 + vcur * VT, lr, hi, o); }
            vcur = vnext;
            VM_WAIT(); __syncthreads();
        }
    } else {
        long pf[4] = {0, 0, 0, 0};
        int vcur = 0, vprev = 2;
#pragma unroll 1
        for (int t = t_lo; t <= t_hi; ++t) {
            const int j = t - t_lo, vnext = (vcur == 2) ? 0 : vcur + 1;
            if (t + 1 < t_hi) F8_DMA(t + 1, KB0 + ((j + 1) & 1) * KT, VB0 + vnext * VT);
            const int k0 = t * 64;
            int lr = lr0; asm volatile("" : "+v"(lr));
            if ((j > 0) && (k0 - 64 <= wave_q0 + 31)) f8_pv(pf, VB0 + vprev * VT, lr, hi, o);
            if ((t < t_hi) && (k0 <= wave_q0 + 31)) { f32x16 p0, p1; const LAS unsigned char* kb = KB0 + (j & 1) * KT;
                F8_QK(kb, p0, p1); f8_softmax(p0, p1, k0 + 63 > wave_q0, k0, qpos, hi, o, m_run, l_run, pf); }
            vprev = vcur; vcur = vnext;
            VM_WAIT(); __syncthreads();
        }
    }
#undef F8_DMA
}
__device__ __forceinline__ void attn_mla_stag(const int tid_in, LAS unsigned char* lds, const unsigned char* gK, const unsigned char* gV, const int t_lo, const int t_hi,
                                              const bf16x8 (&qf)[12], const int qpos, const int wave_q0, f32x16 (&o)[4], float& m_run, float& l_run) {
    constexpr int KT = 24576, VT = 16384;
    int tid = tid_in; asm volatile("" : "+v"(tid));
    const int wid = __builtin_amdgcn_readfirstlane(tid >> 6), lane = tid & 63, lr0 = lane & 31, hi = lane >> 5;
    const bool halfB = wid >= 4;
    LAS unsigned char* KB0 = lds; LAS unsigned char* VB0 = lds + 2 * KT;
    dma_tile<KT>(gK + (size_t)t_lo * KT, KB0, tid, wid); dma_tile<VT>(gV + (size_t)t_lo * VT, VB0, tid, wid);
    VM_WAIT(); __syncthreads();
    if (!halfB) {
        int vcur = 0;
#pragma unroll 1
        for (int t = t_lo; t <= t_hi; ++t) {
            const int j = t - t_lo, vnext = (vcur == 2) ? 0 : vcur + 1;
            if (t + 1 < t_hi) { dma_tile<KT>(gK + (size_t)(t + 1) * KT, KB0 + ((j + 1) & 1) * KT, tid, wid); dma_tile<VT>(gV + (size_t)(t + 1) * VT, VB0 + vnext * VT, tid, wid); }
            const int k0 = t * 64;
            int lr = lr0; asm volatile("" : "+v"(lr));
            if ((t < t_hi) && (k0 <= wave_q0 + 31)) { f32x16 p0, p1; bf16x8 pf[4]; const LAS unsigned char* kb = KB0 + (j & 1) * KT;
                MLA_QK(kb, p0, p1); mla_softmax(p0, p1, k0 + 63 > wave_q0, k0, qpos, hi, o, m_run, l_run, pf); mla_pv(pf, VB0 + vcur * VT, lr, hi, o); }
            vcur = vnext;
            VM_WAIT(); __syncthreads();
        }
    } else {
        bf16x8 pf[4];
#pragma unroll
        for (int s = 0; s < 4; ++s) pf[s] = (bf16x8){0, 0, 0, 0, 0, 0, 0, 0};
        int vcur = 0, vprev = 2;
#pragma unroll 1
        for (int t = t_lo; t <= t_hi; ++t) {
            const int j = t - t_lo, vnext = (vcur == 2) ? 0 : vcur + 1;
            if (t + 1 < t_hi) { dma_tile<KT>(gK + (size_t)(t + 1) * KT, KB0 + ((j + 1) & 1) * KT, tid, wid); dma_tile<VT>(gV + (size_t)(t + 1) * VT, VB0 + vnext * VT, tid, wid); }
            const int k0 = t * 64;
            int lr = lr0; asm volatile("" : "+v"(lr));
            if ((j > 0) && (k0 - 64 <= wave_q0 + 31)) mla_pv(pf, VB0 + vprev * VT, lr, hi, o);
            if ((t < t_hi) && (k0 <= wave_q0 + 31)) { f32x16 p0, p1; const LAS unsigned char* kb = KB0 + (j & 1) * KT;
                MLA_QK(kb, p0, p1); mla_softmax(p0, p1, k0 + 63 > wave_q0, k0, qpos, hi, o, m_run, l_run, pf); }
            vprev = vcur; vcur = vnext;
            VM_WAIT(); __syncthreads();
        }
    }
}
template <int DQK> __device__ __forceinline__ void load_q_norm(const bf16_t* qrow, const float* gain, float scale, int hi, bf16x8 (&qf)[DQK / 16]) {
    float x[DQK / 16][8]; float ss = 0.f;
#pragma unroll
    for (int ks = 0; ks < DQK / 16; ++ks) { const u32x4 w = *(const u32x4*)(qrow + 16 * ks + 8 * hi); unpack8(w, x[ks]);
#pragma unroll
        for (int j = 0; j < 8; ++j) ss += x[ks][j] * x[ks][j]; }
    { auto rr = __builtin_amdgcn_permlane32_swap(__float_as_uint(ss), __float_as_uint(ss), false, false); ss = __uint_as_float(rr[0]) + __uint_as_float(rr[1]); }
    const float rs = rsqrtf(ss * (1.0f / DQK) + EPS) * scale;
#pragma unroll
    for (int ks = 0; ks < DQK / 16; ++ks) { float y[8];
#pragma unroll
        for (int j = 0; j < 8; ++j) y[j] = x[ks][j] * rs * gain[16 * ks + 8 * hi + j];
        qf[ks] = __builtin_bit_cast(bf16x8, pack8(y)); }
}
template <int DQK> __device__ __forceinline__ void load_q_norm_bf16x2(const bf16_t* qa, const bf16_t* qb_, const float* gain, float scale, int hi, bf16x8 (&qf)[DQK / 16]) {
    float x[DQK / 16][8]; float ss = 0.f;
#pragma unroll
    for (int ks = 0; ks < DQK / 16; ++ks) { float a[8], b[8]; unpack8(*(const u32x4*)(qa + 16 * ks + 8 * hi), a); unpack8(*(const u32x4*)(qb_ + 16 * ks + 8 * hi), b);
#pragma unroll
        for (int j = 0; j < 8; ++j) { x[ks][j] = a[j] + b[j]; ss += x[ks][j] * x[ks][j]; } }
    { auto rr = __builtin_amdgcn_permlane32_swap(__float_as_uint(ss), __float_as_uint(ss), false, false); ss = __uint_as_float(rr[0]) + __uint_as_float(rr[1]); }
    const float rs = rsqrtf(ss * (1.0f / DQK) + EPS) * scale;
#pragma unroll
    for (int ks = 0; ks < DQK / 16; ++ks) { float y[8];
#pragma unroll
        for (int j = 0; j < 8; ++j) y[j] = x[ks][j] * rs * gain[16 * ks + 8 * hi + j];
        qf[ks] = __builtin_bit_cast(bf16x8, pack8(y)); }
}
template <int DQK> __device__ __forceinline__ void load_q_norm_bf16x4(const bf16_t* q0, const size_t zs, const float* gain, float scale, int hi, bf16x8 (&qf)[DQK / 16]) {
    float x[DQK / 16][8]; float ss = 0.f;
#pragma unroll
    for (int ks = 0; ks < DQK / 16; ++ks) {
#pragma unroll
        for (int j = 0; j < 8; ++j) x[ks][j] = 0.f;
#pragma unroll
        for (int z = 0; z < 4; ++z) { float a[8]; unpack8(*(const u32x4*)(q0 + z * zs + 16 * ks + 8 * hi), a);
#pragma unroll
            for (int j = 0; j < 8; ++j) x[ks][j] += a[j]; }
#pragma unroll
        for (int j = 0; j < 8; ++j) ss += x[ks][j] * x[ks][j]; }
    { auto rr = __builtin_amdgcn_permlane32_swap(__float_as_uint(ss), __float_as_uint(ss), false, false); ss = __uint_as_float(rr[0]) + __uint_as_float(rr[1]); }
    const float rs = rsqrtf(ss * (1.0f / DQK) + EPS) * scale;
#pragma unroll
    for (int ks = 0; ks < DQK / 16; ++ks) { float y[8];
#pragma unroll
        for (int j = 0; j < 8; ++j) y[j] = x[ks][j] * rs * gain[16 * ks + 8 * hi + j];
        qf[ks] = __builtin_bit_cast(bf16x8, pack8(y)); }
}
template <int DV> __device__ __forceinline__ void store_o(bf16_t* orow, const f32x16 (&o)[DV / 32], float inv_l, int hi) {
#pragma unroll
    for (int db = 0; db < DV / 32; ++db)
#pragma unroll
        for (int r4 = 0; r4 < 4; ++r4) { u32x2 w; w.x = cvt_pk_bf16(o[db][4 * r4] * inv_l, o[db][4 * r4 + 1] * inv_l); w.y = cvt_pk_bf16(o[db][4 * r4 + 2] * inv_l, o[db][4 * r4 + 3] * inv_l);
            *(u32x2*)(orow + 32 * db + 8 * r4 + 4 * hi) = w; }
}

struct Args { const float* in[50]; float* out; unsigned char* ws; int l_lo, l_hi, ph_lo, ph_hi; };
enum { I_X = 0, I_MEM, I_RELB, I_LNMIX, I_WIN, I_SWAQG, I_SWAKG, I_SINK, I_DWW, I_DWB, I_CLNG, I_CLNB, I_PWW, I_PWB, I_QAG, I_KVAG, I_WQB, I_WKVB, I_QNN, I_QNR, I_KNN, I_KNR,
       I_ARE, I_AIM, I_LOGDT, I_BRE, I_BIM, I_CRE, I_CIM, I_SSMD, I_GLUW, I_GLUB, I_MIXG, I_WOUT, I_LNX, I_MEMG, I_XWQ, I_XWK, I_XWV, I_XQG, I_XKG, I_XWO, I_LNMOE, I_WG, I_BG, I_WE, I_BE, I_MG, I_MU, I_MD };
constexpr int NPH = 19;

__constant__ unsigned char T5_BUCKET[128] = {0,1,2,3,4,5,6,7,8,9,10,11,12,13,14,15,16,16,16,17,17,18,18,18,19,19,19,20,20,20,20,21,21,21,21,22,22,22,22,22,23,23,23,23,23,23,24,24,24,24,24,24,25,25,25,25,25,25,25,26,26,26,26,26,26,26,26,27,27,27,27,27,27,27,27,27,27,28,28,28,28,28,28,28,28,28,28,29,29,29,29,29,29,29,29,29,29,29,29,30,30,30,30,30,30,30,30,30,30,30,30,30,30,31,31,31,31,31,31,31,31,31,31,31,31,31,31,31};

__device__ __forceinline__ void tr_item(const float* W, int ldw, int k0, int n0, bf16_t* WT, int ldt, int drow0, const float* kgain, LAS float* scr, int lane) {
    float tv[32];
#pragma unroll
    for (int i = 0; i < 32; ++i) { const int kk = 2 * i + (lane >> 5); tv[i] = W[(size_t)(k0 + kk) * ldw + n0 + (lane & 31)]; }
#pragma unroll
    for (int i = 0; i < 32; ++i) { const int kk = 2 * i + (lane >> 5); float v = tv[i]; if (kgain) v *= kgain[k0 + kk]; scr[kk * 33 + (lane & 31)] = v; }
    LDS_WAIT();
    const int c = lane & 7;
#pragma unroll
    for (int j = 0; j < 4; ++j) { const int n = (lane >> 3) + 8 * j; const LAS float* s = scr + (8 * c) * 33 + n;
        u32x4 o; o.x = cvt_pk_bf16(s[0 * 33], s[1 * 33]); o.y = cvt_pk_bf16(s[2 * 33], s[3 * 33]); o.z = cvt_pk_bf16(s[4 * 33], s[5 * 33]); o.w = cvt_pk_bf16(s[6 * 33], s[7 * 33]);
        *(u32x4*)(WT + (size_t)(drow0 + n) * ldt + k0 + 8 * c) = o; }
    LDS_WAIT();
}
__device__ __forceinline__ void tr_item8(const float* W, int ldw, int k0, int n0, unsigned char* WT8, int ldt, int drow0, const float* kgain, LAS float* scr, int lane) {
    float tv[32];
#pragma unroll
    for (int i = 0; i < 32; ++i) { const int kk = 2 * i + (lane >> 5); tv[i] = W[(size_t)(k0 + kk) * ldw + n0 + (lane & 31)]; }
#pragma unroll
    for (int i = 0; i < 32; ++i) { const int kk = 2 * i + (lane >> 5); float v = tv[i] * 32.0f; if (kgain) v *= kgain[k0 + kk]; scr[kk * 33 + (lane & 31)] = v; }
    LDS_WAIT();
    const int c = lane & 7;
#pragma unroll
    for (int j = 0; j < 4; ++j) { const int n = (lane >> 3) + 8 * j; const LAS float* s = scr + (8 * c) * 33 + n;
        *(u32x2*)(WT8 + (size_t)(drow0 + n) * ldt + k0 + 8 * c) = (u32x2){pk4_fp8(s[0 * 33], s[1 * 33], s[2 * 33], s[3 * 33]), pk4_fp8(s[4 * 33], s[5 * 33], s[6 * 33], s[7 * 33])}; }
    LDS_WAIT();
}
__device__ __forceinline__ void rms_row_store(const f32x4 (&v)[8], const float* gain, bf16_t* orow, int lane) {
    float ss = 0.f;
#pragma unroll
    for (int j = 0; j < 8; ++j) ss += (v[j].x * v[j].x + v[j].y * v[j].y) + (v[j].z * v[j].z + v[j].w * v[j].w);
    const float rs = rsqrtf(wave_sum(ss) * (1.0f / D) + EPS);
#pragma unroll
    for (int j = 0; j < 8; ++j) { const f32x4 g = *(const f32x4*)(gain + 4 * lane + 256 * j); u32x2 w; w.x = cvt_pk_bf16(v[j].x * rs * g.x, v[j].y * rs * g.y); w.y = cvt_pk_bf16(v[j].z * rs * g.z, v[j].w * rs * g.w);
        *(u32x2*)(orow + 4 * lane + 256 * j) = w; }
}
__device__ __forceinline__ f32x2 cmul(f32x2 a, f32x2 b) { return (f32x2){a.x * b.x - a.y * b.y, a.x * b.y + a.y * b.x}; }
__device__ __forceinline__ void sincos_rev(float x, float& s, float& c) { float r = x * 0.15915494309189535f; r -= rintf(r); s = __builtin_amdgcn_sinf(r); c = __builtin_amdgcn_cosf(r); }

#define X ((float*)out_)
#define ROPE ((float*)(ws + WS_ROPE))
#define H ((bf16_t*)(ws + WS_H))
#define P ((bf16_t*)(ws + WS_P))
#define O ((bf16_t*)(ws + WS_O))
#define QRAW ((bf16_t*)(ws + WS_QRAW))
#define KVRAW ((bf16_t*)(ws + WS_KVRAW))
#define Q ((bf16_t*)(ws + WS_Q))
#define KIMG ((unsigned char*)(ws + WS_KIMG))
#define VIMG ((unsigned char*)(ws + WS_VIMG))
#define SWAK ((unsigned char*)(ws + WS_SWAK))
#define SWAV ((unsigned char*)(ws + WS_SWAV))
#define ZC ((bf16_t*)(ws + WS_ZC))
#define UA ((bf16_t*)(ws + WS_UA))
#define EBUF ((float*)(ws + WS_EBUF))
#define YG ((bf16_t*)(ws + WS_YG))
#define QX ((bf16_t*)(ws + WS_QX))
#define OX ((bf16_t*)(ws + WS_OX))
#define MEMN ((bf16_t*)(ws + WS_MEMN))
#define KMEM ((bf16_t*)(ws + WS_KMEM))
#define VMEM ((bf16_t*)(ws + WS_VMEM))
#define XKIMG ((unsigned char*)(ws + WS_XKIMG))
#define XVIMG ((unsigned char*)(ws + WS_XVIMG))
#define LOGI ((float*)(ws + WS_LOG))
#define TOK ((int*)(ws + WS_TOK))
#define WSLOT ((float*)(ws + WS_WSLOT))
#define HID ((bf16_t*)(ws + WS_HID))
#define YS8 ((unsigned char*)(ws + WS_YS))
#define WIN ((bf16_t*)(ws + WS_WIN))
#define WOUT ((bf16_t*)(ws + WS_WOUT))
#define XWQ ((bf16_t*)(ws + WS_XWQ))
#define XWK ((bf16_t*)(ws + WS_XWK))
#define XWV ((bf16_t*)(ws + WS_XWV))
#define XWO ((bf16_t*)(ws + WS_XWO))
#define PW ((bf16_t*)(ws + WS_PW))
#define WQB ((bf16_t*)(ws + WS_WQB))
#define WKVB ((bf16_t*)(ws + WS_WKVB))
#define GLU ((bf16_t*)(ws + WS_GLU))
#define ROUT ((bf16_t*)(ws + WS_ROUT))
#define MOE1 ((bf16_t*)(ws + WS_MOE1))
#define MOE2 ((bf16_t*)(ws + WS_MOE2))
#define W1G ((bf16_t*)(ws + WS_W1G))
#define BTY ((bf16_t*)(ws + WS_BTY))
#define PARTO ((float*)(ws + WS_PARTO))
#define XB ((bf16_t*)(ws + WS_XB))
#define QXP ((float*)(ws + WS_QXP))
#define LOGP ((float*)(ws + WS_LOGP))
#define SSP ((float*)(ws + WS_SSP))
#define RMSV ((float*)(ws + WS_RMSV))
#define RMS1 ((float*)(ws + WS_RMS1))
#define XF8 ((unsigned char*)(ws + WS_XF8))
#define KCG ((float*)(ws + WS_H + 16 * MiB))
#define PQ7 ((bf16_t*)(ws + WS_H))
#define HID8 ((unsigned char*)(ws + WS_HID))
#define MOE1F ((unsigned char*)(ws + WS_MOE1))
#define MOE2F ((unsigned char*)(ws + WS_MOE2))
#define PARTML ((float*)(ws + WS_PARTML))
#define REC_E ((int*)(ws + WS_REC))
#define REC_R (REC_E + 2 * S)
#define REC_W ((float*)(REC_E + 4 * S))
#define REC_S (REC_E + 6 * S)
__device__ __forceinline__ unsigned long long ldp(const LAS unsigned* pt, int i) { unsigned lo = pt[2 * i], hi = pt[2 * i + 1]; lo = __builtin_amdgcn_readfirstlane(lo); hi = __builtin_amdgcn_readfirstlane(hi); return ((unsigned long long)hi << 32) | lo; }
#define INP(i) ((const float*)(const GAS float*)ldp(PT, (i)))
#define FRESH() int tid = (wave_s << 6) + (int)__builtin_amdgcn_mbcnt_hi(~0u, __builtin_amdgcn_mbcnt_lo(~0u, 0u)), G = gridDim.x, bid = blockIdx.x; unsigned lo_ = 0u; asm volatile("" : "+v"(tid), "+s"(G), "+s"(bid), "+s"(lo_)); LAS unsigned char* lds = lds0; const LAS unsigned* PT = (const LAS unsigned*)(lds0 + lo_ + LDSCTL_OFF + 512); volatile LAS unsigned* CTLW = (volatile LAS unsigned*)(lds0 + lo_ + LDSCTL_OFF); (void)CTLW; const int NGW = G * NWAVES; (void)NGW; const int lane = tid & 63, wave = __builtin_amdgcn_readfirstlane(tid >> 6), gw = bid * NWAVES + wave; unsigned char* ws = (unsigned char*)(GAS unsigned char*)ldp(PT, 50); float* out_ = (float*)(GAS float*)ldp(PT, 51); unsigned* ctl = (unsigned*)ws; (void)lane; (void)wave; (void)gw; (void)ws; (void)out_; (void)ctl
#if !MK_MULTI
#define GRID_BAR() do { XcdBarrier bar_; bar_.bar = ctl + CW_BAR; bar_.x = xb_xcc_id(); bar_.st = CTLW; xcd_barrier(bar_, tid); } while (0)
#else
#define GRID_BAR() do { } while (0)
#endif

#ifndef PROBE_REP
#define PROBE_REP 0u
#endif
#ifndef PHASE_MASK
#define PHASE_MASK 0xFFFFFFFFu
#endif
#define IN(k) ((((PHASE_MASK) >> (k)) & 1u) && ({ int a_ = ph_lo, b_ = ph_hi; asm volatile("" : "+s"(a_), "+s"(b_)); (a_ <= (k) && (k) < b_); }))
#define SEAM(k) do { if (IN((k) + 1) || ((k) == NPH - 1 && IN(0) && IN(NPH - 1))) GRID_BAR(); } while (0)


__device__ __forceinline__ void norm_groups(const LAS unsigned* PT, unsigned char* ws, const int l, const int s0, const int sstride, const int glo, const int ghi, const int lane) {
    const float* mg = INP(I_MIXG) + l * D;
    for (int s = s0; s < S; s += sstride) {
#pragma unroll
        for (int grp = 0; grp < 4; ++grp) { if (grp < glo || grp >= ghi) continue; bf16_t* p = O + (size_t)s * D + grp * 512 + 8 * lane; float x[8];
                    if (grp == 2 && s >= S / 2) {
                        const int h = lane >> 4, d0 = (lane & 15) * 8, qb = s >> 8, row = s & 255;
                        const size_t sa = ((size_t)(h * 32 + (qb - 32)) * 2 + 0) * 256 + row, sb = sa + 256;
                        const f32x2 mla = *(const f32x2*)(PARTML + sa * 2), mlb = *(const f32x2*)(PARTML + sb * 2);
                        const float mm = fmaxf(mla.x, mlb.x), fa = fast_exp2(mla.x - mm), fb = fast_exp2(mlb.x - mm), inv = fast_rcp(mla.y * fa + mlb.y * fb);
                        const f32x4 a0 = *(const f32x4*)(PARTO + sa * 128 + d0), a1 = *(const f32x4*)(PARTO + sa * 128 + d0 + 4), b0 = *(const f32x4*)(PARTO + sb * 128 + d0), b1 = *(const f32x4*)(PARTO + sb * 128 + d0 + 4);
#pragma unroll
                        for (int j = 0; j < 4; ++j) { x[j] = (a0[j] * fa + b0[j] * fb) * inv; x[4 + j] = (a1[j] * fa + b1[j] * fb) * inv; }
                    } else unpack8(*(const u32x4*)p, x);
                    float ss = 0.f;
#pragma unroll
                    for (int j = 0; j < 8; ++j) ss += x[j] * x[j];
                    const float rs = rsqrtf(wave_sum(ss) * (1.f / 512.f) + EPS); const float* gn = mg + grp * 512 + 8 * lane;
#pragma unroll
                    for (int j = 0; j < 8; ++j) x[j] = x[j] * rs * gn[j];
                    *(u32x4*)p = pack8(x); }
            }
}

template <int DUMMY> __device__ __forceinline__ void layer_body(const int l, const int wave_s, LAS unsigned char* lds0, const int ph_lo, const int ph_hi) {
        if (IN(0)) {
            FRESH();
            LAS float* scr = (LAS float*)(lds + wave * 16384);
            for (int rep_ = 0; rep_ < (int)(PROBE_REP & 1u) + 1; ++rep_) {
                const float* w_in = INP(I_WIN) + (size_t)l * D * INW; const float* w_out = INP(I_WOUT) + (size_t)l * D * D;
                const float* xwq = INP(I_XWQ) + (size_t)l * D * 512; const float* xwk = INP(I_XWK) + (size_t)l * D * 512; const float* xwv = INP(I_XWV) + (size_t)l * D * 512;
                const float* xwo = INP(I_XWO) + (size_t)l * 512 * D; const float* pww = INP(I_PWW) + (size_t)l * 512 * 512;
                const float* wqb = INP(I_WQB) + (size_t)l * 512 * 768; const float* wkvb = INP(I_WKVB) + (size_t)l * 256 * 1024; const float* gluw = INP(I_GLUW) + (size_t)l * 512 * 512;
                const float* mg = INP(I_MG) + (size_t)l * 32 * D * 512; const float* mu = INP(I_MU) + (size_t)l * 32 * D * 512; const float* md = INP(I_MD) + (size_t)l * 32 * 512 * D;
                const float* qag = INP(I_QAG) + l * 512; const float* kvag = INP(I_KVAG) + l * 256; const float* lnx = INP(I_LNX) + l * D; const float* lnmix = INP(I_LNMIX) + l * D; const float* lnm = INP(I_LNMOE) + l * D;
                constexpr int N_IN = 32 * 98, N_OUT = 32 * 64, N_XQ = 32 * 16, N_XO = 8 * 64, N_PW = 8 * 16, N_QB = 8 * 24, N_KVB = 4 * 32, N_GLU = 8 * 16, N_MG = 32 * 512, N_MD = 32 * 512;
                constexpr int NITEMS = N_IN + N_OUT + 3 * N_XQ + N_XO + N_PW + N_QB + N_KVB + N_GLU + 2 * N_MG + N_MD;
                for (int it = gw; it < NITEMS; it += NGW) {
                    int r = it;
                    if (r < N_MG) { const int e = r >> 9, rr = r & 511, kb = rr >> 4, nb = rr & 15, n0 = 32 * nb; tr_item8(mg + (size_t)e * D * 512, 512, 64 * kb, n0, MOE1F + (size_t)e * 1024 * D, D, (n0 >> 7) * 256 + (n0 & 127), lnm, scr, lane); continue; } r -= N_MG;
                    if (r < N_MG) { const int e = r >> 9, rr = r & 511, kb = rr >> 4, nb = rr & 15, n0 = 32 * nb; tr_item8(mu + (size_t)e * D * 512, 512, 64 * kb, n0, MOE1F + (size_t)e * 1024 * D, D, (n0 >> 7) * 256 + 128 + (n0 & 127), lnm, scr, lane); continue; } r -= N_MG;
                    if (r < N_MD) { const int e = r >> 9, rr = r & 511, kb = rr >> 6, nb = rr & 63; tr_item8(md + (size_t)e * 512 * D, D, 64 * kb, 32 * nb, MOE2F + (size_t)e * D * 512, 512, 32 * nb, nullptr, scr, lane); continue; } r -= N_MD;
                    if (r < N_IN) { const int kb = r / 98, nb = r % 98, n0 = 32 * nb, dr = (n0 < 448) ? n0 : (n0 < 512 ? 3072 + (n0 - 448) : n0 - 64); tr_item(w_in, INW, 64 * kb, n0, WIN, D, dr, lnmix, scr, lane); continue; } r -= N_IN;
                    if (r < N_OUT) { const int kb = r >> 6, nb = r & 63; tr_item(w_out, D, 64 * kb, 32 * nb, WOUT, D, 32 * nb, nullptr, scr, lane); continue; } r -= N_OUT;
                    if (r < N_XQ) { const int kb = r >> 4, nb = r & 15; tr_item(xwq, 512, 64 * kb, 32 * nb, XWQ, D, 32 * nb, lnx, scr, lane); continue; } r -= N_XQ;
                    if (r < N_XQ) { const int kb = r >> 4, nb = r & 15; tr_item(xwk, 512, 64 * kb, 32 * nb, XWK, D, 32 * nb, nullptr, scr, lane); continue; } r -= N_XQ;
                    if (r < N_XQ) { const int kb = r >> 4, nb = r & 15; tr_item(xwv, 512, 64 * kb, 32 * nb, XWV, D, 32 * nb, nullptr, scr, lane); continue; } r -= N_XQ;
                    if (r < N_XO) { const int kb = r >> 6, nb = r & 63; tr_item(xwo, D, 64 * kb, 32 * nb, XWO, 512, 32 * nb, nullptr, scr, lane); continue; } r -= N_XO;
                    if (r < N_PW) { const int kb = r >> 4, nb = r & 15; tr_item(pww, 512, 64 * kb, 32 * nb, PW, 512, 32 * nb, nullptr, scr, lane); continue; } r -= N_PW;
                    if (r < N_QB) { const int kb = r / 24, nb = r % 24; tr_item(wqb, 768, 64 * kb, 32 * nb, WQB, 512, 32 * nb, qag, scr, lane); continue; } r -= N_QB;
                    if (r < N_KVB) { const int kb = r >> 5, nb = r & 31; tr_item(wkvb, 1024, 64 * kb, 32 * nb, WKVB, 256, 32 * nb, kvag, scr, lane); continue; } r -= N_KVB;
                    { const int kb = r >> 4, nb = r & 15; tr_item(gluw, 512, 64 * kb, 32 * nb, GLU, 512, 32 * nb, nullptr, scr, lane); }
                }
                if (bid == 0 && tid < 256) { *(u32x4*)(XB + (size_t)S * D + 8 * tid) = (u32x4){0u, 0u, 0u, 0u}; *(u32x2*)(XF8 + (size_t)S * D + 8 * tid) = (u32x2){0u, 0u}; }
                for (int i = bid * NTHR + tid; i < (WINR - INW) * D / 8; i += G * NTHR) *(u32x4*)(WIN + (size_t)INW * D + (size_t)i * 8) = (u32x4){0u, 0u, 0u, 0u};
                const float* wgp = INP(I_WG) + (size_t)l * D * 4; const float* wep = INP(I_WE) + (size_t)l * D * 32;
                for (int i = bid * NTHR + tid; i < 256 * D / 2; i += G * NTHR) { const int n = i / (D / 2), k = (i % (D / 2)) * 2; float a = 0.f, b = 0.f;
                    if (n < 4) { a = wgp[(size_t)k * 4 + n] * lnm[k]; b = wgp[(size_t)(k + 1) * 4 + n] * lnm[k + 1]; } else if (n < 36) { a = wep[(size_t)k * 32 + n - 4] * lnm[k]; b = wep[(size_t)(k + 1) * 32 + n - 4] * lnm[k + 1]; }
                    *(unsigned*)(ROUT + (size_t)n * D + k) = cvt_pk_bf16(a, b); }
            }
            __syncthreads();
            for (int rep_ = 0; rep_ < (int)((PROBE_REP >> 19) & 1u) + 1; ++rep_)
            for (int task = bid; task < 256; task += G) {
                FRESH();
                const int g = task >> 3, part = task & 7;
                LAS f32x2* LP = (LAS f32x2*)lds;
                LAS f32x2* BB = (LAS f32x2*)(lds + 36864);
                LAS f32x2* CC = (LAS f32x2*)(lds + 45056);
                LAS float* KC = (LAS float*)(lds + 53248);
                const float* are = INP(I_ARE) + (size_t)(l * 32 + g) * 64; const float* aim = INP(I_AIM) + (size_t)(l * 32 + g) * 64;
                const float dt = __expf(INP(I_LOGDT)[l * 32 + g]);
                const float* bre = INP(I_BRE) + (size_t)(l * 32 + g) * 1024; const float* bim = INP(I_BIM) + (size_t)(l * 32 + g) * 1024;
                const float* cre = INP(I_CRE) + (size_t)(l * 32 + g) * 1024; const float* cim = INP(I_CIM) + (size_t)(l * 32 + g) * 1024;
                const float* dsk = INP(I_SSMD) + l * 512 + g * 16;
                if (tid < 64) { const int p = tid; float s, c; sincos_rev(aim[p] * dt, s, c); const float mag = fast_exp2(are[p] * dt * LOG2E); const f32x2 lb = (f32x2){mag * c, mag * s};
                    f32x2 cur = (f32x2){1.f, 0.f}; for (int j = 0; j <= 64; ++j) { LP[p * 65 + j] = cur; cur = cmul(cur, lb); } }
                for (int i = tid; i < 1024; i += NTHR) { const int p = i >> 4, ii = i & 15; float s, c; sincos_rev(aim[p] * dt, s, c); const float mag = fast_exp2(are[p] * dt * LOG2E);
                    const float nr = mag * c - 1.f, ni = mag * s, lr_ = are[p], li = aim[p], den = fast_rcp(lr_ * lr_ + li * li);
                    const f32x2 coef = (f32x2){(nr * lr_ + ni * li) * den, (ni * lr_ - nr * li) * den};
                    BB[p * 16 + ii] = cmul(coef, (f32x2){bre[p * 16 + ii], bim[p * 16 + ii]});
                    CC[i] = (f32x2){cre[i], cim[i]}; }
                __syncthreads();
                {   const int j = part * 8 + (tid >> 6), o = (tid >> 2) & 15, i0 = (tid & 3) * 4; float acc[4] = {0.f, 0.f, 0.f, 0.f};
                    for (int p = 0; p < 64; ++p) { const f32x2 u = cmul(CC[o * 64 + p], LP[p * 65 + j]);
#pragma unroll
                        for (int m = 0; m < 4; ++m) { const f32x2 bb = BB[p * 16 + i0 + m]; acc[m] += u.x * bb.x - u.y * bb.y; } }
#pragma unroll
                    for (int m = 0; m < 4; ++m) if (j == 0 && o == i0 + m) acc[m] += dsk[o];
                    *(f32x4*)(KCG + (size_t)g * 16384 + (j * 16 + o) * 16 + i0) = (f32x4){acc[0], acc[1], acc[2], acc[3]}; }
                for (int ch = tid; ch < 32 * 128; ch += NTHR) { const int n = part * 32 + ch / 128, kc = (ch % 128) * 8, tau = kc >> 4, i0 = kc & 15; float v[8];
                    if (n < 128) { const int p = n & 63; const f32x2 lp = LP[p * 65 + 63 - tau];
#pragma unroll
                        for (int j = 0; j < 8; ++j) { const f32x2 t2 = cmul(lp, BB[p * 16 + i0 + j]); v[j] = (n < 64) ? t2.x : t2.y; } }
                    else {
#pragma unroll
                        for (int j = 0; j < 8; ++j) v[j] = 0.f; }
                    *(u32x4*)(W1G + ((size_t)g * 256 + n) * 1024 + kc) = pack8(v); }
                __syncthreads();
            }
            if (l == 0) { FRESH(); for (int i = bid * NTHR + tid; i < S * 32; i += G * NTHR) { const int pos = i >> 5, f = i & 31; const float inv = fast_exp2(-(float)f * (13.287712379549449f / 32.0f));
                    double tr = (double)pos * (double)inv * 0.15915494309189535; tr -= rint(tr); const float rf = (float)tr;
                    ROPE[2 * i] = __builtin_amdgcn_cosf(rf); ROPE[2 * i + 1] = __builtin_amdgcn_sinf(rf); } }
            for (int rep3_ = (int)((PROBE_REP >> 21) & 1u); rep3_ >= 0; --rep3_)
            {   FRESH(); const float* xin = INP(I_X);
                for (int s = gw; s < S; s += NGW) { float x[4][8];
                    if (l == 0) {
#pragma unroll
                        for (int j = 0; j < 4; ++j) { const f32x4 a = *(const f32x4*)(xin + (size_t)s * D + 8 * lane + 512 * j), b = *(const f32x4*)(xin + (size_t)s * D + 8 * lane + 512 * j + 4);
                            x[j][0] = a[0]; x[j][1] = a[1]; x[j][2] = a[2]; x[j][3] = a[3]; x[j][4] = b[0]; x[j][5] = b[1]; x[j][6] = b[2]; x[j][7] = b[3]; } }
                    else { const int s0 = REC_S[2 * s], s1 = REC_S[2 * s + 1];
#pragma unroll
                        for (int j = 0; j < 4; ++j) { float ya[8], yb[8]; unpack8(*(const u32x4*)(XB + (size_t)s * D + 8 * lane + 512 * j), x[j]);
                            unpack8_fp8(*(const u32x2*)(YS8 + (size_t)s0 * D + 8 * lane + 512 * j), ya); unpack8_fp8(*(const u32x2*)(YS8 + (size_t)s1 * D + 8 * lane + 512 * j), yb);
#pragma unroll
                            for (int e = 0; e < 8; ++e) x[j][e] += (ya[e] + yb[e]) * 0.0625f; } }
                    float ss = 0.f;
#pragma unroll
                    for (int j = 0; j < 4; ++j)
#pragma unroll
                        for (int e = 0; e < 8; ++e) ss += x[j][e] * x[j][e];
                    ss = wave_sum(ss);
                    if (rep3_ == 0) {
#pragma unroll
                        for (int j = 0; j < 4; ++j) *(u32x4*)(XB + (size_t)s * D + 8 * lane + 512 * j) = pack8(x[j]);
                        if (lane == 0) RMS1[s] = rsqrtf(ss * (1.0f / D) + EPS); } }
                const float* mgain = INP(I_MEMG) + l * D; const float* mem = INP(I_MEM);
                for (int s = gw; s < MEMT; s += NGW) { f32x4 v[8];
#pragma unroll
                    for (int j = 0; j < 8; ++j) v[j] = *(const f32x4*)(mem + (size_t)s * D + 4 * lane + 256 * j);
                    rms_row_store(v, mgain, MEMN + (size_t)s * D, lane); }
            }
            SEAM(0);
        }
        if (IN(1)) for (int rep_ = 0; rep_ < (int)((PROBE_REP >> 1) & 1u) + 1; ++rep_) {
            FRESH();
            {
                for (int task = bid; task < 256; task += G) {
                    FRESH();
                    const int g = task >> 3, part = task & 7;
                    LAS f32x2* LP = (LAS f32x2*)lds;
                    LAS f32x2* CC = (LAS f32x2*)(lds + 45056);
                    LAS float* KC = (LAS float*)(lds + 53248);
                    const float* are = INP(I_ARE) + (size_t)(l * 32 + g) * 64; const float* aim = INP(I_AIM) + (size_t)(l * 32 + g) * 64;
                    const float dt = __expf(INP(I_LOGDT)[l * 32 + g]);
                    const float* cre = INP(I_CRE) + (size_t)(l * 32 + g) * 1024; const float* cim = INP(I_CIM) + (size_t)(l * 32 + g) * 1024;
                    if (tid < 64) { const int p = tid; float s_, c_; sincos_rev(aim[p] * dt, s_, c_); const float mag = fast_exp2(are[p] * dt * LOG2E); const f32x2 lb = (f32x2){mag * c_, mag * s_};
                        f32x2 cur = (f32x2){1.f, 0.f}; for (int j = 0; j <= 64; ++j) { LP[p * 65 + j] = cur; cur = cmul(cur, lb); } }
                    for (int i = tid; i < 1024; i += NTHR) CC[i] = (f32x2){cre[i], cim[i]};
#pragma unroll
                    for (int k_ = 0; k_ < 8; ++k_) { const int i = tid + k_ * NTHR; *(LAS f32x4*)(KC + 4 * i) = *(const f32x4*)(KCG + (size_t)g * 16384 + 4 * i); }
                    __syncthreads();
                    for (int ch = tid; ch < 128 * 160; ch += NTHR) { const int rr = part * 128 + ch / 160, kc = (ch % 160) * 8, t = rr >> 4, o = rr & 15; float v[8];
                        if (kc < 1024) { const int tau = kc >> 4, i0 = kc & 15;
#pragma unroll
                            for (int j = 0; j < 8; ++j) v[j] = (tau <= t) ? KC[((t - tau) * 16 + o) * 16 + i0 + j] : 0.f; }
                        else if (kc < 1152) { const bool im = kc >= 1088; const int p0 = (kc - (im ? 1088 : 1024));
#pragma unroll
                            for (int j = 0; j < 8; ++j) { const f32x2 t2 = cmul(CC[o * 64 + p0 + j], LP[(p0 + j) * 65 + t + 1]); v[j] = im ? -t2.y : t2.x; } }
                        else {
#pragma unroll
                            for (int j = 0; j < 8; ++j) v[j] = 0.f; }
                        *(u32x4*)(BTY + ((size_t)g * 1024 + rr) * 1280 + kc) = pack8(v); }
                    __syncthreads();
                } }
            __syncthreads();
            pg8::GSched Sd{(const char*)XB, (const char*)WIN, (size_t)256 * D * 2, (size_t)256 * D * 2, 0, 0, S / 256, 12, 1, G, bid};
            pg8::EpiBf16 E{P, INWP, 0, nullptr, RMS1};
            for (int r2_ = 0; r2_ < (int)((PROBE_REP >> 23) & 1u) + 1; ++r2_)
            pg8::gemm_phase<pg8::EpiBf16, pg8::GSched>(tid, lds, D, D, D, nullptr, Sd, E);
            for (int r3_ = 0; r3_ < (int)((PROBE_REP >> 22) & 1u) * 4 + 1; ++r3_)
            {
                pg8::GSched St{(const char*)XB, (const char*)(WIN + (size_t)3072 * D), (size_t)256 * D * 2, 0, (size_t)512 * 2, (size_t)512 * 2, S / 256, 1, 4, G, bid};
                pg8::EpiBf16Part64 Et{PQ7, (size_t)S * 64, RMS1};
                pg8::gemm_phase<pg8::EpiBf16Part64, pg8::GSched>(tid, lds, 512, D, D, nullptr, St, Et); }
            SEAM(1);
        }
        if (IN(2)) for (int rep_ = 0; rep_ < (int)((PROBE_REP >> 2) & 1u) + 1; ++rep_) {
            FRESH();
            {   pg8::GSched Sd{(const char*)(P + P_CQ), (const char*)WQB, (size_t)256 * INWP * 2, (size_t)256 * 512 * 2, 0, 0, S / 256, 3, 1, G, bid};
                pg8::EpiBf16 E{QRAW, 768, 0, nullptr, nullptr};
                pg8::gemm_phase<pg8::EpiBf16, pg8::GSched>(tid, lds, 512, INWP, 512, nullptr, Sd, E); }
            {   FRESH(); pg8::GSched Sd{(const char*)(P + P_CKV), (const char*)WKVB, (size_t)256 * INWP * 2, (size_t)256 * 256 * 2, 0, 0, S / 256, 4, 1, G, bid};
                pg8::EpiBf16 E{KVRAW, 1024, 0, nullptr, nullptr};
                pg8::gemm_phase<pg8::EpiBf16, pg8::GSched>(tid, lds, 256, INWP, 256, nullptr, Sd, E); }
            __syncthreads();
            for (int rep2_ = 0; rep2_ < (int)((PROBE_REP >> 20) & 1u) + 1; ++rep2_)
            for (int tile = bid; tile < S / 64; tile += G) {
                FRESH();
                const int t0 = tile * 64;
                LAS bf16_t* Z = (LAS bf16_t*)lds;
                LAS bf16_t* DW = (LAS bf16_t*)(lds + 98304);
                const float* dww = INP(I_DWW) + (size_t)l * 31 * 512;
#pragma unroll
                for (int i0_ = 0; i0_ < 12; ++i0_) { const int i = tid + i0_ * NTHR; if (i >= 94 * 64) break; const int rr = i >> 6, c8 = (i & 63) * 8, s = t0 - 30 + rr; float z[8];
                    if (s >= 0) { const u32x4 aw = *(const u32x4*)(P + (size_t)s * INWP + P_BA + c8), gw4 = *(const u32x4*)(P + (size_t)s * INWP + P_BG + c8); float a[8], g[8]; unpack8(aw, a); unpack8(gw4, g);
#pragma unroll
                        for (int j = 0; j < 8; ++j) z[j] = a[j] * sigmoidf_(g[j]); }
                    else {
#pragma unroll
                        for (int j = 0; j < 8; ++j) z[j] = 0.f; }
                    *(LAS u32x4*)(Z + rr * 512 + c8) = pack8(z); }
                for (int i = tid; i < 31 * 64; i += NTHR) { const int w = i >> 6, c8 = (i & 63) * 8; float v[8];
#pragma unroll
                    for (int j = 0; j < 8; ++j) v[j] = dww[w * 512 + c8 + j];
                    *(LAS u32x4*)(DW + w * 512 + c8) = pack8(v); }
                __syncthreads();
                {   const int c8 = lane * 8; const float* dwb = INP(I_DWB) + l * 512 + c8; const float* lg = INP(I_CLNG) + l * 512 + c8; const float* lb = INP(I_CLNB) + l * 512 + c8;
                    for (int j8 = 0; j8 < 8; ++j8) { const int tau = wave * 8 + j8; float acc[8];
#pragma unroll
                        for (int j = 0; j < 8; ++j) acc[j] = dwb[j];
                        for (int w = 0; w < 31; ++w) { float z[8], k[8]; unpack8(*(const LAS u32x4*)(Z + (tau + w) * 512 + c8), z); unpack8(*(const LAS u32x4*)(DW + w * 512 + c8), k);
#pragma unroll
                            for (int j = 0; j < 8; ++j) acc[j] += z[j] * k[j]; }
                        float sm = 0.f;
#pragma unroll
                        for (int j = 0; j < 8; ++j) sm += acc[j];
                        const float mean = wave_sum(sm) * (1.f / 512.f); float sq = 0.f;
#pragma unroll
                        for (int j = 0; j < 8; ++j) { acc[j] -= mean; sq += acc[j] * acc[j]; }
                        const float rstd = rsqrtf(wave_sum(sq) * (1.f / 512.f) + EPS); float y[8];
#pragma unroll
                        for (int j = 0; j < 8; ++j) { const float v = acc[j] * rstd * lg[j] + lb[j]; y[j] = v * sigmoidf_(v); }
                        *(u32x4*)(ZC + (size_t)(t0 + tau) * 512 + c8) = pack8(y); } }
                __syncthreads();
                { u32x4 tmp_[8];
#pragma unroll
                for (int k_ = 0; k_ < 8; ++k_) { const int i = tid + k_ * NTHR; const int half = i & 1, g = (i >> 1) & 31, tau = i >> 6; tmp_[k_] = *(const u32x4*)(P + (size_t)(t0 + tau) * INWP + P_DU + g * 16 + 8 * half); }
#pragma unroll
                for (int k_ = 0; k_ < 8; ++k_) { const int i = tid + k_ * NTHR; const int half = i & 1, g = (i >> 1) & 31, tau = i >> 6;
                    *(u32x4*)(UA + ((size_t)g * 256 + tile) * 1280 + tau * 16 + 8 * half) = tmp_[k_]; } }
                { const int g = tid >> 4, c = tid & 15; *(u32x4*)(UA + ((size_t)g * 256 + tile) * 1280 + 1152 + 8 * c) = (u32x4){0u, 0u, 0u, 0u}; }
                {   LAS bf16_t* vt = (LAS bf16_t*)(lds + wave * 1024);
                    const int j = lane >> 3, c = lane & 7, r = wave * 8 + j, s = t0 + r; const float* kg = INP(I_SWAKG) + l * 64 + 8 * c;
                    for (int kh = 0; kh < 2; ++kh) {
                        float x[8]; unpack8(*(const u32x4*)(P + (size_t)s * INWP + P_AK + kh * 64 + 8 * c), x); float ss = 0.f;
#pragma unroll
                        for (int e = 0; e < 8; ++e) ss += x[e] * x[e];
                        ss += __shfl_xor(ss, 1); ss += __shfl_xor(ss, 2); ss += __shfl_xor(ss, 4);
                        const float rs = rsqrtf(ss * (1.f / 64.f) + EPS);
#pragma unroll
                        for (int e = 0; e < 8; ++e) x[e] = x[e] * rs * kg[e];
                        *(u32x4*)(SWAK + ((size_t)kh * 256 + tile) * 8192 + r * 128 + kswz<128>(r, c) * 16) = pack8(x);
                        *(LAS u32x4*)(vt + j * 64 + 8 * c) = *(const u32x4*)(P + (size_t)s * INWP + P_AV + kh * 64 + 8 * c);
                        LDS_WAIT();
                        { const int d = lane; float v[8];
#pragma unroll
                            for (int jj = 0; jj < 8; ++jj) v[jj] = bf2f(vt[jj * 64 + d]);
                            *(u32x4*)(SWAV + ((size_t)kh * 256 + tile) * 8192 + d * 128 + vswz(d, wave) * 16) = pack8(v); }
                        LDS_WAIT();
                    } }
                __syncthreads();
            }
            SEAM(2);
        }
        if (IN(3)) for (int rep_ = 0; rep_ < (int)((PROBE_REP >> 3) & 1u) + 1; ++rep_) {
            FRESH();
            {   pg8::GSched Sd{(const char*)ZC, (const char*)PW, (size_t)256 * 512 * 2, (size_t)256 * 512 * 2, 0, 0, S / 256, 2, 1, G, (bid + G / 2) % G};
                pg8::EpiBf16 E{O, D, 512, INP(I_PWB) + l * 512, nullptr};
                pg8::gemm_phase<pg8::EpiBf16, pg8::GSched>(tid, lds, 512, 512, 512, nullptr, Sd, E); }
            {   pg8::GSched Sd{(const char*)UA, (const char*)W1G, 0, 0, (size_t)256 * 1280 * 2, (size_t)256 * 1024 * 2, 1, 1, 32, G, (bid + 128) % G};
                pg8::EpiF32Part<128> E{EBUF, 128, (size_t)256 * 128};
                pg8::gemm_phase<pg8::EpiF32Part<128>, pg8::GSched>(tid, lds, 1024, 1280, 1024, nullptr, Sd, E); }
            {   FRESH(); pg8::MemSched Sm{(const char*)MEMN, (const char*)XWK, G, (bid + G - 160) % G};
                pg8::EpiMem Em{KMEM, VMEM};
                pg8::gemm_phase<pg8::EpiMem, pg8::MemSched>(tid, lds, 512, D, D, nullptr, Sm, Em); }
            __syncthreads();
            for (int tile = bid; tile < S / 64; tile += G) {
                FRESH();
                const int t0 = tile * 64; constexpr float QSCALE = 0.07216878364870322f * LOG2E;
                LAS bf16_t* vt = (LAS bf16_t*)(lds + wave * 8192);
                const float* qnn = INP(I_QNN) + l * 128; const float* qnr = INP(I_QNR) + l * 64; const float* knn = INP(I_KNN) + l * 128; const float* knr = INP(I_KNR) + l * 64;
                for (int j2 = 0; j2 < 8; j2 += 2) {
                    u32x2 wkv_[2]; float xkr_[2], cs_[2], sn_[2]; unsigned wqn_[2][4], wkn_[2][4], wv_[2][4]; float xqr_[2][4];
#pragma unroll
                    for (int u = 0; u < 2; ++u) { const int s = t0 + wave * 8 + j2 + u;
                        wkv_[u] = *(const u32x2*)(P + (size_t)s * INWP + P_CKV + 4 * lane);
                        xkr_[u] = bf2f(P[(size_t)s * INWP + P_CKR + lane]);
                        cs_[u] = ROPE[((size_t)s * 32 + (lane & 31)) * 2]; sn_[u] = ROPE[((size_t)s * 32 + (lane & 31)) * 2 + 1];
#pragma unroll
                        for (int h = 0; h < 4; ++h) { wqn_[u][h] = *(const unsigned*)(QRAW + (size_t)s * 768 + h * 192 + 2 * lane); xqr_[u][h] = bf2f(QRAW[(size_t)s * 768 + h * 192 + 128 + lane]);
                            wkn_[u][h] = *(const unsigned*)(KVRAW + (size_t)s * 1024 + h * 256 + 2 * lane); wv_[u][h] = *(const unsigned*)(KVRAW + (size_t)s * 1024 + h * 256 + 128 + 2 * lane); } }
#pragma unroll
                    for (int u = 0; u < 2; ++u) {
                    const int j = j2 + u, r = wave * 8 + j, s = t0 + r;
                    const u32x2 wkv = wkv_[u]; const float xkr = xkr_[u], cs = cs_[u], sn = sn_[u];
                    unsigned wqn[4], wkn[4], wv[4]; float xqr[4];
#pragma unroll
                    for (int h = 0; h < 4; ++h) { wqn[h] = wqn_[u][h]; wkn[h] = wkn_[u][h]; wv[h] = wv_[u][h]; xqr[h] = xqr_[u][h]; }
                    float ps[14];
                    { const float a = bf2f(wkv.x & 0xffffu), b = bf2f(wkv.x >> 16), c = bf2f(wkv.y & 0xffffu), d = bf2f(wkv.y >> 16); ps[0] = a * a + b * b + c * c + d * d; }
                    ps[1] = xkr * xkr;
#pragma unroll
                    for (int h = 0; h < 4; ++h) { const float a = bf2f(wqn[h] & 0xffffu), b = bf2f(wqn[h] >> 16), c = bf2f(wkn[h] & 0xffffu), d = bf2f(wkn[h] >> 16);
                        ps[2 + 3 * h] = a * a + b * b; ps[3 + 3 * h] = xqr[h] * xqr[h]; ps[4 + 3 * h] = c * c + d * d; }
#pragma unroll
                    for (int o = 1; o < 64; o <<= 1)
#pragma unroll
                        for (int k = 0; k < 14; ++k) ps[k] += __shfl_xor(ps[k], o);
                    const float rkv = rsqrtf(ps[0] * (1.f / 256.f) + EPS);
                    float kr; { const float y = xkr * rsqrtf(ps[1] * (1.f / 64.f) + EPS) * knr[lane]; const float pr = __shfl_xor(y, 32);
                        kr = (lane < 32) ? (y * cs - pr * sn) : (pr * sn + y * cs); }
#pragma unroll
                    for (int h = 0; h < 4; ++h) {
                        { const float a = bf2f(wqn[h] & 0xffffu), b = bf2f(wqn[h] >> 16);
                          const float rs = rsqrtf(ps[2 + 3 * h] * (1.f / 128.f) + EPS);
                          *(unsigned short*)((unsigned char*)Q + ((size_t)h * S + s) * 192 + f8pos(2 * lane)) = (unsigned short)(pk4_fp8(a * rs * qnn[2 * lane], b * rs * qnn[2 * lane + 1], 0.f, 0.f) & 0xffffu); }
                        { const float y = xqr[h] * rsqrtf(ps[3 + 3 * h] * (1.f / 64.f) + EPS) * qnr[lane]; const float pr = __shfl_xor(y, 32);
                          const float qr = ((lane < 32) ? (y * cs - pr * sn) : (pr * sn + y * cs));
                          ((unsigned char*)Q)[((size_t)h * S + s) * 192 + f8pos(128 + lane)] = (unsigned char)(pk4_fp8(qr, 0.f, 0.f, 0.f) & 0xffu); }
                        { const float a = bf2f(wkn[h] & 0xffffu), b = bf2f(wkn[h] >> 16);
                          const float rs = rsqrtf(ps[4 + 3 * h] * (1.f / 128.f) + EPS);
                          unsigned char* kimg = KIMG + ((size_t)h * 256 + tile) * 12288 + r * 192; const int pn_ = f8pos(2 * lane), pr_ = f8pos(128 + lane), sw_ = (r >> 2) & 3;
                          *(unsigned short*)(kimg + (((pn_ >> 4) ^ sw_) << 4) + (pn_ & 15)) = (unsigned short)(pk4_fp8(a * rs * knn[2 * lane], b * rs * knn[2 * lane + 1], 0.f, 0.f) & 0xffffu);
                          kimg[(((pr_ >> 4) ^ sw_) << 4) + (pr_ & 15)] = (unsigned char)(pk4_fp8(kr, 0.f, 0.f, 0.f) & 0xffu); }
                        *(LAS unsigned short*)((LAS unsigned char*)vt + (h * 8 + j) * 128 + 2 * lane) = (unsigned short)(pk4_fp8(bf2f(wv[h] & 0xffffu) * rkv, bf2f(wv[h] >> 16) * rkv, 0.f, 0.f) & 0xffffu);
                    }
                                    }
                }
                LDS_WAIT();
                for (int h = 0; h < 4; ++h)
                    for (int dd = 0; dd < 2; ++dd) { const int d = lane + 64 * dd; const LAS unsigned char* v8 = (const LAS unsigned char*)vt; unsigned lo = 0u, hi4 = 0u;
#pragma unroll
                        for (int jj = 0; jj < 4; ++jj) { lo |= (unsigned)v8[(h * 8 + jj) * 128 + d] << (8 * jj); hi4 |= (unsigned)v8[(h * 8 + 4 + jj) * 128 + d] << (8 * jj); }
                        const int off_ = 32 * (wave >> 2) + 8 * (((wave & 1) << 1) | ((wave >> 1) & 1));
                        *(u32x2*)(VIMG + ((size_t)h * 256 + tile) * 8192 + d * 64 + ((((off_ >> 4) ^ ((d >> 2) & 3))) << 4) + (off_ & 15)) = (u32x2){lo, hi4}; }
                LDS_WAIT();
            }
            __syncthreads();
            __syncthreads();
            {   FRESH(); LAS float* tab = (LAS float*)(lds + 98304);
                const float* relb = INP(I_RELB);
                for (int i = tid; i < 1024; i += NTHR) { const int h = i >> 7, dist = i & 127; tab[i] = relb[T5_BUCKET[dist] * 8 + h] * LOG2E; }
                __syncthreads();
                const int lr = lane & 31, hi = lane >> 5;
                for (int it = bid; it < 128; it += G) {
                    const int kh = it & 1, qb = it >> 1, q0 = qb * 256, wq0 = q0 + 32 * wave, qpos = wq0 + lr;
                    const int t_lo = (4 * qb - 2) < 0 ? 0 : (4 * qb - 2), t_hi = 4 * qb + 4;
                    __syncthreads();
                    for (int t = t_lo; t < t_hi; ++t) { dma_tile<8192>(SWAK + ((size_t)kh * 256 + t) * 8192, lds + (t - t_lo) * 16384, tid, wave); dma_tile<8192>(SWAV + ((size_t)kh * 256 + t) * 8192, lds + (t - t_lo) * 16384 + 8192, tid, wave); }
                    VM_WAIT(); __syncthreads();
#pragma unroll 1
                    for (int g = 0; g < 4; ++g) { const int h = 4 * kh + g;
                        bf16x8 qf[4];
                        if (h < 7) load_q_norm<64>(P + (size_t)qpos * INWP + P_AQ + h * 64, INP(I_SWAQG) + l * 64, 0.125f * LOG2E, hi, qf);
                        else load_q_norm_bf16x4<64>(PQ7 + (size_t)qpos * 64, (size_t)S * 64, INP(I_SWAQG) + l * 64, 0.125f * LOG2E, hi, qf);
                        f32x16 o[2];
#pragma unroll
                        for (int db = 0; db < 2; ++db)
#pragma unroll
                            for (int r = 0; r < 16; ++r) o[db][r] = 0.f;
                        float m_run = -1e30f, l_run = 0.f;
#pragma unroll 1
                        for (int t = t_lo; t < t_hi; ++t) { const int k0 = t * 64;
                            if ((k0 <= wq0 + 31) && (k0 + 63 >= wq0 - 127)) attn_tile_compute<64, 64, 1>(lds + (t - t_lo) * 16384, lds + (t - t_lo) * 16384 + 8192, k0, true, qf, qpos, tab + h * 128, lr, hi, o, m_run, l_run); }
                        { auto rr = __builtin_amdgcn_permlane32_swap(__float_as_uint(l_run), __float_as_uint(l_run), false, false); l_run = __uint_as_float(rr[0]) + __uint_as_float(rr[1]); }
                        l_run += fast_exp2(INP(I_SINK)[l * 8 + h] * LOG2E - m_run);
                        store_o<64>(O + (size_t)qpos * D + h * 64, o, fast_rcp(l_run), hi);
                    }
                }
            }
            SEAM(3);
        }
        if (IN(4)) for (int rep_ = 0; rep_ < (int)((PROBE_REP >> 4) & 1u) + 1; ++rep_) {
            FRESH();
            for (int task = bid; task < 64; task += G) {
                FRESH();
                LAS f32x2* SE = (LAS f32x2*)lds;
                const int sl = tid & 31, seg = tid >> 5, st = task * 32 + sl, g = st >> 6, p = st & 63;
                const float dt = __expf(INP(I_LOGDT)[l * 32 + g]); const float are = INP(I_ARE)[(size_t)(l * 32 + g) * 64 + p], aim = INP(I_AIM)[(size_t)(l * 32 + g) * 64 + p];
                float s_, c_; sincos_rev(aim * dt, s_, c_); const float mag = fast_exp2(are * dt * LOG2E); f32x2 lt = (f32x2){mag * c_, mag * s_};
#pragma unroll
                for (int k = 0; k < 6; ++k) lt = cmul(lt, lt);
                f32x2 e[16];
#pragma unroll
                for (int k = 0; k < 16; ++k) { const size_t off = ((size_t)g * 256 + seg * 16 + k) * 128 + p; e[k] = (f32x2){EBUF[off], EBUF[off + 64]}; }
                f32x2 acc = (f32x2){0.f, 0.f};
#pragma unroll
                for (int k = 0; k < 16; ++k) { const f32x2 t = cmul(lt, acc); acc = (f32x2){t.x + e[k].x, t.y + e[k].y}; }
                SE[sl * 16 + seg] = acc;
                f32x2 l16 = lt;
#pragma unroll
                for (int k = 0; k < 4; ++k) l16 = cmul(l16, l16);
                __syncthreads();
                f32x2 carry = (f32x2){0.f, 0.f};
                for (int k = 0; k < seg; ++k) { const f32x2 t = cmul(l16, carry); const f32x2 se = SE[sl * 16 + k]; carry = (f32x2){t.x + se.x, t.y + se.y}; }
#pragma unroll
                for (int k = 0; k < 16; ++k) { const int c = seg * 16 + k; bf16_t* dst = UA + ((size_t)g * 256 + c) * 1280 + 1024 + p;
                    dst[0] = (bf16_t)(cvt_pk_bf16(carry.x, 0.f) & 0xffffu); dst[64] = (bf16_t)(cvt_pk_bf16(carry.y, 0.f) & 0xffffu);
                    const f32x2 t = cmul(lt, carry); carry = (f32x2){t.x + e[k].x, t.y + e[k].y}; }
                __syncthreads();
            }
            {   FRESH(); const int lr = lane & 31, hi = lane >> 5;
                for (int it = bid; it < 256; it += G) {
                    const int xcd_ = it & 7, il_ = ((xcd_ & 1) << 5) | (it >> 3), h = xcd_ >> 1, j = il_ >> 1, part = il_ & 1;
                    for (int sub = 0; sub <= part; ++sub) {
                        const bool fin = (sub == 1);
                        const int qb = fin ? j : 63 - j;
                        const int t_lo = fin ? 0 : (part ? 130 : 0), t_hi = fin ? 4 * j + 4 : (part ? 4 * (64 - j) : 130);
                        const int q0 = qb * 256, wq0 = q0 + 32 * wave, qpos = wq0 + lr;
                        i64x2 qf[6];
#pragma unroll
                        for (int m = 0; m < 6; ++m) qf[m] = *(const i64x2*)((const unsigned char*)Q + ((size_t)h * S + qpos) * 192 + 32 * m + 16 * hi);
                        f32x16 o[4];
#pragma unroll
                        for (int db = 0; db < 4; ++db)
#pragma unroll
                            for (int r = 0; r < 16; ++r) o[db][r] = 0.f;
                        float m_run = -1e30f, l_run = 0.f;
                        attn_mla_f8(tid, lds, KIMG + (size_t)h * 256 * 12288, VIMG + (size_t)h * 256 * 8192, t_lo, t_hi, qf, qpos, wq0, o, m_run, l_run);
                        { auto rr = __builtin_amdgcn_permlane32_swap(__float_as_uint(l_run), __float_as_uint(l_run), false, false); l_run = __uint_as_float(rr[0]) + __uint_as_float(rr[1]); }
                        int tz = tid; asm volatile("" : "+v"(tz));
                        const int lr2 = tz & 31, hi2 = (tz >> 5) & 1, row2 = q0 + (tz >> 6) * 32 + lr2;
                        if (fin) store_o<128>(O + (size_t)row2 * D + 1024 + h * 128, o, fast_rcp(l_run), hi2);
                        else {
                            const size_t slot = ((size_t)(h * 32 + (qb - 32)) * 2 + part) * 256 + (tz >> 6) * 32 + lr2;
                            float* po = PARTO + slot * 128;
#pragma unroll
                            for (int db = 0; db < 4; ++db)
#pragma unroll
                                for (int r4 = 0; r4 < 4; ++r4) *(f32x4*)(po + 32 * db + 8 * r4 + 4 * hi2) = (f32x4){o[db][4 * r4], o[db][4 * r4 + 1], o[db][4 * r4 + 2], o[db][4 * r4 + 3]};
                            if (hi2 == 0) *(f32x2*)(PARTML + slot * 2) = (f32x2){m_run, l_run};
                        }
                    }
                }
            }
            SEAM(4);
        }
        if (IN(5)) for (int rep_ = 0; rep_ < (int)((PROBE_REP >> 5) & 1u) + 1; ++rep_) {
            FRESH();
            pg8::GSched Sd{(const char*)UA, (const char*)BTY, 0, (size_t)256 * 1280 * 2, (size_t)256 * 1280 * 2, (size_t)1024 * 1280 * 2, 1, 4, 32, G, bid};
            pg8::EpiSsmY E{YG};
            pg8::gemm_phase<pg8::EpiSsmY, pg8::GSched>(tid, lds, 1280, 1280, 1280, nullptr, Sd, E);
            if (G == 256 && bid >= 128) { FRESH(); norm_groups(PT, ws, l, (bid - 128) * NWAVES + wave, 128 * NWAVES, 0, 3, lane); }
            SEAM(5);
        }
        if (IN(6)) for (int rep_ = 0; rep_ < (int)((PROBE_REP >> 6) & 1u) + 1; ++rep_) {
            FRESH();
            pg8::GSched Sd{(const char*)YG, (const char*)GLU, (size_t)256 * 512 * 2, (size_t)256 * 512 * 2, 0, 0, S / 256, 2, 1, G, bid};
            pg8::EpiGlu E{YG, INP(I_GLUB) + l * 512, O};
            pg8::gemm_phase<pg8::EpiGlu, pg8::GSched>(tid, lds, 512, 512, 512, nullptr, Sd, E);
            __syncthreads();
            for (int it = (bid + 32) % G; it < 32; it += G) {
                FRESH();
                const int tile = it >> 3, w8 = it & 7, r = w8 * 8 + wave, mrow = tile * 64 + r;
                LAS bf16_t* vt = (LAS bf16_t*)lds; const float* kg = INP(I_XKG) + l * 128;
                unsigned wk[4]; float ps[4];
#pragma unroll
                for (int h = 0; h < 4; ++h) { float a = 0.f, b = 0.f, va = 0.f, vb = 0.f;
#pragma unroll
                    for (int z = 0; z < 4; ++z) { const unsigned k2 = *(const unsigned*)(KMEM + (size_t)z * 256 * 512 + (size_t)mrow * 512 + h * 128 + 2 * lane), v2 = *(const unsigned*)(VMEM + (size_t)z * 256 * 512 + (size_t)mrow * 512 + h * 128 + 2 * lane);
                        a += bf2f(k2 & 0xffffu); b += bf2f(k2 >> 16); va += bf2f(v2 & 0xffffu); vb += bf2f(v2 >> 16); }
                    wk[h] = cvt_pk_bf16(a, b); a = bf2f(wk[h] & 0xffffu); b = bf2f(wk[h] >> 16); ps[h] = a * a + b * b;
                    *(LAS unsigned*)(vt + (h * 8 + wave) * 128 + 2 * lane) = cvt_pk_bf16(va, vb); }
#pragma unroll
                for (int o = 1; o < 64; o <<= 1)
#pragma unroll
                    for (int h = 0; h < 4; ++h) ps[h] += __shfl_xor(ps[h], o);
#pragma unroll
                for (int h = 0; h < 4; ++h) { const float a = bf2f(wk[h] & 0xffffu), b = bf2f(wk[h] >> 16), rs = rsqrtf(ps[h] * (1.f / 128.f) + EPS);
                    *(unsigned*)(XKIMG + ((size_t)h * 4 + tile) * 16384 + r * 256 + kswz<256>(r, lane >> 2) * 16 + (lane & 3) * 4) = cvt_pk_bf16(a * rs * kg[2 * lane], b * rs * kg[2 * lane + 1]); }
                __syncthreads();
                {   const int h = tid >> 7, d = tid & 127; float v[8];
#pragma unroll
                    for (int jj = 0; jj < 8; ++jj) v[jj] = bf2f(vt[(h * 8 + jj) * 128 + d]);
                    *(u32x4*)(XVIMG + ((size_t)h * 4 + tile) * 16384 + d * 128 + vswz(d, w8) * 16) = pack8(v); }
                __syncthreads();
            }
            SEAM(6);
        }
        if (IN(7)) for (int rep_ = 0; rep_ < (int)((PROBE_REP >> 7) & 1u) + 1; ++rep_) {
            FRESH();
            norm_groups(PT, ws, l, gw, NGW, (G == 256) ? 3 : 0, 4, lane);
            SEAM(7);
        }
        if (IN(8)) for (int rep_ = 0; rep_ < (int)((PROBE_REP >> 8) & 1u) + 1; ++rep_) {
            FRESH();
            pg8::GSched Sd{(const char*)O, (const char*)WOUT, (size_t)256 * D * 2, (size_t)256 * D * 2, 0, 0, S / 256, D / 256, 1, G, bid};
            pg8::EpiResid E{XB, D, nullptr, (((PROBE_REP >> 8) & 1u) != 0u) && rep_ == 0, nullptr};
            pg8::gemm_phase<pg8::EpiResid, pg8::GSched>(tid, lds, D, D, D, nullptr, Sd, E);
            SEAM(8);
        }
        if (IN(10)) for (int rep_ = 0; rep_ < (int)((PROBE_REP >> 10) & 1u) + 1; ++rep_) {
            FRESH();
            pg8::GSched Sd{(const char*)XB, (const char*)XWQ, (size_t)256 * D * 2, (size_t)256 * D * 2, (size_t)1024 * 2, (size_t)1024 * 2, S / 256, 2, 2, G, bid};
            pg8::EpiBf16Z E{(bf16_t*)QXP, 512, (size_t)S * 512};
            pg8::gemm_phase<pg8::EpiBf16Z, pg8::GSched>(tid, lds, 1024, D, D, nullptr, Sd, E);
            SEAM(10);
        }
        if (IN(11)) for (int rep_ = 0; rep_ < (int)((PROBE_REP >> 11) & 1u) + 1; ++rep_) {
            FRESH();
            const int lr = lane & 31, hi = lane >> 5;
            for (int it = bid; it < 256; it += G) {
                const int h = it & 3, qb = it >> 2, wq0 = qb * 256 + 32 * wave, qpos = wq0 + lr;
                bf16x8 qf[8]; load_q_norm_bf16x2<128>((const bf16_t*)QXP + (size_t)qpos * 512 + h * 128, (const bf16_t*)QXP + (size_t)S * 512 + (size_t)qpos * 512 + h * 128, INP(I_XQG) + l * 128, 0.08838834764831845f * LOG2E, hi, qf);
                f32x16 o[4];
#pragma unroll
                for (int db = 0; db < 4; ++db)
#pragma unroll
                    for (int r = 0; r < 16; ++r) o[db][r] = 0.f;
                float m_run = -1e30f, l_run = 0.f;
                attn_tiles<128, 128, 2>(tid, lds, XKIMG + (size_t)h * 4 * 16384, XVIMG + (size_t)h * 4 * 16384, 0, 4, qf, qpos, wq0, nullptr, o, m_run, l_run);
                { auto rr = __builtin_amdgcn_permlane32_swap(__float_as_uint(l_run), __float_as_uint(l_run), false, false); l_run = __uint_as_float(rr[0]) + __uint_as_float(rr[1]); }
                store_o<128>(OX + (size_t)qpos * 512 + h * 128, o, fast_rcp(l_run), hi);
            }
            SEAM(11);
        }
        if (IN(12)) for (int rep_ = 0; rep_ < (int)((PROBE_REP >> 12) & 1u) + 1; ++rep_) {
            FRESH();
            pg8::GSched Sd{(const char*)OX, (const char*)XWO, (size_t)256 * 512 * 2, (size_t)256 * 512 * 2, 0, 0, S / 256, D / 256, 1, G, bid};
            pg8::EpiResid E{XB, D, SSP, (((PROBE_REP >> 12) & 1u) != 0u) && rep_ == 0, XF8};
            pg8::gemm_phase<pg8::EpiResid, pg8::GSched>(tid, lds, 512, 512, 512, nullptr, Sd, E);
            SEAM(12);
        }
        if (IN(14)) for (int rep_ = 0; rep_ < (int)((PROBE_REP >> 14) & 1u) + 1; ++rep_) {
            FRESH();
            pg8::GSched Sd{(const char*)XB, (const char*)ROUT, (size_t)256 * D * 2, 0, (size_t)512 * 2, (size_t)512 * 2, S / 256, 1, 4, G, bid};
            pg8::EpiF32Part<64> E{LOGP, 64, (size_t)S * 64};
            pg8::gemm_phase<pg8::EpiF32Part<64>, pg8::GSched>(tid, lds, 512, D, D, nullptr, Sd, E);
            SEAM(14);
        }
        if (IN(15)) for (int rep_ = 0; rep_ < (int)((PROBE_REP >> 15) & 1u) + 1; ++rep_) {
            FRESH();
            for (int i = bid * NTHR + tid; i < NSLOT; i += G * NTHR) { TOK[i] = S; WSLOT[i] = 0.f; }
            if (bid == 0 && tid == 0) RMSV[S] = 0.f;
            LAS unsigned* hist = (LAS unsigned*)lds; LAS unsigned* base = hist + 32;
            const float* bg = INP(I_BG) + l * 4; const float* be = INP(I_BE) + l * 32;
            for (int blk = bid; blk < S / 64; blk += G) {
                if (tid < 64) hist[tid] = 0u;
                __syncthreads();
                int e0 = 0, e1 = 0; unsigned r0 = 0, r1 = 0; float w0 = 0.f, w1 = 0.f; const int s = blk * 64 + tid;
                if (tid < 64) {
                    float ssq = 0.f;
#pragma unroll
                    for (int j4 = 0; j4 < 8; ++j4) { const f32x4 a = *(const f32x4*)(SSP + (size_t)s * 32 + 4 * j4); ssq += (a[0] + a[1]) + (a[2] + a[3]); }
                    const float rms = rsqrtf(ssq * (1.0f / D) + EPS); RMSV[s] = rms;
                    float lg[36];
#pragma unroll
                    for (int j4 = 0; j4 < 9; ++j4) { f32x4 a = *(const f32x4*)(LOGP + (size_t)s * 64 + 4 * j4);
#pragma unroll
                        for (int z = 1; z < 4; ++z) a += *(const f32x4*)(LOGP + (size_t)z * S * 64 + (size_t)s * 64 + 4 * j4);
                        lg[4 * j4] = a[0] * rms; lg[4 * j4 + 1] = a[1] * rms; lg[4 * j4 + 2] = a[2] * rms; lg[4 * j4 + 3] = a[3] * rms; }
                    float gl[4]; int gi = 0; float gm;
#pragma unroll
                    for (int j = 0; j < 4; ++j) gl[j] = lg[j] + bg[j];
                    gm = gl[0];
#pragma unroll
                    for (int j = 1; j < 4; ++j) if (gl[j] > gm) { gm = gl[j]; gi = j; }
                    float gs = 0.f;
#pragma unroll
                    for (int j = 0; j < 4; ++j) gs += __expf(gl[j] - gm);
                    const float gwt = 1.f / gs;
                    float v0 = -__builtin_inff(), v1 = -__builtin_inff(); int i0 = 0, i1 = 0;
#pragma unroll
                    for (int j = 0; j < 8; ++j) { const float lv = (gi == 0) ? lg[4 + j] : (gi == 1) ? lg[12 + j] : (gi == 2) ? lg[20 + j] : lg[28 + j]; const float v = lv + be[gi * 8 + j];
                        if (v > v0) { v1 = v0; i1 = i0; v0 = v; i0 = j; } else if (v > v1) { v1 = v; i1 = j; } }
                    const float ee = __expf(v1 - v0), den = 1.f / (1.f + ee);
                    w0 = gwt * den; w1 = gwt * ee * den; e0 = gi * 8 + i0; e1 = gi * 8 + i1;
                    r0 = __hip_atomic_fetch_add(&hist[e0], 1u, __ATOMIC_RELAXED, __HIP_MEMORY_SCOPE_WORKGROUP); r1 = __hip_atomic_fetch_add(&hist[e1], 1u, __ATOMIC_RELAXED, __HIP_MEMORY_SCOPE_WORKGROUP);
                }
                __syncthreads();
                if (tid < 32) { const unsigned c = hist[tid]; base[tid] = c ? __hip_atomic_fetch_add(ctl + CW_CNT + 64 * l + tid, c, __ATOMIC_RELAXED, __HIP_MEMORY_SCOPE_AGENT) : 0u; }
                __syncthreads();
                if (tid < 64) { REC_E[2 * s] = e0; REC_E[2 * s + 1] = e1; REC_R[2 * s] = (int)(base[e0] + r0); REC_R[2 * s + 1] = (int)(base[e1] + r1); REC_W[2 * s] = w0; REC_W[2 * s + 1] = w1; }
                __syncthreads();
            }
            SEAM(15);
        }
        if (IN(16) || IN(17) || IN(18)) {
            FRESH();
            LAS int* pst = (LAS int*)(CTLW + 16);
            if (tid == 0) { int acc = 0; for (int e = 0; e < 32; ++e) { pst[e] = acc; const int c = (int)__hip_atomic_load(ctl + CW_CNT + 64 * l + e, __ATOMIC_RELAXED, __HIP_MEMORY_SCOPE_AGENT); acc += (c + 255) & ~255; } pst[32] = acc; }
            __syncthreads();
            if (tid < 160) { int e = 0; for (int k = 1; k < 32; ++k) if (pst[k] <= tid * 256) e = k; ((LAS int*)(CTLW + 256))[tid] = e; }
            __syncthreads();
        }
        if (IN(16)) for (int rep_ = 0; rep_ < (int)((PROBE_REP >> 16) & 1u) + 1; ++rep_) {
            FRESH();
            const LAS int* pst = (const LAS int*)(CTLW + 16);
            for (int i = bid * NTHR + tid; i < 2 * S; i += G * NTHR) { const int slot = pst[REC_E[i]] + REC_R[i]; TOK[slot] = i >> 1; WSLOT[slot] = REC_W[i]; REC_S[i] = slot; }
            SEAM(16);
        }
        if (IN(17)) for (int rep_ = 0; rep_ < (int)((PROBE_REP >> 17) & 1u) + 1; ++rep_) {
            FRESH();
            pg8::MoeSched Sd{(const LAS int*)(CTLW + 16), (const char*)MOE1F, TOK, (size_t)1024 * D, (size_t)256 * D, 4, G, bid, 1};
            pg8::EpiMoe1 E{HID8, TOK, RMSV};
            pg8::gemm_phase<pg8::EpiMoe1, pg8::MoeSched, true, true>(tid, lds, D / 2, D / 2, D / 2, (const char*)XF8, Sd, E);
            SEAM(17);
        }
        if (IN(18)) for (int rep_ = 0; rep_ < (int)((PROBE_REP >> 18) & 1u) + 1; ++rep_) {
            {   FRESH();
                pg8::MoeSched Sd{(const LAS int*)(CTLW + 16), (const char*)MOE1F, TOK, (size_t)1024 * D, (size_t)256 * D, 4, G, bid, 2};
                pg8::EpiMoe1 E{HID8, TOK, RMSV};
                pg8::gemm_phase<pg8::EpiMoe1, pg8::MoeSched, true, true>(tid, lds, D / 2, D / 2, D / 2, (const char*)XF8, Sd, E); }
            {   FRESH();
                pg8::MoeSched2 Sd{(const LAS int*)(CTLW + 16), (const char*)HID8, (const char*)MOE2F, (size_t)D * 512, (size_t)256 * 512, 8, G, bid, 1};
                pg8::EpiMoe2 E{YS8, WSLOT};
                pg8::gemm_phase<pg8::EpiMoe2, pg8::MoeSched2, false, true>(tid, lds, 256, 256, 256, nullptr, Sd, E); }
            {   FRESH(); GRID_BAR(); }
            {   FRESH();
                pg8::MoeSched2 Sd{(const LAS int*)(CTLW + 16), (const char*)HID8, (const char*)MOE2F, (size_t)D * 512, (size_t)256 * 512, 8, G, bid, 2};
                pg8::EpiMoe2 E{YS8, WSLOT};
                pg8::gemm_phase<pg8::EpiMoe2, pg8::MoeSched2, false, true>(tid, lds, 256, 256, 256, nullptr, Sd, E); }
            {   FRESH(); SEAM(18); }
        }
}

__global__ void __launch_bounds__(NTHR, 2) fwd_kernel(Args args) {
    extern __shared__ __attribute__((aligned(16))) unsigned char lds_raw[];
    LAS unsigned char* lds0 = (LAS unsigned char*)lds_raw;
    {   int t0 = threadIdx.x; asm volatile("" : "+v"(t0));
        for (int u = t0; u < (LDS_BYTES - LDSCTL_OFF) / 4; u += NTHR) ((LAS unsigned*)(lds0 + LDSCTL_OFF))[u] = 0u;
        __syncthreads();
        if (t0 == 0) { LAS unsigned long long* pw = (LAS unsigned long long*)(lds0 + LDSCTL_OFF + 512);
#pragma unroll
            for (int i = 0; i < 50; ++i) pw[i] = (unsigned long long)args.in[i];
            pw[50] = (unsigned long long)args.ws; pw[51] = (unsigned long long)args.out; }
        __syncthreads();
#if !MK_MULTI
        if (t0 == 0) (void)xb_add(&((unsigned*)args.ws)[CW_BAR + XB_XCNT(xb_xcc_id())], 1u);
#endif
    }
    const int ph_lo = args.ph_lo, ph_hi = args.ph_hi;
    int wave_s = __builtin_amdgcn_readfirstlane(threadIdx.x >> 6); asm volatile("" : "+s"(wave_s));
#if MK_MULTI
    if (args.l_lo < NL) layer_body<0>(args.l_lo, wave_s, lds0, ph_lo, ph_hi);
#else
    layer_body<0>(0, wave_s, lds0, ph_lo, ph_hi);
    layer_body<1>(1, wave_s, lds0, ph_lo, ph_hi);
    layer_body<2>(2, wave_s, lds0, ph_lo, ph_hi);
    layer_body<3>(3, wave_s, lds0, ph_lo, ph_hi);
#endif
    if (args.l_hi > NL) {
        FRESH();
        for (int s = gw; s < S; s += NGW) { const int s0 = REC_S[2 * s], s1 = REC_S[2 * s + 1];
#pragma unroll
            for (int j = 0; j < 4; ++j) { float x[8], ya[8], yb[8]; unpack8(*(const u32x4*)(XB + (size_t)s * D + 8 * lane + 512 * j), x);
                unpack8_fp8(*(const u32x2*)(YS8 + (size_t)s0 * D + 8 * lane + 512 * j), ya); unpack8_fp8(*(const u32x2*)(YS8 + (size_t)s1 * D + 8 * lane + 512 * j), yb);
#pragma unroll
                for (int e = 0; e < 8; ++e) x[e] += (ya[e] + yb[e]) * 0.0625f;
                *(f32x4*)(X + (size_t)s * D + 8 * lane + 512 * j) = (f32x4){x[0], x[1], x[2], x[3]};
                *(f32x4*)(X + (size_t)s * D + 8 * lane + 512 * j + 4) = (f32x4){x[4], x[5], x[6], x[7]}; } }
    }
}

extern "C" void kernel_launch(void* const* d_in, const int* in_sizes, int n_in, void* d_out, int out_size, void* d_ws, size_t ws_size, hipStream_t stream) {
    static int grid = 0;
    if (grid == 0) {
        if (n_in != 50 || out_size != S * D || ws_size < WS_END) { fprintf(stderr, "kernel_launch: unexpected shapes (n_in %d, out %d, ws %zu < %zu)\n", n_in, out_size, ws_size, (size_t)WS_END); grid = -1; return; }
        int dev = 0, cus = 0, per_cu = 0;
        if (hipGetDevice(&dev) != hipSuccess || hipDeviceGetAttribute(&cus, hipDeviceAttributeMultiprocessorCount, dev) != hipSuccess) { grid = -1; return; }
        if (hipFuncSetAttribute((const void*)fwd_kernel, hipFuncAttributeMaxDynamicSharedMemorySize, LDS_BYTES) != hipSuccess) { fprintf(stderr, "kernel_launch: hipFuncSetAttribute failed\n"); grid = -1; return; }
        if (hipOccupancyMaxActiveBlocksPerMultiprocessor(&per_cu, (const void*)fwd_kernel, NTHR, LDS_BYTES) != hipSuccess || per_cu < 1) { fprintf(stderr, "kernel_launch: occupancy query says %d\n", per_cu); }
        (void)hipGetLastError();
        grid = cus;
    }
    if (grid < 0) return;
    (void)in_sizes;
    if (hipMemsetAsync((char*)d_ws + WS_CTL, 0, CTL_ZERO_BYTES, stream) != hipSuccess) return;
    Args a{};
    for (int i = 0; i < 50; ++i) a.in[i] = (const float*)d_in[i];
    a.out = (float*)d_out; a.ws = (unsigned char*)d_ws;
#if MK_MULTI
    for (int l = 0; l < NL; ++l)
        for (int ph = 0; ph < NPH; ++ph) { a.l_lo = l; a.l_hi = l + 1; a.ph_lo = ph; a.ph_hi = ph + 1; hipLaunchKernelGGL(fwd_kernel, dim3(grid), dim3(NTHR), LDS_BYTES, stream, a); }
    a.l_lo = NL; a.l_hi = NL + 1; a.ph_lo = 0; a.ph_hi = 0; hipLaunchKernelGGL(fwd_kernel, dim3(grid), dim3(NTHR), LDS_BYTES, stream, a);
#else
    a.l_lo = 0; a.l_hi = NL + 1; a.ph_lo = 0; a.ph_hi = NPH;
    hipLaunchKernelGGL(fwd_kernel, dim3(grid), dim3(NTHR), LDS_BYTES, stream, a);
#endif
    const hipError_t le = hipPeekAtLastError();
    if (le != hipSuccess) fprintf(stderr, "kernel_launch: launch failed: %s\n", hipGetErrorName(le));
}
```

```cpp
#include <hip/hip_runtime.h>
#include <cstdio>
#include <cstdint>

#ifndef MK_MULTI
#define MK_MULTI 0
#endif

#define LAS __attribute__((address_space(3)))
#define GAS __attribute__((address_space(1)))
typedef unsigned short bf16_t;
typedef short bf16x8 __attribute__((ext_vector_type(8)));
typedef float f32x4 __attribute__((ext_vector_type(4)));
typedef float f32x2 __attribute__((ext_vector_type(2)));
typedef float f32x16 __attribute__((ext_vector_type(16)));
typedef unsigned u32x4 __attribute__((ext_vector_type(4)));
typedef unsigned u32x2 __attribute__((ext_vector_type(2)));

constexpr int S = 16384, D = 2048, NL = 4, INW = 3136, INWP = 3200, WINR = 3328;
constexpr int MEMT = 256;
constexpr int NSLOT = 40960;
constexpr float EPS = 1e-6f;
constexpr float LOG2E = 1.4426950408889634f;
constexpr int P_AQ = 0, P_AK = 448, P_AV = 576, P_BA = 704, P_BG = 1216, P_CQ = 1728, P_CKV = 2240, P_CKR = 2496, P_DU = 2560;

constexpr size_t MiB = 1u << 20;
constexpr size_t WS_CTL = 0, CTL_ZERO_BYTES = 1 * MiB;
constexpr size_t WS_ROPE = 1 * MiB;
constexpr size_t WS_H = WS_ROPE + 4 * MiB;
constexpr size_t WS_P = WS_H + 65 * MiB;
constexpr size_t WS_O = WS_P + 104 * MiB;
constexpr size_t WS_QRAW = WS_O + 64 * MiB;
constexpr size_t WS_KVRAW = WS_QRAW + 24 * MiB;
constexpr size_t WS_Q = WS_KVRAW + 32 * MiB;
constexpr size_t WS_KIMG = WS_Q + 24 * MiB;
constexpr size_t WS_VIMG = WS_KIMG + 24 * MiB;
constexpr size_t WS_SWAK = WS_VIMG + 16 * MiB;
constexpr size_t WS_SWAV = WS_SWAK + 4 * MiB;
constexpr size_t WS_ZC = WS_SWAV + 4 * MiB;
constexpr size_t WS_UA = WS_ZC + 16 * MiB;
constexpr size_t WS_EBUF = WS_UA + 20 * MiB;
constexpr size_t WS_YG = WS_EBUF + 4 * MiB;
constexpr size_t WS_QX = WS_YG + 16 * MiB;
constexpr size_t WS_OX = WS_QX + 16 * MiB;
constexpr size_t WS_MEMN = WS_OX + 16 * MiB;
constexpr size_t WS_KMEM = WS_MEMN + 1 * MiB;
constexpr size_t WS_VMEM = WS_KMEM + 1 * MiB;
constexpr size_t WS_XKIMG = WS_VMEM + 1 * MiB;
constexpr size_t WS_XVIMG = WS_XKIMG + 1 * MiB;
constexpr size_t WS_LOG = WS_XVIMG + 1 * MiB;
constexpr size_t WS_REC = WS_LOG + 4 * MiB;
constexpr size_t WS_TOK = WS_REC + 1 * MiB;
constexpr size_t WS_WSLOT = WS_TOK + 1 * MiB;
constexpr size_t WS_HID = WS_WSLOT + 1 * MiB;
constexpr size_t WS_YS = WS_HID + 40 * MiB;
constexpr size_t WS_WIN = WS_YS + 160 * MiB;
constexpr size_t WS_WOUT = WS_WIN + 13 * MiB;
constexpr size_t WS_XWQ = WS_WOUT + 8 * MiB;
constexpr size_t WS_XWK = WS_XWQ + 2 * MiB;
constexpr size_t WS_XWV = WS_XWK + 2 * MiB;
constexpr size_t WS_XWO = WS_XWV + 2 * MiB;
constexpr size_t WS_PW = WS_XWO + 2 * MiB;
constexpr size_t WS_WQB = WS_PW + 1 * MiB;
constexpr size_t WS_WKVB = WS_WQB + 1 * MiB;
constexpr size_t WS_GLU = WS_WKVB + 1 * MiB;
constexpr size_t WS_ROUT = WS_GLU + 1 * MiB;
constexpr size_t WS_MOE1 = WS_ROUT + 1 * MiB;
constexpr size_t WS_MOE2 = WS_MOE1 + 128 * MiB;
constexpr size_t WS_W1G = WS_MOE2 + 64 * MiB;
constexpr size_t WS_BTY = WS_W1G + 16 * MiB;
constexpr size_t WS_PARTO = WS_BTY + 80 * MiB;
constexpr size_t WS_PARTML = WS_PARTO + 32 * MiB;
constexpr size_t WS_XB = WS_PARTML + 1 * MiB;
constexpr size_t WS_QXP = WS_XB + 65 * MiB;
constexpr size_t WS_LOGP = WS_QXP + 64 * MiB;
constexpr size_t WS_SSP = WS_LOGP + 16 * MiB;
constexpr size_t WS_RMSV = WS_SSP + 2 * MiB;
constexpr size_t WS_RMS1 = WS_RMSV + 1 * MiB;
constexpr size_t WS_XF8 = WS_RMS1 + 1 * MiB;
constexpr size_t WS_END = WS_XF8 + 33 * MiB;
constexpr int CW_BAR = 4096;
constexpr int CW_SS = 32768;
constexpr int CW_CNT = 16384;

constexpr int RING_BYTES = 131072;
constexpr int LDSCTL_OFF = RING_BYTES;
constexpr int LDS_BYTES = 147456;
constexpr int NWAVES = 8, NTHR = 512;

__device__ __forceinline__ float bf2f(unsigned b) { return __uint_as_float(b << 16); }
typedef __bf16 bf16x2_t __attribute__((ext_vector_type(2)));
__device__ __forceinline__ unsigned cvt_pk_bf16(float lo, float hi) { const f32x2 v = {lo, hi}; const bf16x2_t b = __builtin_convertvector(v, bf16x2_t); return __builtin_bit_cast(unsigned, b); }
__device__ __forceinline__ float wave_sum(float v) {
#pragma unroll
    for (int o = 1; o < 64; o <<= 1) v += __shfl_xor(v, o);
    return v;
}
__device__ __forceinline__ float fast_exp2(float x) { return __builtin_amdgcn_exp2f(x); }
__device__ __forceinline__ float fast_rcp(float x) { return __builtin_amdgcn_rcpf(x); }
__device__ __forceinline__ float sigmoidf_(float x) { return fast_rcp(1.f + fast_exp2(-x * LOG2E)); }
__device__ __forceinline__ void unpack8(const u32x4 w, float (&f)[8]) {
    f[0] = bf2f(w.x & 0xffffu); f[1] = bf2f(w.x >> 16); f[2] = bf2f(w.y & 0xffffu); f[3] = bf2f(w.y >> 16);
    f[4] = bf2f(w.z & 0xffffu); f[5] = bf2f(w.z >> 16); f[6] = bf2f(w.w & 0xffffu); f[7] = bf2f(w.w >> 16);
}
__device__ __forceinline__ u32x4 pack8(const float (&f)[8]) { u32x4 w; w.x = cvt_pk_bf16(f[0], f[1]); w.y = cvt_pk_bf16(f[2], f[3]); w.z = cvt_pk_bf16(f[4], f[5]); w.w = cvt_pk_bf16(f[6], f[7]); return w; }
__device__ __forceinline__ unsigned pk4_fp8(float a, float b, float c, float d) { int w = __builtin_amdgcn_cvt_pk_fp8_f32(a, b, 0, false); w = __builtin_amdgcn_cvt_pk_fp8_f32(c, d, w, true); return (unsigned)w; }
__device__ __forceinline__ void unpack8_fp8(const u32x2 w, float (&f)[8]) { const f32x2 a = __builtin_amdgcn_cvt_pk_f32_fp8(w.x, false), b = __builtin_amdgcn_cvt_pk_f32_fp8(w.x, true), c = __builtin_amdgcn_cvt_pk_f32_fp8(w.y, false), d = __builtin_amdgcn_cvt_pk_f32_fp8(w.y, true);
    f[0] = a.x; f[1] = a.y; f[2] = b.x; f[3] = b.y; f[4] = c.x; f[5] = c.y; f[6] = d.x; f[7] = d.y; }
#define LDS_WAIT() asm volatile("s_waitcnt lgkmcnt(0)" ::: "memory")
#define VM_WAIT() asm volatile("s_waitcnt vmcnt(0)" ::: "memory")

namespace pg8 {
constexpr int BM = 256, BK = 64, HALF = 128, HTB = HALF * BK * 2, STAGE_BYTES = 8 * HTB, NXCD = 8, WGM = 8;
__host__ __device__ __forceinline__ int lds_byte(int r, int c) { const int st = (r >> 4) * 2 + (c >> 5), rr = r & 15, cc = c & 31, ob = rr * 64 + cc * 2; return st * 1024 + (ob ^ (((ob >> 9) & 1) << 5)); }
__host__ __device__ __forceinline__ void stage_rc(int b, int& R, int& C) { const int st = b / 1024, sb = b % 1024, swz = sb ^ (((sb >> 9) & 1) << 5); R = (st >> 1) * 16 + swz / 64; C = (st & 1) * 32 + (swz % 64) / 2; }
__host__ __device__ __forceinline__ int perm32(int rho) { const int n = rho >> 4, i = rho & 15; return 8 * (i >> 2) + 4 * n + (i & 3); }

struct Unit { int pm, pn, z; const char* a; const char* b; const int* rows; };

struct GSched {
    const char* A; const char* B; size_t aTile, bTile, aZ, bZ; int nM, nN, nZ, G, c;
    __device__ __forceinline__ bool next(int i, Unit& u) const {
        const int nwg = nM * nN; const long L = (long)i * G + c; if (L >= (long)nwg * nZ) return false;
        const int z = (int)(L / nwg); int wgid = (int)(L - (long)z * nwg);
        { const int q = nwg / NXCD, r = nwg % NXCD, xcd = wgid % NXCD, off = wgid / NXCD; wgid = (xcd < r ? xcd * (q + 1) : r * (q + 1) + (xcd - r) * q) + off; }
        const int nig = WGM * nN, gid = wgid / nig, fm = gid * WGM, gsz = (nM - fm) < WGM ? (nM - fm) : WGM;
        u.pm = fm + ((wgid % nig) % gsz); u.pn = (wgid % nig) / gsz; u.z = z;
        u.a = A + (size_t)z * aZ + (size_t)u.pm * aTile; u.b = B + (size_t)z * bZ + (size_t)u.pn * bTile; u.rows = nullptr; return true;
    }
};

template <class Epi, class Sched, bool GATHER = false, bool F8 = false>
__device__ __forceinline__ void gemm_phase(const int tid_in, LAS unsigned char* lds, const int K, const int lda, const int ldb, const char* Abase, const Sched& S, const Epi& E) {
    int tid = tid_in; asm volatile("" : "+v"(tid));
    const int wid = __builtin_amdgcn_readfirstlane(tid >> 6), lane = tid & 63, wr = wid >> 2, wc = wid & 3, fr = lane & 15, fq = lane >> 4;
    const int nt = K / BK;
    unsigned voffA[2], voffB[2]; int rA[2], cA2[2];
#pragma unroll
    for (int i = 0; i < 2; ++i) { int R, C; stage_rc(tid * 16 + i * 8192, R, C); const int Rb = Epi::PERM ? ((R & ~31) + perm32(R & 31)) : R;
        voffA[i] = (unsigned)(R * lda + C) * 2u; voffB[i] = (unsigned)(Rb * ldb + C) * 2u; rA[i] = R; cA2[i] = C * 2; }
    const size_t kstep = (size_t)(BK * 2);
    const size_t hstepA = (size_t)HALF * lda * 2, hstepB = (size_t)HALF * ldb * 2;
    const unsigned ldsw = (unsigned)wid * 1024u;
    const int aoff = lds_byte(wr * 64 + fr, fq * 8), boff = lds_byte(wc * 32 + fr, fq * 8);
#define PG8_SA(b, h) (((b) * 2 + (h)) * HTB)
#define PG8_SB(b, h) ((4 + (b) * 2 + (h)) * HTB)
#define PG8_STAGE(bufoff, gbase, voff) do { _Pragma("unroll") for (int _i = 0; _i < 2; ++_i) \
        __builtin_amdgcn_global_load_lds((const unsigned*)((const char*)(gbase) + (voff)[_i]), (LAS unsigned*)(lds + (bufoff) + ldsw + _i * 8192), 16, 0, 0); } while (0)
#define PG8_LDA(dst, b, h) do { _Pragma("unroll") for (int m = 0; m < 4; ++m) _Pragma("unroll") for (int k = 0; k < 2; ++k) dst[m][k] = *(const LAS bf16x8*)(lds + PG8_SA(b, h) + aoff + m * 2048 + k * 1024); } while (0)
#define PG8_LDB(dst, b, h) do { _Pragma("unroll") for (int n = 0; n < 2; ++n) _Pragma("unroll") for (int k = 0; k < 2; ++k) dst[n][k] = *(const LAS bf16x8*)(lds + PG8_SB(b, h) + boff + n * 2048 + k * 1024); } while (0)
typedef long pg8_i64x2 __attribute__((ext_vector_type(2)));
#define PG8_MMA(ai, bj, At, Bt) do { __builtin_amdgcn_s_setprio(1); _Pragma("unroll") for (int m = 0; m < 4; ++m) _Pragma("unroll") for (int n = 0; n < 2; ++n) _Pragma("unroll") for (int k = 0; k < 2; ++k) { \
        if constexpr (F8) {   \
            const pg8_i64x2 a_ = __builtin_bit_cast(pg8_i64x2, At[m][k]), b_ = __builtin_bit_cast(pg8_i64x2, Bt[n][k]); \
            acc[ai][bj][m][n] = __builtin_amdgcn_mfma_f32_16x16x32_fp8_fp8(b_.x, a_.x, acc[ai][bj][m][n], 0, 0, 0); \
            acc[ai][bj][m][n] = __builtin_amdgcn_mfma_f32_16x16x32_fp8_fp8(b_.y, a_.y, acc[ai][bj][m][n], 0, 0, 0); \
        } else acc[ai][bj][m][n] = __builtin_amdgcn_mfma_f32_16x16x32_bf16(Bt[n][k], At[m][k], acc[ai][bj][m][n], 0, 0, 0); } \
        __builtin_amdgcn_s_setprio(0); } while (0)
#define PG8_WAIT_V(n) asm volatile("s_waitcnt vmcnt(" #n ")" ::: "memory")
#define PG8_WAIT_L(n) asm volatile("s_waitcnt lgkmcnt(" #n ")" ::: "memory")
#define PG8_BAR __builtin_amdgcn_s_barrier()
#define PG8_SCHED __builtin_amdgcn_sched_barrier(0)
    Unit cur, nxt; int ui = 0;
    if (!S.next(0, cur)) return;
    f32x4 acc[2][2][4][2];
#pragma unroll
    for (int a = 0; a < 2; ++a)
#pragma unroll
        for (int b = 0; b < 2; ++b)
#pragma unroll
            for (int m = 0; m < 4; ++m)
#pragma unroll
                for (int n = 0; n < 2; ++n) acc[a][b][m][n] = (f32x4){0.f, 0.f, 0.f, 0.f};
    bf16x8 At[4][2], B0[2][2], B1[2][2];
    unsigned gc0[2], gc1[2], gn0[2], gn1[2];
    const char* cA = GATHER ? Abase : cur.a; const char* cB = cur.b;
    if constexpr (GATHER) {
#pragma unroll
        for (int i = 0; i < 2; ++i) { gc0[i] = (unsigned)cur.rows[rA[i]] * (unsigned)(lda * 2) + (unsigned)cA2[i]; gc1[i] = (unsigned)cur.rows[HALF + rA[i]] * (unsigned)(lda * 2) + (unsigned)cA2[i]; gn0[i] = gc0[i]; gn1[i] = gc1[i]; }
    }
#define PG8_STAGE_A(bufoff, h, ptr, usenext) do { if constexpr (GATHER) { if (usenext) { if ((h) == 0) PG8_STAGE(bufoff, ptr, gn0); else PG8_STAGE(bufoff, ptr, gn1); } else { if ((h) == 0) PG8_STAGE(bufoff, ptr, gc0); else PG8_STAGE(bufoff, ptr, gc1); } } \
        else { PG8_STAGE(bufoff, (ptr) + ((h) ? hstepA : 0), voffA); } } while (0)
    PG8_STAGE(PG8_SB(0, 0), cB, voffB); PG8_STAGE(PG8_SB(0, 1), cB + hstepB, voffB); PG8_STAGE_A(PG8_SA(0, 0), 0, cA, false); PG8_STAGE_A(PG8_SA(0, 1), 1, cA, false);
    if (wr == 1) PG8_BAR;
    PG8_WAIT_V(2); PG8_BAR;
    PG8_STAGE(PG8_SB(1, 0), cB + kstep, voffB); PG8_STAGE_A(PG8_SA(1, 0), 0, cA + kstep, false); PG8_STAGE(PG8_SB(1, 1), cB + hstepB + kstep, voffB);
    PG8_WAIT_V(6); PG8_BAR;
    for (;;) {
        const bool has_next = S.next(ui + 1, nxt);
        const char* nA = GATHER ? Abase : (has_next ? nxt.a : cA); const char* nB = has_next ? nxt.b : cB;
        if constexpr (GATHER) {
            if (has_next) {
#pragma unroll
                for (int i = 0; i < 2; ++i) { gn0[i] = (unsigned)nxt.rows[rA[i]] * (unsigned)(lda * 2) + (unsigned)cA2[i]; gn1[i] = (unsigned)nxt.rows[HALF + rA[i]] * (unsigned)(lda * 2) + (unsigned)cA2[i]; }
            } else {
#pragma unroll
                for (int i = 0; i < 2; ++i) { gn0[i] = gc0[i]; gn1[i] = gc1[i]; }
            }
        }
#pragma unroll 1
        for (int t = 0; t < nt; t += 2) {
            const bool last = (t == nt - 2);
            const char* a1 = cA + (size_t)(t + 1) * kstep;
            const char* a2 = last ? nA : cA + (size_t)(t + 2) * kstep; const char* b2 = last ? nB : cB + (size_t)(t + 2) * kstep;
            const char* a3 = a2 + kstep; const char* b3 = b2 + kstep;
            PG8_LDB(B0, 0, 0); PG8_LDB(B1, 0, 1); PG8_SCHED; PG8_LDA(At, 0, 0); PG8_STAGE_A(PG8_SA(1, 1), 1, a1, false);
            PG8_WAIT_V(8); PG8_WAIT_L(0); PG8_BAR; PG8_MMA(0, 0, At, B0); PG8_MMA(0, 1, At, B1); PG8_BAR; PG8_SCHED;
            PG8_LDA(At, 0, 1); PG8_STAGE(PG8_SB(0, 0), b2, voffB); PG8_STAGE(PG8_SB(0, 1), b2 + hstepB, voffB); PG8_STAGE_A(PG8_SA(0, 0), 0, a2, last);
            PG8_WAIT_V(8); PG8_WAIT_L(0); PG8_BAR; PG8_MMA(1, 0, At, B0); PG8_MMA(1, 1, At, B1); PG8_BAR; PG8_SCHED;
            PG8_LDB(B0, 1, 0); PG8_LDB(B1, 1, 1); PG8_SCHED; PG8_LDA(At, 1, 0); PG8_STAGE_A(PG8_SA(0, 1), 1, a2, last);
            PG8_WAIT_V(8); PG8_WAIT_L(0); PG8_BAR; PG8_MMA(0, 0, At, B0); PG8_MMA(0, 1, At, B1); PG8_BAR; PG8_SCHED;
            PG8_LDA(At, 1, 1); PG8_STAGE(PG8_SB(1, 0), b3, voffB); PG8_STAGE(PG8_SB(1, 1), b3 + hstepB, voffB); PG8_STAGE_A(PG8_SA(1, 0), 0, a3, last);
            PG8_WAIT_V(8); PG8_WAIT_L(0); PG8_BAR; PG8_MMA(1, 0, At, B0); PG8_MMA(1, 1, At, B1); PG8_BAR; PG8_SCHED;
        }
        if (wr == 0) PG8_BAR;
        E(acc, cur, wr, wc, fr, fq);
        if (!has_next) break;
#pragma unroll
        for (int a = 0; a < 2; ++a)
#pragma unroll
            for (int b = 0; b < 2; ++b)
#pragma unroll
                for (int m = 0; m < 4; ++m)
#pragma unroll
                    for (int n = 0; n < 2; ++n) acc[a][b][m][n] = (f32x4){0.f, 0.f, 0.f, 0.f};
        cur = nxt; cA = nA; cB = nB; ++ui;
        if constexpr (GATHER) {
#pragma unroll
            for (int i = 0; i < 2; ++i) { gc0[i] = gn0[i]; gc1[i] = gn1[i]; }
        }
        if (wr == 1) PG8_BAR;
    }
    PG8_WAIT_V(0);
    PG8_BAR;
#undef PG8_STAGE_A
#undef PG8_SA
#undef PG8_SB
#undef PG8_STAGE
#undef PG8_LDA
#undef PG8_LDB
#undef PG8_MMA
#undef PG8_WAIT_V
#undef PG8_WAIT_L
#undef PG8_BAR
#undef PG8_SCHED
}

struct EpiBf16 {
    static constexpr bool PERM = true;
    bf16_t* O; int ldc; int col_off; const float* bias; const float* rowscale;
    __device__ __forceinline__ void operator()(const f32x4 (&acc)[2][2][4][2], const Unit& u, int wr, int wc, int fr, int fq) const {
        const int row0 = u.pm * BM + wr * 64 + fr, c0 = u.pn * BM + wc * 32 + 8 * fq;
        f32x4 bv[2][2];
#pragma unroll
        for (int bj = 0; bj < 2; ++bj)
#pragma unroll
            for (int n = 0; n < 2; ++n) bv[bj][n] = bias ? *(const f32x4*)(bias + c0 + bj * HALF + 4 * n) : (f32x4){0.f, 0.f, 0.f, 0.f};
#pragma unroll
        for (int ai = 0; ai < 2; ++ai)
#pragma unroll
            for (int m = 0; m < 4; ++m) { const int row = row0 + ai * HALF + m * 16; bf16_t* rowp = O + (size_t)row * ldc + col_off + c0; const float rs = rowscale ? rowscale[row] : 1.f;
#pragma unroll
                for (int bj = 0; bj < 2; ++bj) { const f32x4 v0 = acc[ai][bj][m][0] * rs + bv[bj][0], v1 = acc[ai][bj][m][1] * rs + bv[bj][1];
                    u32x4 w; w.x = cvt_pk_bf16(v0[0], v0[1]); w.y = cvt_pk_bf16(v0[2], v0[3]); w.z = cvt_pk_bf16(v1[0], v1[1]); w.w = cvt_pk_bf16(v1[2], v1[3]);
                    *(u32x4*)(rowp + bj * HALF) = w; } }
    }
};
struct EpiResid {
    static constexpr bool PERM = true;
    bf16_t* XBp; int ldc; float* SS; bool dry; unsigned char* XF8p;
    __device__ __forceinline__ void operator()(const f32x4 (&acc)[2][2][4][2], const Unit& u, int wr, int wc, int fr, int fq) const {
        const int row0 = u.pm * BM + wr * 64 + fr, c0 = u.pn * BM + wc * 32 + 8 * fq;
#pragma unroll
        for (int ai = 0; ai < 2; ++ai)
#pragma unroll
            for (int m = 0; m < 4; ++m) { const int row = row0 + ai * HALF + m * 16; bf16_t* rowb = XBp + (size_t)row * ldc + c0; float ss = 0.f;
                u32x4 old[2];
#pragma unroll
                for (int bj = 0; bj < 2; ++bj) old[bj] = *(const u32x4*)(rowb + bj * HALF);
#pragma unroll
                for (int bj = 0; bj < 2; ++bj) { float x[8]; unpack8(old[bj], x);
#pragma unroll
                    for (int j = 0; j < 4; ++j) { x[j] += acc[ai][bj][m][0][j]; x[4 + j] += acc[ai][bj][m][1][j]; }
#pragma unroll
                    for (int j = 0; j < 8; ++j) ss += x[j] * x[j];
                    if (!dry) *(u32x4*)(rowb + bj * HALF) = pack8(x);
                    if (XF8p) *(u32x2*)(XF8p + (size_t)row * ldc + c0 + bj * HALF) = (u32x2){pk4_fp8(x[0], x[1], x[2], x[3]), pk4_fp8(x[4], x[5], x[6], x[7])}; }
                if (SS) { ss += __shfl_xor(ss, 16); ss += __shfl_xor(ss, 32); if (fq == 0) SS[(size_t)row * 32 + u.pn * 4 + wc] = ss; } }
    }
};
struct EpiF32Z {
    static constexpr bool PERM = false;
    float* C; int ldc; size_t zstride;
    __device__ __forceinline__ void operator()(const f32x4 (&acc)[2][2][4][2], const Unit& u, int wr, int wc, int fr, int fq) const {
        const int row0 = u.pm * BM + wr * 64 + fr, col0 = u.pn * BM + wc * 32 + 4 * fq;
#pragma unroll
        for (int ai = 0; ai < 2; ++ai)
#pragma unroll
            for (int m = 0; m < 4; ++m) { float* rowp = C + (size_t)u.z * zstride + (size_t)(row0 + ai * HALF + m * 16) * ldc + col0;
#pragma unroll
                for (int bj = 0; bj < 2; ++bj)
#pragma unroll
                    for (int n = 0; n < 2; ++n) *(f32x4*)(rowp + bj * HALF + n * 16) = acc[ai][bj][m][n]; }
    }
};
template <int NVALID> struct EpiF32Part {
    static constexpr bool PERM = false;
    float* C; int ldc; size_t zstride;
    __device__ __forceinline__ void operator()(const f32x4 (&acc)[2][2][4][2], const Unit& u, int wr, int wc, int fr, int fq) const {
        if (u.pn != 0) return;
        if (NVALID == 64 && wc >= 2) return;
        const int row0 = u.pm * BM + wr * 64 + fr, col0 = wc * 32 + 4 * fq;
#pragma unroll
        for (int ai = 0; ai < 2; ++ai)
#pragma unroll
            for (int m = 0; m < 4; ++m) { float* rowp = C + (size_t)u.z * zstride + (size_t)(row0 + ai * HALF + m * 16) * ldc + col0;
#pragma unroll
                for (int n = 0; n < 2; ++n) *(f32x4*)(rowp + n * 16) = acc[ai][0][m][n]; }
    }
};
struct EpiSsmY {
    static constexpr bool PERM = true;
    bf16_t* YG;
    __device__ __forceinline__ void operator()(const f32x4 (&acc)[2][2][4][2], const Unit& u, int wr, int wc, int fr, int fq) const {
        const int row0 = wr * 64 + fr, c0 = u.pn * BM + wc * 32 + 8 * fq;
#pragma unroll
        for (int ai = 0; ai < 2; ++ai)
#pragma unroll
            for (int m = 0; m < 4; ++m) { const int chunk = row0 + ai * HALF + m * 16;
#pragma unroll
                for (int bj = 0; bj < 2; ++bj) { const int col = c0 + bj * HALF, t = col >> 4, o0 = col & 15;
                    float v[8];
#pragma unroll
                    for (int j = 0; j < 4; ++j) { v[j] = acc[ai][bj][m][0][j]; v[4 + j] = acc[ai][bj][m][1][j]; }
#pragma unroll
                    for (int j = 0; j < 8; ++j) { const float x = v[j], y = 1.5957691216f * (x + 0.044715f * x * x * x); v[j] = x * fast_rcp(1.f + fast_exp2(-y * LOG2E)); }
                    *(u32x4*)(YG + (size_t)(chunk * 64 + t) * 512 + u.z * 16 + o0) = pack8(v); } }
    }
};
struct EpiGlu {
    static constexpr bool PERM = true;
    const bf16_t* YG; const float* bias; bf16_t* O;
    __device__ __forceinline__ void operator()(const f32x4 (&acc)[2][2][4][2], const Unit& u, int wr, int wc, int fr, int fq) const {
        const int row0 = u.pm * BM + wr * 64 + fr, c0 = u.pn * BM + wc * 32 + 8 * fq;
#pragma unroll
        for (int ai = 0; ai < 2; ++ai)
#pragma unroll
            for (int m = 0; m < 4; ++m) { const int row = row0 + ai * HALF + m * 16;
#pragma unroll
                for (int bj = 0; bj < 2; ++bj) { const int col = c0 + bj * HALF;
                    const u32x4 yw = *(const u32x4*)(YG + (size_t)row * 512 + col); float y[8]; unpack8(yw, y);
                    const f32x4 b0 = *(const f32x4*)(bias + col), b1 = *(const f32x4*)(bias + col + 4);
                    float v[8];
#pragma unroll
                    for (int j = 0; j < 4; ++j) { v[j] = y[j] * sigmoidf_(acc[ai][bj][m][0][j] + b0[j]); v[4 + j] = y[4 + j] * sigmoidf_(acc[ai][bj][m][1][j] + b1[j]); }
                    *(u32x4*)(O + (size_t)row * D + 1536 + col) = pack8(v); } }
    }
};
struct EpiMoe1 {
    static constexpr bool PERM = true;
    unsigned char* HID8; const int* TOKp; const float* SS;
    __device__ __forceinline__ void operator()(const f32x4 (&acc)[2][2][4][2], const Unit& u, int wr, int wc, int fr, int fq) const {
        const int row0 = u.z * BM + wr * 64 + fr, c0 = u.pn * HALF + wc * 32 + 8 * fq;
#pragma unroll
        for (int ai = 0; ai < 2; ++ai)
#pragma unroll
            for (int m = 0; m < 4; ++m) { const int row = row0 + ai * HALF + m * 16; float v[8];
                const float rs = SS[TOKp[row]] * (1.0f / 32.0f);
#pragma unroll
                for (int j = 0; j < 4; ++j) { const float g0 = acc[ai][0][m][0][j] * rs, g1 = acc[ai][0][m][1][j] * rs; v[j] = g0 * sigmoidf_(g0) * (acc[ai][1][m][0][j] * rs); v[4 + j] = g1 * sigmoidf_(g1) * (acc[ai][1][m][1][j] * rs); }
                *(u32x2*)(HID8 + (size_t)row * 512 + c0) = (u32x2){pk4_fp8(v[0], v[1], v[2], v[3]), pk4_fp8(v[4], v[5], v[6], v[7])}; }
    }
};
struct EpiMoe2 {
    static constexpr bool PERM = true;
    unsigned char* YS8; const float* W;
    __device__ __forceinline__ void operator()(const f32x4 (&acc)[2][2][4][2], const Unit& u, int wr, int wc, int fr, int fq) const {
        const int row0 = u.z * BM + wr * 64 + fr, c0 = u.pn * BM + wc * 32 + 8 * fq;
#pragma unroll
        for (int ai = 0; ai < 2; ++ai)
#pragma unroll
            for (int m = 0; m < 4; ++m) { const int row = row0 + ai * HALF + m * 16; const float w = W[row] * (16.0f / 32.0f);
#pragma unroll
                for (int bj = 0; bj < 2; ++bj) { const f32x4 v0 = acc[ai][bj][m][0] * w, v1 = acc[ai][bj][m][1] * w;
                    *(u32x2*)(YS8 + (size_t)row * D + c0 + bj * HALF) = (u32x2){pk4_fp8(v0[0], v0[1], v0[2], v0[3]), pk4_fp8(v1[0], v1[1], v1[2], v1[3])}; } }
    }
};
struct EpiBf16Part64 {
    static constexpr bool PERM = true;
    bf16_t* O; size_t zstride; const float* rowscale;
    __device__ __forceinline__ void operator()(const f32x4 (&acc)[2][2][4][2], const Unit& u, int wr, int wc, int fr, int fq) const {
        if (wc >= 2) return;
        const int row0 = u.pm * BM + wr * 64 + fr, c0 = wc * 32 + 8 * fq;
#pragma unroll
        for (int ai = 0; ai < 2; ++ai)
#pragma unroll
            for (int m = 0; m < 4; ++m) { const int row = row0 + ai * HALF + m * 16; const float rs = rowscale[row]; const f32x4 v0 = acc[ai][0][m][0] * rs, v1 = acc[ai][0][m][1] * rs;
                u32x4 w; w.x = cvt_pk_bf16(v0[0], v0[1]); w.y = cvt_pk_bf16(v0[2], v0[3]); w.z = cvt_pk_bf16(v1[0], v1[1]); w.w = cvt_pk_bf16(v1[2], v1[3]);
                *(u32x4*)(O + (size_t)u.z * zstride + (size_t)row * 64 + c0) = w; }
    }
};
struct EpiBf16Z { static constexpr bool PERM = true; bf16_t* O0; int ldc; size_t zstride;
    __device__ __forceinline__ void operator()(const f32x4 (&acc)[2][2][4][2], const Unit& u, int wr, int wc, int fr, int fq) const { EpiBf16 e{O0 + (size_t)u.z * zstride, ldc, 0, nullptr, nullptr}; e(acc, u, wr, wc, fr, fq); } };
struct EpiMem { static constexpr bool PERM = true; bf16_t* K0; bf16_t* V0;
    __device__ __forceinline__ void operator()(const f32x4 (&acc)[2][2][4][2], const Unit& u, int wr, int wc, int fr, int fq) const { EpiBf16 e{((u.z >> 2) ? V0 : K0) + (size_t)(u.z & 3) * 256 * 512, 512, 0, nullptr, nullptr}; e(acc, u, wr, wc, fr, fq); } };
struct MemSched { const char* A; const char* B; int G, c;
    __device__ __forceinline__ bool next(int i, Unit& u) const {
        const long L = (long)i * G + c; if (L >= 16) return false;
        const int pn = (int)L & 1, ks = ((int)L >> 1) & 3, kv = (int)L >> 3;
        u.pm = 0; u.pn = pn; u.z = kv * 4 + ks; u.a = A + (size_t)ks * 1024; u.b = B + (size_t)kv * 512 * D * 2 + (size_t)pn * 256 * D * 2 + (size_t)ks * 1024; u.rows = nullptr; return true; } };
struct MoeSched { const LAS int* pst; const char* B; const int* tok; size_t bE, bTile; int nN, G, c, mode;
    __device__ __forceinline__ bool next(int i, Unit& u) const {
        const int nb = __builtin_amdgcn_readfirstlane(pst[32]) >> 8; const int n1 = nb * nN, n1a = (n1 / G) * G;
        const int cv = (G % NXCD == 0) ? (c % NXCD) * (G / NXCD) + c / NXCD : c;
        const long L = (long)(mode == 2 ? n1a : 0) + (long)i * G + cv; if (L >= (long)(mode == 1 ? n1a : n1)) return false;
        const int b = (int)(L / nN), pn = (int)(L % nN); const int e = __builtin_amdgcn_readfirstlane(pst[240 + b]);
        u.pm = 0; u.pn = pn; u.z = b; u.a = nullptr; u.rows = tok + b * 256; u.b = B + (size_t)e * bE + (size_t)pn * bTile; return true; } };
struct MoeSched2 { const LAS int* pst; const char* A; const char* B; size_t bE, bTile; int nN, G, c, mode;
    __device__ __forceinline__ bool next(int i, Unit& u) const {
        const int nb = __builtin_amdgcn_readfirstlane(pst[32]) >> 8; const int n1 = nb * 4, r1 = n1 % G, bdone = ((n1 / G) * G) / 4, n2a = bdone * nN, n2 = nb * nN;
        const int cv = (G % NXCD == 0) ? (c % NXCD) * (G / NXCD) + c / NXCD : c;
        long L;
        if (mode == 1) { const int nfree = r1 ? G - r1 : 0; const long E = 3L * nfree;
            if (r1 && cv >= r1) L = (i < 3) ? (long)i * nfree + (cv - r1) : E + (long)(i - 3) * G + cv; else L = E + (long)i * G + cv;
            if (L >= n2a) return false; }
        else { L = (long)n2a + (long)i * G + cv; if (L >= n2) return false; }
        const int b = (int)(L / nN), pn = (int)(L % nN); const int e = __builtin_amdgcn_readfirstlane(pst[240 + b]);
        u.pm = 0; u.pn = pn; u.z = b; u.a = A + (size_t)b * 256 * 512; u.rows = nullptr; u.b = B + (size_t)e * bE + (size_t)pn * bTile; return true; } };
}

#define XB_TMO      128
#define XB_XCNT(j)  (256  + 64 * (j))
#define XB_XSUB(j)  (1280 + 64 * (j))
#define XB_XGEN(j)  (2304 + 64 * (j))
#define XB_TOP      3328
#define XB_TOPGEN   3392
#define XCD_BAR_WORDS 3456
#define XB_SPIN_CAP (1u << 22)
__device__ __forceinline__ unsigned xb_ld(unsigned* p)              { return __hip_atomic_load(p, __ATOMIC_RELAXED, __HIP_MEMORY_SCOPE_AGENT); }
__device__ __forceinline__ unsigned xb_add(unsigned* p, unsigned v) { return __hip_atomic_fetch_add(p, v, __ATOMIC_RELAXED, __HIP_MEMORY_SCOPE_AGENT); }
__device__ __forceinline__ unsigned xb_xcc_id() { return (unsigned)__builtin_amdgcn_s_getreg((3 << 11) | 20) & 0xFu; }
#define XB_SPIN(cond, bar) do { unsigned _sp = 0; while (cond) { __builtin_amdgcn_s_sleep(1); \
    if ((++_sp & 255u) == 0u) { if (xb_ld(&(bar)[XB_TMO])) break; if (_sp > XB_SPIN_CAP) { atomicAdd(&(bar)[XB_TMO], 1u); break; } } } } while (0)
struct XcdBarrier { unsigned* bar; unsigned x; volatile LAS unsigned* st; };
__device__ __forceinline__ XcdBarrier xcd_barrier_post(unsigned* bar, volatile LAS unsigned* st) {
    XcdBarrier b; b.bar = bar; b.x = xb_xcc_id(); b.st = st;
    if (threadIdx.x == 0) (void)xb_add(&bar[XB_XCNT(b.x)], 1u);
    return b;
}
__device__ __forceinline__ void xcd_barrier_complete(unsigned* bar, unsigned x, unsigned& nloc, unsigned& nx) {
    const unsigned G = gridDim.x * gridDim.y * gridDim.z;
    unsigned sum, cnt, mine, sp = 0u;
    for (;;) {
        sum = 0u; cnt = 0u; mine = 0u;
#pragma unroll
        for (unsigned j = 0; j < 16; ++j) { const unsigned c = xb_ld(&bar[XB_XCNT(j)]); sum += c; cnt += (c > 0u) ? 1u : 0u; mine = (j == x) ? c : mine; }
        if (sum == G) break;
        __builtin_amdgcn_s_sleep(1);
        if ((++sp & 255u) == 0u) { if (xb_ld(&bar[XB_TMO])) break; if (sp > XB_SPIN_CAP) { atomicAdd(&bar[XB_TMO], 1u); break; } }
    }
    nloc = mine > 0u ? mine : 1u; nx = cnt > 0u ? cnt : 1u;
}
__device__ __forceinline__ void xcd_barrier(const XcdBarrier& b, const int tid_) {
    asm volatile("s_waitcnt vmcnt(0)" ::: "memory");
    __syncthreads();
    if (tid_ == 0) {
        unsigned* bar = b.bar;
        __builtin_amdgcn_s_waitcnt(0);
        unsigned nloc = b.st[0], nx = b.st[1];
        if (nloc == 0u) { xcd_barrier_complete(bar, b.x, nloc, nx); b.st[0] = nloc; b.st[1] = nx; }
        const unsigned old = xb_add(&bar[XB_XSUB(b.x)], 1u);
        const unsigned gen = old / nloc;
        if (old + 1u == (gen + 1u) * nloc) {
            __builtin_amdgcn_fence(__ATOMIC_RELEASE, "agent");
            asm volatile("s_waitcnt vmcnt(0)" ::: "memory");
            const unsigned og = xb_add(&bar[XB_TOP], 1u);
            const unsigned tg = og / nx;
            if (og + 1u == (tg + 1u) * nx) xb_add(&bar[XB_TOPGEN], 1u);
            else XB_SPIN(xb_ld(&bar[XB_TOPGEN]) == tg, bar);
            __builtin_amdgcn_fence(__ATOMIC_ACQUIRE, "agent");
            xb_add(&bar[XB_XGEN(b.x)], 1u);
            asm volatile("s_waitcnt vmcnt(0)" ::: "memory");
        } else {
            XB_SPIN(xb_ld(&bar[XB_XGEN(b.x)]) == gen, bar);
            __builtin_amdgcn_fence(__ATOMIC_ACQUIRE, "agent");
            asm volatile("s_waitcnt vmcnt(0)" ::: "memory");
        }
    }
    __syncthreads();
}

template <int RB> __device__ __forceinline__ int kswz(int row, int c) { return (RB == 256) ? (c ^ (row & 15)) : (c ^ ((row >> 1) & 7)); }
__device__ __forceinline__ int vswz(int d, int c) { return c ^ ((d >> 1) & 7); }
template <int BYTES> __device__ __forceinline__ void dma_tile(const unsigned char* src, LAS unsigned char* dst, int tid, int wid) {
#pragma unroll
    for (int i = 0; i < BYTES / 8192; ++i)
        __builtin_amdgcn_global_load_lds((const unsigned*)(src + (unsigned)(i * 8192 + tid * 16)), (LAS unsigned*)(dst + i * 8192 + wid * 1024), 16, 0, 0);
}
template <int DQK, int DV, int MODE>
__device__ __forceinline__ void attn_tile_compute(const LAS unsigned char* kb, const LAS unsigned char* vb, const int k0, const bool domask, const bf16x8 (&qf)[DQK / 16],
                                                  const int qpos, const LAS float* biasrow, const int lr, const int hi, f32x16 (&o)[DV / 32], float& m_run, float& l_run) {
    constexpr int RB = DQK * 2, NKS = DQK / 16, NDB = DV / 32;
            f32x16 p0, p1;
#pragma unroll
            for (int r = 0; r < 16; ++r) { p0[r] = 0.f; p1[r] = 0.f; }
#pragma unroll
            for (int ks = 0; ks < NKS; ++ks) {
                const int c = 2 * ks + hi;
                const bf16x8 kf0 = *(const LAS bf16x8*)(kb + lr * RB + kswz<RB>(lr, c) * 16);
                const bf16x8 kf1 = *(const LAS bf16x8*)(kb + (lr + 32) * RB + kswz<RB>(lr + 32, c) * 16);
                p0 = __builtin_amdgcn_mfma_f32_32x32x16_bf16(kf0, qf[ks], p0, 0, 0, 0);
                p1 = __builtin_amdgcn_mfma_f32_32x32x16_bf16(kf1, qf[ks], p1, 0, 0, 0);
            }
            if (domask) {
                const float NEG = -__builtin_inff();
#pragma unroll
                for (int r = 0; r < 16; ++r) {
                    const int key0 = k0 + (r & 3) + 8 * (r >> 2) + 4 * hi, key1 = key0 + 32;
                    if (MODE == 0) { if (key0 > qpos) p0[r] = NEG; if (key1 > qpos) p1[r] = NEG; }
                    if (MODE == 1) { const int d0 = qpos - key0, d1 = qpos - key1;
                        p0[r] = ((unsigned)d0 < 128u) ? p0[r] + biasrow[d0 & 127] : NEG;
                        p1[r] = ((unsigned)d1 < 128u) ? p1[r] + biasrow[d1 & 127] : NEG; }
                }
            }
            float mx = p0[0];
#pragma unroll
            for (int r = 1; r < 16; ++r) mx = fmaxf(mx, p0[r]);
#pragma unroll
            for (int r = 0; r < 16; ++r) mx = fmaxf(mx, p1[r]);
            { auto rr = __builtin_amdgcn_permlane32_swap(__float_as_uint(mx), __float_as_uint(mx), false, false); mx = fmaxf(__uint_as_float(rr[0]), __uint_as_float(rr[1])); }
            const float mn = fmaxf(m_run, mx), alpha = fast_exp2(m_run - mn);
            m_run = mn;
            float ps = 0.f;
#pragma unroll
            for (int r = 0; r < 16; ++r) { p0[r] = fast_exp2(p0[r] - mn); p1[r] = fast_exp2(p1[r] - mn); ps += p0[r] + p1[r]; }
            l_run = l_run * alpha + ps;
            if (!__all(alpha == 1.f)) {
#pragma unroll
                for (int db = 0; db < NDB; ++db)
#pragma unroll
                    for (int r = 0; r < 16; ++r) o[db][r] *= alpha;
            }
            bf16x8 pf[4];
#pragma unroll
            for (int s = 0; s < 4; ++s) {
                const int r0 = 8 * (s & 1);
                unsigned a01, a23, b45, b67;
                if (s < 2) { a01 = cvt_pk_bf16(p0[r0 + 0], p0[r0 + 1]); a23 = cvt_pk_bf16(p0[r0 + 2], p0[r0 + 3]); b45 = cvt_pk_bf16(p0[r0 + 4], p0[r0 + 5]); b67 = cvt_pk_bf16(p0[r0 + 6], p0[r0 + 7]); }
                else       { a01 = cvt_pk_bf16(p1[r0 + 0], p1[r0 + 1]); a23 = cvt_pk_bf16(p1[r0 + 2], p1[r0 + 3]); b45 = cvt_pk_bf16(p1[r0 + 4], p1[r0 + 5]); b67 = cvt_pk_bf16(p1[r0 + 6], p1[r0 + 7]); }
                auto s0 = __builtin_amdgcn_permlane32_swap(a01, b45, false, false);
                auto s1 = __builtin_amdgcn_permlane32_swap(a23, b67, false, false);
                u32x4 w; w.x = s0[0]; w.y = s1[0]; w.z = s0[1]; w.w = s1[1];
                pf[s] = __builtin_bit_cast(bf16x8, w);
            }
#pragma unroll
            for (int db = 0; db < NDB; ++db) {
                const int d = 32 * db + lr;
#pragma unroll
                for (int s = 0; s < 4; ++s) {
                    const bf16x8 vf = *(const LAS bf16x8*)(vb + d * 128 + vswz(d, 2 * s + hi) * 16);
                    o[db] = __builtin_amdgcn_mfma_f32_32x32x16_bf16(vf, pf[s], o[db], 0, 0, 0);
                }
            }
        }
template <int DQK, int DV, int MODE>
__device__ __forceinline__ void attn_tiles(const int tid_in, LAS unsigned char* lds, const unsigned char* gK, const unsigned char* gV, int t_lo, int t_hi,
                                           const bf16x8 (&qf)[DQK / 16], int qpos, int wave_q0, const LAS float* biasrow,
                                           f32x16 (&o)[DV / 32], float& m_run, float& l_run) {
    constexpr int KT = 64 * DQK * 2, VT = DV * 128, BUF = KT + VT;
    int tid = tid_in; asm volatile("" : "+v"(tid));
    const int wid = __builtin_amdgcn_readfirstlane(tid >> 6), lane = tid & 63, lr = lane & 31, hi = lane >> 5;
    dma_tile<KT>(gK + (size_t)t_lo * KT, lds, tid, wid); dma_tile<VT>(gV + (size_t)t_lo * VT, lds + KT, tid, wid);
    VM_WAIT(); __syncthreads();
#pragma unroll 1
    for (int t = t_lo; t < t_hi; ++t) {
        const int cur = (t - t_lo) & 1;
        LAS unsigned char* kb = lds + cur * BUF; LAS unsigned char* vb = kb + KT;
        if (t + 1 < t_hi) { LAS unsigned char* nb = lds + (cur ^ 1) * BUF; dma_tile<KT>(gK + (size_t)(t + 1) * KT, nb, tid, wid); dma_tile<VT>(gV + (size_t)(t + 1) * VT, nb + KT, tid, wid); }
        const int k0 = t * 64;
        bool need = true, domask = false;
        if (MODE == 0) { need = (k0 <= wave_q0 + 31); domask = (k0 + 63 > wave_q0); }
        if (MODE == 1) { need = (k0 <= wave_q0 + 31) && (k0 + 63 >= wave_q0 - 127); domask = true; }
        if (need) attn_tile_compute<DQK, DV, MODE>(kb, vb, k0, domask, qf, qpos, biasrow, lr, hi, o, m_run, l_run);
        VM_WAIT(); __syncthreads();
    }
}
#define MLA_KLD(KB, ks, F0, F1) do { const int c_ = 2 * (ks) + hi; \
        F0 = *(const LAS bf16x8*)((KB) + lr * 384 + kswz<384>(lr, c_) * 16); \
        F1 = *(const LAS bf16x8*)((KB) + (lr + 32) * 384 + kswz<384>(lr + 32, c_) * 16); } while (0)
#define MLA_QK(KB, P0, P1) do { _Pragma("unroll") for (int r = 0; r < 16; ++r) { P0[r] = 0.f; P1[r] = 0.f; } \
    bf16x8 ka_[3], kb_[3]; MLA_KLD(KB, 0, ka_[0], kb_[0]); MLA_KLD(KB, 1, ka_[1], kb_[1]); \
    _Pragma("unroll") for (int ks = 0; ks < 12; ++ks) { \
        if (ks + 2 < 12) MLA_KLD(KB, ks + 2, ka_[(ks + 2) % 3], kb_[(ks + 2) % 3]); \
        __builtin_amdgcn_sched_barrier(0); \
        P0 = __builtin_amdgcn_mfma_f32_32x32x16_bf16(ka_[ks % 3], qf[ks], P0, 0, 0, 0); \
        P1 = __builtin_amdgcn_mfma_f32_32x32x16_bf16(kb_[ks % 3], qf[ks], P1, 0, 0, 0); } } while (0)
__device__ __forceinline__ void mla_softmax(f32x16& p0, f32x16& p1, const bool domask, const int k0, const int qpos, const int hi, f32x16 (&o)[4], float& m_run, float& l_run, bf16x8 (&pf)[4]) {
    if (domask) {
        const float NEG = -__builtin_inff();
#pragma unroll
        for (int r = 0; r < 16; ++r) { const int key0 = k0 + (r & 3) + 8 * (r >> 2) + 4 * hi; if (key0 > qpos) p0[r] = NEG; if (key0 + 32 > qpos) p1[r] = NEG; }
    }
    float mx = p0[0];
#pragma unroll
    for (int r = 1; r < 16; ++r) mx = fmaxf(mx, p0[r]);
#pragma unroll
    for (int r = 0; r < 16; ++r) mx = fmaxf(mx, p1[r]);
    { auto rr = __builtin_amdgcn_permlane32_swap(__float_as_uint(mx), __float_as_uint(mx), false, false); mx = fmaxf(__uint_as_float(rr[0]), __uint_as_float(rr[1])); }
    float mn = m_run, alpha = 1.f;
    if (!__all(mx - m_run <= 8.f)) { mn = fmaxf(m_run, mx); alpha = fast_exp2(m_run - mn); m_run = mn;
#pragma unroll
        for (int db = 0; db < 4; ++db)
#pragma unroll
            for (int r = 0; r < 16; ++r) o[db][r] *= alpha; }
    float ps = 0.f;
#pragma unroll
    for (int r = 0; r < 16; ++r) { p0[r] = fast_exp2(p0[r] - mn); p1[r] = fast_exp2(p1[r] - mn); ps += p0[r] + p1[r]; }
    l_run = l_run * alpha + ps;
#pragma unroll
    for (int s = 0; s < 4; ++s) {
        const int r0 = 8 * (s & 1);
        unsigned a01, a23, b45, b67;
        if (s < 2) { a01 = cvt_pk_bf16(p0[r0 + 0], p0[r0 + 1]); a23 = cvt_pk_bf16(p0[r0 + 2], p0[r0 + 3]); b45 = cvt_pk_bf16(p0[r0 + 4], p0[r0 + 5]); b67 = cvt_pk_bf16(p0[r0 + 6], p0[r0 + 7]); }
        else       { a01 = cvt_pk_bf16(p1[r0 + 0], p1[r0 + 1]); a23 = cvt_pk_bf16(p1[r0 + 2], p1[r0 + 3]); b45 = cvt_pk_bf16(p1[r0 + 4], p1[r0 + 5]); b67 = cvt_pk_bf16(p1[r0 + 6], p1[r0 + 7]); }
        auto s0 = __builtin_amdgcn_permlane32_swap(a01, b45, false, false);
        auto s1 = __builtin_amdgcn_permlane32_swap(a23, b67, false, false);
        u32x4 w; w.x = s0[0]; w.y = s1[0]; w.z = s0[1]; w.w = s1[1];
        pf[s] = __builtin_bit_cast(bf16x8, w);
    }
}
__device__ __forceinline__ void mla_pv(const bf16x8 (&pf)[4], const LAS unsigned char* vb, const int lr, const int hi, f32x16 (&o)[4]) {
    bf16x8 vf[2][4];
#pragma unroll
    for (int s = 0; s < 4; ++s) vf[0][s] = *(const LAS bf16x8*)(vb + lr * 128 + vswz(lr, 2 * s + hi) * 16);
#pragma unroll
    for (int db = 0; db < 4; ++db) {
        if (db + 1 < 4) { const int d = 32 * (db + 1) + lr;
#pragma unroll
            for (int s = 0; s < 4; ++s) vf[(db + 1) & 1][s] = *(const LAS bf16x8*)(vb + d * 128 + vswz(d, 2 * s + hi) * 16); }
        __builtin_amdgcn_sched_barrier(0);
#pragma unroll
        for (int s = 0; s < 4; ++s) o[db] = __builtin_amdgcn_mfma_f32_32x32x16_bf16(vf[db & 1][s], pf[s], o[db], 0, 0, 0);
    }
}
typedef long i64x2 __attribute__((ext_vector_type(2)));
__host__ __device__ __forceinline__ int f8pos(int k) { return (k & ~31) | (((k >> 3) & 1) << 4) | (((k >> 4) & 1) << 3) | (k & 7); }
#define F8_KLD(KB, m, F0, F1) do { const int c_ = (2 * (m) + hi) ^ ((lr >> 2) & 3); \
        F0 = *(const LAS i64x2*)((KB) + lr * 192 + c_ * 16); F1 = *(const LAS i64x2*)((KB) + (lr + 32) * 192 + c_ * 16); } while (0)
#define F8_QK(KB, P0, P1) do { _Pragma("unroll") for (int r = 0; r < 16; ++r) { P0[r] = 0.f; P1[r] = 0.f; } \
    i64x2 ka_[3], kb_[3]; F8_KLD(KB, 0, ka_[0], kb_[0]); F8_KLD(KB, 1, ka_[1], kb_[1]); \
    _Pragma("unroll") for (int m = 0; m < 6; ++m) { \
        if (m + 2 < 6) F8_KLD(KB, m + 2, ka_[(m + 2) % 3], kb_[(m + 2) % 3]); \
        __builtin_amdgcn_sched_barrier(0); \
        P0 = __builtin_amdgcn_mfma_f32_32x32x16_fp8_fp8(ka_[m % 3].x, qf[m].x, P0, 0, 0, 0); \
        P1 = __builtin_amdgcn_mfma_f32_32x32x16_fp8_fp8(kb_[m % 3].x, qf[m].x, P1, 0, 0, 0); \
        P0 = __builtin_amdgcn_mfma_f32_32x32x16_fp8_fp8(ka_[m % 3].y, qf[m].y, P0, 0, 0, 0); \
        P1 = __builtin_amdgcn_mfma_f32_32x32x16_fp8_fp8(kb_[m % 3].y, qf[m].y, P1, 0, 0, 0); } } while (0)
__device__ __forceinline__ void f8_softmax(f32x16& p0, f32x16& p1, const bool domask, const int k0, const int qpos, const int hi, f32x16 (&o)[4], float& m_run, float& l_run, long (&pf)[4]) {
    constexpr float C = 0.07216878364870322f * LOG2E;
    if (domask) {
        const float NEG = -__builtin_inff();
#pragma unroll
        for (int r = 0; r < 16; ++r) { const int key0 = k0 + (r & 3) + 8 * (r >> 2) + 4 * hi; if (key0 > qpos) p0[r] = NEG; if (key0 + 32 > qpos) p1[r] = NEG; }
    }
    float mx = p0[0];
#pragma unroll
    for (int r = 1; r < 16; ++r) mx = fmaxf(mx, p0[r]);
#pragma unroll
    for (int r = 0; r < 16; ++r) mx = fmaxf(mx, p1[r]);
    { auto rr = __builtin_amdgcn_permlane32_swap(__float_as_uint(mx), __float_as_uint(mx), false, false); mx = fmaxf(__uint_as_float(rr[0]), __uint_as_float(rr[1])); }
    mx *= C;
    float mn = m_run, alpha = 1.f;
    if (!__all(mx - m_run <= 8.f)) { mn = fmaxf(m_run, mx); alpha = fast_exp2(m_run - mn); m_run = mn;
#pragma unroll
        for (int db = 0; db < 4; ++db)
#pragma unroll
            for (int r = 0; r < 16; ++r) o[db][r] *= alpha; }
    float ps = 0.f;
#pragma unroll
    for (int r = 0; r < 16; ++r) { p0[r] = fast_exp2(p0[r] * C - mn); p1[r] = fast_exp2(p1[r] * C - mn); ps += p0[r] + p1[r]; }
    l_run = l_run * alpha + ps;
#pragma unroll
    for (int s = 0; s < 4; ++s) {
        const int r0 = 8 * (s & 1);
        unsigned a, b;
        if (s < 2) { a = pk4_fp8(p0[r0 + 0], p0[r0 + 1], p0[r0 + 2], p0[r0 + 3]); b = pk4_fp8(p0[r0 + 4], p0[r0 + 5], p0[r0 + 6], p0[r0 + 7]); }
        else       { a = pk4_fp8(p1[r0 + 0], p1[r0 + 1], p1[r0 + 2], p1[r0 + 3]); b = pk4_fp8(p1[r0 + 4], p1[r0 + 5], p1[r0 + 6], p1[r0 + 7]); }
        auto sw = __builtin_amdgcn_permlane32_swap(a, b, false, false);
        pf[s] = (long)(((unsigned long long)sw[1] << 32) | (unsigned long long)sw[0]);
    }
}
__device__ __forceinline__ void f8_pv(const long (&pf)[4], const LAS unsigned char* vb, const int lr, const int hi, f32x16 (&o)[4]) {
    i64x2 vf[2][2];
#pragma unroll
    for (int m = 0; m < 2; ++m) vf[0][m] = *(const LAS i64x2*)(vb + lr * 64 + (((2 * m + hi) ^ ((lr >> 2) & 3)) << 4));
#pragma unroll
    for (int db = 0; db < 4; ++db) {
        if (db + 1 < 4) { const int d = 32 * (db + 1) + lr;
#pragma unroll
            for (int m = 0; m < 2; ++m) vf[(db + 1) & 1][m] = *(const LAS i64x2*)(vb + d * 64 + (((2 * m + hi) ^ ((d >> 2) & 3)) << 4)); }
        __builtin_amdgcn_sched_barrier(0);
#pragma unroll
        for (int m = 0; m < 2; ++m) { o[db] = __builtin_amdgcn_mfma_f32_32x32x16_fp8_fp8(vf[db & 1][m].x, pf[2 * m], o[db], 0, 0, 0);
                                      o[db] = __builtin_amdgcn_mfma_f32_32x32x16_fp8_fp8(vf[db & 1][m].y, pf[2 * m + 1], o[db], 0, 0, 0); }
    }
}
__device__ __forceinline__ void attn_mla_f8(const int tid_in, LAS unsigned char* lds, const unsigned char* gK, const unsigned char* gV, const int t_lo, const int t_hi,
                                            const i64x2 (&qf)[6], const int qpos, const int wave_q0, f32x16 (&o)[4], float& m_run, float& l_run) {
    constexpr int KT = 12288, VT = 8192;
    int tid = tid_in; asm volatile("" : "+v"(tid));
    const int wid = __builtin_amdgcn_readfirstlane(tid >> 6), lane = tid & 63, lr0 = lane & 31, hi = lane >> 5;
    const bool halfB = wid >= 4;
    LAS unsigned char* KB0 = lds; LAS unsigned char* VB0 = lds + 2 * KT;
#define F8_DMA(T, KDST, VDST) do { const unsigned char* ks_ = gK + (size_t)(T) * KT; \
        __builtin_amdgcn_global_load_lds((const unsigned*)(ks_ + (unsigned)(tid * 16)), (LAS unsigned*)((KDST) + wid * 1024), 16, 0, 0); \
        if (wid < 4) __builtin_amdgcn_global_load_lds((const unsigned*)(ks_ + 8192 + (unsigned)(tid * 16)), (LAS unsigned*)((KDST) + 8192 + wid * 1024), 16, 0, 0); \
        __builtin_amdgcn_global_load_lds((const unsigned*)(gV + (size_t)(T) * VT + (unsigned)(tid * 16)), (LAS unsigned*)((VDST) + wid * 1024), 16, 0, 0); } while (0)
    F8_DMA(t_lo, KB0, VB0);
    VM_WAIT(); __syncthreads();
    if (!halfB) {
        int vcur = 0;
#pragma unroll 1
        for (int t = t_lo; t <= t_hi; ++t) {
            const int j = t - t_lo, vnext = (vcur == 2) ? 0 : vcur + 1;
            if (t + 1 < t_hi) F8_DMA(t + 1, KB0 + ((j + 1) & 1) * KT, VB0 + vnext * VT);
            const int k0 = t * 64;
            int lr = lr0; asm volatile("" : "+v"(lr));
            if ((t < t_hi) && (k0 <= wave_q0 + 31)) { f32x16 p0, p1; long pf[4]; const LAS unsigned char* kb = KB0 + (j & 1) * KT;
                F8_QK(kb, p0, p1); f8_softmax(p0, p1, k0 + 63 > wave_q0, k0, qpos, hi, o, m_run, l_run, pf); f8_pv(pf, VB0 + vcur * VT, lr, hi, o); }
            vcur = vnext;
            VM_WAIT(); __syncthreads();
        }
    } else {
        long pf[4] = {0, 0, 0, 0};
        int vcur = 0, vprev = 2;
#pragma unroll 1
        for (int t = t_lo; t <= t_hi; ++t) {
            const int j = t - t_lo, vnext = (vcur == 2) ? 0 : vcur + 1;
            if (t + 1 < t_hi) F8_DMA(t + 1, KB0 + ((j + 1) & 1) * KT, VB0 + vnext * VT);
            const int k0 = t * 64;
            int lr = lr0; asm volatile("" : "+v"(lr));
            if ((j > 0) && (k0 - 64 <= wave_q0 + 31)) f8_pv(pf, VB0 + vprev * VT, lr, hi, o);
            if ((t < t_hi) && (k0 <= wave_q0 + 31)) { f32x16 p0, p1; const LAS unsigned char* kb = KB0 + (j & 1) * KT;
                F8_QK(kb, p0, p1); f8_softmax(p0, p1, k0 + 63 > wave_q0, k0, qpos, hi, o, m_run, l_run, pf); }
            vprev = vcur; vcur = vnext;
            VM_WAIT(); __syncthreads();
        }
    }
#undef F8_DMA
}
__device__ __forceinline__ void attn_mla_stag(const int tid_in, LAS unsigned char* lds, const unsigned char* gK, const unsigned char* gV, const int t_lo, const int t_hi,
                                              const bf16x8 (&qf)[12], const int qpos, const int wave_q0, f32x16 (&o)[4], float& m_run, float& l_run) {
    constexpr int KT = 24576, VT = 16384;
    int tid = tid_in; asm volatile("" : "+v"(tid));
    const int wid = __builtin_amdgcn_readfirstlane(tid >> 6), lane = tid & 63, lr0 = lane & 31, hi = lane >> 5;
    const bool halfB = wid >= 4;
    LAS unsigned char* KB0 = lds; LAS unsigned char* VB0 = lds + 2 * KT;
    dma_tile<KT>(gK + (size_t)t_lo * KT, KB0, tid, wid); dma_tile<VT>(gV + (size_t)t_lo * VT, VB0, tid, wid);
    VM_WAIT(); __syncthreads();
    if (!halfB) {
        int vcur = 0;
#pragma unroll 1
        for (int t = t_lo; t <= t_hi; ++t) {
            const int j = t - t_lo, vnext = (vcur == 2) ? 0 : vcur + 1;
            if (t + 1 < t_hi) { dma_tile<KT>(gK + (size_t)(t + 1) * KT, KB0 + ((j + 1) & 1) * KT, tid, wid); dma_tile<VT>(gV + (size_t)(t + 1) * VT, VB0 + vnext * VT, tid, wid); }
            const int k0 = t * 64;
            int lr = lr0; asm volatile("" : "+v"(lr));
            if ((t < t_hi) && (k0 <= wave_q0 + 31)) { f32x16 p0, p1; bf16x8 pf[4]; const LAS unsigned char* kb = KB0 + (j & 1) * KT;
                MLA_QK(kb, p0, p1); mla_softmax(p0, p1, k0 + 63 > wave_q0, k0, qpos, hi, o, m_run, l_run, pf); mla_pv(pf, VB0 + vcur * VT, lr, hi, o); }
            vcur = vnext;
            VM_WAIT(); __syncthreads();
        }
    } else {
        bf16x8 pf[4];
#pragma unroll
        for (int s = 0; s < 4; ++s) pf[s] = (bf16x8){0, 0, 0, 0, 0, 0, 0, 0};
        int vcur = 0, vprev = 2;
#pragma unroll 1
        for (int t = t_lo; t <= t_hi; ++t) {
            const int j = t - t_lo, vnext = (vcur == 2) ? 0 : vcur + 1;
            if (t + 1 < t_hi) { dma_tile<KT>(gK + (size_t)(t + 1) * KT, KB0 + ((j + 1) & 1) * KT, tid, wid); dma_tile<VT>(gV + (size_t)(t + 1) * VT, VB0 + vnext * VT, tid, wid); }
            const int k0 = t * 64;
            int lr = lr0; asm volatile("" : "+v"(lr));
            if ((j > 0) && (k0 - 64 <= wave_q0 + 31)) mla_pv(pf, VB0 + vprev * VT, lr, hi, o);
            if ((t < t_hi) && (k0 <= wave_q0 + 31)) { f32x16 p0, p1; const LAS unsigned char* kb = KB0 + (j & 1) * KT;
                MLA_QK(kb, p0, p1); mla_softmax(p0, p1, k0 + 63 > wave_q0, k0, qpos, hi, o, m_run, l_run, pf); }
            vprev = vcur; vcur = vnext;
            VM_WAIT(); __syncthreads();
        }
    }
}
template <int DQK> __device__ __forceinline__ void load_q_norm(const bf16_t* qrow, const float* gain, float scale, int hi, bf16x8 (&qf)[DQK / 16]) {
    float x[DQK / 16][8]; float ss = 0.f;
#pragma unroll
    for (int ks = 0; ks < DQK / 16; ++ks) { const u32x4 w = *(const u32x4*)(qrow + 16 * ks + 8 * hi); unpack8(w, x[ks]);
#pragma unroll
        for (int j = 0; j < 8; ++j) ss += x[ks][j] * x[ks][j]; }
    { auto rr = __builtin_amdgcn_permlane32_swap(__float_as_uint(ss), __float_as_uint(ss), false, false); ss = __uint_as_float(rr[0]) + __uint_as_float(rr[1]); }
    const float rs = rsqrtf(ss * (1.0f / DQK) + EPS) * scale;
#pragma unroll
    for (int ks = 0; ks < DQK / 16; ++ks) { float y[8];
#pragma unroll
        for (int j = 0; j < 8; ++j) y[j] = x[ks][j] * rs * gain[16 * ks + 8 * hi + j];
        qf[ks] = __builtin_bit_cast(bf16x8, pack8(y)); }
}
template <int DQK> __device__ __forceinline__ void load_q_norm_bf16x2(const bf16_t* qa, const bf16_t* qb_, const float* gain, float scale, int hi, bf16x8 (&qf)[DQK / 16]) {
    float x[DQK / 16][8]; float ss = 0.f;
#pragma unroll
    for (int ks = 0; ks < DQK / 16; ++ks) { float a[8], b[8]; unpack8(*(const u32x4*)(qa + 16 * ks + 8 * hi), a); unpack8(*(const u32x4*)(qb_ + 16 * ks + 8 * hi), b);
#pragma unroll
        for (int j = 0; j < 8; ++j) { x[ks][j] = a[j] + b[j]; ss += x[ks][j] * x[ks][j]; } }
    { auto rr = __builtin_amdgcn_permlane32_swap(__float_as_uint(ss), __float_as_uint(ss), false, false); ss = __uint_as_float(rr[0]) + __uint_as_float(rr[1]); }
    const float rs = rsqrtf(ss * (1.0f / DQK) + EPS) * scale;
#pragma unroll
    for (int ks = 0; ks < DQK / 16; ++ks) { float y[8];
#pragma unroll
        for (int j = 0; j < 8; ++j) y[j] = x[ks][j] * rs * gain[16 * ks + 8 * hi + j];
        qf[ks] = __builtin_bit_cast(bf16x8, pack8(y)); }
}
template <int DQK> __device__ __forceinline__ void load_q_norm_bf16x4(const bf16_t* q0, const size_t zs, const float* gain, float scale, int hi, bf16x8 (&qf)[DQK / 16]) {
    float x[DQK / 16][8]; float ss = 0.f;
#pragma unroll
    for (int ks = 0; ks < DQK / 16; ++ks) {
#pragma unroll
        for (int j = 0; j < 8; ++j) x[ks][j] = 0.f;
#pragma unroll
        for (int z = 0; z < 4; ++z) { float a[8]; unpack8(*(const u32x4*)(q0 + z * zs + 16 * ks + 8 * hi), a);
#pragma unroll
            for (int j = 0; j < 8; ++j) x[ks][j] += a[j]; }
#pragma unroll
        for (int j = 0; j < 8; ++j) ss += x[ks][j] * x[ks][j]; }
    { auto rr = __builtin_amdgcn_permlane32_swap(__float_as_uint(ss), __float_as_uint(ss), false, false); ss = __uint_as_float(rr[0]) + __uint_as_float(rr[1]); }
    const float rs = rsqrtf(ss * (1.0f / DQK) + EPS) * scale;
#pragma unroll
    for (int ks = 0; ks < DQK / 16; ++ks) { float y[8];
#pragma unroll
        for (int j = 0; j < 8; ++j) y[j] = x[ks][j] * rs * gain[16 * ks + 8 * hi + j];
        qf[ks] = __builtin_bit_cast(bf16x8, pack8(y)); }
}
template <int DV> __device__ __forceinline__ void store_o(bf16_t* orow, const f32x16 (&o)[DV / 32], float inv_l, int hi) {
#pragma unroll
    for (int db = 0; db < DV / 32; ++db)
#pragma unroll
        for (int r4 = 0; r4 < 4; ++r4) { u32x2 w; w.x = cvt_pk_bf16(o[db][4 * r4] * inv_l, o[db][4 * r4 + 1] * inv_l); w.y = cvt_pk_bf16(o[db][4 * r4 + 2] * inv_l, o[db][4 * r4 + 3] * inv_l);
            *(u32x2*)(orow + 32 * db + 8 * r4 + 4 * hi) = w; }
}

struct Args { const float* in[50]; float* out; unsigned char* ws; int l_lo, l_hi, ph_lo, ph_hi; };
enum { I_X = 0, I_MEM, I_RELB, I_LNMIX, I_WIN, I_SWAQG, I_SWAKG, I_SINK, I_DWW, I_DWB, I_CLNG, I_CLNB, I_PWW, I_PWB, I_QAG, I_KVAG, I_WQB, I_WKVB, I_QNN, I_QNR, I_KNN, I_KNR,
       I_ARE, I_AIM, I_LOGDT, I_BRE, I_BIM, I_CRE, I_CIM, I_SSMD, I_GLUW, I_GLUB, I_MIXG, I_WOUT, I_LNX, I_MEMG, I_XWQ, I_XWK, I_XWV, I_XQG, I_XKG, I_XWO, I_LNMOE, I_WG, I_BG, I_WE, I_BE, I_MG, I_MU, I_MD };
constexpr int NPH = 19;

__constant__ unsigned char T5_BUCKET[128] = {0,1,2,3,4,5,6,7,8,9,10,11,12,13,14,15,16,16,16,17,17,18,18,18,19,19,19,20,20,20,20,21,21,21,21,22,22,22,22,22,23,23,23,23,23,23,24,24,24,24,24,24,25,25,25,25,25,25,25,26,26,26,26,26,26,26,26,27,27,27,27,27,27,27,27,27,27,28,28,28,28,28,28,28,28,28,28,29,29,29,29,29,29,29,29,29,29,29,29,30,30,30,30,30,30,30,30,30,30,30,30,30,30,31,31,31,31,31,31,31,31,31,31,31,31,31,31,31};

__device__ __forceinline__ void tr_item(const float* W, int ldw, int k0, int n0, bf16_t* WT, int ldt, int drow0, const float* kgain, LAS float* scr, int lane) {
    float tv[32];
#pragma unroll
    for (int i = 0; i < 32; ++i) { const int kk = 2 * i + (lane >> 5); tv[i] = W[(size_t)(k0 + kk) * ldw + n0 + (lane & 31)]; }
#pragma unroll
    for (int i = 0; i < 32; ++i) { const int kk = 2 * i + (lane >> 5); float v = tv[i]; if (kgain) v *= kgain[k0 + kk]; scr[kk * 33 + (lane & 31)] = v; }
    LDS_WAIT();
    const int c = lane & 7;
#pragma unroll
    for (int j = 0; j < 4; ++j) { const int n = (lane >> 3) + 8 * j; const LAS float* s = scr + (8 * c) * 33 + n;
        u32x4 o; o.x = cvt_pk_bf16(s[0 * 33], s[1 * 33]); o.y = cvt_pk_bf16(s[2 * 33], s[3 * 33]); o.z = cvt_pk_bf16(s[4 * 33], s[5 * 33]); o.w = cvt_pk_bf16(s[6 * 33], s[7 * 33]);
        *(u32x4*)(WT + (size_t)(drow0 + n) * ldt + k0 + 8 * c) = o; }
    LDS_WAIT();
}
__device__ __forceinline__ void tr_item8(const float* W, int ldw, int k0, int n0, unsigned char* WT8, int ldt, int drow0, const float* kgain, LAS float* scr, int lane) {
    float tv[32];
#pragma unroll
    for (int i = 0; i < 32; ++i) { const int kk = 2 * i + (lane >> 5); tv[i] = W[(size_t)(k0 + kk) * ldw + n0 + (lane & 31)]; }
#pragma unroll
    for (int i = 0; i < 32; ++i) { const int kk = 2 * i + (lane >> 5); float v = tv[i] * 32.0f; if (kgain) v *= kgain[k0 + kk]; scr[kk * 33 + (lane & 31)] = v; }
    LDS_WAIT();
    const int c = lane & 7;
#pragma unroll
    for (int j = 0; j < 4; ++j) { const int n = (lane >> 3) + 8 * j; const LAS float* s = scr + (8 * c) * 33 + n;
        *(u32x2*)(WT8 + (size_t)(drow0 + n) * ldt + k0 + 8 * c) = (u32x2){pk4_fp8(s[0 * 33], s[1 * 33], s[2 * 33], s[3 * 33]), pk4_fp8(s[4 * 33], s[5 * 33], s[6 * 33], s[7 * 33])}; }
    LDS_WAIT();
}
__device__ __forceinline__ void rms_row_store(const f32x4 (&v)[8], const float* gain, bf16_t* orow, int lane) {
    float ss = 0.f;
#pragma unroll
    for (int j = 0; j < 8; ++j) ss += (v[j].x * v[j].x + v[j].y * v[j].y) + (v[j].z * v[j].z + v[j].w * v[j].w);
    const float rs = rsqrtf(wave_sum(ss) * (1.0f / D) + EPS);
#pragma unroll
    for (int j = 0; j < 8; ++j) { const f32x4 g = *(const f32x4*)(gain + 4 * lane + 256 * j); u32x2 w; w.x = cvt_pk_bf16(v[j].x * rs * g.x, v[j].y * rs * g.y); w.y = cvt_pk_bf16(v[j].z * rs * g.z, v[j].w * rs * g.w);
        *(u32x2*)(orow + 4 * lane + 256 * j) = w; }
}
__device__ __forceinline__ f32x2 cmul(f32x2 a, f32x2 b) { return (f32x2){a.x * b.x - a.y * b.y, a.x * b.y + a.y * b.x}; }
__device__ __forceinline__ void sincos_rev(float x, float& s, float& c) { float r = x * 0.15915494309189535f; r -= rintf(r); s = __builtin_amdgcn_sinf(r); c = __builtin_amdgcn_cosf(r); }

#define X ((float*)out_)
#define ROPE ((float*)(ws + WS_ROPE))
#define H ((bf16_t*)(ws + WS_H))
#define P ((bf16_t*)(ws + WS_P))
#define O ((bf16_t*)(ws + WS_O))
#define QRAW ((bf16_t*)(ws + WS_QRAW))
#define KVRAW ((bf16_t*)(ws + WS_KVRAW))
#define Q ((bf16_t*)(ws + WS_Q))
#define KIMG ((unsigned char*)(ws + WS_KIMG))
#define VIMG ((unsigned char*)(ws + WS_VIMG))
#define SWAK ((unsigned char*)(ws + WS_SWAK))
#define SWAV ((unsigned char*)(ws + WS_SWAV))
#define ZC ((bf16_t*)(ws + WS_ZC))
#define UA ((bf16_t*)(ws + WS_UA))
#define EBUF ((float*)(ws + WS_EBUF))
#define YG ((bf16_t*)(ws + WS_YG))
#define QX ((bf16_t*)(ws + WS_QX))
#define OX ((bf16_t*)(ws + WS_OX))
#define MEMN ((bf16_t*)(ws + WS_MEMN))
#define KMEM ((bf16_t*)(ws + WS_KMEM))
#define VMEM ((bf16_t*)(ws + WS_VMEM))
#define XKIMG ((unsigned char*)(ws + WS_XKIMG))
#define XVIMG ((unsigned char*)(ws + WS_XVIMG))
#define LOGI ((float*)(ws + WS_LOG))
#define TOK ((int*)(ws + WS_TOK))
#define WSLOT ((float*)(ws + WS_WSLOT))
#define HID ((bf16_t*)(ws + WS_HID))
#define YS8 ((unsigned char*)(ws + WS_YS))
#define WIN ((bf16_t*)(ws + WS_WIN))
#define WOUT ((bf16_t*)(ws + WS_WOUT))
#define XWQ ((bf16_t*)(ws + WS_XWQ))
#define XWK ((bf16_t*)(ws + WS_XWK))
#define XWV ((bf16_t*)(ws + WS_XWV))
#define XWO ((bf16_t*)(ws + WS_XWO))
#define PW ((bf16_t*)(ws + WS_PW))
#define WQB ((bf16_t*)(ws + WS_WQB))
#define WKVB ((bf16_t*)(ws + WS_WKVB))
#define GLU ((bf16_t*)(ws + WS_GLU))
#define ROUT ((bf16_t*)(ws + WS_ROUT))
#define MOE1 ((bf16_t*)(ws + WS_MOE1))
#define MOE2 ((bf16_t*)(ws + WS_MOE2))
#define W1G ((bf16_t*)(ws + WS_W1G))
#define BTY ((bf16_t*)(ws + WS_BTY))
#define PARTO ((float*)(ws + WS_PARTO))
#define XB ((bf16_t*)(ws + WS_XB))
#define QXP ((float*)(ws + WS_QXP))
#define LOGP ((float*)(ws + WS_LOGP))
#define SSP ((float*)(ws + WS_SSP))
#define RMSV ((float*)(ws + WS_RMSV))
#define RMS1 ((float*)(ws + WS_RMS1))
#define XF8 ((unsigned char*)(ws + WS_XF8))
#define KCG ((float*)(ws + WS_H + 16 * MiB))
#define PQ7 ((bf16_t*)(ws + WS_H))
#define HID8 ((unsigned char*)(ws + WS_HID))
#define MOE1F ((unsigned char*)(ws + WS_MOE1))
#define MOE2F ((unsigned char*)(ws + WS_MOE2))
#define PARTML ((float*)(ws + WS_PARTML))
#define REC_E ((int*)(ws + WS_REC))
#define REC_R (REC_E + 2 * S)
#define REC_W ((float*)(REC_E + 4 * S))
#define REC_S (REC_E + 6 * S)
__device__ __forceinline__ unsigned long long ldp(const LAS unsigned* pt, int i) { unsigned lo = pt[2 * i], hi = pt[2 * i + 1]; lo = __builtin_amdgcn_readfirstlane(lo); hi = __builtin_amdgcn_readfirstlane(hi); return ((unsigned long long)hi << 32) | lo; }
#define INP(i) ((const float*)(const GAS float*)ldp(PT, (i)))
#define FRESH() int tid = (wave_s << 6) + (int)__builtin_amdgcn_mbcnt_hi(~0u, __builtin_amdgcn_mbcnt_lo(~0u, 0u)), G = gridDim.x, bid = blockIdx.x; unsigned lo_ = 0u; asm volatile("" : "+v"(tid), "+s"(G), "+s"(bid), "+s"(lo_)); LAS unsigned char* lds = lds0; const LAS unsigned* PT = (const LAS unsigned*)(lds0 + lo_ + LDSCTL_OFF + 512); volatile LAS unsigned* CTLW = (volatile LAS unsigned*)(lds0 + lo_ + LDSCTL_OFF); (void)CTLW; const int NGW = G * NWAVES; (void)NGW; const int lane = tid & 63, wave = __builtin_amdgcn_readfirstlane(tid >> 6), gw = bid * NWAVES + wave; unsigned char* ws = (unsigned char*)(GAS unsigned char*)ldp(PT, 50); float* out_ = (float*)(GAS float*)ldp(PT, 51); unsigned* ctl = (unsigned*)ws; (void)lane; (void)wave; (void)gw; (void)ws; (void)out_; (void)ctl
#if !MK_MULTI
#define GRID_BAR() do { XcdBarrier bar_; bar_.bar = ctl + CW_BAR; bar_.x = xb_xcc_id(); bar_.st = CTLW; xcd_barrier(bar_, tid); } while (0)
#else
#define GRID_BAR() do { } while (0)
#endif

#ifndef PROBE_REP
#define PROBE_REP 0u
#endif
#ifndef PHASE_MASK
#define PHASE_MASK 0xFFFFFFFFu
#endif
#define IN(k) ((((PHASE_MASK) >> (k)) & 1u) && ({ int a_ = ph_lo, b_ = ph_hi; asm volatile("" : "+s"(a_), "+s"(b_)); (a_ <= (k) && (k) < b_); }))
#define SEAM(k) do { if (IN((k) + 1) || ((k) == NPH - 1 && IN(0) && IN(NPH - 1))) GRID_BAR(); } while (0)


__device__ __forceinline__ void norm_groups(const LAS unsigned* PT, unsigned char* ws, const int l, const int s0, const int sstride, const int glo, const int ghi, const int lane) {
    const float* mg = INP(I_MIXG) + l * D;
    for (int s = s0; s < S; s += sstride) {
#pragma unroll
        for (int grp = 0; grp < 4; ++grp) { if (grp < glo || grp >= ghi) continue; bf16_t* p = O + (size_t)s * D + grp * 512 + 8 * lane; float x[8];
                    if (grp == 2 && s >= S / 2) {
                        const int h = lane >> 4, d0 = (lane & 15) * 8, qb = s >> 8, row = s & 255;
                        const size_t sa = ((size_t)(h * 32 + (qb - 32)) * 2 + 0) * 256 + row, sb = sa + 256;
                        const f32x2 mla = *(const f32x2*)(PARTML + sa * 2), mlb = *(const f32x2*)(PARTML + sb * 2);
                        const float mm = fmaxf(mla.x, mlb.x), fa = fast_exp2(mla.x - mm), fb = fast_exp2(mlb.x - mm), inv = fast_rcp(mla.y * fa + mlb.y * fb);
                        const f32x4 a0 = *(const f32x4*)(PARTO + sa * 128 + d0), a1 = *(const f32x4*)(PARTO + sa * 128 + d0 + 4), b0 = *(const f32x4*)(PARTO + sb * 128 + d0), b1 = *(const f32x4*)(PARTO + sb * 128 + d0 + 4);
#pragma unroll
                        for (int j = 0; j < 4; ++j) { x[j] = (a0[j] * fa + b0[j] * fb) * inv; x[4 + j] = (a1[j] * fa + b1[j] * fb) * inv; }
                    } else unpack8(*(const u32x4*)p, x);
                    float ss = 0.f;
#pragma unroll
                    for (int j = 0; j < 8; ++j) ss += x[j] * x[j];
                    const float rs = rsqrtf(wave_sum(ss) * (1.f / 512.f) + EPS); const float* gn = mg + grp * 512 + 8 * lane;
#pragma unroll
                    for (int j = 0; j < 8; ++j) x[j] = x[j] * rs * gn[j];
                    *(u32x4*)p = pack8(x); }
            }
}

template <int DUMMY> __device__ __forceinline__ void layer_body(const int l, const int wave_s, LAS unsigned char* lds0, const int ph_lo, const int ph_hi) {
        if (IN(0)) {
            FRESH();
            LAS float* scr = (LAS float*)(lds + wave * 16384);
            for (int rep_ = 0; rep_ < (int)(PROBE_REP & 1u) + 1; ++rep_) {
                const float* w_in = INP(I_WIN) + (size_t)l * D * INW; const float* w_out = INP(I_WOUT) + (size_t)l * D * D;
                const float* xwq = INP(I_XWQ) + (size_t)l * D * 512; const float* xwk = INP(I_XWK) + (size_t)l * D * 512; const float* xwv = INP(I_XWV) + (size_t)l * D * 512;
                const float* xwo = INP(I_XWO) + (size_t)l * 512 * D; const float* pww = INP(I_PWW) + (size_t)l * 512 * 512;
                const float* wqb = INP(I_WQB) + (size_t)l * 512 * 768; const float* wkvb = INP(I_WKVB) + (size_t)l * 256 * 1024; const float* gluw = INP(I_GLUW) + (size_t)l * 512 * 512;
                const float* mg = INP(I_MG) + (size_t)l * 32 * D * 512; const float* mu = INP(I_MU) + (size_t)l * 32 * D * 512; const float* md = INP(I_MD) + (size_t)l * 32 * 512 * D;
                const float* qag = INP(I_QAG) + l * 512; const float* kvag = INP(I_KVAG) + l * 256; const float* lnx = INP(I_LNX) + l * D; const float* lnmix = INP(I_LNMIX) + l * D; const float* lnm = INP(I_LNMOE) + l * D;
                constexpr int N_IN = 32 * 98, N_OUT = 32 * 64, N_XQ = 32 * 16, N_XO = 8 * 64, N_PW = 8 * 16, N_QB = 8 * 24, N_KVB = 4 * 32, N_GLU = 8 * 16, N_MG = 32 * 512, N_MD = 32 * 512;
                constexpr int NITEMS = N_IN + N_OUT + 3 * N_XQ + N_XO + N_PW + N_QB + N_KVB + N_GLU + 2 * N_MG + N_MD;
                for (int it = gw; it < NITEMS; it += NGW) {
                    int r = it;
                    if (r < N_MG) { const int e = r >> 9, rr = r & 511, kb = rr >> 4, nb = rr & 15, n0 = 32 * nb; tr_item8(mg + (size_t)e * D * 512, 512, 64 * kb, n0, MOE1F + (size_t)e * 1024 * D, D, (n0 >> 7) * 256 + (n0 & 127), lnm, scr, lane); continue; } r -= N_MG;
                    if (r < N_MG) { const int e = r >> 9, rr = r & 511, kb = rr >> 4, nb = rr & 15, n0 = 32 * nb; tr_item8(mu + (size_t)e * D * 512, 512, 64 * kb, n0, MOE1F + (size_t)e * 1024 * D, D, (n0 >> 7) * 256 + 128 + (n0 & 127), lnm, scr, lane); continue; } r -= N_MG;
                    if (r < N_MD) { const int e = r >> 9, rr = r & 511, kb = rr >> 6, nb = rr & 63; tr_item8(md + (size_t)e * 512 * D, D, 64 * kb, 32 * nb, MOE2F + (size_t)e * D * 512, 512, 32 * nb, nullptr, scr, lane); continue; } r -= N_MD;
                    if (r < N_IN) { const int kb = r / 98, nb = r % 98, n0 = 32 * nb, dr = (n0 < 448) ? n0 : (n0 < 512 ? 3072 + (n0 - 448) : n0 - 64); tr_item(w_in, INW, 64 * kb, n0, WIN, D, dr, lnmix, scr, lane); continue; } r -= N_IN;
                    if (r < N_OUT) { const int kb = r >> 6, nb = r & 63; tr_item(w_out, D, 64 * kb, 32 * nb, WOUT, D, 32 * nb, nullptr, scr, lane); continue; } r -= N_OUT;
                    if (r < N_XQ) { const int kb = r >> 4, nb = r & 15; tr_item(xwq, 512, 64 * kb, 32 * nb, XWQ, D, 32 * nb, lnx, scr, lane); continue; } r -= N_XQ;
                    if (r < N_XQ) { const int kb = r >> 4, nb = r & 15; tr_item(xwk, 512, 64 * kb, 32 * nb, XWK, D, 32 * nb, nullptr, scr, lane); continue; } r -= N_XQ;
                    if (r < N_XQ) { const int kb = r >> 4, nb = r & 15; tr_item(xwv, 512, 64 * kb, 32 * nb, XWV, D, 32 * nb, nullptr, scr, lane); continue; } r -= N_XQ;
                    if (r < N_XO) { const int kb = r >> 6, nb = r & 63; tr_item(xwo, D, 64 * kb, 32 * nb, XWO, 512, 32 * nb, nullptr, scr, lane); continue; } r -= N_XO;
                    if (r < N_PW) { const int kb = r >> 4, nb = r & 15; tr_item(pww, 512, 64 * kb, 32 * nb, PW, 512, 32 * nb, nullptr, scr, lane); continue; } r -= N_PW;
                    if (r < N_QB) { const int kb = r / 24, nb = r % 24; tr_item(wqb, 768, 64 * kb, 32 * nb, WQB, 512, 32 * nb, qag, scr, lane); continue; } r -= N_QB;
                    if (r < N_KVB) { const int kb = r >> 5, nb = r & 31; tr_item(wkvb, 1024, 64 * kb, 32 * nb, WKVB, 256, 32 * nb, kvag, scr, lane); continue; } r -= N_KVB;
                    { const int kb = r >> 4, nb = r & 15; tr_item(gluw, 512, 64 * kb, 32 * nb, GLU, 512, 32 * nb, nullptr, scr, lane); }
                }
                if (bid == 0 && tid < 256) { *(u32x4*)(XB + (size_t)S * D + 8 * tid) = (u32x4){0u, 0u, 0u, 0u}; *(u32x2*)(XF8 + (size_t)S * D + 8 * tid) = (u32x2){0u, 0u}; }
                for (int i = bid * NTHR + tid; i < (WINR - INW) * D / 8; i += G * NTHR) *(u32x4*)(WIN + (size_t)INW * D + (size_t)i * 8) = (u32x4){0u, 0u, 0u, 0u};
                const float* wgp = INP(I_WG) + (size_t)l * D * 4; const float* wep = INP(I_WE) + (size_t)l * D * 32;
                for (int i = bid * NTHR + tid; i < 256 * D / 2; i += G * NTHR) { const int n = i / (D / 2), k = (i % (D / 2)) * 2; float a = 0.f, b = 0.f;
                    if (n < 4) { a = wgp[(size_t)k * 4 + n] * lnm[k]; b = wgp[(size_t)(k + 1) * 4 + n] * lnm[k + 1]; } else if (n < 36) { a = wep[(size_t)k * 32 + n - 4] * lnm[k]; b = wep[(size_t)(k + 1) * 32 + n - 4] * lnm[k + 1]; }
                    *(unsigned*)(ROUT + (size_t)n * D + k) = cvt_pk_bf16(a, b); }
            }
            __syncthreads();
            for (int rep_ = 0; rep_ < (int)((PROBE_REP >> 19) & 1u) + 1; ++rep_)
            for (int task = bid; task < 256; task += G) {
                FRESH();
                const int g = task >> 3, part = task & 7;
                LAS f32x2* LP = (LAS f32x2*)lds;
                LAS f32x2* BB = (LAS f32x2*)(lds + 36864);
                LAS f32x2* CC = (LAS f32x2*)(lds + 45056);
                LAS float* KC = (LAS float*)(lds + 53248);
                const float* are = INP(I_ARE) + (size_t)(l * 32 + g) * 64; const float* aim = INP(I_AIM) + (size_t)(l * 32 + g) * 64;
                const float dt = __expf(INP(I_LOGDT)[l * 32 + g]);
                const float* bre = INP(I_BRE) + (size_t)(l * 32 + g) * 1024; const float* bim = INP(I_BIM) + (size_t)(l * 32 + g) * 1024;
                const float* cre = INP(I_CRE) + (size_t)(l * 32 + g) * 1024; const float* cim = INP(I_CIM) + (size_t)(l * 32 + g) * 1024;
                const float* dsk = INP(I_SSMD) + l * 512 + g * 16;
                if (tid < 64) { const int p = tid; float s, c; sincos_rev(aim[p] * dt, s, c); const float mag = fast_exp2(are[p] * dt * LOG2E); const f32x2 lb = (f32x2){mag * c, mag * s};
                    f32x2 cur = (f32x2){1.f, 0.f}; for (int j = 0; j <= 64; ++j) { LP[p * 65 + j] = cur; cur = cmul(cur, lb); } }
                for (int i = tid; i < 1024; i += NTHR) { const int p = i >> 4, ii = i & 15; float s, c; sincos_rev(aim[p] * dt, s, c); const float mag = fast_exp2(are[p] * dt * LOG2E);
                    const float nr = mag * c - 1.f, ni = mag * s, lr_ = are[p], li = aim[p], den = fast_rcp(lr_ * lr_ + li * li);
                    const f32x2 coef = (f32x2){(nr * lr_ + ni * li) * den, (ni * lr_ - nr * li) * den};
                    BB[p * 16 + ii] = cmul(coef, (f32x2){bre[p * 16 + ii], bim[p * 16 + ii]});
                    CC[i] = (f32x2){cre[i], cim[i]}; }
                __syncthreads();
                {   const int j = part * 8 + (tid >> 6), o = (tid >> 2) & 15, i0 = (tid & 3) * 4; float acc[4] = {0.f, 0.f, 0.f, 0.f};
                    for (int p = 0; p < 64; ++p) { const f32x2 u = cmul(CC[o * 64 + p], LP[p * 65 + j]);
#pragma unroll
                        for (int m = 0; m < 4; ++m) { const f32x2 bb = BB[p * 16 + i0 + m]; acc[m] += u.x * bb.x - u.y * bb.y; } }
#pragma unroll
                    for (int m = 0; m < 4; ++m) if (j == 0 && o == i0 + m) acc[m] += dsk[o];
                    *(f32x4*)(KCG + (size_t)g * 16384 + (j * 16 + o) * 16 + i0) = (f32x4){acc[0], acc[1], acc[2], acc[3]}; }
                for (int ch = tid; ch < 32 * 128; ch += NTHR) { const int n = part * 32 + ch / 128, kc = (ch % 128) * 8, tau = kc >> 4, i0 = kc & 15; float v[8];
                    if (n < 128) { const int p = n & 63; const f32x2 lp = LP[p * 65 + 63 - tau];
#pragma unroll
                        for (int j = 0; j < 8; ++j) { const f32x2 t2 = cmul(lp, BB[p * 16 + i0 + j]); v[j] = (n < 64) ? t2.x : t2.y; } }
                    else {
#pragma unroll
                        for (int j = 0; j < 8; ++j) v[j] = 0.f; }
                    *(u32x4*)(W1G + ((size_t)g * 256 + n) * 1024 + kc) = pack8(v); }
                __syncthreads();
            }
            if (l == 0) { FRESH(); for (int i = bid * NTHR + tid; i < S * 32; i += G * NTHR) { const int pos = i >> 5, f = i & 31; const float inv = fast_exp2(-(float)f * (13.287712379549449f / 32.0f));
                    double tr = (double)pos * (double)inv * 0.15915494309189535; tr -= rint(tr); const float rf = (float)tr;
                    ROPE[2 * i] = __builtin_amdgcn_cosf(rf); ROPE[2 * i + 1] = __builtin_amdgcn_sinf(rf); } }
            for (int rep3_ = (int)((PROBE_REP >> 21) & 1u); rep3_ >= 0; --rep3_)
            {   FRESH(); const float* xin = INP(I_X);
                for (int s = gw; s < S; s += NGW) { float x[4][8];
                    if (l == 0) {
#pragma unroll
                        for (int j = 0; j < 4; ++j) { const f32x4 a = *(const f32x4*)(xin + (size_t)s * D + 8 * lane + 512 * j), b = *(const f32x4*)(xin + (size_t)s * D + 8 * lane + 512 * j + 4);
                            x[j][0] = a[0]; x[j][1] = a[1]; x[j][2] = a[2]; x[j][3] = a[3]; x[j][4] = b[0]; x[j][5] = b[1]; x[j][6] = b[2]; x[j][7] = b[3]; } }
                    else { const int s0 = REC_S[2 * s], s1 = REC_S[2 * s + 1];
#pragma unroll
                        for (int j = 0; j < 4; ++j) { float ya[8], yb[8]; unpack8(*(const u32x4*)(XB + (size_t)s * D + 8 * lane + 512 * j), x[j]);
                            unpack8_fp8(*(const u32x2*)(YS8 + (size_t)s0 * D + 8 * lane + 512 * j), ya); unpack8_fp8(*(const u32x2*)(YS8 + (size_t)s1 * D + 8 * lane + 512 * j), yb);
#pragma unroll
                            for (int e = 0; e < 8; ++e) x[j][e] += (ya[e] + yb[e]) * 0.0625f; } }
                    float ss = 0.f;
#pragma unroll
                    for (int j = 0; j < 4; ++j)
#pragma unroll
                        for (int e = 0; e < 8; ++e) ss += x[j][e] * x[j][e];
                    ss = wave_sum(ss);
                    if (rep3_ == 0) {
#pragma unroll
                        for (int j = 0; j < 4; ++j) *(u32x4*)(XB + (size_t)s * D + 8 * lane + 512 * j) = pack8(x[j]);
                        if (lane == 0) RMS1[s] = rsqrtf(ss * (1.0f / D) + EPS); } }
                const float* mgain = INP(I_MEMG) + l * D; const float* mem = INP(I_MEM);
                for (int s = gw; s < MEMT; s += NGW) { f32x4 v[8];
#pragma unroll
                    for (int j = 0; j < 8; ++j) v[j] = *(const f32x4*)(mem + (size_t)s * D + 4 * lane + 256 * j);
                    rms_row_store(v, mgain, MEMN + (size_t)s * D, lane); }
            }
            SEAM(0);
        }
        if (IN(1)) for (int rep_ = 0; rep_ < (int)((PROBE_REP >> 1) & 1u) + 1; ++rep_) {
            FRESH();
            {
                for (int task = bid; task < 256; task += G) {
                    FRESH();
                    const int g = task >> 3, part = task & 7;
                    LAS f32x2* LP = (LAS f32x2*)lds;
                    LAS f32x2* CC = (LAS f32x2*)(lds + 45056);
                    LAS float* KC = (LAS float*)(lds + 53248);
                    const float* are = INP(I_ARE) + (size_t)(l * 32 + g) * 64; const float* aim = INP(I_AIM) + (size_t)(l * 32 + g) * 64;
                    const float dt = __expf(INP(I_LOGDT)[l * 32 + g]);
                    const float* cre = INP(I_CRE) + (size_t)(l * 32 + g) * 1024; const float* cim = INP(I_CIM) + (size_t)(l * 32 + g) * 1024;
                    if (tid < 64) { const int p = tid; float s_, c_; sincos_rev(aim[p] * dt, s_, c_); const float mag = fast_exp2(are[p] * dt * LOG2E); const f32x2 lb = (f32x2){mag * c_, mag * s_};
                        f32x2 cur = (f32x2){1.f, 0.f}; for (int j = 0; j <= 64; ++j) { LP[p * 65 + j] = cur; cur = cmul(cur, lb); } }
                    for (int i = tid; i < 1024; i += NTHR) CC[i] = (f32x2){cre[i], cim[i]};
#pragma unroll
                    for (int k_ = 0; k_ < 8; ++k_) { const int i = tid + k_ * NTHR; *(LAS f32x4*)(KC + 4 * i) = *(const f32x4*)(KCG + (size_t)g * 16384 + 4 * i); }
                    __syncthreads();
                    for (int ch = tid; ch < 128 * 160; ch += NTHR) { const int rr = part * 128 + ch / 160, kc = (ch % 160) * 8, t = rr >> 4, o = rr & 15; float v[8];
                        if (kc < 1024) { const int tau = kc >> 4, i0 = kc & 15;
#pragma unroll
                            for (int j = 0; j < 8; ++j) v[j] = (tau <= t) ? KC[((t - tau) * 16 + o) * 16 + i0 + j] : 0.f; }
                        else if (kc < 1152) { const bool im = kc >= 1088; const int p0 = (kc - (im ? 1088 : 1024));
#pragma unroll
                            for (int j = 0; j < 8; ++j) { const f32x2 t2 = cmul(CC[o * 64 + p0 + j], LP[(p0 + j) * 65 + t + 1]); v[j] = im ? -t2.y : t2.x; } }
                        else {
#pragma unroll
                            for (int j = 0; j < 8; ++j) v[j] = 0.f; }
                        *(u32x4*)(BTY + ((size_t)g * 1024 + rr) * 1280 + kc) = pack8(v); }
                    __syncthreads();
                } }
            __syncthreads();
            pg8::GSched Sd{(const char*)XB, (const char*)WIN, (size_t)256 * D * 2, (size_t)256 * D * 2, 0, 0, S / 256, 12, 1, G, bid};
            pg8::EpiBf16 E{P, INWP, 0, nullptr, RMS1};
            for (int r2_ = 0; r2_ < (int)((PROBE_REP >> 23) & 1u) + 1; ++r2_)
            pg8::gemm_phase<pg8::EpiBf16, pg8::GSched>(tid, lds, D, D, D, nullptr, Sd, E);
            for (int r3_ = 0; r3_ < (int)((PROBE_REP >> 22) & 1u) * 4 + 1; ++r3_)
            {
                pg8::GSched St{(const char*)XB, (const char*)(WIN + (size_t)3072 * D), (size_t)256 * D * 2, 0, (size_t)512 * 2, (size_t)512 * 2, S / 256, 1, 4, G, bid};
                pg8::EpiBf16Part64 Et{PQ7, (size_t)S * 64, RMS1};
                pg8::gemm_phase<pg8::EpiBf16Part64, pg8::GSched>(tid, lds, 512, D, D, nullptr, St, Et); }
            SEAM(1);
        }
        if (IN(2)) for (int rep_ = 0; rep_ < (int)((PROBE_REP >> 2) & 1u) + 1; ++rep_) {
            FRESH();
            {   pg8::GSched Sd{(const char*)(P + P_CQ), (const char*)WQB, (size_t)256 * INWP * 2, (size_t)256 * 512 * 2, 0, 0, S / 256, 3, 1, G, bid};
                pg8::EpiBf16 E{QRAW, 768, 0, nullptr, nullptr};
                pg8::gemm_phase<pg8::EpiBf16, pg8::GSched>(tid, lds, 512, INWP, 512, nullptr, Sd, E); }
            {   FRESH(); pg8::GSched Sd{(const char*)(P + P_CKV), (const char*)WKVB, (size_t)256 * INWP * 2, (size_t)256 * 256 * 2, 0, 0, S / 256, 4, 1, G, bid};
                pg8::EpiBf16 E{KVRAW, 1024, 0, nullptr, nullptr};
                pg8::gemm_phase<pg8::EpiBf16, pg8::GSched>(tid, lds, 256, INWP, 256, nullptr, Sd, E); }
            __syncthreads();
            for (int rep2_ = 0; rep2_ < (int)((PROBE_REP >> 20) & 1u) + 1; ++rep2_)
            for (int tile = bid; tile < S / 64; tile += G) {
                FRESH();
                const int t0 = tile * 64;
                LAS bf16_t* Z = (LAS bf16_t*)lds;
                LAS bf16_t* DW = (LAS bf16_t*)(lds + 98304);
                const float* dww = INP(I_DWW) + (size_t)l * 31 * 512;
#pragma unroll
                for (int i0_ = 0; i0_ < 12; ++i0_) { const int i = tid + i0_ * NTHR; if (i >= 94 * 64) break; const int rr = i >> 6, c8 = (i & 63) * 8, s = t0 - 30 + rr; float z[8];
                    if (s >= 0) { const u32x4 aw = *(const u32x4*)(P + (size_t)s * INWP + P_BA + c8), gw4 = *(const u32x4*)(P + (size_t)s * INWP + P_BG + c8); float a[8], g[8]; unpack8(aw, a); unpack8(gw4, g);
#pragma unroll
                        for (int j = 0; j < 8; ++j) z[j] = a[j] * sigmoidf_(g[j]); }
                    else {
#pragma unroll
                        for (int j = 0; j < 8; ++j) z[j] = 0.f; }
                    *(LAS u32x4*)(Z + rr * 512 + c8) = pack8(z); }
                for (int i = tid; i < 31 * 64; i += NTHR) { const int w = i >> 6, c8 = (i & 63) * 8; float v[8];
#pragma unroll
                    for (int j = 0; j < 8; ++j) v[j] = dww[w * 512 + c8 + j];
                    *(LAS u32x4*)(DW + w * 512 + c8) = pack8(v); }
                __syncthreads();
                {   const int c8 = lane * 8; const float* dwb = INP(I_DWB) + l * 512 + c8; const float* lg = INP(I_CLNG) + l * 512 + c8; const float* lb = INP(I_CLNB) + l * 512 + c8;
                    for (int g4 = 0; g4 < 2; ++g4) {
                        const int tb = wave * 8 + 4 * g4; float a4[4][8], zw[4][8];
#pragma unroll
                        for (int q = 0; q < 4; ++q)
#pragma unroll
                            for (int j = 0; j < 8; ++j) a4[q][j] = dwb[j];
#pragma unroll
                        for (int q = 0; q < 3; ++q) unpack8(*(const LAS u32x4*)(Z + (tb + q) * 512 + c8), zw[q]);
#pragma unroll 1
                        for (int w0 = 0; w0 < 32; w0 += 4) {
#pragma unroll
                            for (int i = 0; i < 4; ++i) { const int w = w0 + i; if (w < 31) { float k[8]; unpack8(*(const LAS u32x4*)(Z + (tb + 3 + w) * 512 + c8), zw[(i + 3) & 3]); unpack8(*(const LAS u32x4*)(DW + w * 512 + c8), k);
#pragma unroll
                                for (int q = 0; q < 4; ++q)
#pragma unroll
                                    for (int j = 0; j < 8; ++j) a4[q][j] += zw[(i + q) & 3][j] * k[j]; } } }
#pragma unroll
                    for (int q = 0; q < 4; ++q) { const int tau = tb + q; float acc[8];
#pragma unroll
                        for (int j = 0; j < 8; ++j) acc[j] = a4[q][j];
                        float sm = 0.f;
#pragma unroll
                        for (int j = 0; j < 8; ++j) sm += acc[j];
                        const float mean = wave_sum(sm) * (1.f / 512.f); float sq = 0.f;
#pragma unroll
                        for (int j = 0; j < 8; ++j) { acc[j] -= mean; sq += acc[j] * acc[j]; }
                        const float rstd = rsqrtf(wave_sum(sq) * (1.f / 512.f) + EPS); float y[8];
#pragma unroll
                        for (int j = 0; j < 8; ++j) { const float v = acc[j] * rstd * lg[j] + lb[j]; y[j] = v * sigmoidf_(v); }
                        *(u32x4*)(ZC + (size_t)(t0 + tau) * 512 + c8) = pack8(y); } } }
                __syncthreads();
                { u32x4 tmp_[8];
#pragma unroll
                for (int k_ = 0; k_ < 8; ++k_) { const int i = tid + k_ * NTHR; const int half = i & 1, g = (i >> 1) & 31, tau = i >> 6; tmp_[k_] = *(const u32x4*)(P + (size_t)(t0 + tau) * INWP + P_DU + g * 16 + 8 * half); }
#pragma unroll
                for (int k_ = 0; k_ < 8; ++k_) { const int i = tid + k_ * NTHR; const int half = i & 1, g = (i >> 1) & 31, tau = i >> 6;
                    *(u32x4*)(UA + ((size_t)g * 256 + tile) * 1280 + tau * 16 + 8 * half) = tmp_[k_]; } }
                { const int g = tid >> 4, c = tid & 15; *(u32x4*)(UA + ((size_t)g * 256 + tile) * 1280 + 1152 + 8 * c) = (u32x4){0u, 0u, 0u, 0u}; }
                {   LAS bf16_t* vt = (LAS bf16_t*)(lds + wave * 1024);
                    const int j = lane >> 3, c = lane & 7, r = wave * 8 + j, s = t0 + r; const float* kg = INP(I_SWAKG) + l * 64 + 8 * c;
                    for (int kh = 0; kh < 2; ++kh) {
                        float x[8]; unpack8(*(const u32x4*)(P + (size_t)s * INWP + P_AK + kh * 64 + 8 * c), x); float ss = 0.f;
#pragma unroll
                        for (int e = 0; e < 8; ++e) ss += x[e] * x[e];
                        ss += __shfl_xor(ss, 1); ss += __shfl_xor(ss, 2); ss += __shfl_xor(ss, 4);
                        const float rs = rsqrtf(ss * (1.f / 64.f) + EPS);
#pragma unroll
                        for (int e = 0; e < 8; ++e) x[e] = x[e] * rs * kg[e];
                        *(u32x4*)(SWAK + ((size_t)kh * 256 + tile) * 8192 + r * 128 + kswz<128>(r, c) * 16) = pack8(x);
                        *(LAS u32x4*)(vt + j * 64 + 8 * c) = *(const u32x4*)(P + (size_t)s * INWP + P_AV + kh * 64 + 8 * c);
                        LDS_WAIT();
                        { const int d = lane; float v[8];
#pragma unroll
                            for (int jj = 0; jj < 8; ++jj) v[jj] = bf2f(vt[jj * 64 + d]);
                            *(u32x4*)(SWAV + ((size_t)kh * 256 + tile) * 8192 + d * 128 + vswz(d, wave) * 16) = pack8(v); }
                        LDS_WAIT();
                    } }
                __syncthreads();
            }
            SEAM(2);
        }
        if (IN(3)) for (int rep_ = 0; rep_ < (int)((PROBE_REP >> 3) & 1u) + 1; ++rep_) {
            FRESH();
            {   pg8::GSched Sd{(const char*)ZC, (const char*)PW, (size_t)256 * 512 * 2, (size_t)256 * 512 * 2, 0, 0, S / 256, 2, 1, G, (bid + G / 2) % G};
                pg8::EpiBf16 E{O, D, 512, INP(I_PWB) + l * 512, nullptr};
                pg8::gemm_phase<pg8::EpiBf16, pg8::GSched>(tid, lds, 512, 512, 512, nullptr, Sd, E); }
            {   pg8::GSched Sd{(const char*)UA, (const char*)W1G, 0, 0, (size_t)256 * 1280 * 2, (size_t)256 * 1024 * 2, 1, 1, 32, G, (bid + 128) % G};
                pg8::EpiF32Part<128> E{EBUF, 128, (size_t)256 * 128};
                pg8::gemm_phase<pg8::EpiF32Part<128>, pg8::GSched>(tid, lds, 1024, 1280, 1024, nullptr, Sd, E); }
            {   FRESH(); pg8::MemSched Sm{(const char*)MEMN, (const char*)XWK, G, (bid + G - 160) % G};
                pg8::EpiMem Em{KMEM, VMEM};
                pg8::gemm_phase<pg8::EpiMem, pg8::MemSched>(tid, lds, 512, D, D, nullptr, Sm, Em); }
            __syncthreads();
            for (int tile = bid; tile < S / 64; tile += G) {
                FRESH();
                const int t0 = tile * 64; constexpr float QSCALE = 0.07216878364870322f * LOG2E;
                LAS bf16_t* vt = (LAS bf16_t*)(lds + wave * 8192);
                const float* qnn = INP(I_QNN) + l * 128; const float* qnr = INP(I_QNR) + l * 64; const float* knn = INP(I_KNN) + l * 128; const float* knr = INP(I_KNR) + l * 64;
                for (int j2 = 0; j2 < 8; j2 += 2) {
                    u32x2 wkv_[2]; float xkr_[2], cs_[2], sn_[2]; unsigned wqn_[2][4], wkn_[2][4], wv_[2][4]; float xqr_[2][4];
#pragma unroll
                    for (int u = 0; u < 2; ++u) { const int s = t0 + wave * 8 + j2 + u;
                        wkv_[u] = *(const u32x2*)(P + (size_t)s * INWP + P_CKV + 4 * lane);
                        xkr_[u] = bf2f(P[(size_t)s * INWP + P_CKR + lane]);
                        cs_[u] = ROPE[((size_t)s * 32 + (lane & 31)) * 2]; sn_[u] = ROPE[((size_t)s * 32 + (lane & 31)) * 2 + 1];
#pragma unroll
                        for (int h = 0; h < 4; ++h) { wqn_[u][h] = *(const unsigned*)(QRAW + (size_t)s * 768 + h * 192 + 2 * lane); xqr_[u][h] = bf2f(QRAW[(size_t)s * 768 + h * 192 + 128 + lane]);
                            wkn_[u][h] = *(const unsigned*)(KVRAW + (size_t)s * 1024 + h * 256 + 2 * lane); wv_[u][h] = *(const unsigned*)(KVRAW + (size_t)s * 1024 + h * 256 + 128 + 2 * lane); } }
#pragma unroll
                    for (int u = 0; u < 2; ++u) {
                    const int j = j2 + u, r = wave * 8 + j, s = t0 + r;
                    const u32x2 wkv = wkv_[u]; const float xkr = xkr_[u], cs = cs_[u], sn = sn_[u];
                    unsigned wqn[4], wkn[4], wv[4]; float xqr[4];
#pragma unroll
                    for (int h = 0; h < 4; ++h) { wqn[h] = wqn_[u][h]; wkn[h] = wkn_[u][h]; wv[h] = wv_[u][h]; xqr[h] = xqr_[u][h]; }
                    float ps[14];
                    { const float a = bf2f(wkv.x & 0xffffu), b = bf2f(wkv.x >> 16), c = bf2f(wkv.y & 0xffffu), d = bf2f(wkv.y >> 16); ps[0] = a * a + b * b + c * c + d * d; }
                    ps[1] = xkr * xkr;
#pragma unroll
                    for (int h = 0; h < 4; ++h) { const float a = bf2f(wqn[h] & 0xffffu), b = bf2f(wqn[h] >> 16), c = bf2f(wkn[h] & 0xffffu), d = bf2f(wkn[h] >> 16);
                        ps[2 + 3 * h] = a * a + b * b; ps[3 + 3 * h] = xqr[h] * xqr[h]; ps[4 + 3 * h] = c * c + d * d; }
#pragma unroll
                    for (int o = 1; o < 64; o <<= 1)
#pragma unroll
                        for (int k = 0; k < 14; ++k) ps[k] += __shfl_xor(ps[k], o);
                    const float rkv = rsqrtf(ps[0] * (1.f / 256.f) + EPS);
                    float kr; { const float y = xkr * rsqrtf(ps[1] * (1.f / 64.f) + EPS) * knr[lane]; const float pr = __shfl_xor(y, 32);
                        kr = (lane < 32) ? (y * cs - pr * sn) : (pr * sn + y * cs); }
#pragma unroll
                    for (int h = 0; h < 4; ++h) {
                        { const float a = bf2f(wqn[h] & 0xffffu), b = bf2f(wqn[h] >> 16);
                          const float rs = rsqrtf(ps[2 + 3 * h] * (1.f / 128.f) + EPS);
                          *(unsigned short*)((unsigned char*)Q + ((size_t)h * S + s) * 192 + f8pos(2 * lane)) = (unsigned short)(pk4_fp8(a * rs * qnn[2 * lane], b * rs * qnn[2 * lane + 1], 0.f, 0.f) & 0xffffu); }
                        { const float y = xqr[h] * rsqrtf(ps[3 + 3 * h] * (1.f / 64.f) + EPS) * qnr[lane]; const float pr = __shfl_xor(y, 32);
                          const float qr = ((lane < 32) ? (y * cs - pr * sn) : (pr * sn + y * cs));
                          ((unsigned char*)Q)[((size_t)h * S + s) * 192 + f8pos(128 + lane)] = (unsigned char)(pk4_fp8(qr, 0.f, 0.f, 0.f) & 0xffu); }
                        { const float a = bf2f(wkn[h] & 0xffffu), b = bf2f(wkn[h] >> 16);
                          const float rs = rsqrtf(ps[4 + 3 * h] * (1.f / 128.f) + EPS);
                          unsigned char* kimg = KIMG + ((size_t)h * 256 + tile) * 12288 + r * 192; const int pn_ = f8pos(2 * lane), pr_ = f8pos(128 + lane), sw_ = (r >> 2) & 3;
                          *(unsigned short*)(kimg + (((pn_ >> 4) ^ sw_) << 4) + (pn_ & 15)) = (unsigned short)(pk4_fp8(a * rs * knn[2 * lane], b * rs * knn[2 * lane + 1], 0.f, 0.f) & 0xffffu);
                          kimg[(((pr_ >> 4) ^ sw_) << 4) + (pr_ & 15)] = (unsigned char)(pk4_fp8(kr, 0.f, 0.f, 0.f) & 0xffu); }
                        *(LAS unsigned short*)((LAS unsigned char*)vt + (h * 8 + j) * 128 + 2 * lane) = (unsigned short)(pk4_fp8(bf2f(wv[h] & 0xffffu) * rkv, bf2f(wv[h] >> 16) * rkv, 0.f, 0.f) & 0xffffu);
                    }
                                    }
                }
                LDS_WAIT();
                for (int h = 0; h < 4; ++h)
                    for (int dd = 0; dd < 2; ++dd) { const int d = lane + 64 * dd; const LAS unsigned char* v8 = (const LAS unsigned char*)vt; unsigned lo = 0u, hi4 = 0u;
#pragma unroll
                        for (int jj = 0; jj < 4; ++jj) { lo |= (unsigned)v8[(h * 8 + jj) * 128 + d] << (8 * jj); hi4 |= (unsigned)v8[(h * 8 + 4 + jj) * 128 + d] << (8 * jj); }
                        const int off_ = 32 * (wave >> 2) + 8 * (((wave & 1) << 1) | ((wave >> 1) & 1));
                        *(u32x2*)(VIMG + ((size_t)h * 256 + tile) * 8192 + d * 64 + ((((off_ >> 4) ^ ((d >> 2) & 3))) << 4) + (off_ & 15)) = (u32x2){lo, hi4}; }
                LDS_WAIT();
            }
            __syncthreads();
            __syncthreads();
            {   FRESH(); LAS float* tab = (LAS float*)(lds + 98304);
                const float* relb = INP(I_RELB);
                for (int i = tid; i < 1024; i += NTHR) { const int h = i >> 7, dist = i & 127; tab[i] = relb[T5_BUCKET[dist] * 8 + h] * LOG2E; }
                __syncthreads();
                const int lr = lane & 31, hi = lane >> 5;
                for (int it = bid; it < 128; it += G) {
                    const int kh = it & 1, qb = it >> 1, q0 = qb * 256, wq0 = q0 + 32 * wave, qpos = wq0 + lr;
                    const int t_lo = (4 * qb - 2) < 0 ? 0 : (4 * qb - 2), t_hi = 4 * qb + 4;
                    __syncthreads();
                    for (int t = t_lo; t < t_hi; ++t) { dma_tile<8192>(SWAK + ((size_t)kh * 256 + t) * 8192, lds + (t - t_lo) * 16384, tid, wave); dma_tile<8192>(SWAV + ((size_t)kh * 256 + t) * 8192, lds + (t - t_lo) * 16384 + 8192, tid, wave); }
                    VM_WAIT(); __syncthreads();
#pragma unroll 1
                    for (int g = 0; g < 4; ++g) { const int h = 4 * kh + g;
                        bf16x8 qf[4];
                        if (h < 7) load_q_norm<64>(P + (size_t)qpos * INWP + P_AQ + h * 64, INP(I_SWAQG) + l * 64, 0.125f * LOG2E, hi, qf);
                        else load_q_norm_bf16x4<64>(PQ7 + (size_t)qpos * 64, (size_t)S * 64, INP(I_SWAQG) + l * 64, 0.125f * LOG2E, hi, qf);
                        f32x16 o[2];
#pragma unroll
                        for (int db = 0; db < 2; ++db)
#pragma unroll
                            for (int r = 0; r < 16; ++r) o[db][r] = 0.f;
                        float m_run = -1e30f, l_run = 0.f;
#pragma unroll 1
                        for (int t = t_lo; t < t_hi; ++t) { const int k0 = t * 64;
                            if ((k0 <= wq0 + 31) && (k0 + 63 >= wq0 - 127)) attn_tile_compute<64, 64, 1>(lds + (t - t_lo) * 16384, lds + (t - t_lo) * 16384 + 8192, k0, true, qf, qpos, tab + h * 128, lr, hi, o, m_run, l_run); }
                        { auto rr = __builtin_amdgcn_permlane32_swap(__float_as_uint(l_run), __float_as_uint(l_run), false, false); l_run = __uint_as_float(rr[0]) + __uint_as_float(rr[1]); }
                        l_run += fast_exp2(INP(I_SINK)[l * 8 + h] * LOG2E - m_run);
                        store_o<64>(O + (size_t)qpos * D + h * 64, o, fast_rcp(l_run), hi);
                    }
                }
            }
            SEAM(3);
        }
        if (IN(4)) for (int rep_ = 0; rep_ < (int)((PROBE_REP >> 4) & 1u) + 1; ++rep_) {
            FRESH();
            for (int task = bid; task < 64; task += G) {
                FRESH();
                LAS f32x2* SE = (LAS f32x2*)lds;
                const int sl = tid & 31, seg = tid >> 5, st = task * 32 + sl, g = st >> 6, p = st & 63;
                const float dt = __expf(INP(I_LOGDT)[l * 32 + g]); const float are = INP(I_ARE)[(size_t)(l * 32 + g) * 64 + p], aim = INP(I_AIM)[(size_t)(l * 32 + g) * 64 + p];
                float s_, c_; sincos_rev(aim * dt, s_, c_); const float mag = fast_exp2(are * dt * LOG2E); f32x2 lt = (f32x2){mag * c_, mag * s_};
#pragma unroll
                for (int k = 0; k < 6; ++k) lt = cmul(lt, lt);
                f32x2 e[16];
#pragma unroll
                for (int k = 0; k < 16; ++k) { const size_t off = ((size_t)g * 256 + seg * 16 + k) * 128 + p; e[k] = (f32x2){EBUF[off], EBUF[off + 64]}; }
                f32x2 acc = (f32x2){0.f, 0.f};
#pragma unroll
                for (int k = 0; k < 16; ++k) { const f32x2 t = cmul(lt, acc); acc = (f32x2){t.x + e[k].x, t.y + e[k].y}; }
                SE[sl * 16 + seg] = acc;
                f32x2 l16 = lt;
#pragma unroll
                for (int k = 0; k < 4; ++k) l16 = cmul(l16, l16);
                __syncthreads();
                f32x2 carry = (f32x2){0.f, 0.f};
                for (int k = 0; k < seg; ++k) { const f32x2 t = cmul(l16, carry); const f32x2 se = SE[sl * 16 + k]; carry = (f32x2){t.x + se.x, t.y + se.y}; }
#pragma unroll
                for (int k = 0; k < 16; ++k) { const int c = seg * 16 + k; bf16_t* dst = UA + ((size_t)g * 256 + c) * 1280 + 1024 + p;
                    dst[0] = (bf16_t)(cvt_pk_bf16(carry.x, 0.f) & 0xffffu); dst[64] = (bf16_t)(cvt_pk_bf16(carry.y, 0.f) & 0xffffu);
                    const f32x2 t = cmul(lt, carry); carry = (f32x2){t.x + e[k].x, t.y + e[k].y}; }
                __syncthreads();
            }
            {   FRESH(); const int lr = lane & 31, hi = lane >> 5;
                for (int it = bid; it < 256; it += G) {
                    const int xcd_ = it & 7, il_ = ((xcd_ & 1) << 5) | (it >> 3), h = xcd_ >> 1, j = il_ >> 1, part = il_ & 1;
                    for (int sub = 0; sub <= part; ++sub) {
                        const bool fin = (sub == 1);
                        const int qb = fin ? j : 63 - j;
                        const int t_lo = fin ? 0 : (part ? 130 : 0), t_hi = fin ? 4 * j + 4 : (part ? 4 * (64 - j) : 130);
                        const int q0 = qb * 256, wq0 = q0 + 32 * wave, qpos = wq0 + lr;
                        i64x2 qf[6];
#pragma unroll
                        for (int m = 0; m < 6; ++m) qf[m] = *(const i64x2*)((const unsigned char*)Q + ((size_t)h * S + qpos) * 192 + 32 * m + 16 * hi);
                        f32x16 o[4];
#pragma unroll
                        for (int db = 0; db < 4; ++db)
#pragma unroll
                            for (int r = 0; r < 16; ++r) o[db][r] = 0.f;
                        float m_run = -1e30f, l_run = 0.f;
                        attn_mla_f8(tid, lds, KIMG + (size_t)h * 256 * 12288, VIMG + (size_t)h * 256 * 8192, t_lo, t_hi, qf, qpos, wq0, o, m_run, l_run);
                        { auto rr = __builtin_amdgcn_permlane32_swap(__float_as_uint(l_run), __float_as_uint(l_run), false, false); l_run = __uint_as_float(rr[0]) + __uint_as_float(rr[1]); }
                        int tz = tid; asm volatile("" : "+v"(tz));
                        const int lr2 = tz & 31, hi2 = (tz >> 5) & 1, row2 = q0 + (tz >> 6) * 32 + lr2;
                        if (fin) store_o<128>(O + (size_t)row2 * D + 1024 + h * 128, o, fast_rcp(l_run), hi2);
                        else {
                            const size_t slot = ((size_t)(h * 32 + (qb - 32)) * 2 + part) * 256 + (tz >> 6) * 32 + lr2;
                            float* po = PARTO + slot * 128;
#pragma unroll
                            for (int db = 0; db < 4; ++db)
#pragma unroll
                                for (int r4 = 0; r4 < 4; ++r4) *(f32x4*)(po + 32 * db + 8 * r4 + 4 * hi2) = (f32x4){o[db][4 * r4], o[db][4 * r4 + 1], o[db][4 * r4 + 2], o[db][4 * r4 + 3]};
                            if (hi2 == 0) *(f32x2*)(PARTML + slot * 2) = (f32x2){m_run, l_run};
                        }
                    }
                }
            }
            SEAM(4);
        }
        if (IN(5)) for (int rep_ = 0; rep_ < (int)((PROBE_REP >> 5) & 1u) + 1; ++rep_) {
            FRESH();
            pg8::GSched Sd{(const char*)UA, (const char*)BTY, 0, (size_t)256 * 1280 * 2, (size_t)256 * 1280 * 2, (size_t)1024 * 1280 * 2, 1, 4, 32, G, bid};
            pg8::EpiSsmY E{YG};
            pg8::gemm_phase<pg8::EpiSsmY, pg8::GSched>(tid, lds, 1280, 1280, 1280, nullptr, Sd, E);
            if (G == 256 && bid >= 128) { FRESH(); norm_groups(PT, ws, l, (bid - 128) * NWAVES + wave, 128 * NWAVES, 0, 3, lane); }
            SEAM(5);
        }
        if (IN(6)) for (int rep_ = 0; rep_ < (int)((PROBE_REP >> 6) & 1u) + 1; ++rep_) {
            FRESH();
            pg8::GSched Sd{(const char*)YG, (const char*)GLU, (size_t)256 * 512 * 2, (size_t)256 * 512 * 2, 0, 0, S / 256, 2, 1, G, bid};
            pg8::EpiGlu E{YG, INP(I_GLUB) + l * 512, O};
            pg8::gemm_phase<pg8::EpiGlu, pg8::GSched>(tid, lds, 512, 512, 512, nullptr, Sd, E);
            __syncthreads();
            for (int it = (bid + 32) % G; it < 32; it += G) {
                FRESH();
                const int tile = it >> 3, w8 = it & 7, r = w8 * 8 + wave, mrow = tile * 64 + r;
                LAS bf16_t* vt = (LAS bf16_t*)lds; const float* kg = INP(I_XKG) + l * 128;
                unsigned wk[4]; float ps[4];
#pragma unroll
                for (int h = 0; h < 4; ++h) { float a = 0.f, b = 0.f, va = 0.f, vb = 0.f;
#pragma unroll
                    for (int z = 0; z < 4; ++z) { const unsigned k2 = *(const unsigned*)(KMEM + (size_t)z * 256 * 512 + (size_t)mrow * 512 + h * 128 + 2 * lane), v2 = *(const unsigned*)(VMEM + (size_t)z * 256 * 512 + (size_t)mrow * 512 + h * 128 + 2 * lane);
                        a += bf2f(k2 & 0xffffu); b += bf2f(k2 >> 16); va += bf2f(v2 & 0xffffu); vb += bf2f(v2 >> 16); }
                    wk[h] = cvt_pk_bf16(a, b); a = bf2f(wk[h] & 0xffffu); b = bf2f(wk[h] >> 16); ps[h] = a * a + b * b;
                    *(LAS unsigned*)(vt + (h * 8 + wave) * 128 + 2 * lane) = cvt_pk_bf16(va, vb); }
#pragma unroll
                for (int o = 1; o < 64; o <<= 1)
#pragma unroll
                    for (int h = 0; h < 4; ++h) ps[h] += __shfl_xor(ps[h], o);
#pragma unroll
                for (int h = 0; h < 4; ++h) { const float a = bf2f(wk[h] & 0xffffu), b = bf2f(wk[h] >> 16), rs = rsqrtf(ps[h] * (1.f / 128.f) + EPS);
                    *(unsigned*)(XKIMG + ((size_t)h * 4 + tile) * 16384 + r * 256 + kswz<256>(r, lane >> 2) * 16 + (lane & 3) * 4) = cvt_pk_bf16(a * rs * kg[2 * lane], b * rs * kg[2 * lane + 1]); }
                __syncthreads();
                {   const int h = tid >> 7, d = tid & 127; float v[8];
#pragma unroll
                    for (int jj = 0; jj < 8; ++jj) v[jj] = bf2f(vt[(h * 8 + jj) * 128 + d]);
                    *(u32x4*)(XVIMG + ((size_t)h * 4 + tile) * 16384 + d * 128 + vswz(d, w8) * 16) = pack8(v); }
                __syncthreads();
            }
            SEAM(6);
        }
        if (IN(7)) for (int rep_ = 0; rep_ < (int)((PROBE_REP >> 7) & 1u) + 1; ++rep_) {
            FRESH();
            norm_groups(PT, ws, l, gw, NGW, (G == 256) ? 3 : 0, 4, lane);
            SEAM(7);
        }
        if (IN(8)) for (int rep_ = 0; rep_ < (int)((PROBE_REP >> 8) & 1u) + 1; ++rep_) {
            FRESH();
            pg8::GSched Sd{(const char*)O, (const char*)WOUT, (size_t)256 * D * 2, (size_t)256 * D * 2, 0, 0, S / 256, D / 256, 1, G, bid};
            pg8::EpiResid E{XB, D, nullptr, (((PROBE_REP >> 8) & 1u) != 0u) && rep_ == 0, nullptr};
            pg8::gemm_phase<pg8::EpiResid, pg8::GSched>(tid, lds, D, D, D, nullptr, Sd, E);
            SEAM(8);
        }
        if (IN(10)) for (int rep_ = 0; rep_ < (int)((PROBE_REP >> 10) & 1u) + 1; ++rep_) {
            FRESH();
            pg8::GSched Sd{(const char*)XB, (const char*)XWQ, (size_t)256 * D * 2, (size_t)256 * D * 2, (size_t)1024 * 2, (size_t)1024 * 2, S / 256, 2, 2, G, bid};
            pg8::EpiBf16Z E{(bf16_t*)QXP, 512, (size_t)S * 512};
            pg8::gemm_phase<pg8::EpiBf16Z, pg8::GSched>(tid, lds, 1024, D, D, nullptr, Sd, E);
            SEAM(10);
        }
        if (IN(11)) for (int rep_ = 0; rep_ < (int)((PROBE_REP >> 11) & 1u) + 1; ++rep_) {
            FRESH();
            const int lr = lane & 31, hi = lane >> 5;
            for (int it = bid; it < 256; it += G) {
                const int h = it & 3, qb = it >> 2, wq0 = qb * 256 + 32 * wave, qpos = wq0 + lr;
                bf16x8 qf[8]; load_q_norm_bf16x2<128>((const bf16_t*)QXP + (size_t)qpos * 512 + h * 128, (const bf16_t*)QXP + (size_t)S * 512 + (size_t)qpos * 512 + h * 128, INP(I_XQG) + l * 128, 0.08838834764831845f * LOG2E, hi, qf);
                f32x16 o[4];
#pragma unroll
                for (int db = 0; db < 4; ++db)
#pragma unroll
                    for (int r = 0; r < 16; ++r) o[db][r] = 0.f;
                float m_run = -1e30f, l_run = 0.f;
                attn_tiles<128, 128, 2>(tid, lds, XKIMG + (size_t)h * 4 * 16384, XVIMG + (size_t)h * 4 * 16384, 0, 4, qf, qpos, wq0, nullptr, o, m_run, l_run);
                { auto rr = __builtin_amdgcn_permlane32_swap(__float_as_uint(l_run), __float_as_uint(l_run), false, false); l_run = __uint_as_float(rr[0]) + __uint_as_float(rr[1]); }
                store_o<128>(OX + (size_t)qpos * 512 + h * 128, o, fast_rcp(l_run), hi);
            }
            SEAM(11);
        }
        if (IN(12)) for (int rep_ = 0; rep_ < (int)((PROBE_REP >> 12) & 1u) + 1; ++rep_) {
            FRESH();
            pg8::GSched Sd{(const char*)OX, (const char*)XWO, (size_t)256 * 512 * 2, (size_t)256 * 512 * 2, 0, 0, S / 256, D / 256, 1, G, bid};
            pg8::EpiResid E{XB, D, SSP, (((PROBE_REP >> 12) & 1u) != 0u) && rep_ == 0, XF8};
            pg8::gemm_phase<pg8::EpiResid, pg8::GSched>(tid, lds, 512, 512, 512, nullptr, Sd, E);
            SEAM(12);
        }
        if (IN(14)) for (int rep_ = 0; rep_ < (int)((PROBE_REP >> 14) & 1u) + 1; ++rep_) {
            FRESH();
            pg8::GSched Sd{(const char*)XB, (const char*)ROUT, (size_t)256 * D * 2, 0, (size_t)512 * 2, (size_t)512 * 2, S / 256, 1, 4, G, bid};
            pg8::EpiF32Part<64> E{LOGP, 64, (size_t)S * 64};
            pg8::gemm_phase<pg8::EpiF32Part<64>, pg8::GSched>(tid, lds, 512, D, D, nullptr, Sd, E);
            SEAM(14);
        }
        if (IN(15)) for (int rep_ = 0; rep_ < (int)((PROBE_REP >> 15) & 1u) + 1; ++rep_) {
            FRESH();
            for (int i = bid * NTHR + tid; i < NSLOT; i += G * NTHR) { TOK[i] = S; WSLOT[i] = 0.f; }
            if (bid == 0 && tid == 0) RMSV[S] = 0.f;
            LAS unsigned* hist = (LAS unsigned*)lds; LAS unsigned* base = hist + 32;
            const float* bg = INP(I_BG) + l * 4; const float* be = INP(I_BE) + l * 32;
            for (int blk = bid; blk < S / 64; blk += G) {
                if (tid < 64) hist[tid] = 0u;
                __syncthreads();
                int e0 = 0, e1 = 0; unsigned r0 = 0, r1 = 0; float w0 = 0.f, w1 = 0.f; const int s = blk * 64 + tid;
                if (tid < 64) {
                    float ssq = 0.f;
#pragma unroll
                    for (int j4 = 0; j4 < 8; ++j4) { const f32x4 a = *(const f32x4*)(SSP + (size_t)s * 32 + 4 * j4); ssq += (a[0] + a[1]) + (a[2] + a[3]); }
                    const float rms = rsqrtf(ssq * (1.0f / D) + EPS); RMSV[s] = rms;
                    float lg[36];
#pragma unroll
                    for (int j4 = 0; j4 < 9; ++j4) { f32x4 a = *(const f32x4*)(LOGP + (size_t)s * 64 + 4 * j4);
#pragma unroll
                        for (int z = 1; z < 4; ++z) a += *(const f32x4*)(LOGP + (size_t)z * S * 64 + (size_t)s * 64 + 4 * j4);
                        lg[4 * j4] = a[0] * rms; lg[4 * j4 + 1] = a[1] * rms; lg[4 * j4 + 2] = a[2] * rms; lg[4 * j4 + 3] = a[3] * rms; }
                    float gl[4]; int gi = 0; float gm;
#pragma unroll
                    for (int j = 0; j < 4; ++j) gl[j] = lg[j] + bg[j];
                    gm = gl[0];
#pragma unroll
                    for (int j = 1; j < 4; ++j) if (gl[j] > gm) { gm = gl[j]; gi = j; }
                    float gs = 0.f;
#pragma unroll
                    for (int j = 0; j < 4; ++j) gs += __expf(gl[j] - gm);
                    const float gwt = 1.f / gs;
                    float v0 = -__builtin_inff(), v1 = -__builtin_inff(); int i0 = 0, i1 = 0;
#pragma unroll
                    for (int j = 0; j < 8; ++j) { const float lv = (gi == 0) ? lg[4 + j] : (gi == 1) ? lg[12 + j] : (gi == 2) ? lg[20 + j] : lg[28 + j]; const float v = lv + be[gi * 8 + j];
                        if (v > v0) { v1 = v0; i1 = i0; v0 = v; i0 = j; } else if (v > v1) { v1 = v; i1 = j; } }
                    const float ee = __expf(v1 - v0), den = 1.f / (1.f + ee);
                    w0 = gwt * den; w1 = gwt * ee * den; e0 = gi * 8 + i0; e1 = gi * 8 + i1;
                    r0 = __hip_atomic_fetch_add(&hist[e0], 1u, __ATOMIC_RELAXED, __HIP_MEMORY_SCOPE_WORKGROUP); r1 = __hip_atomic_fetch_add(&hist[e1], 1u, __ATOMIC_RELAXED, __HIP_MEMORY_SCOPE_WORKGROUP);
                }
                __syncthreads();
                if (tid < 32) { const unsigned c = hist[tid]; base[tid] = c ? __hip_atomic_fetch_add(ctl + CW_CNT + 64 * l + tid, c, __ATOMIC_RELAXED, __HIP_MEMORY_SCOPE_AGENT) : 0u; }
                __syncthreads();
                if (tid < 64) { REC_E[2 * s] = e0; REC_E[2 * s + 1] = e1; REC_R[2 * s] = (int)(base[e0] + r0); REC_R[2 * s + 1] = (int)(base[e1] + r1); REC_W[2 * s] = w0; REC_W[2 * s + 1] = w1; }
                __syncthreads();
            }
            SEAM(15);
        }
        if (IN(16) || IN(17) || IN(18)) {
            FRESH();
            LAS int* pst = (LAS int*)(CTLW + 16);
            if (tid == 0) { int acc = 0; for (int e = 0; e < 32; ++e) { pst[e] = acc; const int c = (int)__hip_atomic_load(ctl + CW_CNT + 64 * l + e, __ATOMIC_RELAXED, __HIP_MEMORY_SCOPE_AGENT); acc += (c + 255) & ~255; } pst[32] = acc; }
            __syncthreads();
            if (tid < 160) { int e = 0; for (int k = 1; k < 32; ++k) if (pst[k] <= tid * 256) e = k; ((LAS int*)(CTLW + 256))[tid] = e; }
            __syncthreads();
        }
        if (IN(16)) for (int rep_ = 0; rep_ < (int)((PROBE_REP >> 16) & 1u) + 1; ++rep_) {
            FRESH();
            const LAS int* pst = (const LAS int*)(CTLW + 16);
            for (int i = bid * NTHR + tid; i < 2 * S; i += G * NTHR) { const int slot = pst[REC_E[i]] + REC_R[i]; TOK[slot] = i >> 1; WSLOT[slot] = REC_W[i]; REC_S[i] = slot; }
            SEAM(16);
        }
        if (IN(17)) for (int rep_ = 0; rep_ < (int)((PROBE_REP >> 17) & 1u) + 1; ++rep_) {
            FRESH();
            pg8::MoeSched Sd{(const LAS int*)(CTLW + 16), (const char*)MOE1F, TOK, (size_t)1024 * D, (size_t)256 * D, 4, G, bid, 1};
            pg8::EpiMoe1 E{HID8, TOK, RMSV};
            pg8::gemm_phase<pg8::EpiMoe1, pg8::MoeSched, true, true>(tid, lds, D / 2, D / 2, D / 2, (const char*)XF8, Sd, E);
            SEAM(17);
        }
        if (IN(18)) for (int rep_ = 0; rep_ < (int)((PROBE_REP >> 18) & 1u) + 1; ++rep_) {
            {   FRESH();
                pg8::MoeSched Sd{(const LAS int*)(CTLW + 16), (const char*)MOE1F, TOK, (size_t)1024 * D, (size_t)256 * D, 4, G, bid, 2};
                pg8::EpiMoe1 E{HID8, TOK, RMSV};
                pg8::gemm_phase<pg8::EpiMoe1, pg8::MoeSched, true, true>(tid, lds, D / 2, D / 2, D / 2, (const char*)XF8, Sd, E); }
            {   FRESH();
                pg8::MoeSched2 Sd{(const LAS int*)(CTLW + 16), (const char*)HID8, (const char*)MOE2F, (size_t)D * 512, (size_t)256 * 512, 8, G, bid, 1};
                pg8::EpiMoe2 E{YS8, WSLOT};
                pg8::gemm_phase<pg8::EpiMoe2, pg8::MoeSched2, false, true>(tid, lds, 256, 256, 256, nullptr, Sd, E); }
            {   FRESH(); GRID_BAR(); }
            {   FRESH();
                pg8::MoeSched2 Sd{(const LAS int*)(CTLW + 16), (const char*)HID8, (const char*)MOE2F, (size_t)D * 512, (size_t)256 * 512, 8, G, bid, 2};
                pg8::EpiMoe2 E{YS8, WSLOT};
                pg8::gemm_phase<pg8::EpiMoe2, pg8::MoeSched2, false, true>(tid, lds, 256, 256, 256, nullptr, Sd, E); }
            {   FRESH(); SEAM(18); }
        }
}

__global__ void __launch_bounds__(NTHR, 2) fwd_kernel(Args args) {
    extern __shared__ __attribute__((aligned(16))) unsigned char lds_raw[];
    LAS unsigned char* lds0 = (LAS unsigned char*)lds_raw;
    {   int t0 = threadIdx.x; asm volatile("" : "+v"(t0));
        for (int u = t0; u < (LDS_BYTES - LDSCTL_OFF) / 4; u += NTHR) ((LAS unsigned*)(lds0 + LDSCTL_OFF))[u] = 0u;
        __syncthreads();
        if (t0 == 0) { LAS unsigned long long* pw = (LAS unsigned long long*)(lds0 + LDSCTL_OFF + 512);
#pragma unroll
            for (int i = 0; i < 50; ++i) pw[i] = (unsigned long long)args.in[i];
            pw[50] = (unsigned long long)args.ws; pw[51] = (unsigned long long)args.out; }
        __syncthreads();
#if !MK_MULTI
        if (t0 == 0) (void)xb_add(&((unsigned*)args.ws)[CW_BAR + XB_XCNT(xb_xcc_id())], 1u);
#endif
    }
    const int ph_lo = args.ph_lo, ph_hi = args.ph_hi;
    int wave_s = __builtin_amdgcn_readfirstlane(threadIdx.x >> 6); asm volatile("" : "+s"(wave_s));
#if MK_MULTI
    if (args.l_lo < NL) layer_body<0>(args.l_lo, wave_s, lds0, ph_lo, ph_hi);
#else
    layer_body<0>(0, wave_s, lds0, ph_lo, ph_hi);
    layer_body<1>(1, wave_s, lds0, ph_lo, ph_hi);
    layer_body<2>(2, wave_s, lds0, ph_lo, ph_hi);
    layer_body<3>(3, wave_s, lds0, ph_lo, ph_hi);
#endif
    if (args.l_hi > NL) {
        FRESH();
        for (int s = gw; s < S; s += NGW) { const int s0 = REC_S[2 * s], s1 = REC_S[2 * s + 1];
#pragma unroll
            for (int j = 0; j < 4; ++j) { float x[8], ya[8], yb[8]; unpack8(*(const u32x4*)(XB + (size_t)s * D + 8 * lane + 512 * j), x);
                unpack8_fp8(*(const u32x2*)(YS8 + (size_t)s0 * D + 8 * lane + 512 * j), ya); unpack8_fp8(*(const u32x2*)(YS8 + (size_t)s1 * D + 8 * lane + 512 * j), yb);
#pragma unroll
                for (int e = 0; e < 8; ++e) x[e] += (ya[e] + yb[e]) * 0.0625f;
                *(f32x4*)(X + (size_t)s * D + 8 * lane + 512 * j) = (f32x4){x[0], x[1], x[2], x[3]};
                *(f32x4*)(X + (size_t)s * D + 8 * lane + 512 * j + 4) = (f32x4){x[4], x[5], x[6], x[7]}; } }
    }
}

extern "C" void kernel_launch(void* const* d_in, const int* in_sizes, int n_in, void* d_out, int out_size, void* d_ws, size_t ws_size, hipStream_t stream) {
    static int grid = 0;
    if (grid == 0) {
        if (n_in != 50 || out_size != S * D || ws_size < WS_END) { fprintf(stderr, "kernel_launch: unexpected shapes (n_in %d, out %d, ws %zu < %zu)\n", n_in, out_size, ws_size, (size_t)WS_END); grid = -1; return; }
        int dev = 0, cus = 0, per_cu = 0;
        if (hipGetDevice(&dev) != hipSuccess || hipDeviceGetAttribute(&cus, hipDeviceAttributeMultiprocessorCount, dev) != hipSuccess) { grid = -1; return; }
        if (hipFuncSetAttribute((const void*)fwd_kernel, hipFuncAttributeMaxDynamicSharedMemorySize, LDS_BYTES) != hipSuccess) { fprintf(stderr, "kernel_launch: hipFuncSetAttribute failed\n"); grid = -1; return; }
        if (hipOccupancyMaxActiveBlocksPerMultiprocessor(&per_cu, (const void*)fwd_kernel, NTHR, LDS_BYTES) != hipSuccess || per_cu < 1) { fprintf(stderr, "kernel_launch: occupancy query says %d\n", per_cu); }
        (void)hipGetLastError();
        grid = cus;
    }
    if (grid < 0) return;
    (void)in_sizes;
    if (hipMemsetAsync((char*)d_ws + WS_CTL, 0, CTL_ZERO_BYTES, stream) != hipSuccess) return;
    Args a{};
    for (int i = 0; i < 50; ++i) a.in[i] = (const float*)d_in[i];
    a.out = (float*)d_out; a.ws = (unsigned char*)d_ws;
#if MK_MULTI
    for (int l = 0; l < NL; ++l)
        for (int ph = 0; ph < NPH; ++ph) { a.l_lo = l; a.l_hi = l + 1; a.ph_lo = ph; a.ph_hi = ph + 1; hipLaunchKernelGGL(fwd_kernel, dim3(grid), dim3(NTHR), LDS_BYTES, stream, a); }
    a.l_lo = NL; a.l_hi = NL + 1; a.ph_lo = 0; a.ph_hi = 0; hipLaunchKernelGGL(fwd_kernel, dim3(grid), dim3(NTHR), LDS_BYTES, stream, a);
#else
    a.l_lo = 0; a.l_hi = NL + 1; a.ph_lo = 0; a.ph_hi = NPH;
    hipLaunchKernelGGL(fwd_kernel, dim3(grid), dim3(NTHR), LDS_BYTES, stream, a);
#endif
    const hipError_t le = hipPeekAtLastError();
    if (le != hipSuccess) fprintf(stderr, "kernel_launch: launch failed: %s\n", hipGetErrorName(le));
}
```

```cpp
#include <hip/hip_runtime.h>
#include <cstdio>
#include <cstdint>

#ifndef MK_MULTI
#define MK_MULTI 0
#endif

#define LAS __attribute__((address_space(3)))
#define GAS __attribute__((address_space(1)))
typedef unsigned short bf16_t;
typedef short bf16x8 __attribute__((ext_vector_type(8)));
typedef float f32x4 __attribute__((ext_vector_type(4)));
typedef float f32x2 __attribute__((ext_vector_type(2)));
typedef float f32x16 __attribute__((ext_vector_type(16)));
typedef unsigned u32x4 __attribute__((ext_vector_type(4)));
typedef unsigned u32x2 __attribute__((ext_vector_type(2)));

constexpr int S = 16384, D = 2048, NL = 4, INW = 3136, INWP = 3200, WINR = 3328;
constexpr int MEMT = 256;
constexpr int NSLOT = 40960;
constexpr float EPS = 1e-6f;
constexpr float LOG2E = 1.4426950408889634f;
constexpr int P_AQ = 0, P_AK = 448, P_AV = 576, P_BA = 704, P_BG = 1216, P_CQ = 1728, P_CKV = 2240, P_CKR = 2496, P_DU = 2560;

constexpr size_t MiB = 1u << 20;
constexpr size_t WS_CTL = 0, CTL_ZERO_BYTES = 1 * MiB;
constexpr size_t WS_ROPE = 1 * MiB;
constexpr size_t WS_H = WS_ROPE + 4 * MiB;
constexpr size_t WS_P = WS_H + 65 * MiB;
constexpr size_t WS_O = WS_P + 104 * MiB;
constexpr size_t WS_QRAW = WS_O + 64 * MiB;
constexpr size_t WS_KVRAW = WS_QRAW + 24 * MiB;
constexpr size_t WS_Q = WS_KVRAW + 32 * MiB;
constexpr size_t WS_KIMG = WS_Q + 24 * MiB;
constexpr size_t WS_VIMG = WS_KIMG + 24 * MiB;
constexpr size_t WS_SWAK = WS_VIMG + 16 * MiB;
constexpr size_t WS_SWAV = WS_SWAK + 4 * MiB;
constexpr size_t WS_ZC = WS_SWAV + 4 * MiB;
constexpr size_t WS_UA = WS_ZC + 16 * MiB;
constexpr size_t WS_EBUF = WS_UA + 20 * MiB;
constexpr size_t WS_YG = WS_EBUF + 4 * MiB;
constexpr size_t WS_QX = WS_YG + 16 * MiB;
constexpr size_t WS_OX = WS_QX + 16 * MiB;
constexpr size_t WS_MEMN = WS_OX + 16 * MiB;
constexpr size_t WS_KMEM = WS_MEMN + 1 * MiB;
constexpr size_t WS_VMEM = WS_KMEM + 1 * MiB;
constexpr size_t WS_XKIMG = WS_VMEM + 1 * MiB;
constexpr size_t WS_XVIMG = WS_XKIMG + 1 * MiB;
constexpr size_t WS_LOG = WS_XVIMG + 1 * MiB;
constexpr size_t WS_REC = WS_LOG + 4 * MiB;
constexpr size_t WS_TOK = WS_REC + 1 * MiB;
constexpr size_t WS_WSLOT = WS_TOK + 1 * MiB;
constexpr size_t WS_HID = WS_WSLOT + 1 * MiB;
constexpr size_t WS_YS = WS_HID + 40 * MiB;
constexpr size_t WS_WIN = WS_YS + 160 * MiB;
constexpr size_t WS_WOUT = WS_WIN + 13 * MiB;
constexpr size_t WS_XWQ = WS_WOUT + 8 * MiB;
constexpr size_t WS_XWK = WS_XWQ + 2 * MiB;
constexpr size_t WS_XWV = WS_XWK + 2 * MiB;
constexpr size_t WS_XWO = WS_XWV + 2 * MiB;
constexpr size_t WS_PW = WS_XWO + 2 * MiB;
constexpr size_t WS_WQB = WS_PW + 1 * MiB;
constexpr size_t WS_WKVB = WS_WQB + 1 * MiB;
constexpr size_t WS_GLU = WS_WKVB + 1 * MiB;
constexpr size_t WS_ROUT = WS_GLU + 1 * MiB;
constexpr size_t WS_MOE1 = WS_ROUT + 1 * MiB;
constexpr size_t WS_MOE2 = WS_MOE1 + 128 * MiB;
constexpr size_t WS_W1G = WS_MOE2 + 64 * MiB;
constexpr size_t WS_BTY = WS_W1G + 16 * MiB;
constexpr size_t WS_PARTO = WS_BTY + 80 * MiB;
constexpr size_t WS_PARTML = WS_PARTO + 32 * MiB;
constexpr size_t WS_XB = WS_PARTML + 1 * MiB;
constexpr size_t WS_QXP = WS_XB + 65 * MiB;
constexpr size_t WS_LOGP = WS_QXP + 64 * MiB;
constexpr size_t WS_SSP = WS_LOGP + 16 * MiB;
constexpr size_t WS_RMSV = WS_SSP + 2 * MiB;
constexpr size_t WS_RMS1 = WS_RMSV + 1 * MiB;
constexpr size_t WS_XF8 = WS_RMS1 + 1 * MiB;
constexpr size_t WS_END = WS_XF8 + 33 * MiB;
constexpr int CW_BAR = 4096;
constexpr int CW_SS = 32768;
constexpr int CW_CNT = 16384;

constexpr int RING_BYTES = 131072;
constexpr int LDSCTL_OFF = RING_BYTES;
constexpr int LDS_BYTES = 147456;
constexpr int NWAVES = 8, NTHR = 512;

__device__ __forceinline__ float bf2f(unsigned b) { return __uint_as_float(b << 16); }
typedef __bf16 bf16x2_t __attribute__((ext_vector_type(2)));
__device__ __forceinline__ unsigned cvt_pk_bf16(float lo, float hi) { const f32x2 v = {lo, hi}; const bf16x2_t b = __builtin_convertvector(v, bf16x2_t); return __builtin_bit_cast(unsigned, b); }
__device__ __forceinline__ float wave_sum(float v) {
#pragma unroll
    for (int o = 1; o < 64; o <<= 1) v += __shfl_xor(v, o);
    return v;
}
__device__ __forceinline__ float fast_exp2(float x) { return __builtin_amdgcn_exp2f(x); }
__device__ __forceinline__ float fast_rcp(float x) { return __builtin_amdgcn_rcpf(x); }
__device__ __forceinline__ float sigmoidf_(float x) { return fast_rcp(1.f + fast_exp2(-x * LOG2E)); }
__device__ __forceinline__ void unpack8(const u32x4 w, float (&f)[8]) {
    f[0] = bf2f(w.x & 0xffffu); f[1] = bf2f(w.x >> 16); f[2] = bf2f(w.y & 0xffffu); f[3] = bf2f(w.y >> 16);
    f[4] = bf2f(w.z & 0xffffu); f[5] = bf2f(w.z >> 16); f[6] = bf2f(w.w & 0xffffu); f[7] = bf2f(w.w >> 16);
}
__device__ __forceinline__ u32x4 pack8(const float (&f)[8]) { u32x4 w; w.x = cvt_pk_bf16(f[0], f[1]); w.y = cvt_pk_bf16(f[2], f[3]); w.z = cvt_pk_bf16(f[4], f[5]); w.w = cvt_pk_bf16(f[6], f[7]); return w; }
__device__ __forceinline__ unsigned pk4_fp8(float a, float b, float c, float d) { int w = __builtin_amdgcn_cvt_pk_fp8_f32(a, b, 0, false); w = __builtin_amdgcn_cvt_pk_fp8_f32(c, d, w, true); return (unsigned)w; }
__device__ __forceinline__ void unpack8_fp8(const u32x2 w, float (&f)[8]) { const f32x2 a = __builtin_amdgcn_cvt_pk_f32_fp8(w.x, false), b = __builtin_amdgcn_cvt_pk_f32_fp8(w.x, true), c = __builtin_amdgcn_cvt_pk_f32_fp8(w.y, false), d = __builtin_amdgcn_cvt_pk_f32_fp8(w.y, true);
    f[0] = a.x; f[1] = a.y; f[2] = b.x; f[3] = b.y; f[4] = c.x; f[5] = c.y; f[6] = d.x; f[7] = d.y; }
#define LDS_WAIT() asm volatile("s_waitcnt lgkmcnt(0)" ::: "memory")
#define VM_WAIT() asm volatile("s_waitcnt vmcnt(0)" ::: "memory")

namespace pg8 {
constexpr int BM = 256, BK = 64, HALF = 128, HTB = HALF * BK * 2, STAGE_BYTES = 8 * HTB, NXCD = 8, WGM = 8;
__host__ __device__ __forceinline__ int lds_byte(int r, int c) { const int st = (r >> 4) * 2 + (c >> 5), rr = r & 15, cc = c & 31, ob = rr * 64 + cc * 2; return st * 1024 + (ob ^ (((ob >> 9) & 1) << 5)); }
__host__ __device__ __forceinline__ void stage_rc(int b, int& R, int& C) { const int st = b / 1024, sb = b % 1024, swz = sb ^ (((sb >> 9) & 1) << 5); R = (st >> 1) * 16 + swz / 64; C = (st & 1) * 32 + (swz % 64) / 2; }
__host__ __device__ __forceinline__ int perm32(int rho) { const int n = rho >> 4, i = rho & 15; return 8 * (i >> 2) + 4 * n + (i & 3); }

struct Unit { int pm, pn, z; const char* a; const char* b; const int* rows; };

struct GSched {
    const char* A; const char* B; size_t aTile, bTile, aZ, bZ; int nM, nN, nZ, G, c;
    __device__ __forceinline__ bool next(int i, Unit& u) const {
        const int nwg = nM * nN; const long L = (long)i * G + c; if (L >= (long)nwg * nZ) return false;
        const int z = (int)(L / nwg); int wgid = (int)(L - (long)z * nwg);
        { const int q = nwg / NXCD, r = nwg % NXCD, xcd = wgid % NXCD, off = wgid / NXCD; wgid = (xcd < r ? xcd * (q + 1) : r * (q + 1) + (xcd - r) * q) + off; }
        const int nig = WGM * nN, gid = wgid / nig, fm = gid * WGM, gsz = (nM - fm) < WGM ? (nM - fm) : WGM;
        u.pm = fm + ((wgid % nig) % gsz); u.pn = (wgid % nig) / gsz; u.z = z;
        u.a = A + (size_t)z * aZ + (size_t)u.pm * aTile; u.b = B + (size_t)z * bZ + (size_t)u.pn * bTile; u.rows = nullptr; return true;
    }
};

template <class Epi, class Sched, bool GATHER = false, bool F8 = false>
__device__ __forceinline__ void gemm_phase(const int tid_in, LAS unsigned char* lds, const int K, const int lda, const int ldb, const char* Abase, const Sched& S, const Epi& E) {
    int tid = tid_in; asm volatile("" : "+v"(tid));
    const int wid = __builtin_amdgcn_readfirstlane(tid >> 6), lane = tid & 63, wr = wid >> 2, wc = wid & 3, fr = lane & 15, fq = lane >> 4;
    const int nt = K / BK;
    unsigned voffA[2], voffB[2]; int rA[2], cA2[2];
#pragma unroll
    for (int i = 0; i < 2; ++i) { int R, C; stage_rc(tid * 16 + i * 8192, R, C); const int Rb = Epi::PERM ? ((R & ~31) + perm32(R & 31)) : R;
        voffA[i] = (unsigned)(R * lda + C) * 2u; voffB[i] = (unsigned)(Rb * ldb + C) * 2u; rA[i] = R; cA2[i] = C * 2; }
    const size_t kstep = (size_t)(BK * 2);
    const size_t hstepA = (size_t)HALF * lda * 2, hstepB = (size_t)HALF * ldb * 2;
    const unsigned ldsw = (unsigned)wid * 1024u;
    const int aoff = lds_byte(wr * 64 + fr, fq * 8), boff = lds_byte(wc * 32 + fr, fq * 8);
#define PG8_SA(b, h) (((b) * 2 + (h)) * HTB)
#define PG8_SB(b, h) ((4 + (b) * 2 + (h)) * HTB)
#define PG8_STAGE(bufoff, gbase, voff) do { _Pragma("unroll") for (int _i = 0; _i < 2; ++_i) \
        __builtin_amdgcn_global_load_lds((const unsigned*)((const char*)(gbase) + (voff)[_i]), (LAS unsigned*)(lds + (bufoff) + ldsw + _i * 8192), 16, 0, 0); } while (0)
#define PG8_LDA(dst, b, h) do { _Pragma("unroll") for (int m = 0; m < 4; ++m) _Pragma("unroll") for (int k = 0; k < 2; ++k) dst[m][k] = *(const LAS bf16x8*)(lds + PG8_SA(b, h) + aoff + m * 2048 + k * 1024); } while (0)
#define PG8_LDB(dst, b, h) do { _Pragma("unroll") for (int n = 0; n < 2; ++n) _Pragma("unroll") for (int k = 0; k < 2; ++k) dst[n][k] = *(const LAS bf16x8*)(lds + PG8_SB(b, h) + boff + n * 2048 + k * 1024); } while (0)
typedef long pg8_i64x2 __attribute__((ext_vector_type(2)));
#define PG8_MMA(ai, bj, At, Bt) do { __builtin_amdgcn_s_setprio(1); _Pragma("unroll") for (int m = 0; m < 4; ++m) _Pragma("unroll") for (int n = 0; n < 2; ++n) _Pragma("unroll") for (int k = 0; k < 2; ++k) { \
        if constexpr (F8) {   \
            const pg8_i64x2 a_ = __builtin_bit_cast(pg8_i64x2, At[m][k]), b_ = __builtin_bit_cast(pg8_i64x2, Bt[n][k]); \
            acc[ai][bj][m][n] = __builtin_amdgcn_mfma_f32_16x16x32_fp8_fp8(b_.x, a_.x, acc[ai][bj][m][n], 0, 0, 0); \
            acc[ai][bj][m][n] = __builtin_amdgcn_mfma_f32_16x16x32_fp8_fp8(b_.y, a_.y, acc[ai][bj][m][n], 0, 0, 0); \
        } else acc[ai][bj][m][n] = __builtin_amdgcn_mfma_f32_16x16x32_bf16(Bt[n][k], At[m][k], acc[ai][bj][m][n], 0, 0, 0); } \
        __builtin_amdgcn_s_setprio(0); } while (0)
#define PG8_WAIT_V(n) asm volatile("s_waitcnt vmcnt(" #n ")" ::: "memory")
#define PG8_WAIT_L(n) asm volatile("s_waitcnt lgkmcnt(" #n ")" ::: "memory")
#define PG8_BAR __builtin_amdgcn_s_barrier()
#define PG8_SCHED __builtin_amdgcn_sched_barrier(0)
    Unit cur, nxt; int ui = 0;
    if (!S.next(0, cur)) return;
    f32x4 acc[2][2][4][2];
#pragma unroll
    for (int a = 0; a < 2; ++a)
#pragma unroll
        for (int b = 0; b < 2; ++b)
#pragma unroll
            for (int m = 0; m < 4; ++m)
#pragma unroll
                for (int n = 0; n < 2; ++n) acc[a][b][m][n] = (f32x4){0.f, 0.f, 0.f, 0.f};
    bf16x8 At[4][2], B0[2][2], B1[2][2];
    unsigned gc0[2], gc1[2], gn0[2], gn1[2];
    const char* cA = GATHER ? Abase : cur.a; const char* cB = cur.b;
    if constexpr (GATHER) {
#pragma unroll
        for (int i = 0; i < 2; ++i) { gc0[i] = (unsigned)cur.rows[rA[i]] * (unsigned)(lda * 2) + (unsigned)cA2[i]; gc1[i] = (unsigned)cur.rows[HALF + rA[i]] * (unsigned)(lda * 2) + (unsigned)cA2[i]; gn0[i] = gc0[i]; gn1[i] = gc1[i]; }
    }
#define PG8_STAGE_A(bufoff, h, ptr, usenext) do { if constexpr (GATHER) { if (usenext) { if ((h) == 0) PG8_STAGE(bufoff, ptr, gn0); else PG8_STAGE(bufoff, ptr, gn1); } else { if ((h) == 0) PG8_STAGE(bufoff, ptr, gc0); else PG8_STAGE(bufoff, ptr, gc1); } } \
        else { PG8_STAGE(bufoff, (ptr) + ((h) ? hstepA : 0), voffA); } } while (0)
    PG8_STAGE(PG8_SB(0, 0), cB, voffB); PG8_STAGE(PG8_SB(0, 1), cB + hstepB, voffB); PG8_STAGE_A(PG8_SA(0, 0), 0, cA, false); PG8_STAGE_A(PG8_SA(0, 1), 1, cA, false);
    if (wr == 1) PG8_BAR;
    PG8_WAIT_V(2); PG8_BAR;
    PG8_STAGE(PG8_SB(1, 0), cB + kstep, voffB); PG8_STAGE_A(PG8_SA(1, 0), 0, cA + kstep, false); PG8_STAGE(PG8_SB(1, 1), cB + hstepB + kstep, voffB);
    PG8_WAIT_V(6); PG8_BAR;
    for (;;) {
        const bool has_next = S.next(ui + 1, nxt);
        const char* nA = GATHER ? Abase : (has_next ? nxt.a : cA); const char* nB = has_next ? nxt.b : cB;
        if constexpr (GATHER) {
            if (has_next) {
#pragma unroll
                for (int i = 0; i < 2; ++i) { gn0[i] = (unsigned)nxt.rows[rA[i]] * (unsigned)(lda * 2) + (unsigned)cA2[i]; gn1[i] = (unsigned)nxt.rows[HALF + rA[i]] * (unsigned)(lda * 2) + (unsigned)cA2[i]; }
            } else {
#pragma unroll
                for (int i = 0; i < 2; ++i) { gn0[i] = gc0[i]; gn1[i] = gc1[i]; }
            }
        }
#pragma unroll 1
        for (int t = 0; t < nt; t += 2) {
            const bool last = (t == nt - 2);
            const char* a1 = cA + (size_t)(t + 1) * kstep;
            const char* a2 = last ? nA : cA + (size_t)(t + 2) * kstep; const char* b2 = last ? nB : cB + (size_t)(t + 2) * kstep;
            const char* a3 = a2 + kstep; const char* b3 = b2 + kstep;
            PG8_LDB(B0, 0, 0); PG8_LDB(B1, 0, 1); PG8_SCHED; PG8_LDA(At, 0, 0); PG8_STAGE_A(PG8_SA(1, 1), 1, a1, false);
            PG8_WAIT_V(8); PG8_WAIT_L(0); PG8_BAR; PG8_MMA(0, 0, At, B0); PG8_MMA(0, 1, At, B1); PG8_BAR; PG8_SCHED;
            PG8_LDA(At, 0, 1); PG8_STAGE(PG8_SB(0, 0), b2, voffB); PG8_STAGE(PG8_SB(0, 1), b2 + hstepB, voffB); PG8_STAGE_A(PG8_SA(0, 0), 0, a2, last);
            PG8_WAIT_V(8); PG8_WAIT_L(0); PG8_BAR; PG8_MMA(1, 0, At, B0); PG8_MMA(1, 1, At, B1); PG8_BAR; PG8_SCHED;
            PG8_LDB(B0, 1, 0); PG8_LDB(B1, 1, 1); PG8_SCHED; PG8_LDA(At, 1, 0); PG8_STAGE_A(PG8_SA(0, 1), 1, a2, last);
            PG8_WAIT_V(8); PG8_WAIT_L(0); PG8_BAR; PG8_MMA(0, 0, At, B0); PG8_MMA(0, 1, At, B1); PG8_BAR; PG8_SCHED;
            PG8_LDA(At, 1, 1); PG8_STAGE(PG8_SB(1, 0), b3, voffB); PG8_STAGE(PG8_SB(1, 1), b3 + hstepB, voffB); PG8_STAGE_A(PG8_SA(1, 0), 0, a3, last);
            PG8_WAIT_V(8); PG8_WAIT_L(0); PG8_BAR; PG8_MMA(1, 0, At, B0); PG8_MMA(1, 1, At, B1); PG8_BAR; PG8_SCHED;
        }
        if (wr == 0) PG8_BAR;
        E(acc, cur, wr, wc, fr, fq);
        if (!has_next) break;
#pragma unroll
        for (int a = 0; a < 2; ++a)
#pragma unroll
            for (int b = 0; b < 2; ++b)
#pragma unroll
                for (int m = 0; m < 4; ++m)
#pragma unroll
                    for (int n = 0; n < 2; ++n) acc[a][b][m][n] = (f32x4){0.f, 0.f, 0.f, 0.f};
        cur = nxt; cA = nA; cB = nB; ++ui;
        if constexpr (GATHER) {
#pragma unroll
            for (int i = 0; i < 2; ++i) { gc0[i] = gn0[i]; gc1[i] = gn1[i]; }
        }
        if (wr == 1) PG8_BAR;
    }
    PG8_WAIT_V(0);
    PG8_BAR;
#undef PG8_STAGE_A
#undef PG8_SA
#undef PG8_SB
#undef PG8_STAGE
#undef PG8_LDA
#undef PG8_LDB
#undef PG8_MMA
#undef PG8_WAIT_V
#undef PG8_WAIT_L
#undef PG8_BAR
#undef PG8_SCHED
}

struct EpiBf16 {
    static constexpr bool PERM = true;
    bf16_t* O; int ldc; int col_off; const float* bias; const float* rowscale;
    __device__ __forceinline__ void operator()(const f32x4 (&acc)[2][2][4][2], const Unit& u, int wr, int wc, int fr, int fq) const {
        const int row0 = u.pm * BM + wr * 64 + fr, c0 = u.pn * BM + wc * 32 + 8 * fq;
        f32x4 bv[2][2];
#pragma unroll
        for (int bj = 0; bj < 2; ++bj)
#pragma unroll
            for (int n = 0; n < 2; ++n) bv[bj][n] = bias ? *(const f32x4*)(bias + c0 + bj * HALF + 4 * n) : (f32x4){0.f, 0.f, 0.f, 0.f};
#pragma unroll
        for (int ai = 0; ai < 2; ++ai)
#pragma unroll
            for (int m = 0; m < 4; ++m) { const int row = row0 + ai * HALF + m * 16; bf16_t* rowp = O + (size_t)row * ldc + col_off + c0; const float rs = rowscale ? rowscale[row] : 1.f;
#pragma unroll
                for (int bj = 0; bj < 2; ++bj) { const f32x4 v0 = acc[ai][bj][m][0] * rs + bv[bj][0], v1 = acc[ai][bj][m][1] * rs + bv[bj][1];
                    u32x4 w; w.x = cvt_pk_bf16(v0[0], v0[1]); w.y = cvt_pk_bf16(v0[2], v0[3]); w.z = cvt_pk_bf16(v1[0], v1[1]); w.w = cvt_pk_bf16(v1[2], v1[3]);
                    *(u32x4*)(rowp + bj * HALF) = w; } }
    }
};
struct EpiResid {
    static constexpr bool PERM = true;
    bf16_t* XBp; int ldc; float* SS; bool dry; unsigned char* XF8p;
    __device__ __forceinline__ void operator()(const f32x4 (&acc)[2][2][4][2], const Unit& u, int wr, int wc, int fr, int fq) const {
        const int row0 = u.pm * BM + wr * 64 + fr, c0 = u.pn * BM + wc * 32 + 8 * fq;
#pragma unroll
        for (int ai = 0; ai < 2; ++ai)
#pragma unroll
            for (int m = 0; m < 4; ++m) { const int row = row0 + ai * HALF + m * 16; bf16_t* rowb = XBp + (size_t)row * ldc + c0; float ss = 0.f;
                u32x4 old[2];
#pragma unroll
                for (int bj = 0; bj < 2; ++bj) old[bj] = *(const u32x4*)(rowb + bj * HALF);
#pragma unroll
                for (int bj = 0; bj < 2; ++bj) { float x[8]; unpack8(old[bj], x);
#pragma unroll
                    for (int j = 0; j < 4; ++j) { x[j] += acc[ai][bj][m][0][j]; x[4 + j] += acc[ai][bj][m][1][j]; }
#pragma unroll
                    for (int j = 0; j < 8; ++j) ss += x[j] * x[j];
                    if (!dry) *(u32x4*)(rowb + bj * HALF) = pack8(x);
                    if (XF8p) *(u32x2*)(XF8p + (size_t)row * ldc + c0 + bj * HALF) = (u32x2){pk4_fp8(x[0], x[1], x[2], x[3]), pk4_fp8(x[4], x[5], x[6], x[7])}; }
                if (SS) { ss += __shfl_xor(ss, 16); ss += __shfl_xor(ss, 32); if (fq == 0) SS[(size_t)row * 32 + u.pn * 4 + wc] = ss; } }
    }
};
struct EpiF32Z {
    static constexpr bool PERM = false;
    float* C; int ldc; size_t zstride;
    __device__ __forceinline__ void operator()(const f32x4 (&acc)[2][2][4][2], const Unit& u, int wr, int wc, int fr, int fq) const {
        const int row0 = u.pm * BM + wr * 64 + fr, col0 = u.pn * BM + wc * 32 + 4 * fq;
#pragma unroll
        for (int ai = 0; ai < 2; ++ai)
#pragma unroll
            for (int m = 0; m < 4; ++m) { float* rowp = C + (size_t)u.z * zstride + (size_t)(row0 + ai * HALF + m * 16) * ldc + col0;
#pragma unroll
                for (int bj = 0; bj < 2; ++bj)
#pragma unroll
                    for (int n = 0; n < 2; ++n) *(f32x4*)(rowp + bj * HALF + n * 16) = acc[ai][bj][m][n]; }
    }
};
template <int NVALID> struct EpiF32Part {
    static constexpr bool PERM = false;
    float* C; int ldc; size_t zstride;
    __device__ __forceinline__ void operator()(const f32x4 (&acc)[2][2][4][2], const Unit& u, int wr, int wc, int fr, int fq) const {
        if (u.pn != 0) return;
        if (NVALID == 64 && wc >= 2) return;
        const int row0 = u.pm * BM + wr * 64 + fr, col0 = wc * 32 + 4 * fq;
#pragma unroll
        for (int ai = 0; ai < 2; ++ai)
#pragma unroll
            for (int m = 0; m < 4; ++m) { float* rowp = C + (size_t)u.z * zstride + (size_t)(row0 + ai * HALF + m * 16) * ldc + col0;
#pragma unroll
                for (int n = 0; n < 2; ++n) *(f32x4*)(rowp + n * 16) = acc[ai][0][m][n]; }
    }
};
struct EpiSsmY {
    static constexpr bool PERM = true;
    bf16_t* YG;
    __device__ __forceinline__ void operator()(const f32x4 (&acc)[2][2][4][2], const Unit& u, int wr, int wc, int fr, int fq) const {
        const int row0 = wr * 64 + fr, c0 = u.pn * BM + wc * 32 + 8 * fq;
#pragma unroll
        for (int ai = 0; ai < 2; ++ai)
#pragma unroll
            for (int m = 0; m < 4; ++m) { const int chunk = row0 + ai * HALF + m * 16;
#pragma unroll
                for (int bj = 0; bj < 2; ++bj) { const int col = c0 + bj * HALF, t = col >> 4, o0 = col & 15;
                    float v[8];
#pragma unroll
                    for (int j = 0; j < 4; ++j) { v[j] = acc[ai][bj][m][0][j]; v[4 + j] = acc[ai][bj][m][1][j]; }
#pragma unroll
                    for (int j = 0; j < 8; ++j) { const float x = v[j], y = 1.5957691216f * (x + 0.044715f * x * x * x); v[j] = x * fast_rcp(1.f + fast_exp2(-y * LOG2E)); }
                    *(u32x4*)(YG + (size_t)(chunk * 64 + t) * 512 + u.z * 16 + o0) = pack8(v); } }
    }
};
struct EpiGlu {
    static constexpr bool PERM = true;
    const bf16_t* YG; const float* bias; bf16_t* O;
    __device__ __forceinline__ void operator()(const f32x4 (&acc)[2][2][4][2], const Unit& u, int wr, int wc, int fr, int fq) const {
        const int row0 = u.pm * BM + wr * 64 + fr, c0 = u.pn * BM + wc * 32 + 8 * fq;
#pragma unroll
        for (int ai = 0; ai < 2; ++ai)
#pragma unroll
            for (int m = 0; m < 4; ++m) { const int row = row0 + ai * HALF + m * 16;
#pragma unroll
                for (int bj = 0; bj < 2; ++bj) { const int col = c0 + bj * HALF;
                    const u32x4 yw = *(const u32x4*)(YG + (size_t)row * 512 + col); float y[8]; unpack8(yw, y);
                    const f32x4 b0 = *(const f32x4*)(bias + col), b1 = *(const f32x4*)(bias + col + 4);
                    float v[8];
#pragma unroll
                    for (int j = 0; j < 4; ++j) { v[j] = y[j] * sigmoidf_(acc[ai][bj][m][0][j] + b0[j]); v[4 + j] = y[4 + j] * sigmoidf_(acc[ai][bj][m][1][j] + b1[j]); }
                    *(u32x4*)(O + (size_t)row * D + 1536 + col) = pack8(v); } }
    }
};
struct EpiMoe1 {
    static constexpr bool PERM = true;
    unsigned char* HID8; const int* TOKp; const float* SS;
    __device__ __forceinline__ void operator()(const f32x4 (&acc)[2][2][4][2], const Unit& u, int wr, int wc, int fr, int fq) const {
        const int row0 = u.z * BM + wr * 64 + fr, c0 = u.pn * HALF + wc * 32 + 8 * fq;
#pragma unroll
        for (int ai = 0; ai < 2; ++ai)
#pragma unroll
            for (int m = 0; m < 4; ++m) { const int row = row0 + ai * HALF + m * 16; float v[8];
                const float rs = SS[TOKp[row]] * (1.0f / 32.0f);
#pragma unroll
                for (int j = 0; j < 4; ++j) { const float g0 = acc[ai][0][m][0][j] * rs, g1 = acc[ai][0][m][1][j] * rs; v[j] = g0 * sigmoidf_(g0) * (acc[ai][1][m][0][j] * rs); v[4 + j] = g1 * sigmoidf_(g1) * (acc[ai][1][m][1][j] * rs); }
                *(u32x2*)(HID8 + (size_t)row * 512 + c0) = (u32x2){pk4_fp8(v[0], v[1], v[2], v[3]), pk4_fp8(v[4], v[5], v[6], v[7])}; }
    }
};
struct EpiMoe2 {
    static constexpr bool PERM = true;
    unsigned char* YS8; const float* W;
    __device__ __forceinline__ void operator()(const f32x4 (&acc)[2][2][4][2], const Unit& u, int wr, int wc, int fr, int fq) const {
        const int row0 = u.z * BM + wr * 64 + fr, c0 = u.pn * BM + wc * 32 + 8 * fq;
#pragma unroll
        for (int ai = 0; ai < 2; ++ai)
#pragma unroll
            for (int m = 0; m < 4; ++m) { const int row = row0 + ai * HALF + m * 16; const float w = W[row] * (16.0f / 32.0f);
#pragma unroll
                for (int bj = 0; bj < 2; ++bj) { const f32x4 v0 = acc[ai][bj][m][0] * w, v1 = acc[ai][bj][m][1] * w;
                    *(u32x2*)(YS8 + (size_t)row * D + c0 + bj * HALF) = (u32x2){pk4_fp8(v0[0], v0[1], v0[2], v0[3]), pk4_fp8(v1[0], v1[1], v1[2], v1[3])}; } }
    }
};
struct EpiBf16Part64 {
    static constexpr bool PERM = true;
    bf16_t* O; size_t zstride; const float* rowscale;
    __device__ __forceinline__ void operator()(const f32x4 (&acc)[2][2][4][2], const Unit& u, int wr, int wc, int fr, int fq) const {
        if (wc >= 2) return;
        const int row0 = u.pm * BM + wr * 64 + fr, c0 = wc * 32 + 8 * fq;
#pragma unroll
        for (int ai = 0; ai < 2; ++ai)
#pragma unroll
            for (int m = 0; m < 4; ++m) { const int row = row0 + ai * HALF + m * 16; const float rs = rowscale[row]; const f32x4 v0 = acc[ai][0][m][0] * rs, v1 = acc[ai][0][m][1] * rs;
                u32x4 w; w.x = cvt_pk_bf16(v0[0], v0[1]); w.y = cvt_pk_bf16(v0[2], v0[3]); w.z = cvt_pk_bf16(v1[0], v1[1]); w.w = cvt_pk_bf16(v1[2], v1[3]);
                *(u32x4*)(O + (size_t)u.z * zstride + (size_t)row * 64 + c0) = w; }
    }
};
struct EpiBf16Z { static constexpr bool PERM = true; bf16_t* O0; int ldc; size_t zstride;
    __device__ __forceinline__ void operator()(const f32x4 (&acc)[2][2][4][2], const Unit& u, int wr, int wc, int fr, int fq) const { EpiBf16 e{O0 + (size_t)u.z * zstride, ldc, 0, nullptr, nullptr}; e(acc, u, wr, wc, fr, fq); } };
struct EpiMem { static constexpr bool PERM = true; bf16_t* K0; bf16_t* V0;
    __device__ __forceinline__ void operator()(const f32x4 (&acc)[2][2][4][2], const Unit& u, int wr, int wc, int fr, int fq) const { EpiBf16 e{((u.z >> 2) ? V0 : K0) + (size_t)(u.z & 3) * 256 * 512, 512, 0, nullptr, nullptr}; e(acc, u, wr, wc, fr, fq); } };
struct MemSched { const char* A; const char* B; int G, c;
    __device__ __forceinline__ bool next(int i, Unit& u) const {
        const long L = (long)i * G + c; if (L >= 16) return false;
        const int pn = (int)L & 1, ks = ((int)L >> 1) & 3, kv = (int)L >> 3;
        u.pm = 0; u.pn = pn; u.z = kv * 4 + ks; u.a = A + (size_t)ks * 1024; u.b = B + (size_t)kv * 512 * D * 2 + (size_t)pn * 256 * D * 2 + (size_t)ks * 1024; u.rows = nullptr; return true; } };
struct MoeSched { const LAS int* pst; const char* B; const int* tok; size_t bE, bTile; int nN, G, c, mode;
    __device__ __forceinline__ bool next(int i, Unit& u) const {
        const int nb = __builtin_amdgcn_readfirstlane(pst[32]) >> 8; const int n1 = nb * nN, n1a = (n1 / G) * G;
        const int cv = (G % NXCD == 0) ? (c % NXCD) * (G / NXCD) + c / NXCD : c;
        const long L = (long)(mode == 2 ? n1a : 0) + (long)i * G + cv; if (L >= (long)(mode == 1 ? n1a : n1)) return false;
        const int b = (int)(L / nN), pn = (int)(L % nN); const int e = __builtin_amdgcn_readfirstlane(pst[240 + b]);
        u.pm = 0; u.pn = pn; u.z = b; u.a = nullptr; u.rows = tok + b * 256; u.b = B + (size_t)e * bE + (size_t)pn * bTile; return true; } };
struct MoeSched2 { const LAS int* pst; const char* A; const char* B; size_t bE, bTile; int nN, G, c, mode;
    __device__ __forceinline__ bool next(int i, Unit& u) const {
        const int nb = __builtin_amdgcn_readfirstlane(pst[32]) >> 8; const int n1 = nb * 4, r1 = n1 % G, bdone = ((n1 / G) * G) / 4, n2a = bdone * nN, n2 = nb * nN;
        const int cv = (G % NXCD == 0) ? (c % NXCD) * (G / NXCD) + c / NXCD : c;
        long L;
        if (mode == 1) { const int nfree = r1 ? G - r1 : 0; const long E = 3L * nfree;
            if (r1 && cv >= r1) L = (i < 3) ? (long)i * nfree + (cv - r1) : E + (long)(i - 3) * G + cv; else L = E + (long)i * G + cv;
            if (L >= n2a) return false; }
        else { L = (long)n2a + (long)i * G + cv; if (L >= n2) return false; }
        const int b = (int)(L / nN), pn = (int)(L % nN); const int e = __builtin_amdgcn_readfirstlane(pst[240 + b]);
        u.pm = 0; u.pn = pn; u.z = b; u.a = A + (size_t)b * 256 * 512; u.rows = nullptr; u.b = B + (size_t)e * bE + (size_t)pn * bTile; return true; } };
}

#define XB_TMO      128
#define XB_XCNT(j)  (256  + 64 * (j))
#define XB_XSUB(j)  (1280 + 64 * (j))
#define XB_XGEN(j)  (2304 + 64 * (j))
#define XB_TOP      3328
#define XB_TOPGEN   3392
#define XCD_BAR_WORDS 3456
#define XB_SPIN_CAP (1u << 22)
__device__ __forceinline__ unsigned xb_ld(unsigned* p)              { return __hip_atomic_load(p, __ATOMIC_RELAXED, __HIP_MEMORY_SCOPE_AGENT); }
__device__ __forceinline__ unsigned xb_add(unsigned* p, unsigned v) { return __hip_atomic_fetch_add(p, v, __ATOMIC_RELAXED, __HIP_MEMORY_SCOPE_AGENT); }
__device__ __forceinline__ unsigned xb_xcc_id() { return (unsigned)__builtin_amdgcn_s_getreg((3 << 11) | 20) & 0xFu; }
#define XB_SPIN(cond, bar) do { unsigned _sp = 0; while (cond) { __builtin_amdgcn_s_sleep(1); \
    if ((++_sp & 255u) == 0u) { if (xb_ld(&(bar)[XB_TMO])) break; if (_sp > XB_SPIN_CAP) { atomicAdd(&(bar)[XB_TMO], 1u); break; } } } } while (0)
struct XcdBarrier { unsigned* bar; unsigned x; volatile LAS unsigned* st; };
__device__ __forceinline__ XcdBarrier xcd_barrier_post(unsigned* bar, volatile LAS unsigned* st) {
    XcdBarrier b; b.bar = bar; b.x = xb_xcc_id(); b.st = st;
    if (threadIdx.x == 0) (void)xb_add(&bar[XB_XCNT(b.x)], 1u);
    return b;
}
__device__ __forceinline__ void xcd_barrier_complete(unsigned* bar, unsigned x, unsigned& nloc, unsigned& nx) {
    const unsigned G = gridDim.x * gridDim.y * gridDim.z;
    unsigned sum, cnt, mine, sp = 0u;
    for (;;) {
        sum = 0u; cnt = 0u; mine = 0u;
#pragma unroll
        for (unsigned j = 0; j < 16; ++j) { const unsigned c = xb_ld(&bar[XB_XCNT(j)]); sum += c; cnt += (c > 0u) ? 1u : 0u; mine = (j == x) ? c : mine; }
        if (sum == G) break;
        __builtin_amdgcn_s_sleep(1);
        if ((++sp & 255u) == 0u) { if (xb_ld(&bar[XB_TMO])) break; if (sp > XB_SPIN_CAP) { atomicAdd(&bar[XB_TMO], 1u); break; } }
    }
    nloc = mine > 0u ? mine : 1u; nx = cnt > 0u ? cnt : 1u;
}
__device__ __forceinline__ void xcd_barrier(const XcdBarrier& b, const int tid_) {
    asm volatile("s_waitcnt vmcnt(0)" ::: "memory");
    __syncthreads();
    if (tid_ == 0) {
        unsigned* bar = b.bar;
        __builtin_amdgcn_s_waitcnt(0);
        unsigned nloc = b.st[0], nx = b.st[1];
        if (nloc == 0u) { xcd_barrier_complete(bar, b.x, nloc, nx); b.st[0] = nloc; b.st[1] = nx; }
        const unsigned old = xb_add(&bar[XB_XSUB(b.x)], 1u);
        const unsigned gen = old / nloc;
        if (old + 1u == (gen + 1u) * nloc) {
            __builtin_amdgcn_fence(__ATOMIC_RELEASE, "agent");
            asm volatile("s_waitcnt vmcnt(0)" ::: "memory");
            const unsigned og = xb_add(&bar[XB_TOP], 1u);
            const unsigned tg = og / nx;
            if (og + 1u == (tg + 1u) * nx) xb_add(&bar[XB_TOPGEN], 1u);
            else XB_SPIN(xb_ld(&bar[XB_TOPGEN]) == tg, bar);
            __builtin_amdgcn_fence(__ATOMIC_ACQUIRE, "agent");
            xb_add(&bar[XB_XGEN(b.x)], 1u);
            asm volatile("s_waitcnt vmcnt(0)" ::: "memory");
        } else {
            XB_SPIN(xb_ld(&bar[XB_XGEN(b.x)]) == gen, bar);
            __builtin_amdgcn_fence(__ATOMIC_ACQUIRE, "agent");
            asm volatile("s_waitcnt vmcnt(0)" ::: "memory");
        }
    }
    __syncthreads();
}

template <int RB> __device__ __forceinline__ int kswz(int row, int c) { return (RB == 256) ? (c ^ (row & 15)) : (c ^ ((row >> 1) & 7)); }
__device__ __forceinline__ int vswz(int d, int c) { return c ^ ((d >> 1) & 7); }
template <int BYTES> __device__ __forceinline__ void dma_tile(const unsigned char* src, LAS unsigned char* dst, int tid, int wid) {
#pragma unroll
    for (int i = 0; i < BYTES / 8192; ++i)
        __builtin_amdgcn_global_load_lds((const unsigned*)(src + (unsigned)(i * 8192 + tid * 16)), (LAS unsigned*)(dst + i * 8192 + wid * 1024), 16, 0, 0);
}
template <int DQK, int DV, int MODE>
__device__ __forceinline__ void attn_tile_compute(const LAS unsigned char* kb, const LAS unsigned char* vb, const int k0, const bool domask, const bf16x8 (&qf)[DQK / 16],
                                                  const int qpos, const LAS float* biasrow, const int lr, const int hi, f32x16 (&o)[DV / 32], float& m_run, float& l_run) {
    constexpr int RB = DQK * 2, NKS = DQK / 16, NDB = DV / 32;
            f32x16 p0, p1;
#pragma unroll
            for (int r = 0; r < 16; ++r) { p0[r] = 0.f; p1[r] = 0.f; }
#pragma unroll
            for (int ks = 0; ks < NKS; ++ks) {
                const int c = 2 * ks + hi;
                const bf16x8 kf0 = *(const LAS bf16x8*)(kb + lr * RB + kswz<RB>(lr, c) * 16);
                const bf16x8 kf1 = *(const LAS bf16x8*)(kb + (lr + 32) * RB + kswz<RB>(lr + 32, c) * 16);
                p0 = __builtin_amdgcn_mfma_f32_32x32x16_bf16(kf0, qf[ks], p0, 0, 0, 0);
                p1 = __builtin_amdgcn_mfma_f32_32x32x16_bf16(kf1, qf[ks], p1, 0, 0, 0);
            }
            if (domask) {
                const float NEG = -__builtin_inff();
#pragma unroll
                for (int r = 0; r < 16; ++r) {
                    const int key0 = k0 + (r & 3) + 8 * (r >> 2) + 4 * hi, key1 = key0 + 32;
                    if (MODE == 0) { if (key0 > qpos) p0[r] = NEG; if (key1 > qpos) p1[r] = NEG; }
                    if (MODE == 1) { const int d0 = qpos - key0, d1 = qpos - key1;
                        p0[r] = ((unsigned)d0 < 128u) ? p0[r] + biasrow[d0 & 127] : NEG;
                        p1[r] = ((unsigned)d1 < 128u) ? p1[r] + biasrow[d1 & 127] : NEG; }
                }
            }
            float mx = p0[0];
#pragma unroll
            for (int r = 1; r < 16; ++r) mx = fmaxf(mx, p0[r]);
#pragma unroll
            for (int r = 0; r < 16; ++r) mx = fmaxf(mx, p1[r]);
            { auto rr = __builtin_amdgcn_permlane32_swap(__float_as_uint(mx), __float_as_uint(mx), false, false); mx = fmaxf(__uint_as_float(rr[0]), __uint_as_float(rr[1])); }
            const float mn = fmaxf(m_run, mx), alpha = fast_exp2(m_run - mn);
            m_run = mn;
            float ps = 0.f;
#pragma unroll
            for (int r = 0; r < 16; ++r) { p0[r] = fast_exp2(p0[r] - mn); p1[r] = fast_exp2(p1[r] - mn); ps += p0[r] + p1[r]; }
            l_run = l_run * alpha + ps;
            if (!__all(alpha == 1.f)) {
#pragma unroll
                for (int db = 0; db < NDB; ++db)
#pragma unroll
                    for (int r = 0; r < 16; ++r) o[db][r] *= alpha;
            }
            bf16x8 pf[4];
#pragma unroll
            for (int s = 0; s < 4; ++s) {
                const int r0 = 8 * (s & 1);
                unsigned a01, a23, b45, b67;
                if (s < 2) { a01 = cvt_pk_bf16(p0[r0 + 0], p0[r0 + 1]); a23 = cvt_pk_bf16(p0[r0 + 2], p0[r0 + 3]); b45 = cvt_pk_bf16(p0[r0 + 4], p0[r0 + 5]); b67 = cvt_pk_bf16(p0[r0 + 6], p0[r0 + 7]); }
                else       { a01 = cvt_pk_bf16(p1[r0 + 0], p1[r0 + 1]); a23 = cvt_pk_bf16(p1[r0 + 2], p1[r0 + 3]); b45 = cvt_pk_bf16(p1[r0 + 4], p1[r0 + 5]); b67 = cvt_pk_bf16(p1[r0 + 6], p1[r0 + 7]); }
                auto s0 = __builtin_amdgcn_permlane32_swap(a01, b45, false, false);
                auto s1 = __builtin_amdgcn_permlane32_swap(a23, b67, false, false);
                u32x4 w; w.x = s0[0]; w.y = s1[0]; w.z = s0[1]; w.w = s1[1];
                pf[s] = __builtin_bit_cast(bf16x8, w);
            }
#pragma unroll
            for (int db = 0; db < NDB; ++db) {
                const int d = 32 * db + lr;
#pragma unroll
                for (int s = 0; s < 4; ++s) {
                    const bf16x8 vf = *(const LAS bf16x8*)(vb + d * 128 + vswz(d, 2 * s + hi) * 16);
                    o[db] = __builtin_amdgcn_mfma_f32_32x32x16_bf16(vf, pf[s], o[db], 0, 0, 0);
                }
            }
        }
template <int DQK, int DV, int MODE>
__device__ __forceinline__ void attn_tiles(const int tid_in, LAS unsigned char* lds, const unsigned char* gK, const unsigned char* gV, int t_lo, int t_hi,
                                           const bf16x8 (&qf)[DQK / 16], int qpos, int wave_q0, const LAS float* biasrow,
                                           f32x16 (&o)[DV / 32], float& m_run, float& l_run) {
    constexpr int KT = 64 * DQK * 2, VT = DV * 128, BUF = KT + VT;
    int tid = tid_in; asm volatile("" : "+v"(tid));
    const int wid = __builtin_amdgcn_readfirstlane(tid >> 6), lane = tid & 63, lr = lane & 31, hi = lane >> 5;
    dma_tile<KT>(gK + (size_t)t_lo * KT, lds, tid, wid); dma_tile<VT>(gV + (size_t)t_lo * VT, lds + KT, tid, wid);
    VM_WAIT(); __syncthreads();
#pragma unroll 1
    for (int t = t_lo; t < t_hi; ++t) {
        const int cur = (t - t_lo) & 1;
        LAS unsigned char* kb = lds + cur * BUF; LAS unsigned char* vb = kb + KT;
        if (t + 1 < t_hi) { LAS unsigned char* nb = lds + (cur ^ 1) * BUF; dma_tile<KT>(gK + (size_t)(t + 1) * KT, nb, tid, wid); dma_tile<VT>(gV + (size_t)(t + 1) * VT, nb + KT, tid, wid); }
        const int k0 = t * 64;
        bool need = true, domask = false;
        if (MODE == 0) { need = (k0 <= wave_q0 + 31); domask = (k0 + 63 > wave_q0); }
        if (MODE == 1) { need = (k0 <= wave_q0 + 31) && (k0 + 63 >= wave_q0 - 127); domask = true; }
        if (need) attn_tile_compute<DQK, DV, MODE>(kb, vb, k0, domask, qf, qpos, biasrow, lr, hi, o, m_run, l_run);
        VM_WAIT(); __syncthreads();
    }
}
#define MLA_KLD(KB, ks, F0, F1) do { const int c_ = 2 * (ks) + hi; \
        F0 = *(const LAS bf16x8*)((KB) + lr * 384 + kswz<384>(lr, c_) * 16); \
        F1 = *(const LAS bf16x8*)((KB) + (lr + 32) * 384 + kswz<384>(lr + 32, c_) * 16); } while (0)
#define MLA_QK(KB, P0, P1) do { _Pragma("unroll") for (int r = 0; r < 16; ++r) { P0[r] = 0.f; P1[r] = 0.f; } \
    bf16x8 ka_[3], kb_[3]; MLA_KLD(KB, 0, ka_[0], kb_[0]); MLA_KLD(KB, 1, ka_[1], kb_[1]); \
    _Pragma("unroll") for (int ks = 0; ks < 12; ++ks) { \
        if (ks + 2 < 12) MLA_KLD(KB, ks + 2, ka_[(ks + 2) % 3], kb_[(ks + 2) % 3]); \
        __builtin_amdgcn_sched_barrier(0); \
        P0 = __builtin_amdgcn_mfma_f32_32x32x16_bf16(ka_[ks % 3], qf[ks], P0, 0, 0, 0); \
        P1 = __builtin_amdgcn_mfma_f32_32x32x16_bf16(kb_[ks % 3], qf[ks], P1, 0, 0, 0); } } while (0)
__device__ __forceinline__ void mla_softmax(f32x16& p0, f32x16& p1, const bool domask, const int k0, const int qpos, const int hi, f32x16 (&o)[4], float& m_run, float& l_run, bf16x8 (&pf)[4]) {
    if (domask) {
        const float NEG = -__builtin_inff();
#pragma unroll
        for (int r = 0; r < 16; ++r) { const int key0 = k0 + (r & 3) + 8 * (r >> 2) + 4 * hi; if (key0 > qpos) p0[r] = NEG; if (key0 + 32 > qpos) p1[r] = NEG; }
    }
    float mx = p0[0];
#pragma unroll
    for (int r = 1; r < 16; ++r) mx = fmaxf(mx, p0[r]);
#pragma unroll
    for (int r = 0; r < 16; ++r) mx = fmaxf(mx, p1[r]);
    { auto rr = __builtin_amdgcn_permlane32_swap(__float_as_uint(mx), __float_as_uint(mx), false, false); mx = fmaxf(__uint_as_float(rr[0]), __uint_as_float(rr[1])); }
    float mn = m_run, alpha = 1.f;
    if (!__all(mx - m_run <= 8.f)) { mn = fmaxf(m_run, mx); alpha = fast_exp2(m_run - mn); m_run = mn;
#pragma unroll
        for (int db = 0; db < 4; ++db)
#pragma unroll
            for (int r = 0; r < 16; ++r) o[db][r] *= alpha; }
    float ps = 0.f;
#pragma unroll
    for (int r = 0; r < 16; ++r) { p0[r] = fast_exp2(p0[r] - mn); p1[r] = fast_exp2(p1[r] - mn); ps += p0[r] + p1[r]; }
    l_run = l_run * alpha + ps;
#pragma unroll
    for (int s = 0; s < 4; ++s) {
        const int r0 = 8 * (s & 1);
        unsigned a01, a23, b45, b67;
        if (s < 2) { a01 = cvt_pk_bf16(p0[r0 + 0], p0[r0 + 1]); a23 = cvt_pk_bf16(p0[r0 + 2], p0[r0 + 3]); b45 = cvt_pk_bf16(p0[r0 + 4], p0[r0 + 5]); b67 = cvt_pk_bf16(p0[r0 + 6], p0[r0 + 7]); }
        else       { a01 = cvt_pk_bf16(p1[r0 + 0], p1[r0 + 1]); a23 = cvt_pk_bf16(p1[r0 + 2], p1[r0 + 3]); b45 = cvt_pk_bf16(p1[r0 + 4], p1[r0 + 5]); b67 = cvt_pk_bf16(p1[r0 + 6], p1[r0 + 7]); }
        auto s0 = __builtin_amdgcn_permlane32_swap(a01, b45, false, false);
        auto s1 = __builtin_amdgcn_permlane32_swap(a23, b67, false, false);
        u32x4 w; w.x = s0[0]; w.y = s1[0]; w.z = s0[1]; w.w = s1[1];
        pf[s] = __builtin_bit_cast(bf16x8, w);
    }
}
__device__ __forceinline__ void mla_pv(const bf16x8 (&pf)[4], const LAS unsigned char* vb, const int lr, const int hi, f32x16 (&o)[4]) {
    bf16x8 vf[2][4];
#pragma unroll
    for (int s = 0; s < 4; ++s) vf[0][s] = *(const LAS bf16x8*)(vb + lr * 128 + vswz(lr, 2 * s + hi) * 16);
#pragma unroll
    for (int db = 0; db < 4; ++db) {
        if (db + 1 < 4) { const int d = 32 * (db + 1) + lr;
#pragma unroll
            for (int s = 0; s < 4; ++s) vf[(db + 1) & 1][s] = *(const LAS bf16x8*)(vb + d * 128 + vswz(d, 2 * s + hi) * 16); }
        __builtin_amdgcn_sched_barrier(0);
#pragma unroll
        for (int s = 0; s < 4; ++s) o[db] = __builtin_amdgcn_mfma_f32_32x32x16_bf16(vf[db & 1][s], pf[s], o[db], 0, 0, 0);
    }
}
typedef long i64x2 __attribute__((ext_vector_type(2)));
__host__ __device__ __forceinline__ int f8pos(int k) { return (k & ~31) | (((k >> 3) & 1) << 4) | (((k >> 4) & 1) << 3) | (k & 7); }
#define F8_KLD(KB, m, F0, F1) do { const int c_ = (2 * (m) + hi) ^ ((lr >> 2) & 3); \
        F0 = *(const LAS i64x2*)((KB) + lr * 192 + c_ * 16); F1 = *(const LAS i64x2*)((KB) + (lr + 32) * 192 + c_ * 16); } while (0)
#define F8_QK(KB, P0, P1) do { _Pragma("unroll") for (int r = 0; r < 16; ++r) { P0[r] = 0.f; P1[r] = 0.f; } \
    i64x2 ka_[3], kb_[3]; F8_KLD(KB, 0, ka_[0], kb_[0]); F8_KLD(KB, 1, ka_[1], kb_[1]); \
    _Pragma("unroll") for (int m = 0; m < 6; ++m) { \
        if (m + 2 < 6) F8_KLD(KB, m + 2, ka_[(m + 2) % 3], kb_[(m + 2) % 3]); \
        __builtin_amdgcn_sched_barrier(0); \
        P0 = __builtin_amdgcn_mfma_f32_32x32x16_fp8_fp8(ka_[m % 3].x, qf[m].x, P0, 0, 0, 0); \
        P1 = __builtin_amdgcn_mfma_f32_32x32x16_fp8_fp8(kb_[m % 3].x, qf[m].x, P1, 0, 0, 0); \
        P0 = __builtin_amdgcn_mfma_f32_32x32x16_fp8_fp8(ka_[m % 3].y, qf[m].y, P0, 0, 0, 0); \
        P1 = __builtin_amdgcn_mfma_f32_32x32x16_fp8_fp8(kb_[m % 3].y, qf[m].y, P1, 0, 0, 0); } } while (0)
__device__ __forceinline__ void f8_softmax(f32x16& p0, f32x16& p1, const bool domask, const int k0, const int qpos, const int hi, f32x16 (&o)[4], float& m_run, float& l_run, long (&pf)[4]) {
    constexpr float C = 0.07216878364870322f * LOG2E;
    if (domask) {
        const float NEG = -__builtin_inff();
#pragma unroll
        for (int r = 0; r < 16; ++r) { const int key0 = k0 + (r & 3) + 8 * (r >> 2) + 4 * hi; if (key0 > qpos) p0[r] = NEG; if (key0 + 32 > qpos) p1[r] = NEG; }
    }
    float mx = p0[0];
#pragma unroll
    for (int r = 1; r < 16; ++r) mx = fmaxf(mx, p0[r]);
#pragma unroll
    for (int r = 0; r < 16; ++r) mx = fmaxf(mx, p1[r]);
    { auto rr = __builtin_amdgcn_permlane32_swap(__float_as_uint(mx), __float_as_uint(mx), false, false); mx = fmaxf(__uint_as_float(rr[0]), __uint_as_float(rr[1])); }
    mx *= C;
    float mn = m_run, alpha = 1.f;
    if (!__all(mx - m_run <= 8.f)) { mn = fmaxf(m_run, mx); alpha = fast_exp2(m_run - mn); m_run = mn;
#pragma unroll
        for (int db = 0; db < 4; ++db)
#pragma unroll
            for (int r = 0; r < 16; ++r) o[db][r] *= alpha; }
    float ps = 0.f;
#pragma unroll
    for (int r = 0; r < 16; ++r) { p0[r] = fast_exp2(p0[r] * C - mn); p1[r] = fast_exp2(p1[r] * C - mn); ps += p0[r] + p1[r]; }
    l_run = l_run * alpha + ps;
#pragma unroll
    for (int s = 0; s < 4; ++s) {
        const int r0 = 8 * (s & 1);
        unsigned a, b;
        if (s < 2) { a = pk4_fp8(p0[r0 + 0], p0[r0 + 1], p0[r0 + 2], p0[r0 + 3]); b = pk4_fp8(p0[r0 + 4], p0[r0 + 5], p0[r0 + 6], p0[r0 + 7]); }
        else       { a = pk4_fp8(p1[r0 + 0], p1[r0 + 1], p1[r0 + 2], p1[r0 + 3]); b = pk4_fp8(p1[r0 + 4], p1[r0 + 5], p1[r0 + 6], p1[r0 + 7]); }
        auto sw = __builtin_amdgcn_permlane32_swap(a, b, false, false);
        pf[s] = (long)(((unsigned long long)sw[1] << 32) | (unsigned long long)sw[0]);
    }
}
__device__ __forceinline__ void f8_pv(const long (&pf)[4], const LAS unsigned char* vb, const int lr, const int hi, f32x16 (&o)[4]) {
    i64x2 vf[2][2];
#pragma unroll
    for (int m = 0; m < 2; ++m) vf[0][m] = *(const LAS i64x2*)(vb + lr * 64 + (((2 * m + hi) ^ ((lr >> 2) & 3)) << 4));
#pragma unroll
    for (int db = 0; db < 4; ++db) {
        if (db + 1 < 4) { const int d = 32 * (db + 1) + lr;
#pragma unroll
            for (int m = 0; m < 2; ++m) vf[(db + 1) & 1][m] = *(const LAS i64x2*)(vb + d * 64 + (((2 * m + hi) ^ ((d >> 2) & 3)) << 4)); }
        __builtin_amdgcn_sched_barrier(0);
#pragma unroll
        for (int m = 0; m < 2; ++m) { o[db] = __builtin_amdgcn_mfma_f32_32x32x16_fp8_fp8(vf[db & 1][m].x, pf[2 * m], o[db], 0, 0, 0);
                                      o[db] = __builtin_amdgcn_mfma_f32_32x32x16_fp8_fp8(vf[db & 1][m].y, pf[2 * m + 1], o[db], 0, 0, 0); }
    }
}
__device__ __forceinline__ void attn_mla_f8(const int tid_in, LAS unsigned char* lds, const unsigned char* gK, const unsigned char* gV, const int t_lo, const int t_hi,
                                            const i64x2 (&qf)[6], const int qpos, const int wave_q0, f32x16 (&o)[4], float& m_run, float& l_run) {
    constexpr int KT = 12288, VT = 8192;
    int tid = tid_in; asm volatile("" : "+v"(tid));
    const int wid = __builtin_amdgcn_readfirstlane(tid >> 6), lane = tid & 63, lr0 = lane & 31, hi = lane >> 5;
    const bool halfB = wid >= 4;
    LAS unsigned char* KB0 = lds; LAS unsigned char* VB0 = lds + 2 * KT;
#define F8_DMA(T, KDST, VDST) do { const unsigned char* ks_ = gK + (size_t)(T) * KT; \
        __builtin_amdgcn_global_load_lds((const unsigned*)(ks_ + (unsigned)(tid * 16)), (LAS unsigned*)((KDST) + wid * 1024), 16, 0, 0); \
        if (wid < 4) __builtin_amdgcn_global_load_lds((const unsigned*)(ks_ + 8192 + (unsigned)(tid * 16)), (LAS unsigned*)((KDST) + 8192 + wid * 1024), 16, 0, 0); \
        __builtin_amdgcn_global_load_lds((const unsigned*)(gV + (size_t)(T) * VT + (unsigned)(tid * 16)), (LAS unsigned*)((VDST) + wid * 1024), 16, 0, 0); } while (0)
    F8_DMA(t_lo, KB0, VB0);
    VM_WAIT(); __syncthreads();
    if (!halfB) {
        int vcur = 0;
#pragma unroll 1
        for (int t = t_lo; t <= t_hi; ++t) {
            const int j = t - t_lo, vnext = (vcur == 2) ? 0 : vcur + 1;
            if (t + 1 < t_hi) F8_DMA(t + 1, KB0 + ((j + 1) & 1) * KT, VB0 + vnext * VT);
            const int k0 = t * 64;
            int lr = lr0; asm volatile("" : "+v"(lr));
            if ((t < t_hi) && (k0 <= wave_q0 + 31)) { f32x16 p0, p1; long pf[4]; const LAS unsigned char* kb = KB0 + (j & 1) * KT;
                F8_QK(kb, p0, p1); f8_softmax(p0, p1, k0 + 63 > wave_q0, k0, qpos, hi, o, m_run, l_run, pf); f8_pv(pf, VB0 + vcur * VT, lr, hi, o); }
            vcur = vnext;
            VM_WAIT(); __syncthreads();
        }
    } else {
        long pf[4] = {0, 0, 0, 0};
        int vcur = 0, vprev = 2;
#pragma unroll 1
        for (int t = t_lo; t <= t_hi; ++t) {
            const int j = t - t_lo, vnext = (vcur == 2) ? 0 : vcur + 1;
            if (t + 1 < t_hi) F8_DMA(t + 1, KB0 + ((j + 1) & 1) * KT, VB0 + vnext * VT);
            const int k0 = t * 64;
            int lr = lr0; asm volatile("" : "+v"(lr));
            if ((j > 0) && (k0 - 64 <= wave_q0 + 31)) f8_pv(pf, VB0 + vprev * VT, lr, hi, o);
            if ((t < t_hi) && (k0 <= wave_q0 + 31)) { f32x16 p0, p1; const LAS unsigned char* kb = KB0 + (j & 1) * KT;
                F8_QK(kb, p0, p1); f8_softmax(p0, p1, k0 + 63 > wave_q0, k0, qpos, hi, o, m_run, l_run, pf); }
            vprev = vcur; vcur = vnext;
            VM_WAIT(); __syncthreads();
        }
    }
#undef F8_DMA
}
__device__ __forceinline__ void attn_mla_stag(const int tid_in, LAS unsigned char* lds, const unsigned char* gK, const unsigned char* gV, const int t_lo, const int t_hi,
                                              const bf16x8 (&qf)[12], const int qpos, const int wave_q0, f32x16 (&o)[4], float& m_run, float& l_run) {
    constexpr int KT = 24576, VT = 16384;
    int tid = tid_in; asm volatile("" : "+v"(tid));
    const int wid = __builtin_amdgcn_readfirstlane(tid >> 6), lane = tid & 63, lr0 = lane & 31, hi = lane >> 5;
    const bool halfB = wid >= 4;
    LAS unsigned char* KB0 = lds; LAS unsigned char* VB0 = lds + 2 * KT;
    dma_tile<KT>(gK + (size_t)t_lo * KT, KB0, tid, wid); dma_tile<VT>(gV + (size_t)t_lo * VT, VB0, tid, wid);
    VM_WAIT(); __syncthreads();
    if (!halfB) {
        int vcur = 0;
#pragma unroll 1
        for (int t = t_lo; t <= t_hi; ++t) {
            const int j = t - t_lo, vnext = (vcur == 2) ? 0 : vcur + 1;
            if (t + 1 < t_hi) { dma_tile<KT>(gK + (size_t)(t + 1) * KT, KB0 + ((j + 1) & 1) * KT, tid, wid); dma_tile<VT>(gV + (size_t)(t + 1) * VT, VB0 + vnext * VT, tid, wid); }
            const int k0 = t * 64;
            int lr = lr0; asm volatile("" : "+v"(lr));
            if ((t < t_hi) && (k0 <= wave_q0 + 31)) { f32x16 p0, p1; bf16x8 pf[4]; const LAS unsigned char* kb = KB0 + (j & 1) * KT;
                MLA_QK(kb, p0, p1); mla_softmax(p0, p1, k0 + 63 > wave_q0, k0, qpos, hi, o, m_run, l_run, pf); mla_pv(pf, VB0 + vcur * VT, lr, hi, o); }
            vcur = vnext;
            VM_WAIT(); __syncthreads();
        }
    } else {
        bf16x8 pf[4];
#pragma unroll
        for (int s = 0; s < 4; ++s) pf[s] = (bf16x8){0, 0, 0, 0, 0, 0, 0, 0};
        int vcur = 0, vprev = 2;
#pragma unroll 1
        for (int t = t_lo; t <= t_hi; ++t) {
            const int j = t - t_lo, vnext = (vcur == 2) ? 0 : vcur + 1;
            if (t + 1 < t_hi) { dma_tile<KT>(gK + (size_t)(t + 1) * KT, KB0 + ((j + 1) & 1) * KT, tid, wid); dma_tile<VT>(gV + (size_t)(t + 1) * VT, VB0 + vnext * VT, tid, wid); }
            const int k0 = t * 64;
            int lr = lr0; asm volatile("" : "+v"(lr));
            if ((j > 0) && (k0 - 64 <= wave_q0 + 31)) mla_pv(pf, VB0 + vprev * VT, lr, hi, o);
            if ((t < t_hi) && (k0 <= wave_q0 + 31)) { f32x16 p0, p1; const LAS unsigned char* kb = KB0 + (j & 1) * KT;
                MLA_QK(kb, p0, p1); mla_softmax(p0, p1, k0 + 63 > wave_q0, k0, qpos, hi, o, m_run, l_run, pf); }
            vprev = vcur; vcur = vnext;
            VM_WAIT(); __syncthreads();
        }
    }
}
template <int DQK> __device__ __forceinline__ void load_q_norm(const bf16_t* qrow, const float* gain, float scale, int hi, bf16x8 (&qf)[DQK / 16]) {
    float x[DQK / 16][8]; float ss = 0.f;
#pragma unroll
    for (int ks = 0; ks < DQK / 16; ++ks) { const u32x4 w = *(const u32x4*)(qrow + 16 * ks + 8 * hi); unpack8(w, x[ks]);
#pragma unroll
        for (int j = 0; j < 8; ++j) ss += x[ks][j] * x[ks][j]; }
    { auto rr = __builtin_amdgcn_permlane32_swap(__float_as_uint(ss), __float_as_uint(ss), false, false); ss = __uint_as_float(rr[0]) + __uint_as_float(rr[1]); }
    const float rs = rsqrtf(ss * (1.0f / DQK) + EPS) * scale;
#pragma unroll
    for (int ks = 0; ks < DQK / 16; ++ks) { float y[8];
#pragma unroll
        for (int j = 0; j < 8; ++j) y[j] = x[ks][j] * rs * gain[16 * ks + 8 * hi + j];
        qf[ks] = __builtin_bit_cast(bf16x8, pack8(y)); }
}
template <int DQK> __device__ __forceinline__ void load_q_norm_bf16x2(const bf16_t* qa, const bf16_t* qb_, const float* gain, float scale, int hi, bf16x8 (&qf)[DQK / 16]) {
    float x[DQK / 16][8]; float ss = 0.f;
#pragma unroll
    for (int ks = 0; ks < DQK / 16; ++ks) { float a[8], b[8]; unpack8(*(const u32x4*)(qa + 16 * ks + 8 * hi), a); unpack8(*(const u32x4*)(qb_ + 16 * ks + 8 * hi), b);
#pragma unroll
        for (int j = 0; j < 8; ++j) { x[ks][j] = a[j] + b[j]; ss += x[ks][j] * x[ks][j]; } }
    { auto rr = __builtin_amdgcn_permlane32_swap(__float_as_uint(ss), __float_as_uint(ss), false, false); ss = __uint_as_float(rr[0]) + __uint_as_float(rr[1]); }
    const float rs = rsqrtf(ss * (1.0f / DQK) + EPS) * scale;
#pragma unroll
    for (int ks = 0; ks < DQK / 16; ++ks) { float y[8];
#pragma unroll
        for (int j = 0; j < 8; ++j) y[j] = x[ks][j] * rs * gain[16 * ks + 8 * hi + j];
        qf[ks] = __builtin_bit_cast(bf16x8, pack8(y)); }
}
template <int DQK> __device__ __forceinline__ void load_q_norm_bf16x4(const bf16_t* q0, const size_t zs, const float* gain, float scale, int hi, bf16x8 (&qf)[DQK / 16]) {
    float x[DQK / 16][8]; float ss = 0.f;
#pragma unroll
    for (int ks = 0; ks < DQK / 16; ++ks) {
#pragma unroll
        for (int j = 0; j < 8; ++j) x[ks][j] = 0.f;
#pragma unroll
        for (int z = 0; z < 4; ++z) { float a[8]; unpack8(*(const u32x4*)(q0 + z * zs + 16 * ks + 8 * hi), a);
#pragma unroll
            for (int j = 0; j < 8; ++j) x[ks][j] += a[j]; }
#pragma unroll
        for (int j = 0; j < 8; ++j) ss += x[ks][j] * x[ks][j]; }
    { auto rr = __builtin_amdgcn_permlane32_swap(__float_as_uint(ss), __float_as_uint(ss), false, false); ss = __uint_as_float(rr[0]) + __uint_as_float(rr[1]); }
    const float rs = rsqrtf(ss * (1.0f / DQK) + EPS) * scale;
#pragma unroll
    for (int ks = 0; ks < DQK / 16; ++ks) { float y[8];
#pragma unroll
        for (int j = 0; j < 8; ++j) y[j] = x[ks][j] * rs * gain[16 * ks + 8 * hi + j];
        qf[ks] = __builtin_bit_cast(bf16x8, pack8(y)); }
}
template <int DV> __device__ __forceinline__ void store_o(bf16_t* orow, const f32x16 (&o)[DV / 32], float inv_l, int hi) {
#pragma unroll
    for (int db = 0; db < DV / 32; ++db)
#pragma unroll
        for (int r4 = 0; r4 < 4; ++r4) { u32x2 w; w.x = cvt_pk_bf16(o[db][4 * r4] * inv_l, o[db][4 * r4 + 1] * inv_l); w.y = cvt_pk_bf16(o[db][4 * r4 + 2] * inv_l, o[db][4 * r4 + 3] * inv_l);
            *(u32x2*)(orow + 32 * db + 8 * r4 + 4 * hi) = w; }
}

struct Args { const float* in[50]; float* out; unsigned char* ws; int l_lo, l_hi, ph_lo, ph_hi; };
enum { I_X = 0, I_MEM, I_RELB, I_LNMIX, I_WIN, I_SWAQG, I_SWAKG, I_SINK, I_DWW, I_DWB, I_CLNG, I_CLNB, I_PWW, I_PWB, I_QAG, I_KVAG, I_WQB, I_WKVB, I_QNN, I_QNR, I_KNN, I_KNR,
       I_ARE, I_AIM, I_LOGDT, I_BRE, I_BIM, I_CRE, I_CIM, I_SSMD, I_GLUW, I_GLUB, I_MIXG, I_WOUT, I_LNX, I_MEMG, I_XWQ, I_XWK, I_XWV, I_XQG, I_XKG, I_XWO, I_LNMOE, I_WG, I_BG, I_WE, I_BE, I_MG, I_MU, I_MD };
constexpr int NPH = 19;

__constant__ unsigned char T5_BUCKET[128] = {0,1,2,3,4,5,6,7,8,9,10,11,12,13,14,15,16,16,16,17,17,18,18,18,19,19,19,20,20,20,20,21,21,21,21,22,22,22,22,22,23,23,23,23,23,23,24,24,24,24,24,24,25,25,25,25,25,25,25,26,26,26,26,26,26,26,26,27,27,27,27,27,27,27,27,27,27,28,28,28,28,28,28,28,28,28,28,29,29,29,29,29,29,29,29,29,29,29,29,30,30,30,30,30,30,30,30,30,30,30,30,30,30,31,31,31,31,31,31,31,31,31,31,31,31,31,31,31};

__device__ __forceinline__ void tr_item(const float* W, int ldw, int k0, int n0, bf16_t* WT, int ldt, int drow0, const float* kgain, LAS float* scr, int lane) {
    float tv[32];
#pragma unroll
    for (int i = 0; i < 32; ++i) { const int kk = 2 * i + (lane >> 5); tv[i] = W[(size_t)(k0 + kk) * ldw + n0 + (lane & 31)]; }
#pragma unroll
    for (int i = 0; i < 32; ++i) { const int kk = 2 * i + (lane >> 5); float v = tv[i]; if (kgain) v *= kgain[k0 + kk]; scr[kk * 33 + (lane & 31)] = v; }
    LDS_WAIT();
    const int c = lane & 7;
#pragma unroll
    for (int j = 0; j < 4; ++j) { const int n = (lane >> 3) + 8 * j; const LAS float* s = scr + (8 * c) * 33 + n;
        u32x4 o; o.x = cvt_pk_bf16(s[0 * 33], s[1 * 33]); o.y = cvt_pk_bf16(s[2 * 33], s[3 * 33]); o.z = cvt_pk_bf16(s[4 * 33], s[5 * 33]); o.w = cvt_pk_bf16(s[6 * 33], s[7 * 33]);
        *(u32x4*)(WT + (size_t)(drow0 + n) * ldt + k0 + 8 * c) = o; }
    LDS_WAIT();
}
__device__ __forceinline__ void tr_item8(const float* W, int ldw, int k0, int n0, unsigned char* WT8, int ldt, int drow0, const float* kgain, LAS float* scr, int lane) {
    float tv[32];
#pragma unroll
    for (int i = 0; i < 32; ++i) { const int kk = 2 * i + (lane >> 5); tv[i] = W[(size_t)(k0 + kk) * ldw + n0 + (lane & 31)]; }
#pragma unroll
    for (int i = 0; i < 32; ++i) { const int kk = 2 * i + (lane >> 5); float v = tv[i] * 32.0f; if (kgain) v *= kgain[k0 + kk]; scr[kk * 33 + (lane & 31)] = v; }
    LDS_WAIT();
    const int c = lane & 7;
#pragma unroll
    for (int j = 0; j < 4; ++j) { const int n = (lane >> 3) + 8 * j; const LAS float* s = scr + (8 * c) * 33 + n;
        *(u32x2*)(WT8 + (size_t)(drow0 + n) * ldt + k0 + 8 * c) = (u32x2){pk4_fp8(s[0 * 33], s[1 * 33], s[2 * 33], s[3 * 33]), pk4_fp8(s[4 * 33], s[5 * 33], s[6 * 33], s[7 * 33])}; }
    LDS_WAIT();
}
__device__ __forceinline__ void rms_row_store(const f32x4 (&v)[8], const float* gain, bf16_t* orow, int lane) {
    float ss = 0.f;
#pragma unroll
    for (int j = 0; j < 8; ++j) ss += (v[j].x * v[j].x + v[j].y * v[j].y) + (v[j].z * v[j].z + v[j].w * v[j].w);
    const float rs = rsqrtf(wave_sum(ss) * (1.0f / D) + EPS);
#pragma unroll
    for (int j = 0; j < 8; ++j) { const f32x4 g = *(const f32x4*)(gain + 4 * lane + 256 * j); u32x2 w; w.x = cvt_pk_bf16(v[j].x * rs * g.x, v[j].y * rs * g.y); w.y = cvt_pk_bf16(v[j].z * rs * g.z, v[j].w * rs * g.w);
        *(u32x2*)(orow + 4 * lane + 256 * j) = w; }
}
__device__ __forceinline__ f32x2 cmul(f32x2 a, f32x2 b) { return (f32x2){a.x * b.x - a.y * b.y, a.x * b.y + a.y * b.x}; }
__device__ __forceinline__ void sincos_rev(float x, float& s, float& c) { float r = x * 0.15915494309189535f; r -= rintf(r); s = __builtin_amdgcn_sinf(r); c = __builtin_amdgcn_cosf(r); }

#define X ((float*)out_)
#define ROPE ((float*)(ws + WS_ROPE))
#define H ((bf16_t*)(ws + WS_H))
#define P ((bf16_t*)(ws + WS_P))
#define O ((bf16_t*)(ws + WS_O))
#define QRAW ((bf16_t*)(ws + WS_QRAW))
#define KVRAW ((bf16_t*)(ws + WS_KVRAW))
#define Q ((bf16_t*)(ws + WS_Q))
#define KIMG ((unsigned char*)(ws + WS_KIMG))
#define VIMG ((unsigned char*)(ws + WS_VIMG))
#define SWAK ((unsigned char*)(ws + WS_SWAK))
#define SWAV ((unsigned char*)(ws + WS_SWAV))
#define ZC ((bf16_t*)(ws + WS_ZC))
#define UA ((bf16_t*)(ws + WS_UA))
#define EBUF ((float*)(ws + WS_EBUF))
#define YG ((bf16_t*)(ws + WS_YG))
#define QX ((bf16_t*)(ws + WS_QX))
#define OX ((bf16_t*)(ws + WS_OX))
#define MEMN ((bf16_t*)(ws + WS_MEMN))
#define KMEM ((bf16_t*)(ws + WS_KMEM))
#define VMEM ((bf16_t*)(ws + WS_VMEM))
#define XKIMG ((unsigned char*)(ws + WS_XKIMG))
#define XVIMG ((unsigned char*)(ws + WS_XVIMG))
#define LOGI ((float*)(ws + WS_LOG))
#define TOK ((int*)(ws + WS_TOK))
#define WSLOT ((float*)(ws + WS_WSLOT))
#define HID ((bf16_t*)(ws + WS_HID))
#define YS8 ((unsigned char*)(ws + WS_YS))
#define WIN ((bf16_t*)(ws + WS_WIN))
#define WOUT ((bf16_t*)(ws + WS_WOUT))
#define XWQ ((bf16_t*)(ws + WS_XWQ))
#define XWK ((bf16_t*)(ws + WS_XWK))
#define XWV ((bf16_t*)(ws + WS_XWV))
#define XWO ((bf16_t*)(ws + WS_XWO))
#define PW ((bf16_t*)(ws + WS_PW))
#define WQB ((bf16_t*)(ws + WS_WQB))
#define WKVB ((bf16_t*)(ws + WS_WKVB))
#define GLU ((bf16_t*)(ws + WS_GLU))
#define ROUT ((bf16_t*)(ws + WS_ROUT))
#define MOE1 ((bf16_t*)(ws + WS_MOE1))
#define MOE2 ((bf16_t*)(ws + WS_MOE2))
#define W1G ((bf16_t*)(ws + WS_W1G))
#define BTY ((bf16_t*)(ws + WS_BTY))
#define PARTO ((float*)(ws + WS_PARTO))
#define XB ((bf16_t*)(ws + WS_XB))
#define QXP ((float*)(ws + WS_QXP))
#define LOGP ((float*)(ws + WS_LOGP))
#define SSP ((float*)(ws + WS_SSP))
#define RMSV ((float*)(ws + WS_RMSV))
#define RMS1 ((float*)(ws + WS_RMS1))
#define XF8 ((unsigned char*)(ws + WS_XF8))
#define KCG ((float*)(ws + WS_H + 16 * MiB))
#define PQ7 ((bf16_t*)(ws + WS_H))
#define HID8 ((unsigned char*)(ws + WS_HID))
#define MOE1F ((unsigned char*)(ws + WS_MOE1))
#define MOE2F ((unsigned char*)(ws + WS_MOE2))
#define PARTML ((float*)(ws + WS_PARTML))
#define REC_E ((int*)(ws + WS_REC))
#define REC_R (REC_E + 2 * S)
#define REC_W ((float*)(REC_E + 4 * S))
#define REC_S (REC_E + 6 * S)
__device__ __forceinline__ unsigned long long ldp(const LAS unsigned* pt, int i) { unsigned lo = pt[2 * i], hi = pt[2 * i + 1]; lo = __builtin_amdgcn_readfirstlane(lo); hi = __builtin_amdgcn_readfirstlane(hi); return ((unsigned long long)hi << 32) | lo; }
#define INP(i) ((const float*)(const GAS float*)ldp(PT, (i)))
#define FRESH() int tid = (wave_s << 6) + (int)__builtin_amdgcn_mbcnt_hi(~0u, __builtin_amdgcn_mbcnt_lo(~0u, 0u)), G = gridDim.x, bid = blockIdx.x; unsigned lo_ = 0u; asm volatile("" : "+v"(tid), "+s"(G), "+s"(bid), "+s"(lo_)); LAS unsigned char* lds = lds0; const LAS unsigned* PT = (const LAS unsigned*)(lds0 + lo_ + LDSCTL_OFF + 512); volatile LAS unsigned* CTLW = (volatile LAS unsigned*)(lds0 + lo_ + LDSCTL_OFF); (void)CTLW; const int NGW = G * NWAVES; (void)NGW; const int lane = tid & 63, wave = __builtin_amdgcn_readfirstlane(tid >> 6), gw = bid * NWAVES + wave; unsigned char* ws = (unsigned char*)(GAS unsigned char*)ldp(PT, 50); float* out_ = (float*)(GAS float*)ldp(PT, 51); unsigned* ctl = (unsigned*)ws; (void)lane; (void)wave; (void)gw; (void)ws; (void)out_; (void)ctl
#if !MK_MULTI
#define GRID_BAR() do { XcdBarrier bar_; bar_.bar = ctl + CW_BAR; bar_.x = xb_xcc_id(); bar_.st = CTLW; xcd_barrier(bar_, tid); } while (0)
#else
#define GRID_BAR() do { } while (0)
#endif

#ifndef PROBE_REP
#define PROBE_REP 0u
#endif
#ifndef PHASE_MASK
#define PHASE_MASK 0xFFFFFFFFu
#endif
#define IN(k) ((((PHASE_MASK) >> (k)) & 1u) && ({ int a_ = ph_lo, b_ = ph_hi; asm volatile("" : "+s"(a_), "+s"(b_)); (a_ <= (k) && (k) < b_); }))
#define SEAM(k) do { if (IN((k) + 1) || ((k) == NPH - 1 && IN(0) && IN(NPH - 1))) GRID_BAR(); } while (0)


__device__ __forceinline__ void norm_groups(const LAS unsigned* PT, unsigned char* ws, const int l, const int s0, const int sstride, const int glo, const int ghi, const int lane) {
    const float* mg = INP(I_MIXG) + l * D;
    for (int s = s0; s < S; s += sstride) {
#pragma unroll
        for (int grp = 0; grp < 4; ++grp) { if (grp < glo || grp >= ghi) continue; bf16_t* p = O + (size_t)s * D + grp * 512 + 8 * lane; float x[8];
                    if (grp == 2 && s >= S / 2) {
                        const int h = lane >> 4, d0 = (lane & 15) * 8, qb = s >> 8, row = s & 255;
                        const size_t sa = ((size_t)(h * 32 + (qb - 32)) * 2 + 0) * 256 + row, sb = sa + 256;
                        const f32x2 mla = *(const f32x2*)(PARTML + sa * 2), mlb = *(const f32x2*)(PARTML + sb * 2);
                        const float mm = fmaxf(mla.x, mlb.x), fa = fast_exp2(mla.x - mm), fb = fast_exp2(mlb.x - mm), inv = fast_rcp(mla.y * fa + mlb.y * fb);
                        const f32x4 a0 = *(const f32x4*)(PARTO + sa * 128 + d0), a1 = *(const f32x4*)(PARTO + sa * 128 + d0 + 4), b0 = *(const f32x4*)(PARTO + sb * 128 + d0), b1 = *(const f32x4*)(PARTO + sb * 128 + d0 + 4);
#pragma unroll
                        for (int j = 0; j < 4; ++j) { x[j] = (a0[j] * fa + b0[j] * fb) * inv; x[4 + j] = (a1[j] * fa + b1[j] * fb) * inv; }
                    } else unpack8(*(const u32x4*)p, x);
                    float ss = 0.f;
#pragma unroll
                    for (int j = 0; j < 8; ++j) ss += x[j] * x[j];
                    const float rs = rsqrtf(wave_sum(ss) * (1.f / 512.f) + EPS); const float* gn = mg + grp * 512 + 8 * lane;
#pragma unroll
                    for (int j = 0; j < 8; ++j) x[j] = x[j] * rs * gn[j];
                    *(u32x4*)p = pack8(x); }
            }
}

template <int DUMMY> __device__ __forceinline__ void layer_body(const int l, const int wave_s, LAS unsigned char* lds0, const int ph_lo, const int ph_hi) {
        if (IN(0)) {
            FRESH();
            LAS float* scr = (LAS float*)(lds + wave * 16384);
            for (int rep_ = 0; rep_ < (int)(PROBE_REP & 1u) + 1; ++rep_) {
                const float* w_in = INP(I_WIN) + (size_t)l * D * INW; const float* w_out = INP(I_WOUT) + (size_t)l * D * D;
                const float* xwq = INP(I_XWQ) + (size_t)l * D * 512; const float* xwk = INP(I_XWK) + (size_t)l * D * 512; const float* xwv = INP(I_XWV) + (size_t)l * D * 512;
                const float* xwo = INP(I_XWO) + (size_t)l * 512 * D; const float* pww = INP(I_PWW) + (size_t)l * 512 * 512;
                const float* wqb = INP(I_WQB) + (size_t)l * 512 * 768; const float* wkvb = INP(I_WKVB) + (size_t)l * 256 * 1024; const float* gluw = INP(I_GLUW) + (size_t)l * 512 * 512;
                const float* mg = INP(I_MG) + (size_t)l * 32 * D * 512; const float* mu = INP(I_MU) + (size_t)l * 32 * D * 512; const float* md = INP(I_MD) + (size_t)l * 32 * 512 * D;
                const float* qag = INP(I_QAG) + l * 512; const float* kvag = INP(I_KVAG) + l * 256; const float* lnx = INP(I_LNX) + l * D; const float* lnmix = INP(I_LNMIX) + l * D; const float* lnm = INP(I_LNMOE) + l * D;
                constexpr int N_IN = 32 * 98, N_OUT = 32 * 64, N_XQ = 32 * 16, N_XO = 8 * 64, N_PW = 8 * 16, N_QB = 8 * 24, N_KVB = 4 * 32, N_GLU = 8 * 16, N_MG = 32 * 512, N_MD = 32 * 512;
                constexpr int NITEMS = N_IN + N_OUT + 3 * N_XQ + N_XO + N_PW + N_QB + N_KVB + N_GLU + 2 * N_MG + N_MD;
                for (int it = gw; it < NITEMS; it += NGW) {
                    int r = it;
                    if (r < N_MG) { const int e = r >> 9, rr = r & 511, kb = rr >> 4, nb = rr & 15, n0 = 32 * nb; tr_item8(mg + (size_t)e * D * 512, 512, 64 * kb, n0, MOE1F + (size_t)e * 1024 * D, D, (n0 >> 7) * 256 + (n0 & 127), lnm, scr, lane); continue; } r -= N_MG;
                    if (r < N_MG) { const int e = r >> 9, rr = r & 511, kb = rr >> 4, nb = rr & 15, n0 = 32 * nb; tr_item8(mu + (size_t)e * D * 512, 512, 64 * kb, n0, MOE1F + (size_t)e * 1024 * D, D, (n0 >> 7) * 256 + 128 + (n0 & 127), lnm, scr, lane); continue; } r -= N_MG;
                    if (r < N_MD) { const int e = r >> 9, rr = r & 511, kb = rr >> 6, nb = rr & 63; tr_item8(md + (size_t)e * 512 * D, D, 64 * kb, 32 * nb, MOE2F + (size_t)e * D * 512, 512, 32 * nb, nullptr, scr, lane); continue; } r -= N_MD;
                    if (r < N_IN) { const int kb = r / 98, nb = r % 98, n0 = 32 * nb, dr = (n0 < 448) ? n0 : (n0 < 512 ? 3072 + (n0 - 448) : n0 - 64); tr_item(w_in, INW, 64 * kb, n0, WIN, D, dr, lnmix, scr, lane); continue; } r -= N_IN;
                    if (r < N_OUT) { const int kb = r >> 6, nb = r & 63; tr_item(w_out, D, 64 * kb, 32 * nb, WOUT, D, 32 * nb, nullptr, scr, lane); continue; } r -= N_OUT;
                    if (r < N_XQ) { const int kb = r >> 4, nb = r & 15; tr_item(xwq, 512, 64 * kb, 32 * nb, XWQ, D, 32 * nb, lnx, scr, lane); continue; } r -= N_XQ;
                    if (r < N_XQ) { const int kb = r >> 4, nb = r & 15; tr_item(xwk, 512, 64 * kb, 32 * nb, XWK, D, 32 * nb, nullptr, scr, lane); continue; } r -= N_XQ;
                    if (r < N_XQ) { const int kb = r >> 4, nb = r & 15; tr_item(xwv, 512, 64 * kb, 32 * nb, XWV, D, 32 * nb, nullptr, scr, lane); continue; } r -= N_XQ;
                    if (r < N_XO) { const int kb = r >> 6, nb = r & 63; tr_item(xwo, D, 64 * kb, 32 * nb, XWO, 512, 32 * nb, nullptr, scr, lane); continue; } r -= N_XO;
                    if (r < N_PW) { const int kb = r >> 4, nb = r & 15; tr_item(pww, 512, 64 * kb, 32 * nb, PW, 512, 32 * nb, nullptr, scr, lane); continue; } r -= N_PW;
                    if (r < N_QB) { const int kb = r / 24, nb = r % 24; tr_item(wqb, 768, 64 * kb, 32 * nb, WQB, 512, 32 * nb, qag, scr, lane); continue; } r -= N_QB;
                    if (r < N_KVB) { const int kb = r >> 5, nb = r & 31; tr_item(wkvb, 1024, 64 * kb, 32 * nb, WKVB, 256, 32 * nb, kvag, scr, lane); continue; } r -= N_KVB;
                    { const int kb = r >> 4, nb = r & 15; tr_item(gluw, 512, 64 * kb, 32 * nb, GLU, 512, 32 * nb, nullptr, scr, lane); }
                }
                if (bid == 0 && tid < 256) { *(u32x4*)(XB + (size_t)S * D + 8 * tid) = (u32x4){0u, 0u, 0u, 0u}; *(u32x2*)(XF8 + (size_t)S * D + 8 * tid) = (u32x2){0u, 0u}; }
                for (int i = bid * NTHR + tid; i < (WINR - INW) * D / 8; i += G * NTHR) *(u32x4*)(WIN + (size_t)INW * D + (size_t)i * 8) = (u32x4){0u, 0u, 0u, 0u};
                const float* wgp = INP(I_WG) + (size_t)l * D * 4; const float* wep = INP(I_WE) + (size_t)l * D * 32;
                for (int i = bid * NTHR + tid; i < 256 * D / 2; i += G * NTHR) { const int n = i / (D / 2), k = (i % (D / 2)) * 2; float a = 0.f, b = 0.f;
                    if (n < 4) { a = wgp[(size_t)k * 4 + n] * lnm[k]; b = wgp[(size_t)(k + 1) * 4 + n] * lnm[k + 1]; } else if (n < 36) { a = wep[(size_t)k * 32 + n - 4] * lnm[k]; b = wep[(size_t)(k + 1) * 32 + n - 4] * lnm[k + 1]; }
                    *(unsigned*)(ROUT + (size_t)n * D + k) = cvt_pk_bf16(a, b); }
            }
            __syncthreads();
            for (int rep_ = 0; rep_ < (int)((PROBE_REP >> 19) & 1u) + 1; ++rep_)
            for (int task = bid; task < 256; task += G) {
                FRESH();
                const int g = task >> 3, part = task & 7;
                LAS f32x2* LP = (LAS f32x2*)lds;
                LAS f32x2* BB = (LAS f32x2*)(lds + 36864);
                LAS f32x2* CC = (LAS f32x2*)(lds + 45056);
                LAS float* KC = (LAS float*)(lds + 53248);
                const float* are = INP(I_ARE) + (size_t)(l * 32 + g) * 64; const float* aim = INP(I_AIM) + (size_t)(l * 32 + g) * 64;
                const float dt = __expf(INP(I_LOGDT)[l * 32 + g]);
                const float* bre = INP(I_BRE) + (size_t)(l * 32 + g) * 1024; const float* bim = INP(I_BIM) + (size_t)(l * 32 + g) * 1024;
                const float* cre = INP(I_CRE) + (size_t)(l * 32 + g) * 1024; const float* cim = INP(I_CIM) + (size_t)(l * 32 + g) * 1024;
                const float* dsk = INP(I_SSMD) + l * 512 + g * 16;
                if (tid < 64) { const int p = tid; float s, c; sincos_rev(aim[p] * dt, s, c); const float mag = fast_exp2(are[p] * dt * LOG2E); const f32x2 lb = (f32x2){mag * c, mag * s};
                    f32x2 cur = (f32x2){1.f, 0.f}; for (int j = 0; j <= 64; ++j) { LP[p * 65 + j] = cur; cur = cmul(cur, lb); } }
                for (int i = tid; i < 1024; i += NTHR) { const int p = i >> 4, ii = i & 15; float s, c; sincos_rev(aim[p] * dt, s, c); const float mag = fast_exp2(are[p] * dt * LOG2E);
                    const float nr = mag * c - 1.f, ni = mag * s, lr_ = are[p], li = aim[p], den = fast_rcp(lr_ * lr_ + li * li);
                    const f32x2 coef = (f32x2){(nr * lr_ + ni * li) * den, (ni * lr_ - nr * li) * den};
                    BB[p * 16 + ii] = cmul(coef, (f32x2){bre[p * 16 + ii], bim[p * 16 + ii]});
                    CC[i] = (f32x2){cre[i], cim[i]}; }
                __syncthreads();
                {   const int j = part * 8 + (tid >> 6), o = (tid >> 2) & 15, i0 = (tid & 3) * 4; float acc[4] = {0.f, 0.f, 0.f, 0.f};
                    for (int p = 0; p < 64; ++p) { const f32x2 u = cmul(CC[o * 64 + p], LP[p * 65 + j]);
#pragma unroll
                        for (int m = 0; m < 4; ++m) { const f32x2 bb = BB[p * 16 + i0 + m]; acc[m] += u.x * bb.x - u.y * bb.y; } }
#pragma unroll
                    for (int m = 0; m < 4; ++m) if (j == 0 && o == i0 + m) acc[m] += dsk[o];
                    *(f32x4*)(KCG + (size_t)g * 16384 + (j * 16 + o) * 16 + i0) = (f32x4){acc[0], acc[1], acc[2], acc[3]}; }
                for (int ch = tid; ch < 32 * 128; ch += NTHR) { const int n = part * 32 + ch / 128, kc = (ch % 128) * 8, tau = kc >> 4, i0 = kc & 15; float v[8];
                    if (n < 128) { const int p = n & 63; const f32x2 lp = LP[p * 65 + 63 - tau];
#pragma unroll
                        for (int j = 0; j < 8; ++j) { const f32x2 t2 = cmul(lp, BB[p * 16 + i0 + j]); v[j] = (n < 64) ? t2.x : t2.y; } }
                    else {
#pragma unroll
                        for (int j = 0; j < 8; ++j) v[j] = 0.f; }
                    *(u32x4*)(W1G + ((size_t)g * 256 + n) * 1024 + kc) = pack8(v); }
                __syncthreads();
            }
            if (l == 0) { FRESH(); for (int i = bid * NTHR + tid; i < S * 32; i += G * NTHR) { const int pos = i >> 5, f = i & 31; const float inv = fast_exp2(-(float)f * (13.287712379549449f / 32.0f));
                    double tr = (double)pos * (double)inv * 0.15915494309189535; tr -= rint(tr); const float rf = (float)tr;
                    ROPE[2 * i] = __builtin_amdgcn_cosf(rf); ROPE[2 * i + 1] = __builtin_amdgcn_sinf(rf); } }
            for (int rep3_ = (int)((PROBE_REP >> 21) & 1u); rep3_ >= 0; --rep3_)
            {   FRESH(); const float* xin = INP(I_X);
                for (int s = gw; s < S; s += NGW) { float x[4][8];
                    if (l == 0) {
#pragma unroll
                        for (int j = 0; j < 4; ++j) { const f32x4 a = *(const f32x4*)(xin + (size_t)s * D + 8 * lane + 512 * j), b = *(const f32x4*)(xin + (size_t)s * D + 8 * lane + 512 * j + 4);
                            x[j][0] = a[0]; x[j][1] = a[1]; x[j][2] = a[2]; x[j][3] = a[3]; x[j][4] = b[0]; x[j][5] = b[1]; x[j][6] = b[2]; x[j][7] = b[3]; } }
                    else { const int s0 = REC_S[2 * s], s1 = REC_S[2 * s + 1];
#pragma unroll
                        for (int j = 0; j < 4; ++j) { float ya[8], yb[8]; unpack8(*(const u32x4*)(XB + (size_t)s * D + 8 * lane + 512 * j), x[j]);
                            unpack8_fp8(*(const u32x2*)(YS8 + (size_t)s0 * D + 8 * lane + 512 * j), ya); unpack8_fp8(*(const u32x2*)(YS8 + (size_t)s1 * D + 8 * lane + 512 * j), yb);
#pragma unroll
                            for (int e = 0; e < 8; ++e) x[j][e] += (ya[e] + yb[e]) * 0.0625f; } }
                    float ss = 0.f;
#pragma unroll
                    for (int j = 0; j < 4; ++j)
#pragma unroll
                        for (int e = 0; e < 8; ++e) ss += x[j][e] * x[j][e];
                    ss = wave_sum(ss);
                    if (rep3_ == 0) {
#pragma unroll
                        for (int j = 0; j < 4; ++j) *(u32x4*)(XB + (size_t)s * D + 8 * lane + 512 * j) = pack8(x[j]);
                        if (lane == 0) RMS1[s] = rsqrtf(ss * (1.0f / D) + EPS); } }
                const float* mgain = INP(I_MEMG) + l * D; const float* mem = INP(I_MEM);
                for (int s = gw; s < MEMT; s += NGW) { f32x4 v[8];
#pragma unroll
                    for (int j = 0; j < 8; ++j) v[j] = *(const f32x4*)(mem + (size_t)s * D + 4 * lane + 256 * j);
                    rms_row_store(v, mgain, MEMN + (size_t)s * D, lane); }
            }
            SEAM(0);
        }
        if (IN(1)) for (int rep_ = 0; rep_ < (int)((PROBE_REP >> 1) & 1u) + 1; ++rep_) {
            FRESH();
            {
                for (int task = bid; task < 256; task += G) {
                    FRESH();
                    const int g = task >> 3, part = task & 7;
                    LAS f32x2* LP = (LAS f32x2*)lds;
                    LAS f32x2* CC = (LAS f32x2*)(lds + 45056);
                    LAS float* KC = (LAS float*)(lds + 53248);
                    const float* are = INP(I_ARE) + (size_t)(l * 32 + g) * 64; const float* aim = INP(I_AIM) + (size_t)(l * 32 + g) * 64;
                    const float dt = __expf(INP(I_LOGDT)[l * 32 + g]);
                    const float* cre = INP(I_CRE) + (size_t)(l * 32 + g) * 1024; const float* cim = INP(I_CIM) + (size_t)(l * 32 + g) * 1024;
                    if (tid < 64) { const int p = tid; float s_, c_; sincos_rev(aim[p] * dt, s_, c_); const float mag = fast_exp2(are[p] * dt * LOG2E); const f32x2 lb = (f32x2){mag * c_, mag * s_};
                        f32x2 cur = (f32x2){1.f, 0.f}; for (int j = 0; j <= 64; ++j) { LP[p * 65 + j] = cur; cur = cmul(cur, lb); } }
                    for (int i = tid; i < 1024; i += NTHR) CC[i] = (f32x2){cre[i], cim[i]};
#pragma unroll
                    for (int k_ = 0; k_ < 8; ++k_) { const int i = tid + k_ * NTHR; *(LAS f32x4*)(KC + 4 * i) = *(const f32x4*)(KCG + (size_t)g * 16384 + 4 * i); }
                    __syncthreads();
                    for (int ch = tid; ch < 128 * 160; ch += NTHR) { const int rr = part * 128 + ch / 160, kc = (ch % 160) * 8, t = rr >> 4, o = rr & 15; float v[8];
                        if (kc < 1024) { const int tau = kc >> 4, i0 = kc & 15;
#pragma unroll
                            for (int j = 0; j < 8; ++j) v[j] = (tau <= t) ? KC[((t - tau) * 16 + o) * 16 + i0 + j] : 0.f; }
                        else if (kc < 1152) { const bool im = kc >= 1088; const int p0 = (kc - (im ? 1088 : 1024));
#pragma unroll
                            for (int j = 0; j < 8; ++j) { const f32x2 t2 = cmul(CC[o * 64 + p0 + j], LP[(p0 + j) * 65 + t + 1]); v[j] = im ? -t2.y : t2.x; } }
                        else {
#pragma unroll
                            for (int j = 0; j < 8; ++j) v[j] = 0.f; }
                        *(u32x4*)(BTY + ((size_t)g * 1024 + rr) * 1280 + kc) = pack8(v); }
                    __syncthreads();
                } }
            __syncthreads();
            pg8::GSched Sd{(const char*)XB, (const char*)WIN, (size_t)256 * D * 2, (size_t)256 * D * 2, 0, 0, S / 256, 12, 1, G, bid};
            pg8::EpiBf16 E{P, INWP, 0, nullptr, RMS1};
            for (int r2_ = 0; r2_ < (int)((PROBE_REP >> 23) & 1u) + 1; ++r2_)
            pg8::gemm_phase<pg8::EpiBf16, pg8::GSched>(tid, lds, D, D, D, nullptr, Sd, E);
            for (int r3_ = 0; r3_ < (int)((PROBE_REP >> 22) & 1u) * 4 + 1; ++r3_)
            {
                pg8::GSched St{(const char*)XB, (const char*)(WIN + (size_t)3072 * D), (size_t)256 * D * 2, 0, (size_t)512 * 2, (size_t)512 * 2, S / 256, 1, 4, G, bid};
                pg8::EpiBf16Part64 Et{PQ7, (size_t)S * 64, RMS1};
                pg8::gemm_phase<pg8::EpiBf16Part64, pg8::GSched>(tid, lds, 512, D, D, nullptr, St, Et); }
            SEAM(1);
        }
        if (IN(2)) for (int rep_ = 0; rep_ < (int)((PROBE_REP >> 2) & 1u) + 1; ++rep_) {
            FRESH();
            {   pg8::GSched Sd{(const char*)(P + P_CQ), (const char*)WQB, (size_t)256 * INWP * 2, (size_t)256 * 512 * 2, 0, 0, S / 256, 3, 1, G, bid};
                pg8::EpiBf16 E{QRAW, 768, 0, nullptr, nullptr};
                pg8::gemm_phase<pg8::EpiBf16, pg8::GSched>(tid, lds, 512, INWP, 512, nullptr, Sd, E); }
            {   FRESH(); pg8::GSched Sd{(const char*)(P + P_CKV), (const char*)WKVB, (size_t)256 * INWP * 2, (size_t)256 * 256 * 2, 0, 0, S / 256, 4, 1, G, bid};
                pg8::EpiBf16 E{KVRAW, 1024, 0, nullptr, nullptr};
                pg8::gemm_phase<pg8::EpiBf16, pg8::GSched>(tid, lds, 256, INWP, 256, nullptr, Sd, E); }
            __syncthreads();
            for (int rep2_ = 0; rep2_ < (int)((PROBE_REP >> 20) & 1u) + 1; ++rep2_)
            for (int tile = bid; tile < S / 64; tile += G) {
                FRESH();
                const int t0 = tile * 64;
                LAS bf16_t* Z = (LAS bf16_t*)lds;
                LAS bf16_t* DW = (LAS bf16_t*)(lds + 98304);
                const float* dww = INP(I_DWW) + (size_t)l * 31 * 512;
                u32x4 tmp_[8], kraw_[2], vraw_[2];
#pragma unroll
                for (int k_ = 0; k_ < 8; ++k_) { const int i = tid + k_ * NTHR; const int half = i & 1, g = (i >> 1) & 31, tau = i >> 6; tmp_[k_] = *(const u32x4*)(P + (size_t)(t0 + tau) * INWP + P_DU + g * 16 + 8 * half); }
#pragma unroll
                for (int kh = 0; kh < 2; ++kh) { const int s_ = t0 + wave * 8 + (lane >> 3), c_ = lane & 7; kraw_[kh] = *(const u32x4*)(P + (size_t)s_ * INWP + P_AK + kh * 64 + 8 * c_); vraw_[kh] = *(const u32x4*)(P + (size_t)s_ * INWP + P_AV + kh * 64 + 8 * c_); }
#pragma unroll
                for (int hb = 0; hb < 2; ++hb) { u32x4 aw_[6], gw_[6];
#pragma unroll
                    for (int i1 = 0; i1 < 6; ++i1) { const int i = tid + (hb * 6 + i1) * NTHR, rr = (i < 94 * 64) ? (i >> 6) : 93, c8 = (i & 63) * 8, s = t0 - 30 + rr, sc = s < 0 ? 0 : s;
                        aw_[i1] = *(const u32x4*)(P + (size_t)sc * INWP + P_BA + c8); gw_[i1] = *(const u32x4*)(P + (size_t)sc * INWP + P_BG + c8); }
#pragma unroll
                    for (int i1 = 0; i1 < 6; ++i1) { const int i = tid + (hb * 6 + i1) * NTHR, rr = i >> 6, c8 = (i & 63) * 8, s = t0 - 30 + rr; float z[8], a[8], g[8]; unpack8(aw_[i1], a); unpack8(gw_[i1], g);
#pragma unroll
                        for (int j = 0; j < 8; ++j) z[j] = (s >= 0) ? a[j] * sigmoidf_(g[j]) : 0.f;
                        if (i < 94 * 64) *(LAS u32x4*)(Z + rr * 512 + c8) = pack8(z); } }
                for (int i = tid; i < 31 * 64; i += NTHR) { const int w = i >> 6, c8 = (i & 63) * 8; float v[8];
#pragma unroll
                    for (int j = 0; j < 8; ++j) v[j] = dww[w * 512 + c8 + j];
                    *(LAS u32x4*)(DW + w * 512 + c8) = pack8(v); }
                __syncthreads();
                {   const int c8 = lane * 8; const float* dwb = INP(I_DWB) + l * 512 + c8; const float* lg = INP(I_CLNG) + l * 512 + c8; const float* lb = INP(I_CLNB) + l * 512 + c8;
                    for (int g4 = 0; g4 < 2; ++g4) {
                        const int tb = wave * 8 + 4 * g4; float a4[4][8], zw[4][8];
#pragma unroll
                        for (int q = 0; q < 4; ++q)
#pragma unroll
                            for (int j = 0; j < 8; ++j) a4[q][j] = dwb[j];
#pragma unroll
                        for (int q = 0; q < 3; ++q) unpack8(*(const LAS u32x4*)(Z + (tb + q) * 512 + c8), zw[q]);
#pragma unroll 1
                        for (int w0 = 0; w0 < 32; w0 += 4) {
#pragma unroll
                            for (int i = 0; i < 4; ++i) { const int w = w0 + i; if (w < 31) { float k[8]; unpack8(*(const LAS u32x4*)(Z + (tb + 3 + w) * 512 + c8), zw[(i + 3) & 3]); unpack8(*(const LAS u32x4*)(DW + w * 512 + c8), k);
#pragma unroll
                                for (int q = 0; q < 4; ++q)
#pragma unroll
                                    for (int j = 0; j < 8; ++j) a4[q][j] += zw[(i + q) & 3][j] * k[j]; } } }
#pragma unroll
                    for (int q = 0; q < 4; ++q) { const int tau = tb + q; float acc[8];
#pragma unroll
                        for (int j = 0; j < 8; ++j) acc[j] = a4[q][j];
                        float sm = 0.f;
#pragma unroll
                        for (int j = 0; j < 8; ++j) sm += acc[j];
                        const float mean = wave_sum(sm) * (1.f / 512.f); float sq = 0.f;
#pragma unroll
                        for (int j = 0; j < 8; ++j) { acc[j] -= mean; sq += acc[j] * acc[j]; }
                        const float rstd = rsqrtf(wave_sum(sq) * (1.f / 512.f) + EPS); float y[8];
#pragma unroll
                        for (int j = 0; j < 8; ++j) { const float v = acc[j] * rstd * lg[j] + lb[j]; y[j] = v * sigmoidf_(v); }
                        *(u32x4*)(ZC + (size_t)(t0 + tau) * 512 + c8) = pack8(y); } } }
                __syncthreads();
                {
#pragma unroll
                for (int k_ = 0; k_ < 8; ++k_) { const int i = tid + k_ * NTHR; const int half = i & 1, g = (i >> 1) & 31, tau = i >> 6;
                    *(u32x4*)(UA + ((size_t)g * 256 + tile) * 1280 + tau * 16 + 8 * half) = tmp_[k_]; } }
                { const int g = tid >> 4, c = tid & 15; *(u32x4*)(UA + ((size_t)g * 256 + tile) * 1280 + 1152 + 8 * c) = (u32x4){0u, 0u, 0u, 0u}; }
                {   LAS bf16_t* vt = (LAS bf16_t*)(lds + wave * 1024);
                    const int j = lane >> 3, c = lane & 7, r = wave * 8 + j, s = t0 + r; const float* kg = INP(I_SWAKG) + l * 64 + 8 * c;
#pragma unroll
                    for (int kh = 0; kh < 2; ++kh) {
                        float x[8]; unpack8(kraw_[kh], x); float ss = 0.f;
#pragma unroll
                        for (int e = 0; e < 8; ++e) ss += x[e] * x[e];
                        ss += __shfl_xor(ss, 1); ss += __shfl_xor(ss, 2); ss += __shfl_xor(ss, 4);
                        const float rs = rsqrtf(ss * (1.f / 64.f) + EPS);
#pragma unroll
                        for (int e = 0; e < 8; ++e) x[e] = x[e] * rs * kg[e];
                        *(u32x4*)(SWAK + ((size_t)kh * 256 + tile) * 8192 + r * 128 + kswz<128>(r, c) * 16) = pack8(x);
                        *(LAS u32x4*)(vt + j * 64 + 8 * c) = vraw_[kh];
                        LDS_WAIT();
                        { const int d = lane; float v[8];
#pragma unroll
                            for (int jj = 0; jj < 8; ++jj) v[jj] = bf2f(vt[jj * 64 + d]);
                            *(u32x4*)(SWAV + ((size_t)kh * 256 + tile) * 8192 + d * 128 + vswz(d, wave) * 16) = pack8(v); }
                        LDS_WAIT();
                    } }
                __syncthreads();
            }
            SEAM(2);
        }
        if (IN(3)) for (int rep_ = 0; rep_ < (int)((PROBE_REP >> 3) & 1u) + 1; ++rep_) {
            FRESH();
            {   pg8::GSched Sd{(const char*)ZC, (const char*)PW, (size_t)256 * 512 * 2, (size_t)256 * 512 * 2, 0, 0, S / 256, 2, 1, G, (bid + G / 2) % G};
                pg8::EpiBf16 E{O, D, 512, INP(I_PWB) + l * 512, nullptr};
                pg8::gemm_phase<pg8::EpiBf16, pg8::GSched>(tid, lds, 512, 512, 512, nullptr, Sd, E); }
            {   pg8::GSched Sd{(const char*)UA, (const char*)W1G, 0, 0, (size_t)256 * 1280 * 2, (size_t)256 * 1024 * 2, 1, 1, 32, G, (bid + 128) % G};
                pg8::EpiF32Part<128> E{EBUF, 128, (size_t)256 * 128};
                pg8::gemm_phase<pg8::EpiF32Part<128>, pg8::GSched>(tid, lds, 1024, 1280, 1024, nullptr, Sd, E); }
            {   FRESH(); pg8::MemSched Sm{(const char*)MEMN, (const char*)XWK, G, (bid + G - 160) % G};
                pg8::EpiMem Em{KMEM, VMEM};
                pg8::gemm_phase<pg8::EpiMem, pg8::MemSched>(tid, lds, 512, D, D, nullptr, Sm, Em); }
            __syncthreads();
            for (int tile = bid; tile < S / 64; tile += G) {
                FRESH();
                const int t0 = tile * 64; constexpr float QSCALE = 0.07216878364870322f * LOG2E;
                LAS bf16_t* vt = (LAS bf16_t*)(lds + wave * 8192);
                const float* qnn = INP(I_QNN) + l * 128; const float* qnr = INP(I_QNR) + l * 64; const float* knn = INP(I_KNN) + l * 128; const float* knr = INP(I_KNR) + l * 64;
                for (int j2 = 0; j2 < 8; j2 += 2) {
                    u32x2 wkv_[2]; float xkr_[2], cs_[2], sn_[2]; unsigned wqn_[2][4], wkn_[2][4], wv_[2][4]; float xqr_[2][4];
#pragma unroll
                    for (int u = 0; u < 2; ++u) { const int s = t0 + wave * 8 + j2 + u;
                        wkv_[u] = *(const u32x2*)(P + (size_t)s * INWP + P_CKV + 4 * lane);
                        xkr_[u] = bf2f(P[(size_t)s * INWP + P_CKR + lane]);
                        cs_[u] = ROPE[((size_t)s * 32 + (lane & 31)) * 2]; sn_[u] = ROPE[((size_t)s * 32 + (lane & 31)) * 2 + 1];
#pragma unroll
                        for (int h = 0; h < 4; ++h) { wqn_[u][h] = *(const unsigned*)(QRAW + (size_t)s * 768 + h * 192 + 2 * lane); xqr_[u][h] = bf2f(QRAW[(size_t)s * 768 + h * 192 + 128 + lane]);
                            wkn_[u][h] = *(const unsigned*)(KVRAW + (size_t)s * 1024 + h * 256 + 2 * lane); wv_[u][h] = *(const unsigned*)(KVRAW + (size_t)s * 1024 + h * 256 + 128 + 2 * lane); } }
#pragma unroll
                    for (int u = 0; u < 2; ++u) {
                    const int j = j2 + u, r = wave * 8 + j, s = t0 + r;
                    const u32x2 wkv = wkv_[u]; const float xkr = xkr_[u], cs = cs_[u], sn = sn_[u];
                    unsigned wqn[4], wkn[4], wv[4]; float xqr[4];
#pragma unroll
                    for (int h = 0; h < 4; ++h) { wqn[h] = wqn_[u][h]; wkn[h] = wkn_[u][h]; wv[h] = wv_[u][h]; xqr[h] = xqr_[u][h]; }
                    float ps[14];
                    { const float a = bf2f(wkv.x & 0xffffu), b = bf2f(wkv.x >> 16), c = bf2f(wkv.y & 0xffffu), d = bf2f(wkv.y >> 16); ps[0] = a * a + b * b + c * c + d * d; }
                    ps[1] = xkr * xkr;
#pragma unroll
                    for (int h = 0; h < 4; ++h) { const float a = bf2f(wqn[h] & 0xffffu), b = bf2f(wqn[h] >> 16), c = bf2f(wkn[h] & 0xffffu), d = bf2f(wkn[h] >> 16);
                        ps[2 + 3 * h] = a * a + b * b; ps[3 + 3 * h] = xqr[h] * xqr[h]; ps[4 + 3 * h] = c * c + d * d; }
#pragma unroll
                    for (int o = 1; o < 64; o <<= 1)
#pragma unroll
                        for (int k = 0; k < 14; ++k) ps[k] += __shfl_xor(ps[k], o);
                    const float rkv = rsqrtf(ps[0] * (1.f / 256.f) + EPS);
                    float kr; { const float y = xkr * rsqrtf(ps[1] * (1.f / 64.f) + EPS) * knr[lane]; const float pr = __shfl_xor(y, 32);
                        kr = (lane < 32) ? (y * cs - pr * sn) : (pr * sn + y * cs); }
#pragma unroll
                    for (int h = 0; h < 4; ++h) {
                        { const float a = bf2f(wqn[h] & 0xffffu), b = bf2f(wqn[h] >> 16);
                          const float rs = rsqrtf(ps[2 + 3 * h] * (1.f / 128.f) + EPS);
                          *(unsigned short*)((unsigned char*)Q + ((size_t)h * S + s) * 192 + f8pos(2 * lane)) = (unsigned short)(pk4_fp8(a * rs * qnn[2 * lane], b * rs * qnn[2 * lane + 1], 0.f, 0.f) & 0xffffu); }
                        { const float y = xqr[h] * rsqrtf(ps[3 + 3 * h] * (1.f / 64.f) + EPS) * qnr[lane]; const float pr = __shfl_xor(y, 32);
                          const float qr = ((lane < 32) ? (y * cs - pr * sn) : (pr * sn + y * cs));
                          ((unsigned char*)Q)[((size_t)h * S + s) * 192 + f8pos(128 + lane)] = (unsigned char)(pk4_fp8(qr, 0.f, 0.f, 0.f) & 0xffu); }
                        { const float a = bf2f(wkn[h] & 0xffffu), b = bf2f(wkn[h] >> 16);
                          const float rs = rsqrtf(ps[4 + 3 * h] * (1.f / 128.f) + EPS);
                          unsigned char* kimg = KIMG + ((size_t)h * 256 + tile) * 12288 + r * 192; const int pn_ = f8pos(2 * lane), pr_ = f8pos(128 + lane), sw_ = (r >> 2) & 3;
                          *(unsigned short*)(kimg + (((pn_ >> 4) ^ sw_) << 4) + (pn_ & 15)) = (unsigned short)(pk4_fp8(a * rs * knn[2 * lane], b * rs * knn[2 * lane + 1], 0.f, 0.f) & 0xffffu);
                          kimg[(((pr_ >> 4) ^ sw_) << 4) + (pr_ & 15)] = (unsigned char)(pk4_fp8(kr, 0.f, 0.f, 0.f) & 0xffu); }
                        *(LAS unsigned short*)((LAS unsigned char*)vt + (h * 8 + j) * 128 + 2 * lane) = (unsigned short)(pk4_fp8(bf2f(wv[h] & 0xffffu) * rkv, bf2f(wv[h] >> 16) * rkv, 0.f, 0.f) & 0xffffu);
                    }
                                    }
                }
                LDS_WAIT();
                for (int h = 0; h < 4; ++h)
                    for (int dd = 0; dd < 2; ++dd) { const int d = lane + 64 * dd; const LAS unsigned char* v8 = (const LAS unsigned char*)vt; unsigned lo = 0u, hi4 = 0u;
#pragma unroll
                        for (int jj = 0; jj < 4; ++jj) { lo |= (unsigned)v8[(h * 8 + jj) * 128 + d] << (8 * jj); hi4 |= (unsigned)v8[(h * 8 + 4 + jj) * 128 + d] << (8 * jj); }
                        const int off_ = 32 * (wave >> 2) + 8 * (((wave & 1) << 1) | ((wave >> 1) & 1));
                        *(u32x2*)(VIMG + ((size_t)h * 256 + tile) * 8192 + d * 64 + ((((off_ >> 4) ^ ((d >> 2) & 3))) << 4) + (off_ & 15)) = (u32x2){lo, hi4}; }
                LDS_WAIT();
            }
            __syncthreads();
            __syncthreads();
            {   FRESH(); LAS float* tab = (LAS float*)(lds + 98304);
                const float* relb = INP(I_RELB);
                for (int i = tid; i < 1024; i += NTHR) { const int h = i >> 7, dist = i & 127; tab[i] = relb[T5_BUCKET[dist] * 8 + h] * LOG2E; }
                __syncthreads();
                const int lr = lane & 31, hi = lane >> 5;
                for (int it = bid; it < 128; it += G) {
                    const int kh = it & 1, qb = it >> 1, q0 = qb * 256, wq0 = q0 + 32 * wave, qpos = wq0 + lr;
                    const int t_lo = (4 * qb - 2) < 0 ? 0 : (4 * qb - 2), t_hi = 4 * qb + 4;
                    __syncthreads();
                    for (int t = t_lo; t < t_hi; ++t) { dma_tile<8192>(SWAK + ((size_t)kh * 256 + t) * 8192, lds + (t - t_lo) * 16384, tid, wave); dma_tile<8192>(SWAV + ((size_t)kh * 256 + t) * 8192, lds + (t - t_lo) * 16384 + 8192, tid, wave); }
                    VM_WAIT(); __syncthreads();
#pragma unroll 1
                    for (int g = 0; g < 4; ++g) { const int h = 4 * kh + g;
                        bf16x8 qf[4];
                        if (h < 7) load_q_norm<64>(P + (size_t)qpos * INWP + P_AQ + h * 64, INP(I_SWAQG) + l * 64, 0.125f * LOG2E, hi, qf);
                        else load_q_norm_bf16x4<64>(PQ7 + (size_t)qpos * 64, (size_t)S * 64, INP(I_SWAQG) + l * 64, 0.125f * LOG2E, hi, qf);
                        f32x16 o[2];
#pragma unroll
                        for (int db = 0; db < 2; ++db)
#pragma unroll
                            for (int r = 0; r < 16; ++r) o[db][r] = 0.f;
                        float m_run = -1e30f, l_run = 0.f;
#pragma unroll 1
                        for (int t = t_lo; t < t_hi; ++t) { const int k0 = t * 64;
                            if ((k0 <= wq0 + 31) && (k0 + 63 >= wq0 - 127)) attn_tile_compute<64, 64, 1>(lds + (t - t_lo) * 16384, lds + (t - t_lo) * 16384 + 8192, k0, true, qf, qpos, tab + h * 128, lr, hi, o, m_run, l_run); }
                        { auto rr = __builtin_amdgcn_permlane32_swap(__float_as_uint(l_run), __float_as_uint(l_run), false, false); l_run = __uint_as_float(rr[0]) + __uint_as_float(rr[1]); }
                        l_run += fast_exp2(INP(I_SINK)[l * 8 + h] * LOG2E - m_run);
                        store_o<64>(O + (size_t)qpos * D + h * 64, o, fast_rcp(l_run), hi);
                    }
                }
            }
            SEAM(3);
        }
        if (IN(4)) for (int rep_ = 0; rep_ < (int)((PROBE_REP >> 4) & 1u) + 1; ++rep_) {
            FRESH();
            for (int task = bid; task < 64; task += G) {
                FRESH();
                LAS f32x2* SE = (LAS f32x2*)lds;
                const int sl = tid & 31, seg = tid >> 5, st = task * 32 + sl, g = st >> 6, p = st & 63;
                const float dt = __expf(INP(I_LOGDT)[l * 32 + g]); const float are = INP(I_ARE)[(size_t)(l * 32 + g) * 64 + p], aim = INP(I_AIM)[(size_t)(l * 32 + g) * 64 + p];
                float s_, c_; sincos_rev(aim * dt, s_, c_); const float mag = fast_exp2(are * dt * LOG2E); f32x2 lt = (f32x2){mag * c_, mag * s_};
#pragma unroll
                for (int k = 0; k < 6; ++k) lt = cmul(lt, lt);
                f32x2 e[16];
#pragma unroll
                for (int k = 0; k < 16; ++k) { const size_t off = ((size_t)g * 256 + seg * 16 + k) * 128 + p; e[k] = (f32x2){EBUF[off], EBUF[off + 64]}; }
                f32x2 acc = (f32x2){0.f, 0.f};
#pragma unroll
                for (int k = 0; k < 16; ++k) { const f32x2 t = cmul(lt, acc); acc = (f32x2){t.x + e[k].x, t.y + e[k].y}; }
                SE[sl * 16 + seg] = acc;
                f32x2 l16 = lt;
#pragma unroll
                for (int k = 0; k < 4; ++k) l16 = cmul(l16, l16);
                __syncthreads();
                f32x2 carry = (f32x2){0.f, 0.f};
                for (int k = 0; k < seg; ++k) { const f32x2 t = cmul(l16, carry); const f32x2 se = SE[sl * 16 + k]; carry = (f32x2){t.x + se.x, t.y + se.y}; }
#pragma unroll
                for (int k = 0; k < 16; ++k) { const int c = seg * 16 + k; bf16_t* dst = UA + ((size_t)g * 256 + c) * 1280 + 1024 + p;
                    dst[0] = (bf16_t)(cvt_pk_bf16(carry.x, 0.f) & 0xffffu); dst[64] = (bf16_t)(cvt_pk_bf16(carry.y, 0.f) & 0xffffu);
                    const f32x2 t = cmul(lt, carry); carry = (f32x2){t.x + e[k].x, t.y + e[k].y}; }
                __syncthreads();
            }
            {   FRESH(); const int lr = lane & 31, hi = lane >> 5;
                for (int it = bid; it < 256; it += G) {
                    const int xcd_ = it & 7, il_ = ((xcd_ & 1) << 5) | (it >> 3), h = xcd_ >> 1, j = il_ >> 1, part = il_ & 1;
                    for (int sub = 0; sub <= part; ++sub) {
                        const bool fin = (sub == 1);
                        const int qb = fin ? j : 63 - j;
                        const int t_lo = fin ? 0 : (part ? 130 : 0), t_hi = fin ? 4 * j + 4 : (part ? 4 * (64 - j) : 130);
                        const int q0 = qb * 256, wq0 = q0 + 32 * wave, qpos = wq0 + lr;
                        i64x2 qf[6];
#pragma unroll
                        for (int m = 0; m < 6; ++m) qf[m] = *(const i64x2*)((const unsigned char*)Q + ((size_t)h * S + qpos) * 192 + 32 * m + 16 * hi);
                        f32x16 o[4];
#pragma unroll
                        for (int db = 0; db < 4; ++db)
#pragma unroll
                            for (int r = 0; r < 16; ++r) o[db][r] = 0.f;
                        float m_run = -1e30f, l_run = 0.f;
                        attn_mla_f8(tid, lds, KIMG + (size_t)h * 256 * 12288, VIMG + (size_t)h * 256 * 8192, t_lo, t_hi, qf, qpos, wq0, o, m_run, l_run);
                        { auto rr = __builtin_amdgcn_permlane32_swap(__float_as_uint(l_run), __float_as_uint(l_run), false, false); l_run = __uint_as_float(rr[0]) + __uint_as_float(rr[1]); }
                        int tz = tid; asm volatile("" : "+v"(tz));
                        const int lr2 = tz & 31, hi2 = (tz >> 5) & 1, row2 = q0 + (tz >> 6) * 32 + lr2;
                        if (fin) store_o<128>(O + (size_t)row2 * D + 1024 + h * 128, o, fast_rcp(l_run), hi2);
                        else {
                            const size_t slot = ((size_t)(h * 32 + (qb - 32)) * 2 + part) * 256 + (tz >> 6) * 32 + lr2;
                            float* po = PARTO + slot * 128;
#pragma unroll
                            for (int db = 0; db < 4; ++db)
#pragma unroll
                                for (int r4 = 0; r4 < 4; ++r4) *(f32x4*)(po + 32 * db + 8 * r4 + 4 * hi2) = (f32x4){o[db][4 * r4], o[db][4 * r4 + 1], o[db][4 * r4 + 2], o[db][4 * r4 + 3]};
                            if (hi2 == 0) *(f32x2*)(PARTML + slot * 2) = (f32x2){m_run, l_run};
                        }
                    }
                }
            }
            SEAM(4);
        }
        if (IN(5)) for (int rep_ = 0; rep_ < (int)((PROBE_REP >> 5) & 1u) + 1; ++rep_) {
            FRESH();
            pg8::GSched Sd{(const char*)UA, (const char*)BTY, 0, (size_t)256 * 1280 * 2, (size_t)256 * 1280 * 2, (size_t)1024 * 1280 * 2, 1, 4, 32, G, bid};
            pg8::EpiSsmY E{YG};
            pg8::gemm_phase<pg8::EpiSsmY, pg8::GSched>(tid, lds, 1280, 1280, 1280, nullptr, Sd, E);
            if (G == 256 && bid >= 128) { FRESH(); norm_groups(PT, ws, l, (bid - 128) * NWAVES + wave, 128 * NWAVES, 0, 3, lane); }
            SEAM(5);
        }
        if (IN(6)) for (int rep_ = 0; rep_ < (int)((PROBE_REP >> 6) & 1u) + 1; ++rep_) {
            FRESH();
            pg8::GSched Sd{(const char*)YG, (const char*)GLU, (size_t)256 * 512 * 2, (size_t)256 * 512 * 2, 0, 0, S / 256, 2, 1, G, bid};
            pg8::EpiGlu E{YG, INP(I_GLUB) + l * 512, O};
            pg8::gemm_phase<pg8::EpiGlu, pg8::GSched>(tid, lds, 512, 512, 512, nullptr, Sd, E);
            __syncthreads();
            for (int it = (bid + 32) % G; it < 32; it += G) {
                FRESH();
                const int tile = it >> 3, w8 = it & 7, r = w8 * 8 + wave, mrow = tile * 64 + r;
                LAS bf16_t* vt = (LAS bf16_t*)lds; const float* kg = INP(I_XKG) + l * 128;
                unsigned wk[4]; float ps[4];
#pragma unroll
                for (int h = 0; h < 4; ++h) { float a = 0.f, b = 0.f, va = 0.f, vb = 0.f;
#pragma unroll
                    for (int z = 0; z < 4; ++z) { const unsigned k2 = *(const unsigned*)(KMEM + (size_t)z * 256 * 512 + (size_t)mrow * 512 + h * 128 + 2 * lane), v2 = *(const unsigned*)(VMEM + (size_t)z * 256 * 512 + (size_t)mrow * 512 + h * 128 + 2 * lane);
                        a += bf2f(k2 & 0xffffu); b += bf2f(k2 >> 16); va += bf2f(v2 & 0xffffu); vb += bf2f(v2 >> 16); }
                    wk[h] = cvt_pk_bf16(a, b); a = bf2f(wk[h] & 0xffffu); b = bf2f(wk[h] >> 16); ps[h] = a * a + b * b;
                    *(LAS unsigned*)(vt + (h * 8 + wave) * 128 + 2 * lane) = cvt_pk_bf16(va, vb); }
#pragma unroll
                for (int o = 1; o < 64; o <<= 1)
#pragma unroll
                    for (int h = 0; h < 4; ++h) ps[h] += __shfl_xor(ps[h], o);
#pragma unroll
                for (int h = 0; h < 4; ++h) { const float a = bf2f(wk[h] & 0xffffu), b = bf2f(wk[h] >> 16), rs = rsqrtf(ps[h] * (1.f / 128.f) + EPS);
                    *(unsigned*)(XKIMG + ((size_t)h * 4 + tile) * 16384 + r * 256 + kswz<256>(r, lane >> 2) * 16 + (lane & 3) * 4) = cvt_pk_bf16(a * rs * kg[2 * lane], b * rs * kg[2 * lane + 1]); }
                __syncthreads();
                {   const int h = tid >> 7, d = tid & 127; float v[8];
#pragma unroll
                    for (int jj = 0; jj < 8; ++jj) v[jj] = bf2f(vt[(h * 8 + jj) * 128 + d]);
                    *(u32x4*)(XVIMG + ((size_t)h * 4 + tile) * 16384 + d * 128 + vswz(d, w8) * 16) = pack8(v); }
                __syncthreads();
            }
            SEAM(6);
        }
        if (IN(7)) for (int rep_ = 0; rep_ < (int)((PROBE_REP >> 7) & 1u) + 1; ++rep_) {
            FRESH();
            norm_groups(PT, ws, l, gw, NGW, (G == 256) ? 3 : 0, 4, lane);
            SEAM(7);
        }
        if (IN(8)) for (int rep_ = 0; rep_ < (int)((PROBE_REP >> 8) & 1u) + 1; ++rep_) {
            FRESH();
            pg8::GSched Sd{(const char*)O, (const char*)WOUT, (size_t)256 * D * 2, (size_t)256 * D * 2, 0, 0, S / 256, D / 256, 1, G, bid};
            pg8::EpiResid E{XB, D, nullptr, (((PROBE_REP >> 8) & 1u) != 0u) && rep_ == 0, nullptr};
            pg8::gemm_phase<pg8::EpiResid, pg8::GSched>(tid, lds, D, D, D, nullptr, Sd, E);
            SEAM(8);
        }
        if (IN(10)) for (int rep_ = 0; rep_ < (int)((PROBE_REP >> 10) & 1u) + 1; ++rep_) {
            FRESH();
            pg8::GSched Sd{(const char*)XB, (const char*)XWQ, (size_t)256 * D * 2, (size_t)256 * D * 2, (size_t)1024 * 2, (size_t)1024 * 2, S / 256, 2, 2, G, bid};
            pg8::EpiBf16Z E{(bf16_t*)QXP, 512, (size_t)S * 512};
            pg8::gemm_phase<pg8::EpiBf16Z, pg8::GSched>(tid, lds, 1024, D, D, nullptr, Sd, E);
            SEAM(10);
        }
        if (IN(11)) for (int rep_ = 0; rep_ < (int)((PROBE_REP >> 11) & 1u) + 1; ++rep_) {
            FRESH();
            const int lr = lane & 31, hi = lane >> 5;
            for (int it = bid; it < 256; it += G) {
                const int h = it & 3, qb = it >> 2, wq0 = qb * 256 + 32 * wave, qpos = wq0 + lr;
                bf16x8 qf[8]; load_q_norm_bf16x2<128>((const bf16_t*)QXP + (size_t)qpos * 512 + h * 128, (const bf16_t*)QXP + (size_t)S * 512 + (size_t)qpos * 512 + h * 128, INP(I_XQG) + l * 128, 0.08838834764831845f * LOG2E, hi, qf);
                f32x16 o[4];
#pragma unroll
                for (int db = 0; db < 4; ++db)
#pragma unroll
                    for (int r = 0; r < 16; ++r) o[db][r] = 0.f;
                float m_run = -1e30f, l_run = 0.f;
                attn_tiles<128, 128, 2>(tid, lds, XKIMG + (size_t)h * 4 * 16384, XVIMG + (size_t)h * 4 * 16384, 0, 4, qf, qpos, wq0, nullptr, o, m_run, l_run);
                { auto rr = __builtin_amdgcn_permlane32_swap(__float_as_uint(l_run), __float_as_uint(l_run), false, false); l_run = __uint_as_float(rr[0]) + __uint_as_float(rr[1]); }
                store_o<128>(OX + (size_t)qpos * 512 + h * 128, o, fast_rcp(l_run), hi);
            }
            SEAM(11);
        }
        if (IN(12)) for (int rep_ = 0; rep_ < (int)((PROBE_REP >> 12) & 1u) + 1; ++rep_) {
            FRESH();
            pg8::GSched Sd{(const char*)OX, (const char*)XWO, (size_t)256 * 512 * 2, (size_t)256 * 512 * 2, 0, 0, S / 256, D / 256, 1, G, bid};
            pg8::EpiResid E{XB, D, SSP, (((PROBE_REP >> 12) & 1u) != 0u) && rep_ == 0, XF8};
            pg8::gemm_phase<pg8::EpiResid, pg8::GSched>(tid, lds, 512, 512, 512, nullptr, Sd, E);
            SEAM(12);
        }
        if (IN(14)) for (int rep_ = 0; rep_ < (int)((PROBE_REP >> 14) & 1u) + 1; ++rep_) {
            FRESH();
            pg8::GSched Sd{(const char*)XB, (const char*)ROUT, (size_t)256 * D * 2, 0, (size_t)512 * 2, (size_t)512 * 2, S / 256, 1, 4, G, bid};
            pg8::EpiF32Part<64> E{LOGP, 64, (size_t)S * 64};
            pg8::gemm_phase<pg8::EpiF32Part<64>, pg8::GSched>(tid, lds, 512, D, D, nullptr, Sd, E);
            SEAM(14);
        }
        if (IN(15)) for (int rep_ = 0; rep_ < (int)((PROBE_REP >> 15) & 1u) + 1; ++rep_) {
            FRESH();
            for (int i = bid * NTHR + tid; i < NSLOT; i += G * NTHR) { TOK[i] = S; WSLOT[i] = 0.f; }
            if (bid == 0 && tid == 0) RMSV[S] = 0.f;
            LAS unsigned* hist = (LAS unsigned*)lds; LAS unsigned* base = hist + 32;
            const float* bg = INP(I_BG) + l * 4; const float* be = INP(I_BE) + l * 32;
            for (int blk = bid; blk < S / 64; blk += G) {
                if (tid < 64) hist[tid] = 0u;
                __syncthreads();
                int e0 = 0, e1 = 0; unsigned r0 = 0, r1 = 0; float w0 = 0.f, w1 = 0.f; const int s = blk * 64 + tid;
                if (tid < 64) {
                    float ssq = 0.f;
#pragma unroll
                    for (int j4 = 0; j4 < 8; ++j4) { const f32x4 a = *(const f32x4*)(SSP + (size_t)s * 32 + 4 * j4); ssq += (a[0] + a[1]) + (a[2] + a[3]); }
                    const float rms = rsqrtf(ssq * (1.0f / D) + EPS); RMSV[s] = rms;
                    float lg[36];
#pragma unroll
                    for (int j4 = 0; j4 < 9; ++j4) { f32x4 a = *(const f32x4*)(LOGP + (size_t)s * 64 + 4 * j4);
#pragma unroll
                        for (int z = 1; z < 4; ++z) a += *(const f32x4*)(LOGP + (size_t)z * S * 64 + (size_t)s * 64 + 4 * j4);
                        lg[4 * j4] = a[0] * rms; lg[4 * j4 + 1] = a[1] * rms; lg[4 * j4 + 2] = a[2] * rms; lg[4 * j4 + 3] = a[3] * rms; }
                    float gl[4]; int gi = 0; float gm;
#pragma unroll
                    for (int j = 0; j < 4; ++j) gl[j] = lg[j] + bg[j];
                    gm = gl[0];
#pragma unroll
                    for (int j = 1; j < 4; ++j) if (gl[j] > gm) { gm = gl[j]; gi = j; }
                    float gs = 0.f;
#pragma unroll
                    for (int j = 0; j < 4; ++j) gs += __expf(gl[j] - gm);
                    const float gwt = 1.f / gs;
                    float v0 = -__builtin_inff(), v1 = -__builtin_inff(); int i0 = 0, i1 = 0;
#pragma unroll
                    for (int j = 0; j < 8; ++j) { const float lv = (gi == 0) ? lg[4 + j] : (gi == 1) ? lg[12 + j] : (gi == 2) ? lg[20 + j] : lg[28 + j]; const float v = lv + be[gi * 8 + j];
                        if (v > v0) { v1 = v0; i1 = i0; v0 = v; i0 = j; } else if (v > v1) { v1 = v; i1 = j; } }
                    const float ee = __expf(v1 - v0), den = 1.f / (1.f + ee);
                    w0 = gwt * den; w1 = gwt * ee * den; e0 = gi * 8 + i0; e1 = gi * 8 + i1;
                    r0 = __hip_atomic_fetch_add(&hist[e0], 1u, __ATOMIC_RELAXED, __HIP_MEMORY_SCOPE_WORKGROUP); r1 = __hip_atomic_fetch_add(&hist[e1], 1u, __ATOMIC_RELAXED, __HIP_MEMORY_SCOPE_WORKGROUP);
                }
                __syncthreads();
                if (tid < 32) { const unsigned c = hist[tid]; base[tid] = c ? __hip_atomic_fetch_add(ctl + CW_CNT + 64 * l + tid, c, __ATOMIC_RELAXED, __HIP_MEMORY_SCOPE_AGENT) : 0u; }
                __syncthreads();
                if (tid < 64) { REC_E[2 * s] = e0; REC_E[2 * s + 1] = e1; REC_R[2 * s] = (int)(base[e0] + r0); REC_R[2 * s + 1] = (int)(base[e1] + r1); REC_W[2 * s] = w0; REC_W[2 * s + 1] = w1; }
                __syncthreads();
            }
            SEAM(15);
        }
        if (IN(16) || IN(17) || IN(18)) {
            FRESH();
            LAS int* pst = (LAS int*)(CTLW + 16);
            if (tid == 0) { int acc = 0; for (int e = 0; e < 32; ++e) { pst[e] = acc; const int c = (int)__hip_atomic_load(ctl + CW_CNT + 64 * l + e, __ATOMIC_RELAXED, __HIP_MEMORY_SCOPE_AGENT); acc += (c + 255) & ~255; } pst[32] = acc; }
            __syncthreads();
            if (tid < 160) { int e = 0; for (int k = 1; k < 32; ++k) if (pst[k] <= tid * 256) e = k; ((LAS int*)(CTLW + 256))[tid] = e; }
            __syncthreads();
        }
        if (IN(16)) for (int rep_ = 0; rep_ < (int)((PROBE_REP >> 16) & 1u) + 1; ++rep_) {
            FRESH();
            const LAS int* pst = (const LAS int*)(CTLW + 16);
            for (int i = bid * NTHR + tid; i < 2 * S; i += G * NTHR) { const int slot = pst[REC_E[i]] + REC_R[i]; TOK[slot] = i >> 1; WSLOT[slot] = REC_W[i]; REC_S[i] = slot; }
            SEAM(16);
        }
        if (IN(17)) for (int rep_ = 0; rep_ < (int)((PROBE_REP >> 17) & 1u) + 1; ++rep_) {
            FRESH();
            pg8::MoeSched Sd{(const LAS int*)(CTLW + 16), (const char*)MOE1F, TOK, (size_t)1024 * D, (size_t)256 * D, 4, G, bid, 1};
            pg8::EpiMoe1 E{HID8, TOK, RMSV};
            pg8::gemm_phase<pg8::EpiMoe1, pg8::MoeSched, true, true>(tid, lds, D / 2, D / 2, D / 2, (const char*)XF8, Sd, E);
            SEAM(17);
        }
        if (IN(18)) for (int rep_ = 0; rep_ < (int)((PROBE_REP >> 18) & 1u) + 1; ++rep_) {
            {   FRESH();
                pg8::MoeSched Sd{(const LAS int*)(CTLW + 16), (const char*)MOE1F, TOK, (size_t)1024 * D, (size_t)256 * D, 4, G, bid, 2};
                pg8::EpiMoe1 E{HID8, TOK, RMSV};
                pg8::gemm_phase<pg8::EpiMoe1, pg8::MoeSched, true, true>(tid, lds, D / 2, D / 2, D / 2, (const char*)XF8, Sd, E); }
            {   FRESH();
                pg8::MoeSched2 Sd{(const LAS int*)(CTLW + 16), (const char*)HID8, (const char*)MOE2F, (size_t)D * 512, (size_t)256 * 512, 8, G, bid, 1};
                pg8::EpiMoe2 E{YS8, WSLOT};
                pg8::gemm_phase<pg8::EpiMoe2, pg8::MoeSched2, false, true>(tid, lds, 256, 256, 256, nullptr, Sd, E); }
            {   FRESH(); GRID_BAR(); }
            {   FRESH();
                pg8::MoeSched2 Sd{(const LAS int*)(CTLW + 16), (const char*)HID8, (const char*)MOE2F, (size_t)D * 512, (size_t)256 * 512, 8, G, bid, 2};
                pg8::EpiMoe2 E{YS8, WSLOT};
                pg8::gemm_phase<pg8::EpiMoe2, pg8::MoeSched2, false, true>(tid, lds, 256, 256, 256, nullptr, Sd, E); }
            {   FRESH(); SEAM(18); }
        }
}

__global__ void __launch_bounds__(NTHR, 2) fwd_kernel(Args args) {
    extern __shared__ __attribute__((aligned(16))) unsigned char lds_raw[];
    LAS unsigned char* lds0 = (LAS unsigned char*)lds_raw;
    {   int t0 = threadIdx.x; asm volatile("" : "+v"(t0));
        for (int u = t0; u < (LDS_BYTES - LDSCTL_OFF) / 4; u += NTHR) ((LAS unsigned*)(lds0 + LDSCTL_OFF))[u] = 0u;
        __syncthreads();
        if (t0 == 0) { LAS unsigned long long* pw = (LAS unsigned long long*)(lds0 + LDSCTL_OFF + 512);
#pragma unroll
            for (int i = 0; i < 50; ++i) pw[i] = (unsigned long long)args.in[i];
            pw[50] = (unsigned long long)args.ws; pw[51] = (unsigned long long)args.out; }
        __syncthreads();
#if !MK_MULTI
        if (t0 == 0) (void)xb_add(&((unsigned*)args.ws)[CW_BAR + XB_XCNT(xb_xcc_id())], 1u);
#endif
    }
    const int ph_lo = args.ph_lo, ph_hi = args.ph_hi;
    int wave_s = __builtin_amdgcn_readfirstlane(threadIdx.x >> 6); asm volatile("" : "+s"(wave_s));
#if MK_MULTI
    if (args.l_lo < NL) layer_body<0>(args.l_lo, wave_s, lds0, ph_lo, ph_hi);
#else
    layer_body<0>(0, wave_s, lds0, ph_lo, ph_hi);
    layer_body<1>(1, wave_s, lds0, ph_lo, ph_hi);
    layer_body<2>(2, wave_s, lds0, ph_lo, ph_hi);
    layer_body<3>(3, wave_s, lds0, ph_lo, ph_hi);
#endif
    if (args.l_hi > NL) {
        FRESH();
        for (int s = gw; s < S; s += NGW) { const int s0 = REC_S[2 * s], s1 = REC_S[2 * s + 1];
#pragma unroll
            for (int j = 0; j < 4; ++j) { float x[8], ya[8], yb[8]; unpack8(*(const u32x4*)(XB + (size_t)s * D + 8 * lane + 512 * j), x);
                unpack8_fp8(*(const u32x2*)(YS8 + (size_t)s0 * D + 8 * lane + 512 * j), ya); unpack8_fp8(*(const u32x2*)(YS8 + (size_t)s1 * D + 8 * lane + 512 * j), yb);
#pragma unroll
                for (int e = 0; e < 8; ++e) x[e] += (ya[e] + yb[e]) * 0.0625f;
                *(f32x4*)(X + (size_t)s * D + 8 * lane + 512 * j) = (f32x4){x[0], x[1], x[2], x[3]};
                *(f32x4*)(X + (size_t)s * D + 8 * lane + 512 * j + 4) = (f32x4){x[4], x[5], x[6], x[7]}; } }
    }
}

extern "C" void kernel_launch(void* const* d_in, const int* in_sizes, int n_in, void* d_out, int out_size, void* d_ws, size_t ws_size, hipStream_t stream) {
    static int grid = 0;
    if (grid == 0) {
        if (n_in != 50 || out_size != S * D || ws_size < WS_END) { fprintf(stderr, "kernel_launch: unexpected shapes (n_in %d, out %d, ws %zu < %zu)\n", n_in, out_size, ws_size, (size_t)WS_END); grid = -1; return; }
        int dev = 0, cus = 0, per_cu = 0;
        if (hipGetDevice(&dev) != hipSuccess || hipDeviceGetAttribute(&cus, hipDeviceAttributeMultiprocessorCount, dev) != hipSuccess) { grid = -1; return; }
        if (hipFuncSetAttribute((const void*)fwd_kernel, hipFuncAttributeMaxDynamicSharedMemorySize, LDS_BYTES) != hipSuccess) { fprintf(stderr, "kernel_launch: hipFuncSetAttribute failed\n"); grid = -1; return; }
        if (hipOccupancyMaxActiveBlocksPerMultiprocessor(&per_cu, (const void*)fwd_kernel, NTHR, LDS_BYTES) != hipSuccess || per_cu < 1) { fprintf(stderr, "kernel_launch: occupancy query says %d\n", per_cu); }
        (void)hipGetLastError();
        grid = cus;
    }
    if (grid < 0) return;
    (void)in_sizes;
    if (hipMemsetAsync((char*)d_ws + WS_CTL, 0, CTL_ZERO_BYTES, stream) != hipSuccess) return;
    Args a{};
    for (int i = 0; i < 50; ++i) a.in[i] = (const float*)d_in[i];
    a.out = (float*)d_out; a.ws = (unsigned char*)d_ws;
#if MK_MULTI
    for (int l = 0; l < NL; ++l)
        for (int ph = 0; ph < NPH; ++ph) { a.l_lo = l; a.l_hi = l + 1; a.ph_lo = ph; a.ph_hi = ph + 1; hipLaunchKernelGGL(fwd_kernel, dim3(grid), dim3(NTHR), LDS_BYTES, stream, a); }
    a.l_lo = NL; a.l_hi = NL + 1; a.ph_lo = 0; a.ph_hi = 0; hipLaunchKernelGGL(fwd_kernel, dim3(grid), dim3(NTHR), LDS_BYTES, stream, a);
#else
    a.l_lo = 0; a.l_hi = NL + 1; a.ph_lo = 0; a.ph_hi = NPH;
    hipLaunchKernelGGL(fwd_kernel, dim3(grid), dim3(NTHR), LDS_BYTES, stream, a);
#endif
    const hipError_t le = hipPeekAtLastError();
    if (le != hipSuccess) fprintf(stderr, "kernel_launch: launch failed: %s\n", hipGetErrorName(le));
}
```

```cpp
#include <hip/hip_runtime.h>
#include <cstdio>
#include <cstdint>

#ifndef MK_MULTI
#define MK_MULTI 0
#endif

#define LAS __attribute__((address_space(3)))
#define GAS __attribute__((address_space(1)))
typedef unsigned short bf16_t;
typedef short bf16x8 __attribute__((ext_vector_type(8)));
typedef float f32x4 __attribute__((ext_vector_type(4)));
typedef float f32x2 __attribute__((ext_vector_type(2)));
typedef float f32x16 __attribute__((ext_vector_type(16)));
typedef unsigned u32x4 __attribute__((ext_vector_type(4)));
typedef unsigned u32x2 __attribute__((ext_vector_type(2)));

constexpr int S = 16384, D = 2048, NL = 4, INW = 3136, INWP = 3200, WINR = 3328;
constexpr int MEMT = 256;
constexpr int NSLOT = 40960;
constexpr float EPS = 1e-6f;
constexpr float LOG2E = 1.4426950408889634f;
constexpr int P_AQ = 0, P_AK = 448, P_AV = 576, P_BA = 704, P_BG = 1216, P_CQ = 1728, P_CKV = 2240, P_CKR = 2496, P_DU = 2560;

constexpr size_t MiB = 1u << 20;
constexpr size_t WS_CTL = 0, CTL_ZERO_BYTES = 1 * MiB;
constexpr size_t WS_ROPE = 1 * MiB;
constexpr size_t WS_H = WS_ROPE + 4 * MiB;
constexpr size_t WS_P = WS_H + 65 * MiB;
constexpr size_t WS_O = WS_P + 104 * MiB;
constexpr size_t WS_QRAW = WS_O + 64 * MiB;
constexpr size_t WS_KVRAW = WS_QRAW + 24 * MiB;
constexpr size_t WS_Q = WS_KVRAW + 32 * MiB;
constexpr size_t WS_KIMG = WS_Q + 24 * MiB;
constexpr size_t WS_VIMG = WS_KIMG + 24 * MiB;
constexpr size_t WS_SWAK = WS_VIMG + 16 * MiB;
constexpr size_t WS_SWAV = WS_SWAK + 4 * MiB;
constexpr size_t WS_ZC = WS_SWAV + 4 * MiB;
constexpr size_t WS_UA = WS_ZC + 16 * MiB;
constexpr size_t WS_EBUF = WS_UA + 20 * MiB;
constexpr size_t WS_YG = WS_EBUF + 4 * MiB;
constexpr size_t WS_QX = WS_YG + 16 * MiB;
constexpr size_t WS_OX = WS_QX + 16 * MiB;
constexpr size_t WS_MEMN = WS_OX + 16 * MiB;
constexpr size_t WS_KMEM = WS_MEMN + 1 * MiB;
constexpr size_t WS_VMEM = WS_KMEM + 1 * MiB;
constexpr size_t WS_XKIMG = WS_VMEM + 1 * MiB;
constexpr size_t WS_XVIMG = WS_XKIMG + 1 * MiB;
constexpr size_t WS_LOG = WS_XVIMG + 1 * MiB;
constexpr size_t WS_REC = WS_LOG + 4 * MiB;
constexpr size_t WS_TOK = WS_REC + 1 * MiB;
constexpr size_t WS_WSLOT = WS_TOK + 1 * MiB;
constexpr size_t WS_HID = WS_WSLOT + 1 * MiB;
constexpr size_t WS_YS = WS_HID + 40 * MiB;
constexpr size_t WS_WIN = WS_YS + 160 * MiB;
constexpr size_t WS_WOUT = WS_WIN + 13 * MiB;
constexpr size_t WS_XWQ = WS_WOUT + 8 * MiB;
constexpr size_t WS_XWK = WS_XWQ + 2 * MiB;
constexpr size_t WS_XWV = WS_XWK + 2 * MiB;
constexpr size_t WS_XWO = WS_XWV + 2 * MiB;
constexpr size_t WS_PW = WS_XWO + 2 * MiB;
constexpr size_t WS_WQB = WS_PW + 1 * MiB;
constexpr size_t WS_WKVB = WS_WQB + 1 * MiB;
constexpr size_t WS_GLU = WS_WKVB + 1 * MiB;
constexpr size_t WS_ROUT = WS_GLU + 1 * MiB;
constexpr size_t WS_MOE1 = WS_ROUT + 1 * MiB;
constexpr size_t WS_MOE2 = WS_MOE1 + 128 * MiB;
constexpr size_t WS_W1G = WS_MOE2 + 64 * MiB;
constexpr size_t WS_BTY = WS_W1G + 16 * MiB;
constexpr size_t WS_PARTO = WS_BTY + 80 * MiB;
constexpr size_t WS_PARTML = WS_PARTO + 32 * MiB;
constexpr size_t WS_XB = WS_PARTML + 1 * MiB;
constexpr size_t WS_QXP = WS_XB + 65 * MiB;
constexpr size_t WS_LOGP = WS_QXP + 64 * MiB;
constexpr size_t WS_SSP = WS_LOGP + 16 * MiB;
constexpr size_t WS_RMSV = WS_SSP + 2 * MiB;
constexpr size_t WS_RMS1 = WS_RMSV + 1 * MiB;
constexpr size_t WS_XF8 = WS_RMS1 + 1 * MiB;
constexpr size_t WS_END = WS_XF8 + 33 * MiB;
constexpr int CW_BAR = 4096;
constexpr int CW_SS = 32768;
constexpr int CW_CNT = 16384;

constexpr int RING_BYTES = 131072;
constexpr int LDSCTL_OFF = RING_BYTES;
constexpr int LDS_BYTES = 147456;
constexpr int NWAVES = 8, NTHR = 512;

__device__ __forceinline__ float bf2f(unsigned b) { return __uint_as_float(b << 16); }
typedef __bf16 bf16x2_t __attribute__((ext_vector_type(2)));
__device__ __forceinline__ unsigned cvt_pk_bf16(float lo, float hi) { const f32x2 v = {lo, hi}; const bf16x2_t b = __builtin_convertvector(v, bf16x2_t); return __builtin_bit_cast(unsigned, b); }
__device__ __forceinline__ float wave_sum(float v) {
#pragma unroll
    for (int o = 1; o < 64; o <<= 1) v += __shfl_xor(v, o);
    return v;
}
__device__ __forceinline__ float fast_exp2(float x) { return __builtin_amdgcn_exp2f(x); }
__device__ __forceinline__ float fast_rcp(float x) { return __builtin_amdgcn_rcpf(x); }
__device__ __forceinline__ float sigmoidf_(float x) { return fast_rcp(1.f + fast_exp2(-x * LOG2E)); }
__device__ __forceinline__ void unpack8(const u32x4 w, float (&f)[8]) {
    f[0] = bf2f(w.x & 0xffffu); f[1] = bf2f(w.x >> 16); f[2] = bf2f(w.y & 0xffffu); f[3] = bf2f(w.y >> 16);
    f[4] = bf2f(w.z & 0xffffu); f[5] = bf2f(w.z >> 16); f[6] = bf2f(w.w & 0xffffu); f[7] = bf2f(w.w >> 16);
}
__device__ __forceinline__ u32x4 pack8(const float (&f)[8]) { u32x4 w; w.x = cvt_pk_bf16(f[0], f[1]); w.y = cvt_pk_bf16(f[2], f[3]); w.z = cvt_pk_bf16(f[4], f[5]); w.w = cvt_pk_bf16(f[6], f[7]); return w; }
__device__ __forceinline__ unsigned pk4_fp8(float a, float b, float c, float d) { int w = __builtin_amdgcn_cvt_pk_fp8_f32(a, b, 0, false); w = __builtin_amdgcn_cvt_pk_fp8_f32(c, d, w, true); return (unsigned)w; }
__device__ __forceinline__ void unpack8_fp8(const u32x2 w, float (&f)[8]) { const f32x2 a = __builtin_amdgcn_cvt_pk_f32_fp8(w.x, false), b = __builtin_amdgcn_cvt_pk_f32_fp8(w.x, true), c = __builtin_amdgcn_cvt_pk_f32_fp8(w.y, false), d = __builtin_amdgcn_cvt_pk_f32_fp8(w.y, true);
    f[0] = a.x; f[1] = a.y; f[2] = b.x; f[3] = b.y; f[4] = c.x; f[5] = c.y; f[6] = d.x; f[7] = d.y; }
#define LDS_WAIT() asm volatile("s_waitcnt lgkmcnt(0)" ::: "memory")
#define VM_WAIT() asm volatile("s_waitcnt vmcnt(0)" ::: "memory")

namespace pg8 {
constexpr int BM = 256, BK = 64, HALF = 128, HTB = HALF * BK * 2, STAGE_BYTES = 8 * HTB, NXCD = 8, WGM = 8;
__host__ __device__ __forceinline__ int lds_byte(int r, int c) { const int st = (r >> 4) * 2 + (c >> 5), rr = r & 15, cc = c & 31, ob = rr * 64 + cc * 2; return st * 1024 + (ob ^ (((ob >> 9) & 1) << 5)); }
__host__ __device__ __forceinline__ void stage_rc(int b, int& R, int& C) { const int st = b / 1024, sb = b % 1024, swz = sb ^ (((sb >> 9) & 1) << 5); R = (st >> 1) * 16 + swz / 64; C = (st & 1) * 32 + (swz % 64) / 2; }
__host__ __device__ __forceinline__ int perm32(int rho) { const int n = rho >> 4, i = rho & 15; return 8 * (i >> 2) + 4 * n + (i & 3); }

struct Unit { int pm, pn, z; const char* a; const char* b; const int* rows; };

struct GSched {
    const char* A; const char* B; size_t aTile, bTile, aZ, bZ; int nM, nN, nZ, G, c;
    __device__ __forceinline__ bool next(int i, Unit& u) const {
        const int nwg = nM * nN; const long L = (long)i * G + c; if (L >= (long)nwg * nZ) return false;
        const int z = (int)(L / nwg); int wgid = (int)(L - (long)z * nwg);
        { const int q = nwg / NXCD, r = nwg % NXCD, xcd = wgid % NXCD, off = wgid / NXCD; wgid = (xcd < r ? xcd * (q + 1) : r * (q + 1) + (xcd - r) * q) + off; }
        const int nig = WGM * nN, gid = wgid / nig, fm = gid * WGM, gsz = (nM - fm) < WGM ? (nM - fm) : WGM;
        u.pm = fm + ((wgid % nig) % gsz); u.pn = (wgid % nig) / gsz; u.z = z;
        u.a = A + (size_t)z * aZ + (size_t)u.pm * aTile; u.b = B + (size_t)z * bZ + (size_t)u.pn * bTile; u.rows = nullptr; return true;
    }
};

template <class Epi, class Sched, bool GATHER = false, bool F8 = false>
__device__ __forceinline__ void gemm_phase(const int tid_in, LAS unsigned char* lds, const int K, const int lda, const int ldb, const char* Abase, const Sched& S, const Epi& E) {
    int tid = tid_in; asm volatile("" : "+v"(tid));
    const int wid = __builtin_amdgcn_readfirstlane(tid >> 6), lane = tid & 63, wr = wid >> 2, wc = wid & 3, fr = lane & 15, fq = lane >> 4;
    const int nt = K / BK;
    unsigned voffA[2], voffB[2]; int rA[2], cA2[2];
#pragma unroll
    for (int i = 0; i < 2; ++i) { int R, C; stage_rc(tid * 16 + i * 8192, R, C); const int Rb = Epi::PERM ? ((R & ~31) + perm32(R & 31)) : R;
        voffA[i] = (unsigned)(R * lda + C) * 2u; voffB[i] = (unsigned)(Rb * ldb + C) * 2u; rA[i] = R; cA2[i] = C * 2; }
    const size_t kstep = (size_t)(BK * 2);
    const size_t hstepA = (size_t)HALF * lda * 2, hstepB = (size_t)HALF * ldb * 2;
    const unsigned ldsw = (unsigned)wid * 1024u;
    const int aoff = lds_byte(wr * 64 + fr, fq * 8), boff = lds_byte(wc * 32 + fr, fq * 8);
#define PG8_SA(b, h) (((b) * 2 + (h)) * HTB)
#define PG8_SB(b, h) ((4 + (b) * 2 + (h)) * HTB)
#define PG8_STAGE(bufoff, gbase, voff) do { _Pragma("unroll") for (int _i = 0; _i < 2; ++_i) \
        __builtin_amdgcn_global_load_lds((const unsigned*)((const char*)(gbase) + (voff)[_i]), (LAS unsigned*)(lds + (bufoff) + ldsw + _i * 8192), 16, 0, 0); } while (0)
#define PG8_LDA(dst, b, h) do { _Pragma("unroll") for (int m = 0; m < 4; ++m) _Pragma("unroll") for (int k = 0; k < 2; ++k) dst[m][k] = *(const LAS bf16x8*)(lds + PG8_SA(b, h) + aoff + m * 2048 + k * 1024); } while (0)
#define PG8_LDB(dst, b, h) do { _Pragma("unroll") for (int n = 0; n < 2; ++n) _Pragma("unroll") for (int k = 0; k < 2; ++k) dst[n][k] = *(const LAS bf16x8*)(lds + PG8_SB(b, h) + boff + n * 2048 + k * 1024); } while (0)
typedef long pg8_i64x2 __attribute__((ext_vector_type(2)));
#define PG8_MMA(ai, bj, At, Bt) do { __builtin_amdgcn_s_setprio(1); _Pragma("unroll") for (int m = 0; m < 4; ++m) _Pragma("unroll") for (int n = 0; n < 2; ++n) _Pragma("unroll") for (int k = 0; k < 2; ++k) { \
        if constexpr (F8) {   \
            const pg8_i64x2 a_ = __builtin_bit_cast(pg8_i64x2, At[m][k]), b_ = __builtin_bit_cast(pg8_i64x2, Bt[n][k]); \
            acc[ai][bj][m][n] = __builtin_amdgcn_mfma_f32_16x16x32_fp8_fp8(b_.x, a_.x, acc[ai][bj][m][n], 0, 0, 0); \
            acc[ai][bj][m][n] = __builtin_amdgcn_mfma_f32_16x16x32_fp8_fp8(b_.y, a_.y, acc[ai][bj][m][n], 0, 0, 0); \
        } else acc[ai][bj][m][n] = __builtin_amdgcn_mfma_f32_16x16x32_bf16(Bt[n][k], At[m][k], acc[ai][bj][m][n], 0, 0, 0); } \
        __builtin_amdgcn_s_setprio(0); } while (0)
#define PG8_WAIT_V(n) asm volatile("s_waitcnt vmcnt(" #n ")" ::: "memory")
#define PG8_WAIT_L(n) asm volatile("s_waitcnt lgkmcnt(" #n ")" ::: "memory")
#define PG8_BAR __builtin_amdgcn_s_barrier()
#define PG8_SCHED __builtin_amdgcn_sched_barrier(0)
    Unit cur, nxt; int ui = 0;
    if (!S.next(0, cur)) return;
    f32x4 acc[2][2][4][2];
#pragma unroll
    for (int a = 0; a < 2; ++a)
#pragma unroll
        for (int b = 0; b < 2; ++b)
#pragma unroll
            for (int m = 0; m < 4; ++m)
#pragma unroll
                for (int n = 0; n < 2; ++n) acc[a][b][m][n] = (f32x4){0.f, 0.f, 0.f, 0.f};
    bf16x8 At[4][2], B0[2][2], B1[2][2];
    unsigned gc0[2], gc1[2], gn0[2], gn1[2];
    const char* cA = GATHER ? Abase : cur.a; const char* cB = cur.b;
    if constexpr (GATHER) {
#pragma unroll
        for (int i = 0; i < 2; ++i) { gc0[i] = (unsigned)cur.rows[rA[i]] * (unsigned)(lda * 2) + (unsigned)cA2[i]; gc1[i] = (unsigned)cur.rows[HALF + rA[i]] * (unsigned)(lda * 2) + (unsigned)cA2[i]; gn0[i] = gc0[i]; gn1[i] = gc1[i]; }
    }
#define PG8_STAGE_A(bufoff, h, ptr, usenext) do { if constexpr (GATHER) { if (usenext) { if ((h) == 0) PG8_STAGE(bufoff, ptr, gn0); else PG8_STAGE(bufoff, ptr, gn1); } else { if ((h) == 0) PG8_STAGE(bufoff, ptr, gc0); else PG8_STAGE(bufoff, ptr, gc1); } } \
        else { PG8_STAGE(bufoff, (ptr) + ((h) ? hstepA : 0), voffA); } } while (0)
    PG8_STAGE(PG8_SB(0, 0), cB, voffB); PG8_STAGE(PG8_SB(0, 1), cB + hstepB, voffB); PG8_STAGE_A(PG8_SA(0, 0), 0, cA, false); PG8_STAGE_A(PG8_SA(0, 1), 1, cA, false);
    if (wr == 1) PG8_BAR;
    PG8_WAIT_V(2); PG8_BAR;
    PG8_STAGE(PG8_SB(1, 0), cB + kstep, voffB); PG8_STAGE_A(PG8_SA(1, 0), 0, cA + kstep, false); PG8_STAGE(PG8_SB(1, 1), cB + hstepB + kstep, voffB);
    PG8_WAIT_V(6); PG8_BAR;
    for (;;) {
        const bool has_next = S.next(ui + 1, nxt);
        const char* nA = GATHER ? Abase : (has_next ? nxt.a : cA); const char* nB = has_next ? nxt.b : cB;
        if constexpr (GATHER) {
            if (has_next) {
#pragma unroll
                for (int i = 0; i < 2; ++i) { gn0[i] = (unsigned)nxt.rows[rA[i]] * (unsigned)(lda * 2) + (unsigned)cA2[i]; gn1[i] = (unsigned)nxt.rows[HALF + rA[i]] * (unsigned)(lda * 2) + (unsigned)cA2[i]; }
            } else {
#pragma unroll
                for (int i = 0; i < 2; ++i) { gn0[i] = gc0[i]; gn1[i] = gc1[i]; }
            }
        }
#pragma unroll 1
        for (int t = 0; t < nt; t += 2) {
            const bool last = (t == nt - 2);
            const char* a1 = cA + (size_t)(t + 1) * kstep;
            const char* a2 = last ? nA : cA + (size_t)(t + 2) * kstep; const char* b2 = last ? nB : cB + (size_t)(t + 2) * kstep;
            const char* a3 = a2 + kstep; const char* b3 = b2 + kstep;
            PG8_LDB(B0, 0, 0); PG8_LDB(B1, 0, 1); PG8_SCHED; PG8_LDA(At, 0, 0); PG8_STAGE_A(PG8_SA(1, 1), 1, a1, false);
            PG8_WAIT_V(8); PG8_WAIT_L(0); PG8_BAR; PG8_MMA(0, 0, At, B0); PG8_MMA(0, 1, At, B1); PG8_BAR; PG8_SCHED;
            PG8_LDA(At, 0, 1); PG8_STAGE(PG8_SB(0, 0), b2, voffB); PG8_STAGE(PG8_SB(0, 1), b2 + hstepB, voffB); PG8_STAGE_A(PG8_SA(0, 0), 0, a2, last);
            PG8_WAIT_V(8); PG8_WAIT_L(0); PG8_BAR; PG8_MMA(1, 0, At, B0); PG8_MMA(1, 1, At, B1); PG8_BAR; PG8_SCHED;
            PG8_LDB(B0, 1, 0); PG8_LDB(B1, 1, 1); PG8_SCHED; PG8_LDA(At, 1, 0); PG8_STAGE_A(PG8_SA(0, 1), 1, a2, last);
            PG8_WAIT_V(8); PG8_WAIT_L(0); PG8_BAR; PG8_MMA(0, 0, At, B0); PG8_MMA(0, 1, At, B1); PG8_BAR; PG8_SCHED;
            PG8_LDA(At, 1, 1); PG8_STAGE(PG8_SB(1, 0), b3, voffB); PG8_STAGE(PG8_SB(1, 1), b3 + hstepB, voffB); PG8_STAGE_A(PG8_SA(1, 0), 0, a3, last);
            PG8_WAIT_V(8); PG8_WAIT_L(0); PG8_BAR; PG8_MMA(1, 0, At, B0); PG8_MMA(1, 1, At, B1); PG8_BAR; PG8_SCHED;
        }
        if (wr == 0) PG8_BAR;
        E(acc, cur, wr, wc, fr, fq);
        if (!has_next) break;
#pragma unroll
        for (int a = 0; a < 2; ++a)
#pragma unroll
            for (int b = 0; b < 2; ++b)
#pragma unroll
                for (int m = 0; m < 4; ++m)
#pragma unroll
                    for (int n = 0; n < 2; ++n) acc[a][b][m][n] = (f32x4){0.f, 0.f, 0.f, 0.f};
        cur = nxt; cA = nA; cB = nB; ++ui;
        if constexpr (GATHER) {
#pragma unroll
            for (int i = 0; i < 2; ++i) { gc0[i] = gn0[i]; gc1[i] = gn1[i]; }
        }
        if (wr == 1) PG8_BAR;
    }
    PG8_WAIT_V(0);
    PG8_BAR;
#undef PG8_STAGE_A
#undef PG8_SA
#undef PG8_SB
#undef PG8_STAGE
#undef PG8_LDA
#undef PG8_LDB
#undef PG8_MMA
#undef PG8_WAIT_V
#undef PG8_WAIT_L
#undef PG8_BAR
#undef PG8_SCHED
}

struct EpiBf16 {
    static constexpr bool PERM = true;
    bf16_t* O; int ldc; int col_off; const float* bias; const float* rowscale;
    __device__ __forceinline__ void operator()(const f32x4 (&acc)[2][2][4][2], const Unit& u, int wr, int wc, int fr, int fq) const {
        const int row0 = u.pm * BM + wr * 64 + fr, c0 = u.pn * BM + wc * 32 + 8 * fq;
        f32x4 bv[2][2];
#pragma unroll
        for (int bj = 0; bj < 2; ++bj)
#pragma unroll
            for (int n = 0; n < 2; ++n) bv[bj][n] = bias ? *(const f32x4*)(bias + c0 + bj * HALF + 4 * n) : (f32x4){0.f, 0.f, 0.f, 0.f};
#pragma unroll
        for (int ai = 0; ai < 2; ++ai)
#pragma unroll
            for (int m = 0; m < 4; ++m) { const int row = row0 + ai * HALF + m * 16; bf16_t* rowp = O + (size_t)row * ldc + col_off + c0; const float rs = rowscale ? rowscale[row] : 1.f;
#pragma unroll
                for (int bj = 0; bj < 2; ++bj) { const f32x4 v0 = acc[ai][bj][m][0] * rs + bv[bj][0], v1 = acc[ai][bj][m][1] * rs + bv[bj][1];
                    u32x4 w; w.x = cvt_pk_bf16(v0[0], v0[1]); w.y = cvt_pk_bf16(v0[2], v0[3]); w.z = cvt_pk_bf16(v1[0], v1[1]); w.w = cvt_pk_bf16(v1[2], v1[3]);
                    *(u32x4*)(rowp + bj * HALF) = w; } }
    }
};
struct EpiResid {
    static constexpr bool PERM = true;
    bf16_t* XBp; int ldc; float* SS; bool dry; unsigned char* XF8p;
    __device__ __forceinline__ void operator()(const f32x4 (&acc)[2][2][4][2], const Unit& u, int wr, int wc, int fr, int fq) const {
        const int row0 = u.pm * BM + wr * 64 + fr, c0 = u.pn * BM + wc * 32 + 8 * fq;
#pragma unroll
        for (int ai = 0; ai < 2; ++ai)
#pragma unroll
            for (int m = 0; m < 4; ++m) { const int row = row0 + ai * HALF + m * 16; bf16_t* rowb = XBp + (size_t)row * ldc + c0; float ss = 0.f;
                u32x4 old[2];
#pragma unroll
                for (int bj = 0; bj < 2; ++bj) old[bj] = *(const u32x4*)(rowb + bj * HALF);
#pragma unroll
                for (int bj = 0; bj < 2; ++bj) { float x[8]; unpack8(old[bj], x);
#pragma unroll
                    for (int j = 0; j < 4; ++j) { x[j] += acc[ai][bj][m][0][j]; x[4 + j] += acc[ai][bj][m][1][j]; }
#pragma unroll
                    for (int j = 0; j < 8; ++j) ss += x[j] * x[j];
                    if (!dry) *(u32x4*)(rowb + bj * HALF) = pack8(x);
                    if (XF8p) *(u32x2*)(XF8p + (size_t)row * ldc + c0 + bj * HALF) = (u32x2){pk4_fp8(x[0], x[1], x[2], x[3]), pk4_fp8(x[4], x[5], x[6], x[7])}; }
                if (SS) { ss += __shfl_xor(ss, 16); ss += __shfl_xor(ss, 32); if (fq == 0) SS[(size_t)row * 32 + u.pn * 4 + wc] = ss; } }
    }
};
struct EpiF32Z {
    static constexpr bool PERM = false;
    float* C; int ldc; size_t zstride;
    __device__ __forceinline__ void operator()(const f32x4 (&acc)[2][2][4][2], const Unit& u, int wr, int wc, int fr, int fq) const {
        const int row0 = u.pm * BM + wr * 64 + fr, col0 = u.pn * BM + wc * 32 + 4 * fq;
#pragma unroll
        for (int ai = 0; ai < 2; ++ai)
#pragma unroll
            for (int m = 0; m < 4; ++m) { float* rowp = C + (size_t)u.z * zstride + (size_t)(row0 + ai * HALF + m * 16) * ldc + col0;
#pragma unroll
                for (int bj = 0; bj < 2; ++bj)
#pragma unroll
                    for (int n = 0; n < 2; ++n) *(f32x4*)(rowp + bj * HALF + n * 16) = acc[ai][bj][m][n]; }
    }
};
template <int NVALID> struct EpiF32Part {
    static constexpr bool PERM = false;
    float* C; int ldc; size_t zstride;
    __device__ __forceinline__ void operator()(const f32x4 (&acc)[2][2][4][2], const Unit& u, int wr, int wc, int fr, int fq) const {
        if (u.pn != 0) return;
        if (NVALID == 64 && wc >= 2) return;
        const int row0 = u.pm * BM + wr * 64 + fr, col0 = wc * 32 + 4 * fq;
#pragma unroll
        for (int ai = 0; ai < 2; ++ai)
#pragma unroll
            for (int m = 0; m < 4; ++m) { float* rowp = C + (size_t)u.z * zstride + (size_t)(row0 + ai * HALF + m * 16) * ldc + col0;
#pragma unroll
                for (int n = 0; n < 2; ++n) *(f32x4*)(rowp + n * 16) = acc[ai][0][m][n]; }
    }
};
struct EpiSsmY {
    static constexpr bool PERM = true;
    bf16_t* YG;
    __device__ __forceinline__ void operator()(const f32x4 (&acc)[2][2][4][2], const Unit& u, int wr, int wc, int fr, int fq) const {
        const int row0 = wr * 64 + fr, c0 = u.pn * BM + wc * 32 + 8 * fq;
#pragma unroll
        for (int ai = 0; ai < 2; ++ai)
#pragma unroll
            for (int m = 0; m < 4; ++m) { const int chunk = row0 + ai * HALF + m * 16;
#pragma unroll
                for (int bj = 0; bj < 2; ++bj) { const int col = c0 + bj * HALF, t = col >> 4, o0 = col & 15;
                    float v[8];
#pragma unroll
                    for (int j = 0; j < 4; ++j) { v[j] = acc[ai][bj][m][0][j]; v[4 + j] = acc[ai][bj][m][1][j]; }
#pragma unroll
                    for (int j = 0; j < 8; ++j) { const float x = v[j], y = 1.5957691216f * (x + 0.044715f * x * x * x); v[j] = x * fast_rcp(1.f + fast_exp2(-y * LOG2E)); }
                    *(u32x4*)(YG + (size_t)(chunk * 64 + t) * 512 + u.z * 16 + o0) = pack8(v); } }
    }
};
struct EpiGlu {
    static constexpr bool PERM = true;
    const bf16_t* YG; const float* bias; bf16_t* O;
    __device__ __forceinline__ void operator()(const f32x4 (&acc)[2][2][4][2], const Unit& u, int wr, int wc, int fr, int fq) const {
        const int row0 = u.pm * BM + wr * 64 + fr, c0 = u.pn * BM + wc * 32 + 8 * fq;
#pragma unroll
        for (int ai = 0; ai < 2; ++ai)
#pragma unroll
            for (int m = 0; m < 4; ++m) { const int row = row0 + ai * HALF + m * 16;
#pragma unroll
                for (int bj = 0; bj < 2; ++bj) { const int col = c0 + bj * HALF;
                    const u32x4 yw = *(const u32x4*)(YG + (size_t)row * 512 + col); float y[8]; unpack8(yw, y);
                    const f32x4 b0 = *(const f32x4*)(bias + col), b1 = *(const f32x4*)(bias + col + 4);
                    float v[8];
#pragma unroll
                    for (int j = 0; j < 4; ++j) { v[j] = y[j] * sigmoidf_(acc[ai][bj][m][0][j] + b0[j]); v[4 + j] = y[4 + j] * sigmoidf_(acc[ai][bj][m][1][j] + b1[j]); }
                    *(u32x4*)(O + (size_t)row * D + 1536 + col) = pack8(v); } }
    }
};
struct EpiMoe1 {
    static constexpr bool PERM = true;
    unsigned char* HID8; const int* TOKp; const float* SS;
    __device__ __forceinline__ void operator()(const f32x4 (&acc)[2][2][4][2], const Unit& u, int wr, int wc, int fr, int fq) const {
        const int row0 = u.z * BM + wr * 64 + fr, c0 = u.pn * HALF + wc * 32 + 8 * fq;
#pragma unroll
        for (int ai = 0; ai < 2; ++ai)
#pragma unroll
            for (int m = 0; m < 4; ++m) { const int row = row0 + ai * HALF + m * 16; float v[8];
                const float rs = SS[TOKp[row]] * (1.0f / 32.0f);
#pragma unroll
                for (int j = 0; j < 4; ++j) { const float g0 = acc[ai][0][m][0][j] * rs, g1 = acc[ai][0][m][1][j] * rs; v[j] = g0 * sigmoidf_(g0) * (acc[ai][1][m][0][j] * rs); v[4 + j] = g1 * sigmoidf_(g1) * (acc[ai][1][m][1][j] * rs); }
                *(u32x2*)(HID8 + (size_t)row * 512 + c0) = (u32x2){pk4_fp8(v[0], v[1], v[2], v[3]), pk4_fp8(v[4], v[5], v[6], v[7])}; }
    }
};
struct EpiMoe2 {
    static constexpr bool PERM = true;
    unsigned char* YS8; const float* W;
    __device__ __forceinline__ void operator()(const f32x4 (&acc)[2][2][4][2], const Unit& u, int wr, int wc, int fr, int fq) const {
        const int row0 = u.z * BM + wr * 64 + fr, c0 = u.pn * BM + wc * 32 + 8 * fq;
#pragma unroll
        for (int ai = 0; ai < 2; ++ai)
#pragma unroll
            for (int m = 0; m < 4; ++m) { const int row = row0 + ai * HALF + m * 16; const float w = W[row] * (16.0f / 32.0f);
#pragma unroll
                for (int bj = 0; bj < 2; ++bj) { const f32x4 v0 = acc[ai][bj][m][0] * w, v1 = acc[ai][bj][m][1] * w;
                    *(u32x2*)(YS8 + (size_t)row * D + c0 + bj * HALF) = (u32x2){pk4_fp8(v0[0], v0[1], v0[2], v0[3]), pk4_fp8(v1[0], v1[1], v1[2], v1[3])}; } }
    }
};
struct EpiBf16Part64 {
    static constexpr bool PERM = true;
    bf16_t* O; size_t zstride; const float* rowscale;
    __device__ __forceinline__ void operator()(const f32x4 (&acc)[2][2][4][2], const Unit& u, int wr, int wc, int fr, int fq) const {
        if (wc >= 2) return;
        const int row0 = u.pm * BM + wr * 64 + fr, c0 = wc * 32 + 8 * fq;
#pragma unroll
        for (int ai = 0; ai < 2; ++ai)
#pragma unroll
            for (int m = 0; m < 4; ++m) { const int row = row0 + ai * HALF + m * 16; const float rs = rowscale[row]; const f32x4 v0 = acc[ai][0][m][0] * rs, v1 = acc[ai][0][m][1] * rs;
                u32x4 w; w.x = cvt_pk_bf16(v0[0], v0[1]); w.y = cvt_pk_bf16(v0[2], v0[3]); w.z = cvt_pk_bf16(v1[0], v1[1]); w.w = cvt_pk_bf16(v1[2], v1[3]);
                *(u32x4*)(O + (size_t)u.z * zstride + (size_t)row * 64 + c0) = w; }
    }
};
struct EpiBf16Z { static constexpr bool PERM = true; bf16_t* O0; int ldc; size_t zstride;
    __device__ __forceinline__ void operator()(const f32x4 (&acc)[2][2][4][2], const Unit& u, int wr, int wc, int fr, int fq) const { EpiBf16 e{O0 + (size_t)u.z * zstride, ldc, 0, nullptr, nullptr}; e(acc, u, wr, wc, fr, fq); } };
struct EpiMem { static constexpr bool PERM = true; bf16_t* K0; bf16_t* V0;
    __device__ __forceinline__ void operator()(const f32x4 (&acc)[2][2][4][2], const Unit& u, int wr, int wc, int fr, int fq) const { EpiBf16 e{((u.z >> 2) ? V0 : K0) + (size_t)(u.z & 3) * 256 * 512, 512, 0, nullptr, nullptr}; e(acc, u, wr, wc, fr, fq); } };
struct MemSched { const char* A; const char* B; int G, c;
    __device__ __forceinline__ bool next(int i, Unit& u) const {
        const long L = (long)i * G + c; if (L >= 16) return false;
        const int pn = (int)L & 1, ks = ((int)L >> 1) & 3, kv = (int)L >> 3;
        u.pm = 0; u.pn = pn; u.z = kv * 4 + ks; u.a = A + (size_t)ks * 1024; u.b = B + (size_t)kv * 512 * D * 2 + (size_t)pn * 256 * D * 2 + (size_t)ks * 1024; u.rows = nullptr; return true; } };
struct MoeSched { const LAS int* pst; const char* B; const int* tok; size_t bE, bTile; int nN, G, c, mode;
    __device__ __forceinline__ bool next(int i, Unit& u) const {
        const int nb = __builtin_amdgcn_readfirstlane(pst[32]) >> 8; const int n1 = nb * nN, n1a = (n1 / G) * G;
        const int cv = (G % NXCD == 0) ? (c % NXCD) * (G / NXCD) + c / NXCD : c;
        const long L = (long)(mode == 2 ? n1a : 0) + (long)i * G + cv; if (L >= (long)(mode == 1 ? n1a : n1)) return false;
        const int b = (int)(L / nN), pn = (int)(L % nN); const int e = __builtin_amdgcn_readfirstlane(pst[240 + b]);
        u.pm = 0; u.pn = pn; u.z = b; u.a = nullptr; u.rows = tok + b * 256; u.b = B + (size_t)e * bE + (size_t)pn * bTile; return true; } };
struct MoeSched2 { const LAS int* pst; const char* A; const char* B; size_t bE, bTile; int nN, G, c, mode;
    __device__ __forceinline__ bool next(int i, Unit& u) const {
        const int nb = __builtin_amdgcn_readfirstlane(pst[32]) >> 8; const int n1 = nb * 4, r1 = n1 % G, bdone = ((n1 / G) * G) / 4, n2a = bdone * nN, n2 = nb * nN;
        const int cv = (G % NXCD == 0) ? (c % NXCD) * (G / NXCD) + c / NXCD : c;
        long L;
        if (mode == 1) { const int nfree = r1 ? G - r1 : 0; const long E = 3L * nfree;
            if (r1 && cv >= r1) L = (i < 3) ? (long)i * nfree + (cv - r1) : E + (long)(i - 3) * G + cv; else L = E + (long)i * G + cv;
            if (L >= n2a) return false; }
        else { L = (long)n2a + (long)i * G + cv; if (L >= n2) return false; }
        const int b = (int)(L / nN), pn = (int)(L % nN); const int e = __builtin_amdgcn_readfirstlane(pst[240 + b]);
        u.pm = 0; u.pn = pn; u.z = b; u.a = A + (size_t)b * 256 * 512; u.rows = nullptr; u.b = B + (size_t)e * bE + (size_t)pn * bTile; return true; } };
}

#define XB_TMO      128
#define XB_XCNT(j)  (256  + 64 * (j))
#define XB_XSUB(j)  (1280 + 64 * (j))
#define XB_XGEN(j)  (2304 + 64 * (j))
#define XB_TOP      3328
#define XB_TOPGEN   3392
#define XCD_BAR_WORDS 3456
#define XB_SPIN_CAP (1u << 22)
__device__ __forceinline__ unsigned xb_ld(unsigned* p)              { return __hip_atomic_load(p, __ATOMIC_RELAXED, __HIP_MEMORY_SCOPE_AGENT); }
__device__ __forceinline__ unsigned xb_add(unsigned* p, unsigned v) { return __hip_atomic_fetch_add(p, v, __ATOMIC_RELAXED, __HIP_MEMORY_SCOPE_AGENT); }
__device__ __forceinline__ unsigned xb_xcc_id() { return (unsigned)__builtin_amdgcn_s_getreg((3 << 11) | 20) & 0xFu; }
#define XB_SPIN(cond, bar) do { unsigned _sp = 0; while (cond) { __builtin_amdgcn_s_sleep(1); \
    if ((++_sp & 255u) == 0u) { if (xb_ld(&(bar)[XB_TMO])) break; if (_sp > XB_SPIN_CAP) { atomicAdd(&(bar)[XB_TMO], 1u); break; } } } } while (0)
struct XcdBarrier { unsigned* bar; unsigned x; volatile LAS unsigned* st; };
__device__ __forceinline__ XcdBarrier xcd_barrier_post(unsigned* bar, volatile LAS unsigned* st) {
    XcdBarrier b; b.bar = bar; b.x = xb_xcc_id(); b.st = st;
    if (threadIdx.x == 0) (void)xb_add(&bar[XB_XCNT(b.x)], 1u);
    return b;
}
__device__ __forceinline__ void xcd_barrier_complete(unsigned* bar, unsigned x, unsigned& nloc, unsigned& nx) {
    const unsigned G = gridDim.x * gridDim.y * gridDim.z;
    unsigned sum, cnt, mine, sp = 0u;
    for (;;) {
        sum = 0u; cnt = 0u; mine = 0u;
#pragma unroll
        for (unsigned j = 0; j < 16; ++j) { const unsigned c = xb_ld(&bar[XB_XCNT(j)]); sum += c; cnt += (c > 0u) ? 1u : 0u; mine = (j == x) ? c : mine; }
        if (sum == G) break;
        __builtin_amdgcn_s_sleep(1);
        if ((++sp & 255u) == 0u) { if (xb_ld(&bar[XB_TMO])) break; if (sp > XB_SPIN_CAP) { atomicAdd(&bar[XB_TMO], 1u); break; } }
    }
    nloc = mine > 0u ? mine : 1u; nx = cnt > 0u ? cnt : 1u;
}
__device__ __forceinline__ void xcd_barrier(const XcdBarrier& b, const int tid_) {
    asm volatile("s_waitcnt vmcnt(0)" ::: "memory");
    __syncthreads();
    if (tid_ == 0) {
        unsigned* bar = b.bar;
        __builtin_amdgcn_s_waitcnt(0);
        unsigned nloc = b.st[0], nx = b.st[1];
        if (nloc == 0u) { xcd_barrier_complete(bar, b.x, nloc, nx); b.st[0] = nloc; b.st[1] = nx; }
        const unsigned old = xb_add(&bar[XB_XSUB(b.x)], 1u);
        const unsigned gen = old / nloc;
        if (old + 1u == (gen + 1u) * nloc) {
            __builtin_amdgcn_fence(__ATOMIC_RELEASE, "agent");
            asm volatile("s_waitcnt vmcnt(0)" ::: "memory");
            const unsigned og = xb_add(&bar[XB_TOP], 1u);
            const unsigned tg = og / nx;
            if (og + 1u == (tg + 1u) * nx) xb_add(&bar[XB_TOPGEN], 1u);
            else XB_SPIN(xb_ld(&bar[XB_TOPGEN]) == tg, bar);
            __builtin_amdgcn_fence(__ATOMIC_ACQUIRE, "agent");
            xb_add(&bar[XB_XGEN(b.x)], 1u);
            asm volatile("s_waitcnt vmcnt(0)" ::: "memory");
        } else {
            XB_SPIN(xb_ld(&bar[XB_XGEN(b.x)]) == gen, bar);
            __builtin_amdgcn_fence(__ATOMIC_ACQUIRE, "agent");
            asm volatile("s_waitcnt vmcnt(0)" ::: "memory");
        }
    }
    __syncthreads();
}

template <int RB> __device__ __forceinline__ int kswz(int row, int c) { return (RB == 256) ? (c ^ (row & 15)) : (c ^ ((row >> 1) & 7)); }
__device__ __forceinline__ int vswz(int d, int c) { return c ^ ((d >> 1) & 7); }
template <int BYTES> __device__ __forceinline__ void dma_tile(const unsigned char* src, LAS unsigned char* dst, int tid, int wid) {
#pragma unroll
    for (int i = 0; i < BYTES / 8192; ++i)
        __builtin_amdgcn_global_load_lds((const unsigned*)(src + (unsigned)(i * 8192 + tid * 16)), (LAS unsigned*)(dst + i * 8192 + wid * 1024), 16, 0, 0);
}
template <int DQK, int DV, int MODE>
__device__ __forceinline__ void attn_tile_compute(const LAS unsigned char* kb, const LAS unsigned char* vb, const int k0, const bool domask, const bf16x8 (&qf)[DQK / 16],
                                                  const int qpos, const LAS float* biasrow, const int lr, const int hi, f32x16 (&o)[DV / 32], float& m_run, float& l_run) {
    constexpr int RB = DQK * 2, NKS = DQK / 16, NDB = DV / 32;
            f32x16 p0, p1;
#pragma unroll
            for (int r = 0; r < 16; ++r) { p0[r] = 0.f; p1[r] = 0.f; }
#pragma unroll
            for (int ks = 0; ks < NKS; ++ks) {
                const int c = 2 * ks + hi;
                const bf16x8 kf0 = *(const LAS bf16x8*)(kb + lr * RB + kswz<RB>(lr, c) * 16);
                const bf16x8 kf1 = *(const LAS bf16x8*)(kb + (lr + 32) * RB + kswz<RB>(lr + 32, c) * 16);
                p0 = __builtin_amdgcn_mfma_f32_32x32x16_bf16(kf0, qf[ks], p0, 0, 0, 0);
                p1 = __builtin_amdgcn_mfma_f32_32x32x16_bf16(kf1, qf[ks], p1, 0, 0, 0);
            }
            if (domask) {
                const float NEG = -__builtin_inff();
#pragma unroll
                for (int r = 0; r < 16; ++r) {
                    const int key0 = k0 + (r & 3) + 8 * (r >> 2) + 4 * hi, key1 = key0 + 32;
                    if (MODE == 0) { if (key0 > qpos) p0[r] = NEG; if (key1 > qpos) p1[r] = NEG; }
                    if (MODE == 1) { const int d0 = qpos - key0, d1 = qpos - key1;
                        p0[r] = ((unsigned)d0 < 128u) ? p0[r] + biasrow[d0 & 127] : NEG;
                        p1[r] = ((unsigned)d1 < 128u) ? p1[r] + biasrow[d1 & 127] : NEG; }
                }
            }
            float mx = p0[0];
#pragma unroll
            for (int r = 1; r < 16; ++r) mx = fmaxf(mx, p0[r]);
#pragma unroll
            for (int r = 0; r < 16; ++r) mx = fmaxf(mx, p1[r]);
            { auto rr = __builtin_amdgcn_permlane32_swap(__float_as_uint(mx), __float_as_uint(mx), false, false); mx = fmaxf(__uint_as_float(rr[0]), __uint_as_float(rr[1])); }
            const float mn = fmaxf(m_run, mx), alpha = fast_exp2(m_run - mn);
            m_run = mn;
            float ps = 0.f;
#pragma unroll
            for (int r = 0; r < 16; ++r) { p0[r] = fast_exp2(p0[r] - mn); p1[r] = fast_exp2(p1[r] - mn); ps += p0[r] + p1[r]; }
            l_run = l_run * alpha + ps;
            if (!__all(alpha == 1.f)) {
#pragma unroll
                for (int db = 0; db < NDB; ++db)
#pragma unroll
                    for (int r = 0; r < 16; ++r) o[db][r] *= alpha;
            }
            bf16x8 pf[4];
#pragma unroll
            for (int s = 0; s < 4; ++s) {
                const int r0 = 8 * (s & 1);
                unsigned a01, a23, b45, b67;
                if (s < 2) { a01 = cvt_pk_bf16(p0[r0 + 0], p0[r0 + 1]); a23 = cvt_pk_bf16(p0[r0 + 2], p0[r0 + 3]); b45 = cvt_pk_bf16(p0[r0 + 4], p0[r0 + 5]); b67 = cvt_pk_bf16(p0[r0 + 6], p0[r0 + 7]); }
                else       { a01 = cvt_pk_bf16(p1[r0 + 0], p1[r0 + 1]); a23 = cvt_pk_bf16(p1[r0 + 2], p1[r0 + 3]); b45 = cvt_pk_bf16(p1[r0 + 4], p1[r0 + 5]); b67 = cvt_pk_bf16(p1[r0 + 6], p1[r0 + 7]); }
                auto s0 = __builtin_amdgcn_permlane32_swap(a01, b45, false, false);
                auto s1 = __builtin_amdgcn_permlane32_swap(a23, b67, false, false);
                u32x4 w; w.x = s0[0]; w.y = s1[0]; w.z = s0[1]; w.w = s1[1];
                pf[s] = __builtin_bit_cast(bf16x8, w);
            }
#pragma unroll
            for (int db = 0; db < NDB; ++db) {
                const int d = 32 * db + lr;
#pragma unroll
                for (int s = 0; s < 4; ++s) {
                    const bf16x8 vf = *(const LAS bf16x8*)(vb + d * 128 + vswz(d, 2 * s + hi) * 16);
                    o[db] = __builtin_amdgcn_mfma_f32_32x32x16_bf16(vf, pf[s], o[db], 0, 0, 0);
                }
            }
        }
template <int DQK, int DV, int MODE>
__device__ __forceinline__ void attn_tiles(const int tid_in, LAS unsigned char* lds, const unsigned char* gK, const unsigned char* gV, int t_lo, int t_hi,
                                           const bf16x8 (&qf)[DQK / 16], int qpos, int wave_q0, const LAS float* biasrow,
                                           f32x16 (&o)[DV / 32], float& m_run, float& l_run) {
    constexpr int KT = 64 * DQK * 2, VT = DV * 128, BUF = KT + VT;
    int tid = tid_in; asm volatile("" : "+v"(tid));
    const int wid = __builtin_amdgcn_readfirstlane(tid >> 6), lane = tid & 63, lr = lane & 31, hi = lane >> 5;
    dma_tile<KT>(gK + (size_t)t_lo * KT, lds, tid, wid); dma_tile<VT>(gV + (size_t)t_lo * VT, lds + KT, tid, wid);
    VM_WAIT(); __syncthreads();
#pragma unroll 1
    for (int t = t_lo; t < t_hi; ++t) {
        const int cur = (t - t_lo) & 1;
        LAS unsigned char* kb = lds + cur * BUF; LAS unsigned char* vb = kb + KT;
        if (t + 1 < t_hi) { LAS unsigned char* nb = lds + (cur ^ 1) * BUF; dma_tile<KT>(gK + (size_t)(t + 1) * KT, nb, tid, wid); dma_tile<VT>(gV + (size_t)(t + 1) * VT, nb + KT, tid, wid); }
        const int k0 = t * 64;
        bool need = true, domask = false;
        if (MODE == 0) { need = (k0 <= wave_q0 + 31); domask = (k0 + 63 > wave_q0); }
        if (MODE == 1) { need = (k0 <= wave_q0 + 31) && (k0 + 63 >= wave_q0 - 127); domask = true; }
        if (need) attn_tile_compute<DQK, DV, MODE>(kb, vb, k0, domask, qf, qpos, biasrow, lr, hi, o, m_run, l_run);
        VM_WAIT(); __syncthreads();
    }
}
#define MLA_KLD(KB, ks, F0, F1) do { const int c_ = 2 * (ks) + hi; \
        F0 = *(const LAS bf16x8*)((KB) + lr * 384 + kswz<384>(lr, c_) * 16); \
        F1 = *(const LAS bf16x8*)((KB) + (lr + 32) * 384 + kswz<384>(lr + 32, c_) * 16); } while (0)
#define MLA_QK(KB, P0, P1) do { _Pragma("unroll") for (int r = 0; r < 16; ++r) { P0[r] = 0.f; P1[r] = 0.f; } \
    bf16x8 ka_[3], kb_[3]; MLA_KLD(KB, 0, ka_[0], kb_[0]); MLA_KLD(KB, 1, ka_[1], kb_[1]); \
    _Pragma("unroll") for (int ks = 0; ks < 12; ++ks) { \
        if (ks + 2 < 12) MLA_KLD(KB, ks + 2, ka_[(ks + 2) % 3], kb_[(ks + 2) % 3]); \
        __builtin_amdgcn_sched_barrier(0); \
        P0 = __builtin_amdgcn_mfma_f32_32x32x16_bf16(ka_[ks % 3], qf[ks], P0, 0, 0, 0); \
        P1 = __builtin_amdgcn_mfma_f32_32x32x16_bf16(kb_[ks % 3], qf[ks], P1, 0, 0, 0); } } while (0)
__device__ __forceinline__ void mla_softmax(f32x16& p0, f32x16& p1, const bool domask, const int k0, const int qpos, const int hi, f32x16 (&o)[4], float& m_run, float& l_run, bf16x8 (&pf)[4]) {
    if (domask) {
        const float NEG = -__builtin_inff();
#pragma unroll
        for (int r = 0; r < 16; ++r) { const int key0 = k0 + (r & 3) + 8 * (r >> 2) + 4 * hi; if (key0 > qpos) p0[r] = NEG; if (key0 + 32 > qpos) p1[r] = NEG; }
    }
    float mx = p0[0];
#pragma unroll
    for (int r = 1; r < 16; ++r) mx = fmaxf(mx, p0[r]);
#pragma unroll
    for (int r = 0; r < 16; ++r) mx = fmaxf(mx, p1[r]);
    { auto rr = __builtin_amdgcn_permlane32_swap(__float_as_uint(mx), __float_as_uint(mx), false, false); mx = fmaxf(__uint_as_float(rr[0]), __uint_as_float(rr[1])); }
    float mn = m_run, alpha = 1.f;
    if (!__all(mx - m_run <= 8.f)) { mn = fmaxf(m_run, mx); alpha = fast_exp2(m_run - mn); m_run = mn;
#pragma unroll
        for (int db = 0; db < 4; ++db)
#pragma unroll
            for (int r = 0; r < 16; ++r) o[db][r] *= alpha; }
    float ps = 0.f;
#pragma unroll
    for (int r = 0; r < 16; ++r) { p0[r] = fast_exp2(p0[r] - mn); p1[r] = fast_exp2(p1[r] - mn); ps += p0[r] + p1[r]; }
    l_run = l_run * alpha + ps;
#pragma unroll
    for (int s = 0; s < 4; ++s) {
        const int r0 = 8 * (s & 1);
        unsigned a01, a23, b45, b67;
        if (s < 2) { a01 = cvt_pk_bf16(p0[r0 + 0], p0[r0 + 1]); a23 = cvt_pk_bf16(p0[r0 + 2], p0[r0 + 3]); b45 = cvt_pk_bf16(p0[r0 + 4], p0[r0 + 5]); b67 = cvt_pk_bf16(p0[r0 + 6], p0[r0 + 7]); }
        else       { a01 = cvt_pk_bf16(p1[r0 + 0], p1[r0 + 1]); a23 = cvt_pk_bf16(p1[r0 + 2], p1[r0 + 3]); b45 = cvt_pk_bf16(p1[r0 + 4], p1[r0 + 5]); b67 = cvt_pk_bf16(p1[r0 + 6], p1[r0 + 7]); }
        auto s0 = __builtin_amdgcn_permlane32_swap(a01, b45, false, false);
        auto s1 = __builtin_amdgcn_permlane32_swap(a23, b67, false, false);
        u32x4 w; w.x = s0[0]; w.y = s1[0]; w.z = s0[1]; w.w = s1[1];
        pf[s] = __builtin_bit_cast(bf16x8, w);
    }
}
__device__ __forceinline__ void mla_pv(const bf16x8 (&pf)[4], const LAS unsigned char* vb, const int lr, const int hi, f32x16 (&o)[4]) {
    bf16x8 vf[2][4];
#pragma unroll
    for (int s = 0; s < 4; ++s) vf[0][s] = *(const LAS bf16x8*)(vb + lr * 128 + vswz(lr, 2 * s + hi) * 16);
#pragma unroll
    for (int db = 0; db < 4; ++db) {
        if (db + 1 < 4) { const int d = 32 * (db + 1) + lr;
#pragma unroll
            for (int s = 0; s < 4; ++s) vf[(db + 1) & 1][s] = *(const LAS bf16x8*)(vb + d * 128 + vswz(d, 2 * s + hi) * 16); }
        __builtin_amdgcn_sched_barrier(0);
#pragma unroll
        for (int s = 0; s < 4; ++s) o[db] = __builtin_amdgcn_mfma_f32_32x32x16_bf16(vf[db & 1][s], pf[s], o[db], 0, 0, 0);
    }
}
typedef long i64x2 __attribute__((ext_vector_type(2)));
__host__ __device__ __forceinline__ int f8pos(int k) { return (k & ~31) | (((k >> 3) & 1) << 4) | (((k >> 4) & 1) << 3) | (k & 7); }
#define F8_KLD(KB, m, F0, F1) do { const int c_ = (2 * (m) + hi) ^ ((lr >> 2) & 3); \
        F0 = *(const LAS i64x2*)((KB) + lr * 192 + c_ * 16); F1 = *(const LAS i64x2*)((KB) + (lr + 32) * 192 + c_ * 16); } while (0)
#define F8_QK(KB, P0, P1) do { _Pragma("unroll") for (int r = 0; r < 16; ++r) { P0[r] = 0.f; P1[r] = 0.f; } \
    i64x2 ka_[3], kb_[3]; F8_KLD(KB, 0, ka_[0], kb_[0]); F8_KLD(KB, 1, ka_[1], kb_[1]); \
    _Pragma("unroll") for (int m = 0; m < 6; ++m) { \
        if (m + 2 < 6) F8_KLD(KB, m + 2, ka_[(m + 2) % 3], kb_[(m + 2) % 3]); \
        __builtin_amdgcn_sched_barrier(0); \
        P0 = __builtin_amdgcn_mfma_f32_32x32x16_fp8_fp8(ka_[m % 3].x, qf[m].x, P0, 0, 0, 0); \
        P1 = __builtin_amdgcn_mfma_f32_32x32x16_fp8_fp8(kb_[m % 3].x, qf[m].x, P1, 0, 0, 0); \
        P0 = __builtin_amdgcn_mfma_f32_32x32x16_fp8_fp8(ka_[m % 3].y, qf[m].y, P0, 0, 0, 0); \
        P1 = __builtin_amdgcn_mfma_f32_32x32x16_fp8_fp8(kb_[m % 3].y, qf[m].y, P1, 0, 0, 0); } } while (0)
__device__ __forceinline__ void f8_softmax(f32x16& p0, f32x16& p1, const bool domask, const int k0, const int qpos, const int hi, f32x16 (&o)[4], float& m_run, float& l_run, long (&pf)[4]) {
    constexpr float C = 0.07216878364870322f * LOG2E;
    if (domask) {
        const float NEG = -__builtin_inff();
#pragma unroll
        for (int r = 0; r < 16; ++r) { const int key0 = k0 + (r & 3) + 8 * (r >> 2) + 4 * hi; if (key0 > qpos) p0[r] = NEG; if (key0 + 32 > qpos) p1[r] = NEG; }
    }
    float mx = p0[0];
#pragma unroll
    for (int r = 1; r < 16; ++r) mx = fmaxf(mx, p0[r]);
#pragma unroll
    for (int r = 0; r < 16; ++r) mx = fmaxf(mx, p1[r]);
    { auto rr = __builtin_amdgcn_permlane32_swap(__float_as_uint(mx), __float_as_uint(mx), false, false); mx = fmaxf(__uint_as_float(rr[0]), __uint_as_float(rr[1])); }
    mx *= C;
    float mn = m_run, alpha = 1.f;
    if (!__all(mx - m_run <= 8.f)) { mn = fmaxf(m_run, mx); alpha = fast_exp2(m_run - mn); m_run = mn;
#pragma unroll
        for (int db = 0; db < 4; ++db)
#pragma unroll
            for (int r = 0; r < 16; ++r) o[db][r] *= alpha; }
    float ps = 0.f;
#pragma unroll
    for (int r = 0; r < 16; ++r) { p0[r] = fast_exp2(p0[r] * C - mn); p1[r] = fast_exp2(p1[r] * C - mn); ps += p0[r] + p1[r]; }
    l_run = l_run * alpha + ps;
#pragma unroll
    for (int s = 0; s < 4; ++s) {
        const int r0 = 8 * (s & 1);
        unsigned a, b;
        if (s < 2) { a = pk4_fp8(p0[r0 + 0], p0[r0 + 1], p0[r0 + 2], p0[r0 + 3]); b = pk4_fp8(p0[r0 + 4], p0[r0 + 5], p0[r0 + 6], p0[r0 + 7]); }
        else       { a = pk4_fp8(p1[r0 + 0], p1[r0 + 1], p1[r0 + 2], p1[r0 + 3]); b = pk4_fp8(p1[r0 + 4], p1[r0 + 5], p1[r0 + 6], p1[r0 + 7]); }
        auto sw = __builtin_amdgcn_permlane32_swap(a, b, false, false);
        pf[s] = (long)(((unsigned long long)sw[1] << 32) | (unsigned long long)sw[0]);
    }
}
__device__ __forceinline__ void f8_pv(const long (&pf)[4], const LAS unsigned char* vb, const int lr, const int hi, f32x16 (&o)[4]) {
    i64x2 vf[2][2];
#pragma unroll
    for (int m = 0; m < 2; ++m) vf[0][m] = *(const LAS i64x2*)(vb + lr * 64 + (((2 * m + hi) ^ ((lr >> 2) & 3)) << 4));
#pragma unroll
    for (int db = 0; db < 4; ++db) {
        if (db + 1 < 4) { const int d = 32 * (db + 1) + lr;
#pragma unroll
            for (int m = 0; m < 2; ++m) vf[(db + 1) & 1][m] = *(const LAS i64x2*)(vb + d * 64 + (((2 * m + hi) ^ ((d >> 2) & 3)) << 4)); }
        __builtin_amdgcn_sched_barrier(0);
#pragma unroll
        for (int m = 0; m < 2; ++m) { o[db] = __builtin_amdgcn_mfma_f32_32x32x16_fp8_fp8(vf[db & 1][m].x, pf[2 * m], o[db], 0, 0, 0);
                                      o[db] = __builtin_amdgcn_mfma_f32_32x32x16_fp8_fp8(vf[db & 1][m].y, pf[2 * m + 1], o[db], 0, 0, 0); }
    }
}
__device__ __forceinline__ void attn_mla_f8(const int tid_in, LAS unsigned char* lds, const unsigned char* gK, const unsigned char* gV, const int t_lo, const int t_hi,
                                            const i64x2 (&qf)[6], const int qpos, const int wave_q0, f32x16 (&o)[4], float& m_run, float& l_run) {
    constexpr int KT = 12288, VT = 8192;
    int tid = tid_in; asm volatile("" : "+v"(tid));
    const int wid = __builtin_amdgcn_readfirstlane(tid >> 6), lane = tid & 63, lr0 = lane & 31, hi = lane >> 5;
    const bool halfB = wid >= 4;
    LAS unsigned char* KB0 = lds; LAS unsigned char* VB0 = lds + 2 * KT;
#define F8_DMA(T, KDST, VDST) do { const unsigned char* ks_ = gK + (size_t)(T) * KT; \
        __builtin_amdgcn_global_load_lds((const unsigned*)(ks_ + (unsigned)(tid * 16)), (LAS unsigned*)((KDST) + wid * 1024), 16, 0, 0); \
        if (wid < 4) __builtin_amdgcn_global_load_lds((const unsigned*)(ks_ + 8192 + (unsigned)(tid * 16)), (LAS unsigned*)((KDST) + 8192 + wid * 1024), 16, 0, 0); \
        __builtin_amdgcn_global_load_lds((const unsigned*)(gV + (size_t)(T) * VT + (unsigned)(tid * 16)), (LAS unsigned*)((VDST) + wid * 1024), 16, 0, 0); } while (0)
    F8_DMA(t_lo, KB0, VB0);
    VM_WAIT(); __syncthreads();
    if (!halfB) {
        int vcur = 0;
#pragma unroll 1
        for (int t = t_lo; t <= t_hi; ++t) {
            const int j = t - t_lo, vnext = (vcur == 2) ? 0 : vcur + 1;
            if (t + 1 < t_hi) F8_DMA(t + 1, KB0 + ((j + 1) & 1) * KT, VB0 + vnext * VT);
            const int k0 = t * 64;
            int lr = lr0; asm volatile("" : "+v"(lr));
            if ((t < t_hi) && (k0 <= wave_q0 + 31)) { f32x16 p0, p1; long pf[4]; const LAS unsigned char* kb = KB0 + (j & 1) * KT;
                F8_QK(kb, p0, p1); f8_softmax(p0, p1, k0 + 63 > wave_q0, k0, qpos, hi, o, m_run, l_run, pf); f8_pv(pf, VB0 + vcur * VT, lr, hi, o); }
            vcur = vnext;
            VM_WAIT(); __syncthreads();
        }
    } else {
        long pf[4] = {0, 0, 0, 0};
        int vcur = 0, vprev = 2;
#pragma unroll 1
        for (int t = t_lo; t <= t_hi; ++t) {
            const int j = t - t_lo, vnext = (vcur == 2) ? 0 : vcur + 1;
            if (t + 1 < t_hi) F8_DMA(t + 1, KB0 + ((j + 1) & 1) * KT, VB0 + vnext * VT);
            const int k0 = t * 64;
            int lr = lr0; asm volatile("" : "+v"(lr));
            if ((j > 0) && (k0 - 64 <= wave_q0 + 31)) f8_pv(pf, VB0 + vprev * VT, lr, hi, o);
            if ((t < t_hi) && (k0 <= wave_q0 + 31)) { f32x16 p0, p1; const LAS unsigned char* kb = KB0 + (j & 1) * KT;
                F8_QK(kb, p0, p1); f8_softmax(p0, p1, k0 + 63 > wave_q0, k0, qpos, hi, o, m_run, l_run, pf); }
            vprev = vcur; vcur = vnext;
            VM_WAIT(); __syncthreads();
        }
    }
#undef F8_DMA
}
__device__ __forceinline__ void attn_mla_stag(const int tid_in, LAS unsigned char* lds, const unsigned char* gK, const unsigned char* gV, const int t_lo, const int t_hi,
                                              const bf16x8 (&qf)[12], const int qpos, const int wave_q0, f32x16 (&o)[4], float& m_run, float& l_run) {
    constexpr int KT = 24576, VT = 16384;
    int tid = tid_in; asm volatile("" : "+v"(tid));
    const int wid = __builtin_amdgcn_readfirstlane(tid >> 6), lane = tid & 63, lr0 = lane & 31, hi = lane >> 5;
    const bool halfB = wid >= 4;
    LAS unsigned char* KB0 = lds; LAS unsigned char* VB0 = lds + 2 * KT;
    dma_tile<KT>(gK + (size_t)t_lo * KT, KB0, tid, wid); dma_tile<VT>(gV + (size_t)t_lo * VT, VB0, tid, wid);
    VM_WAIT(); __syncthreads();
    if (!halfB) {
        int vcur = 0;
#pragma unroll 1
        for (int t = t_lo; t <= t_hi; ++t) {
            const int j = t - t_lo, vnext = (vcur == 2) ? 0 : vcur + 1;
            if (t + 1 < t_hi) { dma_tile<KT>(gK + (size_t)(t + 1) * KT, KB0 + ((j + 1) & 1) * KT, tid, wid); dma_tile<VT>(gV + (size_t)(t + 1) * VT, VB0 + vnext * VT, tid, wid); }
            const int k0 = t * 64;
            int lr = lr0; asm volatile("" : "+v"(lr));
            if ((t < t_hi) && (k0 <= wave_q0 + 31)) { f32x16 p0, p1; bf16x8 pf[4]; const LAS unsigned char* kb = KB0 + (j & 1) * KT;
                MLA_QK(kb, p0, p1); mla_softmax(p0, p1, k0 + 63 > wave_q0, k0, qpos, hi, o, m_run, l_run, pf); mla_pv(pf, VB0 + vcur * VT, lr, hi, o); }
            vcur = vnext;
            VM_WAIT(); __syncthreads();
        }
    } else {
        bf16x8 pf[4];
#pragma unroll
        for (int s = 0; s < 4; ++s) pf[s] = (bf16x8){0, 0, 0, 0, 0, 0, 0, 0};
        int vcur = 0, vprev = 2;
#pragma unroll 1
        for (int t = t_lo; t <= t_hi; ++t) {
            const int j = t - t_lo, vnext = (vcur == 2) ? 0 : vcur + 1;
            if (t + 1 < t_hi) { dma_tile<KT>(gK + (size_t)(t + 1) * KT, KB0 + ((j + 1) & 1) * KT, tid, wid); dma_tile<VT>(gV + (size_t)(t + 1) * VT, VB0 + vnext * VT, tid, wid); }
            const int k0 = t * 64;
            int lr = lr0; asm volatile("" : "+v"(lr));
            if ((j > 0) && (k0 - 64 <= wave_q0 + 31)) mla_pv(pf, VB0 + vprev * VT, lr, hi, o);
            if ((t < t_hi) && (k0 <= wave_q0 + 31)) { f32x16 p0, p1; const LAS unsigned char* kb = KB0 + (j & 1) * KT;
                MLA_QK(kb, p0, p1); mla_softmax(p0, p1, k0 + 63 > wave_q0, k0, qpos, hi, o, m_run, l_run, pf); }
            vprev = vcur; vcur = vnext;
            VM_WAIT(); __syncthreads();
        }
    }
}
template <int DQK> __device__ __forceinline__ void load_q_norm(const bf16_t* qrow, const float* gain, float scale, int hi, bf16x8 (&qf)[DQK / 16]) {
    float x[DQK / 16][8]; float ss = 0.f;
#pragma unroll
    for (int ks = 0; ks < DQK / 16; ++ks) { const u32x4 w = *(const u32x4*)(qrow + 16 * ks + 8 * hi); unpack8(w, x[ks]);
#pragma unroll
        for (int j = 0; j < 8; ++j) ss += x[ks][j] * x[ks][j]; }
    { auto rr = __builtin_amdgcn_permlane32_swap(__float_as_uint(ss), __float_as_uint(ss), false, false); ss = __uint_as_float(rr[0]) + __uint_as_float(rr[1]); }
    const float rs = rsqrtf(ss * (1.0f / DQK) + EPS) * scale;
#pragma unroll
    for (int ks = 0; ks < DQK / 16; ++ks) { float y[8];
#pragma unroll
        for (int j = 0; j < 8; ++j) y[j] = x[ks][j] * rs * gain[16 * ks + 8 * hi + j];
        qf[ks] = __builtin_bit_cast(bf16x8, pack8(y)); }
}
template <int DQK> __device__ __forceinline__ void load_q_norm_bf16x2(const bf16_t* qa, const bf16_t* qb_, const float* gain, float scale, int hi, bf16x8 (&qf)[DQK / 16]) {
    float x[DQK / 16][8]; float ss = 0.f;
#pragma unroll
    for (int ks = 0; ks < DQK / 16; ++ks) { float a[8], b[8]; unpack8(*(const u32x4*)(qa + 16 * ks + 8 * hi), a); unpack8(*(const u32x4*)(qb_ + 16 * ks + 8 * hi), b);
#pragma unroll
        for (int j = 0; j < 8; ++j) { x[ks][j] = a[j] + b[j]; ss += x[ks][j] * x[ks][j]; } }
    { auto rr = __builtin_amdgcn_permlane32_swap(__float_as_uint(ss), __float_as_uint(ss), false, false); ss = __uint_as_float(rr[0]) + __uint_as_float(rr[1]); }
    const float rs = rsqrtf(ss * (1.0f / DQK) + EPS) * scale;
#pragma unroll
    for (int ks = 0; ks < DQK / 16; ++ks) { float y[8];
#pragma unroll
        for (int j = 0; j < 8; ++j) y[j] = x[ks][j] * rs * gain[16 * ks + 8 * hi + j];
        qf[ks] = __builtin_bit_cast(bf16x8, pack8(y)); }
}
template <int DQK> __device__ __forceinline__ void load_q_norm_bf16x4(const bf16_t* q0, const size_t zs, const float* gain, float scale, int hi, bf16x8 (&qf)[DQK / 16]) {
    float x[DQK / 16][8]; float ss = 0.f;
#pragma unroll
    for (int ks = 0; ks < DQK / 16; ++ks) {
#pragma unroll
        for (int j = 0; j < 8; ++j) x[ks][j] = 0.f;
#pragma unroll
        for (int z = 0; z < 4; ++z) { float a[8]; unpack8(*(const u32x4*)(q0 + z * zs + 16 * ks + 8 * hi), a);
#pragma unroll
            for (int j = 0; j < 8; ++j) x[ks][j] += a[j]; }
#pragma unroll
        for (int j = 0; j < 8; ++j) ss += x[ks][j] * x[ks][j]; }
    { auto rr = __builtin_amdgcn_permlane32_swap(__float_as_uint(ss), __float_as_uint(ss), false, false); ss = __uint_as_float(rr[0]) + __uint_as_float(rr[1]); }
    const float rs = rsqrtf(ss * (1.0f / DQK) + EPS) * scale;
#pragma unroll
    for (int ks = 0; ks < DQK / 16; ++ks) { float y[8];
#pragma unroll
        for (int j = 0; j < 8; ++j) y[j] = x[ks][j] * rs * gain[16 * ks + 8 * hi + j];
        qf[ks] = __builtin_bit_cast(bf16x8, pack8(y)); }
}
template <int DV> __device__ __forceinline__ void store_o(bf16_t* orow, const f32x16 (&o)[DV / 32], float inv_l, int hi) {
#pragma unroll
    for (int db = 0; db < DV / 32; ++db)
#pragma unroll
        for (int r4 = 0; r4 < 4; ++r4) { u32x2 w; w.x = cvt_pk_bf16(o[db][4 * r4] * inv_l, o[db][4 * r4 + 1] * inv_l); w.y = cvt_pk_bf16(o[db][4 * r4 + 2] * inv_l, o[db][4 * r4 + 3] * inv_l);
            *(u32x2*)(orow + 32 * db + 8 * r4 + 4 * hi) = w; }
}

struct Args { const float* in[50]; float* out; unsigned char* ws; int l_lo, l_hi, ph_lo, ph_hi; };
enum { I_X = 0, I_MEM, I_RELB, I_LNMIX, I_WIN, I_SWAQG, I_SWAKG, I_SINK, I_DWW, I_DWB, I_CLNG, I_CLNB, I_PWW, I_PWB, I_QAG, I_KVAG, I_WQB, I_WKVB, I_QNN, I_QNR, I_KNN, I_KNR,
       I_ARE, I_AIM, I_LOGDT, I_BRE, I_BIM, I_CRE, I_CIM, I_SSMD, I_GLUW, I_GLUB, I_MIXG, I_WOUT, I_LNX, I_MEMG, I_XWQ, I_XWK, I_XWV, I_XQG, I_XKG, I_XWO, I_LNMOE, I_WG, I_BG, I_WE, I_BE, I_MG, I_MU, I_MD };
constexpr int NPH = 19;

__constant__ unsigned char T5_BUCKET[128] = {0,1,2,3,4,5,6,7,8,9,10,11,12,13,14,15,16,16,16,17,17,18,18,18,19,19,19,20,20,20,20,21,21,21,21,22,22,22,22,22,23,23,23,23,23,23,24,24,24,24,24,24,25,25,25,25,25,25,25,26,26,26,26,26,26,26,26,27,27,27,27,27,27,27,27,27,27,28,28,28,28,28,28,28,28,28,28,29,29,29,29,29,29,29,29,29,29,29,29,30,30,30,30,30,30,30,30,30,30,30,30,30,30,31,31,31,31,31,31,31,31,31,31,31,31,31,31,31};

__device__ __forceinline__ void tr_item(const float* W, int ldw, int k0, int n0, bf16_t* WT, int ldt, int drow0, const float* kgain, LAS float* scr, int lane) {
    float tv[32];
#pragma unroll
    for (int i = 0; i < 32; ++i) { const int kk = 2 * i + (lane >> 5); tv[i] = W[(size_t)(k0 + kk) * ldw + n0 + (lane & 31)]; }
#pragma unroll
    for (int i = 0; i < 32; ++i) { const int kk = 2 * i + (lane >> 5); float v = tv[i]; if (kgain) v *= kgain[k0 + kk]; scr[kk * 33 + (lane & 31)] = v; }
    LDS_WAIT();
    const int c = lane & 7;
#pragma unroll
    for (int j = 0; j < 4; ++j) { const int n = (lane >> 3) + 8 * j; const LAS float* s = scr + (8 * c) * 33 + n;
        u32x4 o; o.x = cvt_pk_bf16(s[0 * 33], s[1 * 33]); o.y = cvt_pk_bf16(s[2 * 33], s[3 * 33]); o.z = cvt_pk_bf16(s[4 * 33], s[5 * 33]); o.w = cvt_pk_bf16(s[6 * 33], s[7 * 33]);
        *(u32x4*)(WT + (size_t)(drow0 + n) * ldt + k0 + 8 * c) = o; }
    LDS_WAIT();
}
struct TrD { const float* src; const float* kg; unsigned char* dst; int ldw, ldtB, f8; };
__device__ __forceinline__ void tr_load(const TrD& d, int lane, float (&tv)[32], f32x4 (&kq)[2]) {
#pragma unroll
    for (int i = 0; i < 32; ++i) { const int kk = 2 * i + (lane >> 5); tv[i] = d.src[(size_t)kk * d.ldw + (lane & 31)]; }
    if (d.kg) { kq[0] = *(const f32x4*)(d.kg + 8 * (lane & 7)); kq[1] = *(const f32x4*)(d.kg + 8 * (lane & 7) + 4); }
    else { kq[0] = (f32x4){1.f, 1.f, 1.f, 1.f}; kq[1] = kq[0]; }
}
__device__ __forceinline__ void tr_fin(const TrD& d, int lane, const float (&tv)[32], const f32x4 (&kq)[2], LAS float* scr) {
#pragma unroll
    for (int i = 0; i < 32; ++i) { const int kk = 2 * i + (lane >> 5); scr[kk * 33 + (lane & 31)] = tv[i]; }
    LDS_WAIT();
    const int c = lane & 7;
    if (d.f8) {
#pragma unroll
        for (int j = 0; j < 4; ++j) { const int n = (lane >> 3) + 8 * j; const LAS float* s = scr + (8 * c) * 33 + n;
            *(u32x2*)(d.dst + (size_t)n * d.ldtB + 8 * c) = (u32x2){pk4_fp8(s[0 * 33] * 32.0f * kq[0].x, s[1 * 33] * 32.0f * kq[0].y, s[2 * 33] * 32.0f * kq[0].z, s[3 * 33] * 32.0f * kq[0].w),
                                                                    pk4_fp8(s[4 * 33] * 32.0f * kq[1].x, s[5 * 33] * 32.0f * kq[1].y, s[6 * 33] * 32.0f * kq[1].z, s[7 * 33] * 32.0f * kq[1].w)}; }
    } else {
#pragma unroll
        for (int j = 0; j < 4; ++j) { const int n = (lane >> 3) + 8 * j; const LAS float* s = scr + (8 * c) * 33 + n;
            u32x4 o; o.x = cvt_pk_bf16(s[0 * 33] * kq[0].x, s[1 * 33] * kq[0].y); o.y = cvt_pk_bf16(s[2 * 33] * kq[0].z, s[3 * 33] * kq[0].w); o.z = cvt_pk_bf16(s[4 * 33] * kq[1].x, s[5 * 33] * kq[1].y); o.w = cvt_pk_bf16(s[6 * 33] * kq[1].z, s[7 * 33] * kq[1].w);
            *(u32x4*)(d.dst + (size_t)n * d.ldtB + 16 * c) = o; }
    }
    LDS_WAIT();
}
__device__ __forceinline__ void tr_item8(const float* W, int ldw, int k0, int n0, unsigned char* WT8, int ldt, int drow0, const float* kgain, LAS float* scr, int lane) {
    float tv[32];
#pragma unroll
    for (int i = 0; i < 32; ++i) { const int kk = 2 * i + (lane >> 5); tv[i] = W[(size_t)(k0 + kk) * ldw + n0 + (lane & 31)]; }
#pragma unroll
    for (int i = 0; i < 32; ++i) { const int kk = 2 * i + (lane >> 5); float v = tv[i] * 32.0f; if (kgain) v *= kgain[k0 + kk]; scr[kk * 33 + (lane & 31)] = v; }
    LDS_WAIT();
    const int c = lane & 7;
#pragma unroll
    for (int j = 0; j < 4; ++j) { const int n = (lane >> 3) + 8 * j; const LAS float* s = scr + (8 * c) * 33 + n;
        *(u32x2*)(WT8 + (size_t)(drow0 + n) * ldt + k0 + 8 * c) = (u32x2){pk4_fp8(s[0 * 33], s[1 * 33], s[2 * 33], s[3 * 33]), pk4_fp8(s[4 * 33], s[5 * 33], s[6 * 33], s[7 * 33])}; }
    LDS_WAIT();
}
__device__ __forceinline__ void rms_row_store(const f32x4 (&v)[8], const float* gain, bf16_t* orow, int lane) {
    float ss = 0.f;
#pragma unroll
    for (int j = 0; j < 8; ++j) ss += (v[j].x * v[j].x + v[j].y * v[j].y) + (v[j].z * v[j].z + v[j].w * v[j].w);
    const float rs = rsqrtf(wave_sum(ss) * (1.0f / D) + EPS);
#pragma unroll
    for (int j = 0; j < 8; ++j) { const f32x4 g = *(const f32x4*)(gain + 4 * lane + 256 * j); u32x2 w; w.x = cvt_pk_bf16(v[j].x * rs * g.x, v[j].y * rs * g.y); w.y = cvt_pk_bf16(v[j].z * rs * g.z, v[j].w * rs * g.w);
        *(u32x2*)(orow + 4 * lane + 256 * j) = w; }
}
__device__ __forceinline__ f32x2 cmul(f32x2 a, f32x2 b) { return (f32x2){a.x * b.x - a.y * b.y, a.x * b.y + a.y * b.x}; }
__device__ __forceinline__ void sincos_rev(float x, float& s, float& c) { float r = x * 0.15915494309189535f; r -= rintf(r); s = __builtin_amdgcn_sinf(r); c = __builtin_amdgcn_cosf(r); }

#define X ((float*)out_)
#define ROPE ((float*)(ws + WS_ROPE))
#define H ((bf16_t*)(ws + WS_H))
#define P ((bf16_t*)(ws + WS_P))
#define O ((bf16_t*)(ws + WS_O))
#define QRAW ((bf16_t*)(ws + WS_QRAW))
#define KVRAW ((bf16_t*)(ws + WS_KVRAW))
#define Q ((bf16_t*)(ws + WS_Q))
#define KIMG ((unsigned char*)(ws + WS_KIMG))
#define VIMG ((unsigned char*)(ws + WS_VIMG))
#define SWAK ((unsigned char*)(ws + WS_SWAK))
#define SWAV ((unsigned char*)(ws + WS_SWAV))
#define ZC ((bf16_t*)(ws + WS_ZC))
#define UA ((bf16_t*)(ws + WS_UA))
#define EBUF ((float*)(ws + WS_EBUF))
#define YG ((bf16_t*)(ws + WS_YG))
#define QX ((bf16_t*)(ws + WS_QX))
#define OX ((bf16_t*)(ws + WS_OX))
#define MEMN ((bf16_t*)(ws + WS_MEMN))
#define KMEM ((bf16_t*)(ws + WS_KMEM))
#define VMEM ((bf16_t*)(ws + WS_VMEM))
#define XKIMG ((unsigned char*)(ws + WS_XKIMG))
#define XVIMG ((unsigned char*)(ws + WS_XVIMG))
#define LOGI ((float*)(ws + WS_LOG))
#define TOK ((int*)(ws + WS_TOK))
#define WSLOT ((float*)(ws + WS_WSLOT))
#define HID ((bf16_t*)(ws + WS_HID))
#define YS8 ((unsigned char*)(ws + WS_YS))
#define WIN ((bf16_t*)(ws + WS_WIN))
#define WOUT ((bf16_t*)(ws + WS_WOUT))
#define XWQ ((bf16_t*)(ws + WS_XWQ))
#define XWK ((bf16_t*)(ws + WS_XWK))
#define XWV ((bf16_t*)(ws + WS_XWV))
#define XWO ((bf16_t*)(ws + WS_XWO))
#define PW ((bf16_t*)(ws + WS_PW))
#define WQB ((bf16_t*)(ws + WS_WQB))
#define WKVB ((bf16_t*)(ws + WS_WKVB))
#define GLU ((bf16_t*)(ws + WS_GLU))
#define ROUT ((bf16_t*)(ws + WS_ROUT))
#define MOE1 ((bf16_t*)(ws + WS_MOE1))
#define MOE2 ((bf16_t*)(ws + WS_MOE2))
#define W1G ((bf16_t*)(ws + WS_W1G))
#define BTY ((bf16_t*)(ws + WS_BTY))
#define PARTO ((float*)(ws + WS_PARTO))
#define XB ((bf16_t*)(ws + WS_XB))
#define QXP ((float*)(ws + WS_QXP))
#define LOGP ((float*)(ws + WS_LOGP))
#define SSP ((float*)(ws + WS_SSP))
#define RMSV ((float*)(ws + WS_RMSV))
#define RMS1 ((float*)(ws + WS_RMS1))
#define XF8 ((unsigned char*)(ws + WS_XF8))
#define KCG ((float*)(ws + WS_H + 16 * MiB))
#define PQ7 ((bf16_t*)(ws + WS_H))
#define HID8 ((unsigned char*)(ws + WS_HID))
#define MOE1F ((unsigned char*)(ws + WS_MOE1))
#define MOE2F ((unsigned char*)(ws + WS_MOE2))
#define PARTML ((float*)(ws + WS_PARTML))
#define REC_E ((int*)(ws + WS_REC))
#define REC_R (REC_E + 2 * S)
#define REC_W ((float*)(REC_E + 4 * S))
#define REC_S (REC_E + 6 * S)
__device__ __forceinline__ unsigned long long ldp(const LAS unsigned* pt, int i) { unsigned lo = pt[2 * i], hi = pt[2 * i + 1]; lo = __builtin_amdgcn_readfirstlane(lo); hi = __builtin_amdgcn_readfirstlane(hi); return ((unsigned long long)hi << 32) | lo; }
#define INP(i) ((const float*)(const GAS float*)ldp(PT, (i)))
#define FRESH() int tid = (wave_s << 6) + (int)__builtin_amdgcn_mbcnt_hi(~0u, __builtin_amdgcn_mbcnt_lo(~0u, 0u)), G = gridDim.x, bid = blockIdx.x; unsigned lo_ = 0u; asm volatile("" : "+v"(tid), "+s"(G), "+s"(bid), "+s"(lo_)); LAS unsigned char* lds = lds0; const LAS unsigned* PT = (const LAS unsigned*)(lds0 + lo_ + LDSCTL_OFF + 512); volatile LAS unsigned* CTLW = (volatile LAS unsigned*)(lds0 + lo_ + LDSCTL_OFF); (void)CTLW; const int NGW = G * NWAVES; (void)NGW; const int lane = tid & 63, wave = __builtin_amdgcn_readfirstlane(tid >> 6), gw = bid * NWAVES + wave; unsigned char* ws = (unsigned char*)(GAS unsigned char*)ldp(PT, 50); float* out_ = (float*)(GAS float*)ldp(PT, 51); unsigned* ctl = (unsigned*)ws; (void)lane; (void)wave; (void)gw; (void)ws; (void)out_; (void)ctl
#if !MK_MULTI
#define GRID_BAR() do { XcdBarrier bar_; bar_.bar = ctl + CW_BAR; bar_.x = xb_xcc_id(); bar_.st = CTLW; xcd_barrier(bar_, tid); } while (0)
#else
#define GRID_BAR() do { } while (0)
#endif

#ifndef PROBE_REP
#define PROBE_REP 0u
#endif
#ifndef PHASE_MASK
#define PHASE_MASK 0xFFFFFFFFu
#endif
#define IN(k) ((((PHASE_MASK) >> (k)) & 1u) && ({ int a_ = ph_lo, b_ = ph_hi; asm volatile("" : "+s"(a_), "+s"(b_)); (a_ <= (k) && (k) < b_); }))
#define SEAM(k) do { if (IN((k) + 1) || ((k) == NPH - 1 && IN(0) && IN(NPH - 1))) GRID_BAR(); } while (0)


__device__ __forceinline__ void norm_groups(const LAS unsigned* PT, unsigned char* ws, const int l, const int s0, const int sstride, const int glo, const int ghi, const int lane) {
    const float* mg = INP(I_MIXG) + l * D;
    for (int s = s0; s < S; s += sstride) {
#pragma unroll
        for (int grp = 0; grp < 4; ++grp) { if (grp < glo || grp >= ghi) continue; bf16_t* p = O + (size_t)s * D + grp * 512 + 8 * lane; float x[8];
                    if (grp == 2 && s >= S / 2) {
                        const int h = lane >> 4, d0 = (lane & 15) * 8, qb = s >> 8, row = s & 255;
                        const size_t sa = ((size_t)(h * 32 + (qb - 32)) * 2 + 0) * 256 + row, sb = sa + 256;
                        const f32x2 mla = *(const f32x2*)(PARTML + sa * 2), mlb = *(const f32x2*)(PARTML + sb * 2);
                        const float mm = fmaxf(mla.x, mlb.x), fa = fast_exp2(mla.x - mm), fb = fast_exp2(mlb.x - mm), inv = fast_rcp(mla.y * fa + mlb.y * fb);
                        const f32x4 a0 = *(const f32x4*)(PARTO + sa * 128 + d0), a1 = *(const f32x4*)(PARTO + sa * 128 + d0 + 4), b0 = *(const f32x4*)(PARTO + sb * 128 + d0), b1 = *(const f32x4*)(PARTO + sb * 128 + d0 + 4);
#pragma unroll
                        for (int j = 0; j < 4; ++j) { x[j] = (a0[j] * fa + b0[j] * fb) * inv; x[4 + j] = (a1[j] * fa + b1[j] * fb) * inv; }
                    } else unpack8(*(const u32x4*)p, x);
                    float ss = 0.f;
#pragma unroll
                    for (int j = 0; j < 8; ++j) ss += x[j] * x[j];
                    const float rs = rsqrtf(wave_sum(ss) * (1.f / 512.f) + EPS); const float* gn = mg + grp * 512 + 8 * lane;
#pragma unroll
                    for (int j = 0; j < 8; ++j) x[j] = x[j] * rs * gn[j];
                    *(u32x4*)p = pack8(x); }
            }
}

template <int DUMMY> __device__ __forceinline__ void layer_body(const int l, const int wave_s, LAS unsigned char* lds0, const int ph_lo, const int ph_hi) {
        if (IN(0)) {
            FRESH();
            LAS float* scr = (LAS float*)(lds + wave * 16384);
            for (int rep_ = 0; rep_ < (int)(PROBE_REP & 1u) + 1; ++rep_) {
                const float* w_in = INP(I_WIN) + (size_t)l * D * INW; const float* w_out = INP(I_WOUT) + (size_t)l * D * D;
                const float* xwq = INP(I_XWQ) + (size_t)l * D * 512; const float* xwk = INP(I_XWK) + (size_t)l * D * 512; const float* xwv = INP(I_XWV) + (size_t)l * D * 512;
                const float* xwo = INP(I_XWO) + (size_t)l * 512 * D; const float* pww = INP(I_PWW) + (size_t)l * 512 * 512;
                const float* wqb = INP(I_WQB) + (size_t)l * 512 * 768; const float* wkvb = INP(I_WKVB) + (size_t)l * 256 * 1024; const float* gluw = INP(I_GLUW) + (size_t)l * 512 * 512;
                const float* mg = INP(I_MG) + (size_t)l * 32 * D * 512; const float* mu = INP(I_MU) + (size_t)l * 32 * D * 512; const float* md = INP(I_MD) + (size_t)l * 32 * 512 * D;
                const float* qag = INP(I_QAG) + l * 512; const float* kvag = INP(I_KVAG) + l * 256; const float* lnx = INP(I_LNX) + l * D; const float* lnmix = INP(I_LNMIX) + l * D; const float* lnm = INP(I_LNMOE) + l * D;
                constexpr int N_IN = 32 * 98, N_OUT = 32 * 64, N_XQ = 32 * 16, N_XO = 8 * 64, N_PW = 8 * 16, N_QB = 8 * 24, N_KVB = 4 * 32, N_GLU = 8 * 16, N_MG = 32 * 512, N_MD = 32 * 512;
                constexpr int NITEMS = N_IN + N_OUT + 3 * N_XQ + N_XO + N_PW + N_QB + N_KVB + N_GLU + 2 * N_MG + N_MD;
                auto decode = [&](int r) -> TrD {
                    const float* W; int ldw, k0, n0, drow0, ldt; unsigned char* base; const float* kgn = nullptr; int f8 = 0;
                    if (r < N_MG) { const int e = r >> 9, rr = r & 511, kb = rr >> 4, nb = rr & 15; n0 = 32 * nb; k0 = 64 * kb; W = mg + (size_t)e * D * 512; ldw = 512; base = MOE1F + (size_t)e * 1024 * D; ldt = D; drow0 = (n0 >> 7) * 256 + (n0 & 127); kgn = lnm; f8 = 1; }
                    else if ((r -= N_MG) < N_MG) { const int e = r >> 9, rr = r & 511, kb = rr >> 4, nb = rr & 15; n0 = 32 * nb; k0 = 64 * kb; W = mu + (size_t)e * D * 512; ldw = 512; base = MOE1F + (size_t)e * 1024 * D; ldt = D; drow0 = (n0 >> 7) * 256 + 128 + (n0 & 127); kgn = lnm; f8 = 1; }
                    else if ((r -= N_MG) < N_MD) { const int e = r >> 9, rr = r & 511, kb = rr >> 6, nb = rr & 63; n0 = 32 * nb; k0 = 64 * kb; W = md + (size_t)e * 512 * D; ldw = D; base = MOE2F + (size_t)e * D * 512; ldt = 512; drow0 = n0; f8 = 1; }
                    else if ((r -= N_MD) < N_IN) { const int kb = r / 98, nb = r % 98; n0 = 32 * nb; k0 = 64 * kb; W = w_in; ldw = INW; base = (unsigned char*)WIN; ldt = D; drow0 = (n0 < 448) ? n0 : (n0 < 512 ? 3072 + (n0 - 448) : n0 - 64); kgn = lnmix; }
                    else if ((r -= N_IN) < N_OUT) { const int kb = r >> 6, nb = r & 63; n0 = 32 * nb; k0 = 64 * kb; W = w_out; ldw = D; base = (unsigned char*)WOUT; ldt = D; drow0 = n0; }
                    else if ((r -= N_OUT) < N_XQ) { const int kb = r >> 4, nb = r & 15; n0 = 32 * nb; k0 = 64 * kb; W = xwq; ldw = 512; base = (unsigned char*)XWQ; ldt = D; drow0 = n0; kgn = lnx; }
                    else if ((r -= N_XQ) < N_XQ) { const int kb = r >> 4, nb = r & 15; n0 = 32 * nb; k0 = 64 * kb; W = xwk; ldw = 512; base = (unsigned char*)XWK; ldt = D; drow0 = n0; }
                    else if ((r -= N_XQ) < N_XQ) { const int kb = r >> 4, nb = r & 15; n0 = 32 * nb; k0 = 64 * kb; W = xwv; ldw = 512; base = (unsigned char*)XWV; ldt = D; drow0 = n0; }
                    else if ((r -= N_XQ) < N_XO) { const int kb = r >> 6, nb = r & 63; n0 = 32 * nb; k0 = 64 * kb; W = xwo; ldw = D; base = (unsigned char*)XWO; ldt = 512; drow0 = n0; }
                    else if ((r -= N_XO) < N_PW) { const int kb = r >> 4, nb = r & 15; n0 = 32 * nb; k0 = 64 * kb; W = pww; ldw = 512; base = (unsigned char*)PW; ldt = 512; drow0 = n0; }
                    else if ((r -= N_PW) < N_QB) { const int kb = r / 24, nb = r % 24; n0 = 32 * nb; k0 = 64 * kb; W = wqb; ldw = 768; base = (unsigned char*)WQB; ldt = 512; drow0 = n0; kgn = qag; }
                    else if ((r -= N_QB) < N_KVB) { const int kb = r >> 5, nb = r & 31; n0 = 32 * nb; k0 = 64 * kb; W = wkvb; ldw = 1024; base = (unsigned char*)WKVB; ldt = 256; drow0 = n0; kgn = kvag; }
                    else { r -= N_KVB; const int kb = r >> 4, nb = r & 15; n0 = 32 * nb; k0 = 64 * kb; W = gluw; ldw = 512; base = (unsigned char*)GLU; ldt = 512; drow0 = n0; }
                    TrD d; d.src = W + (size_t)k0 * ldw + n0; d.ldw = ldw; d.kg = kgn ? kgn + k0 : nullptr; d.f8 = f8; d.ldtB = f8 ? ldt : 2 * ldt; d.dst = base + (size_t)drow0 * d.ldtB + (f8 ? k0 : 2 * k0);
                    return d; };
#pragma unroll 1
                for (int it = gw; it < NITEMS; it += 2 * NGW) {
                    const int it2 = it + NGW; const bool two = it2 < NITEMS;
                    const TrD d0 = decode(it); TrD d1 = d0; float ta[32], tb[32]; f32x4 ka[2], kb2[2];
                    tr_load(d0, lane, ta, ka);
                    if (two) { d1 = decode(it2); tr_load(d1, lane, tb, kb2); }
                    tr_fin(d0, lane, ta, ka, scr);
                    if (two) tr_fin(d1, lane, tb, kb2, scr);
                }
                if (bid == 0 && tid < 256) { *(u32x4*)(XB + (size_t)S * D + 8 * tid) = (u32x4){0u, 0u, 0u, 0u}; *(u32x2*)(XF8 + (size_t)S * D + 8 * tid) = (u32x2){0u, 0u}; }
                for (int i = bid * NTHR + tid; i < (WINR - INW) * D / 8; i += G * NTHR) *(u32x4*)(WIN + (size_t)INW * D + (size_t)i * 8) = (u32x4){0u, 0u, 0u, 0u};
                const float* wgp = INP(I_WG) + (size_t)l * D * 4; const float* wep = INP(I_WE) + (size_t)l * D * 32;
                for (int i = bid * NTHR + tid; i < 256 * D / 2; i += G * NTHR) { const int n = i / (D / 2), k = (i % (D / 2)) * 2; float a = 0.f, b = 0.f;
                    if (n < 4) { a = wgp[(size_t)k * 4 + n] * lnm[k]; b = wgp[(size_t)(k + 1) * 4 + n] * lnm[k + 1]; } else if (n < 36) { a = wep[(size_t)k * 32 + n - 4] * lnm[k]; b = wep[(size_t)(k + 1) * 32 + n - 4] * lnm[k + 1]; }
                    *(unsigned*)(ROUT + (size_t)n * D + k) = cvt_pk_bf16(a, b); }
            }
            __syncthreads();
            for (int rep_ = 0; rep_ < (int)((PROBE_REP >> 19) & 1u) + 1; ++rep_)
            for (int task = bid; task < 256; task += G) {
                FRESH();
                const int g = task >> 3, part = task & 7;
                LAS f32x2* LP = (LAS f32x2*)lds;
                LAS f32x2* BB = (LAS f32x2*)(lds + 36864);
                LAS f32x2* CC = (LAS f32x2*)(lds + 45056);
                LAS float* KC = (LAS float*)(lds + 53248);
                const float* are = INP(I_ARE) + (size_t)(l * 32 + g) * 64; const float* aim = INP(I_AIM) + (size_t)(l * 32 + g) * 64;
                const float dt = __expf(INP(I_LOGDT)[l * 32 + g]);
                const float* bre = INP(I_BRE) + (size_t)(l * 32 + g) * 1024; const float* bim = INP(I_BIM) + (size_t)(l * 32 + g) * 1024;
                const float* cre = INP(I_CRE) + (size_t)(l * 32 + g) * 1024; const float* cim = INP(I_CIM) + (size_t)(l * 32 + g) * 1024;
                const float* dsk = INP(I_SSMD) + l * 512 + g * 16;
                if (tid < 64) { const int p = tid; float s, c; sincos_rev(aim[p] * dt, s, c); const float mag = fast_exp2(are[p] * dt * LOG2E); const f32x2 lb = (f32x2){mag * c, mag * s};
                    f32x2 cur = (f32x2){1.f, 0.f}; for (int j = 0; j <= 64; ++j) { LP[p * 65 + j] = cur; cur = cmul(cur, lb); } }
                for (int i = tid; i < 1024; i += NTHR) { const int p = i >> 4, ii = i & 15; float s, c; sincos_rev(aim[p] * dt, s, c); const float mag = fast_exp2(are[p] * dt * LOG2E);
                    const float nr = mag * c - 1.f, ni = mag * s, lr_ = are[p], li = aim[p], den = fast_rcp(lr_ * lr_ + li * li);
                    const f32x2 coef = (f32x2){(nr * lr_ + ni * li) * den, (ni * lr_ - nr * li) * den};
                    BB[p * 16 + ii] = cmul(coef, (f32x2){bre[p * 16 + ii], bim[p * 16 + ii]});
                    CC[i] = (f32x2){cre[i], cim[i]}; }
                __syncthreads();
                {   const int j = part * 8 + (tid >> 6), o = (tid >> 2) & 15, i0 = (tid & 3) * 4; float acc[4] = {0.f, 0.f, 0.f, 0.f};
                    for (int p = 0; p < 64; ++p) { const f32x2 u = cmul(CC[o * 64 + p], LP[p * 65 + j]);
#pragma unroll
                        for (int m = 0; m < 4; ++m) { const f32x2 bb = BB[p * 16 + i0 + m]; acc[m] += u.x * bb.x - u.y * bb.y; } }
#pragma unroll
                    for (int m = 0; m < 4; ++m) if (j == 0 && o == i0 + m) acc[m] += dsk[o];
                    *(f32x4*)(KCG + (size_t)g * 16384 + (j * 16 + o) * 16 + i0) = (f32x4){acc[0], acc[1], acc[2], acc[3]}; }
                for (int ch = tid; ch < 32 * 128; ch += NTHR) { const int n = part * 32 + ch / 128, kc = (ch % 128) * 8, tau = kc >> 4, i0 = kc & 15; float v[8];
                    if (n < 128) { const int p = n & 63; const f32x2 lp = LP[p * 65 + 63 - tau];
#pragma unroll
                        for (int j = 0; j < 8; ++j) { const f32x2 t2 = cmul(lp, BB[p * 16 + i0 + j]); v[j] = (n < 64) ? t2.x : t2.y; } }
                    else {
#pragma unroll
                        for (int j = 0; j < 8; ++j) v[j] = 0.f; }
                    *(u32x4*)(W1G + ((size_t)g * 256 + n) * 1024 + kc) = pack8(v); }
                __syncthreads();
            }
            if (l == 0) { FRESH(); for (int i = bid * NTHR + tid; i < S * 32; i += G * NTHR) { const int pos = i >> 5, f = i & 31; const float inv = fast_exp2(-(float)f * (13.287712379549449f / 32.0f));
                    double tr = (double)pos * (double)inv * 0.15915494309189535; tr -= rint(tr); const float rf = (float)tr;
                    ROPE[2 * i] = __builtin_amdgcn_cosf(rf); ROPE[2 * i + 1] = __builtin_amdgcn_sinf(rf); } }
            for (int rep3_ = (int)((PROBE_REP >> 21) & 1u); rep3_ >= 0; --rep3_)
            {   FRESH(); const float* xin = INP(I_X);
                for (int s = gw; s < S; s += NGW) { float x[4][8];
                    if (l == 0) {
#pragma unroll
                        for (int j = 0; j < 4; ++j) { const f32x4 a = *(const f32x4*)(xin + (size_t)s * D + 8 * lane + 512 * j), b = *(const f32x4*)(xin + (size_t)s * D + 8 * lane + 512 * j + 4);
                            x[j][0] = a[0]; x[j][1] = a[1]; x[j][2] = a[2]; x[j][3] = a[3]; x[j][4] = b[0]; x[j][5] = b[1]; x[j][6] = b[2]; x[j][7] = b[3]; } }
                    else { const int s0 = REC_S[2 * s], s1 = REC_S[2 * s + 1];
#pragma unroll
                        for (int j = 0; j < 4; ++j) { float ya[8], yb[8]; unpack8(*(const u32x4*)(XB + (size_t)s * D + 8 * lane + 512 * j), x[j]);
                            unpack8_fp8(*(const u32x2*)(YS8 + (size_t)s0 * D + 8 * lane + 512 * j), ya); unpack8_fp8(*(const u32x2*)(YS8 + (size_t)s1 * D + 8 * lane + 512 * j), yb);
#pragma unroll
                            for (int e = 0; e < 8; ++e) x[j][e] += (ya[e] + yb[e]) * 0.0625f; } }
                    float ss = 0.f;
#pragma unroll
                    for (int j = 0; j < 4; ++j)
#pragma unroll
                        for (int e = 0; e < 8; ++e) ss += x[j][e] * x[j][e];
                    ss = wave_sum(ss);
                    if (rep3_ == 0) {
#pragma unroll
                        for (int j = 0; j < 4; ++j) *(u32x4*)(XB + (size_t)s * D + 8 * lane + 512 * j) = pack8(x[j]);
                        if (lane == 0) RMS1[s] = rsqrtf(ss * (1.0f / D) + EPS); } }
                const float* mgain = INP(I_MEMG) + l * D; const float* mem = INP(I_MEM);
                for (int s = gw; s < MEMT; s += NGW) { f32x4 v[8];
#pragma unroll
                    for (int j = 0; j < 8; ++j) v[j] = *(const f32x4*)(mem + (size_t)s * D + 4 * lane + 256 * j);
                    rms_row_store(v, mgain, MEMN + (size_t)s * D, lane); }
            }
            SEAM(0);
        }
        if (IN(1)) for (int rep_ = 0; rep_ < (int)((PROBE_REP >> 1) & 1u) + 1; ++rep_) {
            FRESH();
            {
                for (int task = bid; task < 256; task += G) {
                    FRESH();
                    const int g = task >> 3, part = task & 7;
                    LAS f32x2* LP = (LAS f32x2*)lds;
                    LAS f32x2* CC = (LAS f32x2*)(lds + 45056);
                    LAS float* KC = (LAS float*)(lds + 53248);
                    const float* are = INP(I_ARE) + (size_t)(l * 32 + g) * 64; const float* aim = INP(I_AIM) + (size_t)(l * 32 + g) * 64;
                    const float dt = __expf(INP(I_LOGDT)[l * 32 + g]);
                    const float* cre = INP(I_CRE) + (size_t)(l * 32 + g) * 1024; const float* cim = INP(I_CIM) + (size_t)(l * 32 + g) * 1024;
                    if (tid < 64) { const int p = tid; float s_, c_; sincos_rev(aim[p] * dt, s_, c_); const float mag = fast_exp2(are[p] * dt * LOG2E); const f32x2 lb = (f32x2){mag * c_, mag * s_};
                        f32x2 cur = (f32x2){1.f, 0.f}; for (int j = 0; j <= 64; ++j) { LP[p * 65 + j] = cur; cur = cmul(cur, lb); } }
                    for (int i = tid; i < 1024; i += NTHR) CC[i] = (f32x2){cre[i], cim[i]};
#pragma unroll
                    for (int k_ = 0; k_ < 8; ++k_) { const int i = tid + k_ * NTHR; *(LAS f32x4*)(KC + 4 * i) = *(const f32x4*)(KCG + (size_t)g * 16384 + 4 * i); }
                    __syncthreads();
                    for (int ch = tid; ch < 128 * 160; ch += NTHR) { const int rr = part * 128 + ch / 160, kc = (ch % 160) * 8, t = rr >> 4, o = rr & 15; float v[8];
                        if (kc < 1024) { const int tau = kc >> 4, i0 = kc & 15;
#pragma unroll
                            for (int j = 0; j < 8; ++j) v[j] = (tau <= t) ? KC[((t - tau) * 16 + o) * 16 + i0 + j] : 0.f; }
                        else if (kc < 1152) { const bool im = kc >= 1088; const int p0 = (kc - (im ? 1088 : 1024));
#pragma unroll
                            for (int j = 0; j < 8; ++j) { const f32x2 t2 = cmul(CC[o * 64 + p0 + j], LP[(p0 + j) * 65 + t + 1]); v[j] = im ? -t2.y : t2.x; } }
                        else {
#pragma unroll
                            for (int j = 0; j < 8; ++j) v[j] = 0.f; }
                        *(u32x4*)(BTY + ((size_t)g * 1024 + rr) * 1280 + kc) = pack8(v); }
                    __syncthreads();
                } }
            __syncthreads();
            pg8::GSched Sd{(const char*)XB, (const char*)WIN, (size_t)256 * D * 2, (size_t)256 * D * 2, 0, 0, S / 256, 12, 1, G, bid};
            pg8::EpiBf16 E{P, INWP, 0, nullptr, RMS1};
            for (int r2_ = 0; r2_ < (int)((PROBE_REP >> 23) & 1u) + 1; ++r2_)
            pg8::gemm_phase<pg8::EpiBf16, pg8::GSched>(tid, lds, D, D, D, nullptr, Sd, E);
            for (int r3_ = 0; r3_ < (int)((PROBE_REP >> 22) & 1u) * 4 + 1; ++r3_)
            {
                pg8::GSched St{(const char*)XB, (const char*)(WIN + (size_t)3072 * D), (size_t)256 * D * 2, 0, (size_t)512 * 2, (size_t)512 * 2, S / 256, 1, 4, G, bid};
                pg8::EpiBf16Part64 Et{PQ7, (size_t)S * 64, RMS1};
                pg8::gemm_phase<pg8::EpiBf16Part64, pg8::GSched>(tid, lds, 512, D, D, nullptr, St, Et); }
            SEAM(1);
        }
        if (IN(2)) for (int rep_ = 0; rep_ < (int)((PROBE_REP >> 2) & 1u) + 1; ++rep_) {
            FRESH();
            {   pg8::GSched Sd{(const char*)(P + P_CQ), (const char*)WQB, (size_t)256 * INWP * 2, (size_t)256 * 512 * 2, 0, 0, S / 256, 3, 1, G, bid};
                pg8::EpiBf16 E{QRAW, 768, 0, nullptr, nullptr};
                pg8::gemm_phase<pg8::EpiBf16, pg8::GSched>(tid, lds, 512, INWP, 512, nullptr, Sd, E); }
            {   FRESH(); pg8::GSched Sd{(const char*)(P + P_CKV), (const char*)WKVB, (size_t)256 * INWP * 2, (size_t)256 * 256 * 2, 0, 0, S / 256, 4, 1, G, bid};
                pg8::EpiBf16 E{KVRAW, 1024, 0, nullptr, nullptr};
                pg8::gemm_phase<pg8::EpiBf16, pg8::GSched>(tid, lds, 256, INWP, 256, nullptr, Sd, E); }
            __syncthreads();
            for (int rep2_ = 0; rep2_ < (int)((PROBE_REP >> 20) & 1u) + 1; ++rep2_)
            for (int tile = bid; tile < S / 64; tile += G) {
                FRESH();
                const int t0 = tile * 64;
                LAS bf16_t* Z = (LAS bf16_t*)lds;
                LAS bf16_t* DW = (LAS bf16_t*)(lds + 98304);
                const float* dww = INP(I_DWW) + (size_t)l * 31 * 512;
                u32x4 tmp_[8], kraw_[2], vraw_[2];
#pragma unroll
                for (int k_ = 0; k_ < 8; ++k_) { const int i = tid + k_ * NTHR; const int half = i & 1, g = (i >> 1) & 31, tau = i >> 6; tmp_[k_] = *(const u32x4*)(P + (size_t)(t0 + tau) * INWP + P_DU + g * 16 + 8 * half); }
#pragma unroll
                for (int kh = 0; kh < 2; ++kh) { const int s_ = t0 + wave * 8 + (lane >> 3), c_ = lane & 7; kraw_[kh] = *(const u32x4*)(P + (size_t)s_ * INWP + P_AK + kh * 64 + 8 * c_); vraw_[kh] = *(const u32x4*)(P + (size_t)s_ * INWP + P_AV + kh * 64 + 8 * c_); }
#pragma unroll
                for (int hb = 0; hb < 2; ++hb) { u32x4 aw_[6], gw_[6];
#pragma unroll
                    for (int i1 = 0; i1 < 6; ++i1) { const int i = tid + (hb * 6 + i1) * NTHR, rr = (i < 94 * 64) ? (i >> 6) : 93, c8 = (i & 63) * 8, s = t0 - 30 + rr, sc = s < 0 ? 0 : s;
                        aw_[i1] = *(const u32x4*)(P + (size_t)sc * INWP + P_BA + c8); gw_[i1] = *(const u32x4*)(P + (size_t)sc * INWP + P_BG + c8); }
#pragma unroll
                    for (int i1 = 0; i1 < 6; ++i1) { const int i = tid + (hb * 6 + i1) * NTHR, rr = i >> 6, c8 = (i & 63) * 8, s = t0 - 30 + rr; float z[8], a[8], g[8]; unpack8(aw_[i1], a); unpack8(gw_[i1], g);
#pragma unroll
                        for (int j = 0; j < 8; ++j) z[j] = (s >= 0) ? a[j] * sigmoidf_(g[j]) : 0.f;
                        if (i < 94 * 64) *(LAS u32x4*)(Z + rr * 512 + c8) = pack8(z); } }
                for (int i = tid; i < 31 * 64; i += NTHR) { const int w = i >> 6, c8 = (i & 63) * 8; float v[8];
#pragma unroll
                    for (int j = 0; j < 8; ++j) v[j] = dww[w * 512 + c8 + j];
                    *(LAS u32x4*)(DW + w * 512 + c8) = pack8(v); }
                __syncthreads();
                {   const int c8 = lane * 8; const float* dwb = INP(I_DWB) + l * 512 + c8; const float* lg = INP(I_CLNG) + l * 512 + c8; const float* lb = INP(I_CLNB) + l * 512 + c8;
                    for (int g4 = 0; g4 < 2; ++g4) {
                        const int tb = wave * 8 + 4 * g4; float a4[4][8], zw[4][8];
#pragma unroll
                        for (int q = 0; q < 4; ++q)
#pragma unroll
                            for (int j = 0; j < 8; ++j) a4[q][j] = dwb[j];
#pragma unroll
                        for (int q = 0; q < 3; ++q) unpack8(*(const LAS u32x4*)(Z + (tb + q) * 512 + c8), zw[q]);
#pragma unroll 1
                        for (int w0 = 0; w0 < 32; w0 += 4) {
#pragma unroll
                            for (int i = 0; i < 4; ++i) { const int w = w0 + i; if (w < 31) { float k[8]; unpack8(*(const LAS u32x4*)(Z + (tb + 3 + w) * 512 + c8), zw[(i + 3) & 3]); unpack8(*(const LAS u32x4*)(DW + w * 512 + c8), k);
#pragma unroll
                                for (int q = 0; q < 4; ++q)
#pragma unroll
                                    for (int j = 0; j < 8; ++j) a4[q][j] += zw[(i + q) & 3][j] * k[j]; } } }
#pragma unroll
                    for (int q = 0; q < 4; ++q) { const int tau = tb + q; float acc[8];
#pragma unroll
                        for (int j = 0; j < 8; ++j) acc[j] = a4[q][j];
                        float sm = 0.f;
#pragma unroll
                        for (int j = 0; j < 8; ++j) sm += acc[j];
                        const float mean = wave_sum(sm) * (1.f / 512.f); float sq = 0.f;
#pragma unroll
                        for (int j = 0; j < 8; ++j) { acc[j] -= mean; sq += acc[j] * acc[j]; }
                        const float rstd = rsqrtf(wave_sum(sq) * (1.f / 512.f) + EPS); float y[8];
#pragma unroll
                        for (int j = 0; j < 8; ++j) { const float v = acc[j] * rstd * lg[j] + lb[j]; y[j] = v * sigmoidf_(v); }
                        *(u32x4*)(ZC + (size_t)(t0 + tau) * 512 + c8) = pack8(y); } } }
                __syncthreads();
                {
#pragma unroll
                for (int k_ = 0; k_ < 8; ++k_) { const int i = tid + k_ * NTHR; const int half = i & 1, g = (i >> 1) & 31, tau = i >> 6;
                    *(u32x4*)(UA + ((size_t)g * 256 + tile) * 1280 + tau * 16 + 8 * half) = tmp_[k_]; } }
                { const int g = tid >> 4, c = tid & 15; *(u32x4*)(UA + ((size_t)g * 256 + tile) * 1280 + 1152 + 8 * c) = (u32x4){0u, 0u, 0u, 0u}; }
                {   LAS bf16_t* vt = (LAS bf16_t*)(lds + wave * 1024);
                    const int j = lane >> 3, c = lane & 7, r = wave * 8 + j, s = t0 + r; const float* kg = INP(I_SWAKG) + l * 64 + 8 * c;
#pragma unroll
                    for (int kh = 0; kh < 2; ++kh) {
                        float x[8]; unpack8(kraw_[kh], x); float ss = 0.f;
#pragma unroll
                        for (int e = 0; e < 8; ++e) ss += x[e] * x[e];
                        ss += __shfl_xor(ss, 1); ss += __shfl_xor(ss, 2); ss += __shfl_xor(ss, 4);
                        const float rs = rsqrtf(ss * (1.f / 64.f) + EPS);
#pragma unroll
                        for (int e = 0; e < 8; ++e) x[e] = x[e] * rs * kg[e];
                        *(u32x4*)(SWAK + ((size_t)kh * 256 + tile) * 8192 + r * 128 + kswz<128>(r, c) * 16) = pack8(x);
                        *(LAS u32x4*)(vt + j * 64 + 8 * c) = vraw_[kh];
                        LDS_WAIT();
                        { const int d = lane; float v[8];
#pragma unroll
                            for (int jj = 0; jj < 8; ++jj) v[jj] = bf2f(vt[jj * 64 + d]);
                            *(u32x4*)(SWAV + ((size_t)kh * 256 + tile) * 8192 + d * 128 + vswz(d, wave) * 16) = pack8(v); }
                        LDS_WAIT();
                    } }
                __syncthreads();
            }
            SEAM(2);
        }
        if (IN(3)) for (int rep_ = 0; rep_ < (int)((PROBE_REP >> 3) & 1u) + 1; ++rep_) {
            FRESH();
            {   pg8::GSched Sd{(const char*)ZC, (const char*)PW, (size_t)256 * 512 * 2, (size_t)256 * 512 * 2, 0, 0, S / 256, 2, 1, G, (bid + G / 2) % G};
                pg8::EpiBf16 E{O, D, 512, INP(I_PWB) + l * 512, nullptr};
                pg8::gemm_phase<pg8::EpiBf16, pg8::GSched>(tid, lds, 512, 512, 512, nullptr, Sd, E); }
            {   pg8::GSched Sd{(const char*)UA, (const char*)W1G, 0, 0, (size_t)256 * 1280 * 2, (size_t)256 * 1024 * 2, 1, 1, 32, G, (bid + 128) % G};
                pg8::EpiF32Part<128> E{EBUF, 128, (size_t)256 * 128};
                pg8::gemm_phase<pg8::EpiF32Part<128>, pg8::GSched>(tid, lds, 1024, 1280, 1024, nullptr, Sd, E); }
            {   FRESH(); pg8::MemSched Sm{(const char*)MEMN, (const char*)XWK, G, (bid + G - 160) % G};
                pg8::EpiMem Em{KMEM, VMEM};
                pg8::gemm_phase<pg8::EpiMem, pg8::MemSched>(tid, lds, 512, D, D, nullptr, Sm, Em); }
            __syncthreads();
            for (int tile = bid; tile < S / 64; tile += G) {
                FRESH();
                const int t0 = tile * 64; constexpr float QSCALE = 0.07216878364870322f * LOG2E;
                LAS bf16_t* vt = (LAS bf16_t*)(lds + wave * 8192);
                const float* qnn = INP(I_QNN) + l * 128; const float* qnr = INP(I_QNR) + l * 64; const float* knn = INP(I_KNN) + l * 128; const float* knr = INP(I_KNR) + l * 64;
                for (int j2 = 0; j2 < 8; j2 += 2) {
                    u32x2 wkv_[2]; float xkr_[2], cs_[2], sn_[2]; unsigned wqn_[2][4], wkn_[2][4], wv_[2][4]; float xqr_[2][4];
#pragma unroll
                    for (int u = 0; u < 2; ++u) { const int s = t0 + wave * 8 + j2 + u;
                        wkv_[u] = *(const u32x2*)(P + (size_t)s * INWP + P_CKV + 4 * lane);
                        xkr_[u] = bf2f(P[(size_t)s * INWP + P_CKR + lane]);
                        cs_[u] = ROPE[((size_t)s * 32 + (lane & 31)) * 2]; sn_[u] = ROPE[((size_t)s * 32 + (lane & 31)) * 2 + 1];
#pragma unroll
                        for (int h = 0; h < 4; ++h) { wqn_[u][h] = *(const unsigned*)(QRAW + (size_t)s * 768 + h * 192 + 2 * lane); xqr_[u][h] = bf2f(QRAW[(size_t)s * 768 + h * 192 + 128 + lane]);
                            wkn_[u][h] = *(const unsigned*)(KVRAW + (size_t)s * 1024 + h * 256 + 2 * lane); wv_[u][h] = *(const unsigned*)(KVRAW + (size_t)s * 1024 + h * 256 + 128 + 2 * lane); } }
#pragma unroll
                    for (int u = 0; u < 2; ++u) {
                    const int j = j2 + u, r = wave * 8 + j, s = t0 + r;
                    const u32x2 wkv = wkv_[u]; const float xkr = xkr_[u], cs = cs_[u], sn = sn_[u];
                    unsigned wqn[4], wkn[4], wv[4]; float xqr[4];
#pragma unroll
                    for (int h = 0; h < 4; ++h) { wqn[h] = wqn_[u][h]; wkn[h] = wkn_[u][h]; wv[h] = wv_[u][h]; xqr[h] = xqr_[u][h]; }
                    float ps[14];
                    { const float a = bf2f(wkv.x & 0xffffu), b = bf2f(wkv.x >> 16), c = bf2f(wkv.y & 0xffffu), d = bf2f(wkv.y >> 16); ps[0] = a * a + b * b + c * c + d * d; }
                    ps[1] = xkr * xkr;
#pragma unroll
                    for (int h = 0; h < 4; ++h) { const float a = bf2f(wqn[h] & 0xffffu), b = bf2f(wqn[h] >> 16), c = bf2f(wkn[h] & 0xffffu), d = bf2f(wkn[h] >> 16);
                        ps[2 + 3 * h] = a * a + b * b; ps[3 + 3 * h] = xqr[h] * xqr[h]; ps[4 + 3 * h] = c * c + d * d; }
#pragma unroll
                    for (int o = 1; o < 64; o <<= 1)
#pragma unroll
                        for (int k = 0; k < 14; ++k) ps[k] += __shfl_xor(ps[k], o);
                    const float rkv = rsqrtf(ps[0] * (1.f / 256.f) + EPS);
                    float kr; { const float y = xkr * rsqrtf(ps[1] * (1.f / 64.f) + EPS) * knr[lane]; const float pr = __shfl_xor(y, 32);
                        kr = (lane < 32) ? (y * cs - pr * sn) : (pr * sn + y * cs); }
#pragma unroll
                    for (int h = 0; h < 4; ++h) {
                        { const float a = bf2f(wqn[h] & 0xffffu), b = bf2f(wqn[h] >> 16);
                          const float rs = rsqrtf(ps[2 + 3 * h] * (1.f / 128.f) + EPS);
                          *(unsigned short*)((unsigned char*)Q + ((size_t)h * S + s) * 192 + f8pos(2 * lane)) = (unsigned short)(pk4_fp8(a * rs * qnn[2 * lane], b * rs * qnn[2 * lane + 1], 0.f, 0.f) & 0xffffu); }
                        { const float y = xqr[h] * rsqrtf(ps[3 + 3 * h] * (1.f / 64.f) + EPS) * qnr[lane]; const float pr = __shfl_xor(y, 32);
                          const float qr = ((lane < 32) ? (y * cs - pr * sn) : (pr * sn + y * cs));
                          ((unsigned char*)Q)[((size_t)h * S + s) * 192 + f8pos(128 + lane)] = (unsigned char)(pk4_fp8(qr, 0.f, 0.f, 0.f) & 0xffu); }
                        { const float a = bf2f(wkn[h] & 0xffffu), b = bf2f(wkn[h] >> 16);
                          const float rs = rsqrtf(ps[4 + 3 * h] * (1.f / 128.f) + EPS);
                          unsigned char* kimg = KIMG + ((size_t)h * 256 + tile) * 12288 + r * 192; const int pn_ = f8pos(2 * lane), pr_ = f8pos(128 + lane), sw_ = (r >> 2) & 3;
                          *(unsigned short*)(kimg + (((pn_ >> 4) ^ sw_) << 4) + (pn_ & 15)) = (unsigned short)(pk4_fp8(a * rs * knn[2 * lane], b * rs * knn[2 * lane + 1], 0.f, 0.f) & 0xffffu);
                          kimg[(((pr_ >> 4) ^ sw_) << 4) + (pr_ & 15)] = (unsigned char)(pk4_fp8(kr, 0.f, 0.f, 0.f) & 0xffu); }
                        *(LAS unsigned short*)((LAS unsigned char*)vt + (h * 8 + j) * 128 + 2 * lane) = (unsigned short)(pk4_fp8(bf2f(wv[h] & 0xffffu) * rkv, bf2f(wv[h] >> 16) * rkv, 0.f, 0.f) & 0xffffu);
                    }
                                    }
                }
                LDS_WAIT();
                for (int h = 0; h < 4; ++h)
                    for (int dd = 0; dd < 2; ++dd) { const int d = lane + 64 * dd; const LAS unsigned char* v8 = (const LAS unsigned char*)vt; unsigned lo = 0u, hi4 = 0u;
#pragma unroll
                        for (int jj = 0; jj < 4; ++jj) { lo |= (unsigned)v8[(h * 8 + jj) * 128 + d] << (8 * jj); hi4 |= (unsigned)v8[(h * 8 + 4 + jj) * 128 + d] << (8 * jj); }
                        const int off_ = 32 * (wave >> 2) + 8 * (((wave & 1) << 1) | ((wave >> 1) & 1));
                        *(u32x2*)(VIMG + ((size_t)h * 256 + tile) * 8192 + d * 64 + ((((off_ >> 4) ^ ((d >> 2) & 3))) << 4) + (off_ & 15)) = (u32x2){lo, hi4}; }
                LDS_WAIT();
            }
            __syncthreads();
            __syncthreads();
            {   FRESH(); LAS float* tab = (LAS float*)(lds + 98304);
                const float* relb = INP(I_RELB);
                for (int i = tid; i < 1024; i += NTHR) { const int h = i >> 7, dist = i & 127; tab[i] = relb[T5_BUCKET[dist] * 8 + h] * LOG2E; }
                __syncthreads();
                const int lr = lane & 31, hi = lane >> 5;
                for (int it = bid; it < 128; it += G) {
                    const int kh = it & 1, qb = it >> 1, q0 = qb * 256, wq0 = q0 + 32 * wave, qpos = wq0 + lr;
                    const int t_lo = (4 * qb - 2) < 0 ? 0 : (4 * qb - 2), t_hi = 4 * qb + 4;
                    __syncthreads();
                    for (int t = t_lo; t < t_hi; ++t) { dma_tile<8192>(SWAK + ((size_t)kh * 256 + t) * 8192, lds + (t - t_lo) * 16384, tid, wave); dma_tile<8192>(SWAV + ((size_t)kh * 256 + t) * 8192, lds + (t - t_lo) * 16384 + 8192, tid, wave); }
                    VM_WAIT(); __syncthreads();
#pragma unroll 1
                    for (int g = 0; g < 4; ++g) { const int h = 4 * kh + g;
                        bf16x8 qf[4];
                        if (h < 7) load_q_norm<64>(P + (size_t)qpos * INWP + P_AQ + h * 64, INP(I_SWAQG) + l * 64, 0.125f * LOG2E, hi, qf);
                        else load_q_norm_bf16x4<64>(PQ7 + (size_t)qpos * 64, (size_t)S * 64, INP(I_SWAQG) + l * 64, 0.125f * LOG2E, hi, qf);
                        f32x16 o[2];
#pragma unroll
                        for (int db = 0; db < 2; ++db)
#pragma unroll
                            for (int r = 0; r < 16; ++r) o[db][r] = 0.f;
                        float m_run = -1e30f, l_run = 0.f;
#pragma unroll 1
                        for (int t = t_lo; t < t_hi; ++t) { const int k0 = t * 64;
                            if ((k0 <= wq0 + 31) && (k0 + 63 >= wq0 - 127)) attn_tile_compute<64, 64, 1>(lds + (t - t_lo) * 16384, lds + (t - t_lo) * 16384 + 8192, k0, true, qf, qpos, tab + h * 128, lr, hi, o, m_run, l_run); }
                        { auto rr = __builtin_amdgcn_permlane32_swap(__float_as_uint(l_run), __float_as_uint(l_run), false, false); l_run = __uint_as_float(rr[0]) + __uint_as_float(rr[1]); }
                        l_run += fast_exp2(INP(I_SINK)[l * 8 + h] * LOG2E - m_run);
                        store_o<64>(O + (size_t)qpos * D + h * 64, o, fast_rcp(l_run), hi);
                    }
                }
            }
            SEAM(3);
        }
        if (IN(4)) for (int rep_ = 0; rep_ < (int)((PROBE_REP >> 4) & 1u) + 1; ++rep_) {
            FRESH();
            for (int task = bid; task < 64; task += G) {
                FRESH();
                LAS f32x2* SE = (LAS f32x2*)lds;
                const int sl = tid & 31, seg = tid >> 5, st = task * 32 + sl, g = st >> 6, p = st & 63;
                const float dt = __expf(INP(I_LOGDT)[l * 32 + g]); const float are = INP(I_ARE)[(size_t)(l * 32 + g) * 64 + p], aim = INP(I_AIM)[(size_t)(l * 32 + g) * 64 + p];
                float s_, c_; sincos_rev(aim * dt, s_, c_); const float mag = fast_exp2(are * dt * LOG2E); f32x2 lt = (f32x2){mag * c_, mag * s_};
#pragma unroll
                for (int k = 0; k < 6; ++k) lt = cmul(lt, lt);
                f32x2 e[16];
#pragma unroll
                for (int k = 0; k < 16; ++k) { const size_t off = ((size_t)g * 256 + seg * 16 + k) * 128 + p; e[k] = (f32x2){EBUF[off], EBUF[off + 64]}; }
                f32x2 acc = (f32x2){0.f, 0.f};
#pragma unroll
                for (int k = 0; k < 16; ++k) { const f32x2 t = cmul(lt, acc); acc = (f32x2){t.x + e[k].x, t.y + e[k].y}; }
                SE[sl * 16 + seg] = acc;
                f32x2 l16 = lt;
#pragma unroll
                for (int k = 0; k < 4; ++k) l16 = cmul(l16, l16);
                __syncthreads();
                f32x2 carry = (f32x2){0.f, 0.f};
                for (int k = 0; k < seg; ++k) { const f32x2 t = cmul(l16, carry); const f32x2 se = SE[sl * 16 + k]; carry = (f32x2){t.x + se.x, t.y + se.y}; }
#pragma unroll
                for (int k = 0; k < 16; ++k) { const int c = seg * 16 + k; bf16_t* dst = UA + ((size_t)g * 256 + c) * 1280 + 1024 + p;
                    dst[0] = (bf16_t)(cvt_pk_bf16(carry.x, 0.f) & 0xffffu); dst[64] = (bf16_t)(cvt_pk_bf16(carry.y, 0.f) & 0xffffu);
                    const f32x2 t = cmul(lt, carry); carry = (f32x2){t.x + e[k].x, t.y + e[k].y}; }
                __syncthreads();
            }
            {   FRESH(); const int lr = lane & 31, hi = lane >> 5;
                for (int it = bid; it < 256; it += G) {
                    const int xcd_ = it & 7, il_ = ((xcd_ & 1) << 5) | (it >> 3), h = xcd_ >> 1, j = il_ >> 1, part = il_ & 1;
                    for (int sub = 0; sub <= part; ++sub) {
                        const bool fin = (sub == 1);
                        const int qb = fin ? j : 63 - j;
                        const int t_lo = fin ? 0 : (part ? 130 : 0), t_hi = fin ? 4 * j + 4 : (part ? 4 * (64 - j) : 130);
                        const int q0 = qb * 256, wq0 = q0 + 32 * wave, qpos = wq0 + lr;
                        i64x2 qf[6];
#pragma unroll
                        for (int m = 0; m < 6; ++m) qf[m] = *(const i64x2*)((const unsigned char*)Q + ((size_t)h * S + qpos) * 192 + 32 * m + 16 * hi);
                        f32x16 o[4];
#pragma unroll
                        for (int db = 0; db < 4; ++db)
#pragma unroll
                            for (int r = 0; r < 16; ++r) o[db][r] = 0.f;
                        float m_run = -1e30f, l_run = 0.f;
                        attn_mla_f8(tid, lds, KIMG + (size_t)h * 256 * 12288, VIMG + (size_t)h * 256 * 8192, t_lo, t_hi, qf, qpos, wq0, o, m_run, l_run);
                        { auto rr = __builtin_amdgcn_permlane32_swap(__float_as_uint(l_run), __float_as_uint(l_run), false, false); l_run = __uint_as_float(rr[0]) + __uint_as_float(rr[1]); }
                        int tz = tid; asm volatile("" : "+v"(tz));
                        const int lr2 = tz & 31, hi2 = (tz >> 5) & 1, row2 = q0 + (tz >> 6) * 32 + lr2;
                        if (fin) store_o<128>(O + (size_t)row2 * D + 1024 + h * 128, o, fast_rcp(l_run), hi2);
                        else {
                            const size_t slot = ((size_t)(h * 32 + (qb - 32)) * 2 + part) * 256 + (tz >> 6) * 32 + lr2;
                            float* po = PARTO + slot * 128;
#pragma unroll
                            for (int db = 0; db < 4; ++db)
#pragma unroll
                                for (int r4 = 0; r4 < 4; ++r4) *(f32x4*)(po + 32 * db + 8 * r4 + 4 * hi2) = (f32x4){o[db][4 * r4], o[db][4 * r4 + 1], o[db][4 * r4 + 2], o[db][4 * r4 + 3]};
                            if (hi2 == 0) *(f32x2*)(PARTML + slot * 2) = (f32x2){m_run, l_run};
                        }
                    }
                }
            }
            SEAM(4);
        }
        if (IN(5)) for (int rep_ = 0; rep_ < (int)((PROBE_REP >> 5) & 1u) + 1; ++rep_) {
            FRESH();
            pg8::GSched Sd{(const char*)UA, (const char*)BTY, 0, (size_t)256 * 1280 * 2, (size_t)256 * 1280 * 2, (size_t)1024 * 1280 * 2, 1, 4, 32, G, bid};
            pg8::EpiSsmY E{YG};
            pg8::gemm_phase<pg8::EpiSsmY, pg8::GSched>(tid, lds, 1280, 1280, 1280, nullptr, Sd, E);
            if (G == 256 && bid >= 128) { FRESH(); norm_groups(PT, ws, l, (bid - 128) * NWAVES + wave, 128 * NWAVES, 0, 3, lane); }
            SEAM(5);
        }
        if (IN(6)) for (int rep_ = 0; rep_ < (int)((PROBE_REP >> 6) & 1u) + 1; ++rep_) {
            FRESH();
            pg8::GSched Sd{(const char*)YG, (const char*)GLU, (size_t)256 * 512 * 2, (size_t)256 * 512 * 2, 0, 0, S / 256, 2, 1, G, bid};
            pg8::EpiGlu E{YG, INP(I_GLUB) + l * 512, O};
            pg8::gemm_phase<pg8::EpiGlu, pg8::GSched>(tid, lds, 512, 512, 512, nullptr, Sd, E);
            __syncthreads();
            for (int it = (bid + 32) % G; it < 32; it += G) {
                FRESH();
                const int tile = it >> 3, w8 = it & 7, r = w8 * 8 + wave, mrow = tile * 64 + r;
                LAS bf16_t* vt = (LAS bf16_t*)lds; const float* kg = INP(I_XKG) + l * 128;
                unsigned wk[4]; float ps[4];
#pragma unroll
                for (int h = 0; h < 4; ++h) { float a = 0.f, b = 0.f, va = 0.f, vb = 0.f;
#pragma unroll
                    for (int z = 0; z < 4; ++z) { const unsigned k2 = *(const unsigned*)(KMEM + (size_t)z * 256 * 512 + (size_t)mrow * 512 + h * 128 + 2 * lane), v2 = *(const unsigned*)(VMEM + (size_t)z * 256 * 512 + (size_t)mrow * 512 + h * 128 + 2 * lane);
                        a += bf2f(k2 & 0xffffu); b += bf2f(k2 >> 16); va += bf2f(v2 & 0xffffu); vb += bf2f(v2 >> 16); }
                    wk[h] = cvt_pk_bf16(a, b); a = bf2f(wk[h] & 0xffffu); b = bf2f(wk[h] >> 16); ps[h] = a * a + b * b;
                    *(LAS unsigned*)(vt + (h * 8 + wave) * 128 + 2 * lane) = cvt_pk_bf16(va, vb); }
#pragma unroll
                for (int o = 1; o < 64; o <<= 1)
#pragma unroll
                    for (int h = 0; h < 4; ++h) ps[h] += __shfl_xor(ps[h], o);
#pragma unroll
                for (int h = 0; h < 4; ++h) { const float a = bf2f(wk[h] & 0xffffu), b = bf2f(wk[h] >> 16), rs = rsqrtf(ps[h] * (1.f / 128.f) + EPS);
                    *(unsigned*)(XKIMG + ((size_t)h * 4 + tile) * 16384 + r * 256 + kswz<256>(r, lane >> 2) * 16 + (lane & 3) * 4) = cvt_pk_bf16(a * rs * kg[2 * lane], b * rs * kg[2 * lane + 1]); }
                __syncthreads();
                {   const int h = tid >> 7, d = tid & 127; float v[8];
#pragma unroll
                    for (int jj = 0; jj < 8; ++jj) v[jj] = bf2f(vt[(h * 8 + jj) * 128 + d]);
                    *(u32x4*)(XVIMG + ((size_t)h * 4 + tile) * 16384 + d * 128 + vswz(d, w8) * 16) = pack8(v); }
                __syncthreads();
            }
            SEAM(6);
        }
        if (IN(7)) for (int rep_ = 0; rep_ < (int)((PROBE_REP >> 7) & 1u) + 1; ++rep_) {
            FRESH();
            norm_groups(PT, ws, l, gw, NGW, (G == 256) ? 3 : 0, 4, lane);
            SEAM(7);
        }
        if (IN(8)) for (int rep_ = 0; rep_ < (int)((PROBE_REP >> 8) & 1u) + 1; ++rep_) {
            FRESH();
            pg8::GSched Sd{(const char*)O, (const char*)WOUT, (size_t)256 * D * 2, (size_t)256 * D * 2, 0, 0, S / 256, D / 256, 1, G, bid};
            pg8::EpiResid E{XB, D, nullptr, (((PROBE_REP >> 8) & 1u) != 0u) && rep_ == 0, nullptr};
            pg8::gemm_phase<pg8::EpiResid, pg8::GSched>(tid, lds, D, D, D, nullptr, Sd, E);
            SEAM(8);
        }
        if (IN(10)) for (int rep_ = 0; rep_ < (int)((PROBE_REP >> 10) & 1u) + 1; ++rep_) {
            FRESH();
            pg8::GSched Sd{(const char*)XB, (const char*)XWQ, (size_t)256 * D * 2, (size_t)256 * D * 2, (size_t)1024 * 2, (size_t)1024 * 2, S / 256, 2, 2, G, bid};
            pg8::EpiBf16Z E{(bf16_t*)QXP, 512, (size_t)S * 512};
            pg8::gemm_phase<pg8::EpiBf16Z, pg8::GSched>(tid, lds, 1024, D, D, nullptr, Sd, E);
            SEAM(10);
        }
        if (IN(11)) for (int rep_ = 0; rep_ < (int)((PROBE_REP >> 11) & 1u) + 1; ++rep_) {
            FRESH();
            const int lr = lane & 31, hi = lane >> 5;
            for (int it = bid; it < 256; it += G) {
                const int h = it & 3, qb = it >> 2, wq0 = qb * 256 + 32 * wave, qpos = wq0 + lr;
                bf16x8 qf[8]; load_q_norm_bf16x2<128>((const bf16_t*)QXP + (size_t)qpos * 512 + h * 128, (const bf16_t*)QXP + (size_t)S * 512 + (size_t)qpos * 512 + h * 128, INP(I_XQG) + l * 128, 0.08838834764831845f * LOG2E, hi, qf);
                f32x16 o[4];
#pragma unroll
                for (int db = 0; db < 4; ++db)
#pragma unroll
                    for (int r = 0; r < 16; ++r) o[db][r] = 0.f;
                float m_run = -1e30f, l_run = 0.f;
                attn_tiles<128, 128, 2>(tid, lds, XKIMG + (size_t)h * 4 * 16384, XVIMG + (size_t)h * 4 * 16384, 0, 4, qf, qpos, wq0, nullptr, o, m_run, l_run);
                { auto rr = __builtin_amdgcn_permlane32_swap(__float_as_uint(l_run), __float_as_uint(l_run), false, false); l_run = __uint_as_float(rr[0]) + __uint_as_float(rr[1]); }
                store_o<128>(OX + (size_t)qpos * 512 + h * 128, o, fast_rcp(l_run), hi);
            }
            SEAM(11);
        }
        if (IN(12)) for (int rep_ = 0; rep_ < (int)((PROBE_REP >> 12) & 1u) + 1; ++rep_) {
            FRESH();
            pg8::GSched Sd{(const char*)OX, (const char*)XWO, (size_t)256 * 512 * 2, (size_t)256 * 512 * 2, 0, 0, S / 256, D / 256, 1, G, bid};
            pg8::EpiResid E{XB, D, SSP, (((PROBE_REP >> 12) & 1u) != 0u) && rep_ == 0, XF8};
            pg8::gemm_phase<pg8::EpiResid, pg8::GSched>(tid, lds, 512, 512, 512, nullptr, Sd, E);
            SEAM(12);
        }
        if (IN(14)) for (int rep_ = 0; rep_ < (int)((PROBE_REP >> 14) & 1u) + 1; ++rep_) {
            FRESH();
            pg8::GSched Sd{(const char*)XB, (const char*)ROUT, (size_t)256 * D * 2, 0, (size_t)512 * 2, (size_t)512 * 2, S / 256, 1, 4, G, bid};
            pg8::EpiF32Part<64> E{LOGP, 64, (size_t)S * 64};
            pg8::gemm_phase<pg8::EpiF32Part<64>, pg8::GSched>(tid, lds, 512, D, D, nullptr, Sd, E);
            SEAM(14);
        }
        if (IN(15)) for (int rep_ = 0; rep_ < (int)((PROBE_REP >> 15) & 1u) + 1; ++rep_) {
            FRESH();
            for (int i = bid * NTHR + tid; i < NSLOT; i += G * NTHR) { TOK[i] = S; WSLOT[i] = 0.f; }
            if (bid == 0 && tid == 0) RMSV[S] = 0.f;
            LAS unsigned* hist = (LAS unsigned*)lds; LAS unsigned* base = hist + 32;
            const float* bg = INP(I_BG) + l * 4; const float* be = INP(I_BE) + l * 32;
            for (int blk = bid; blk < S / 64; blk += G) {
                if (tid < 64) hist[tid] = 0u;
                __syncthreads();
                int e0 = 0, e1 = 0; unsigned r0 = 0, r1 = 0; float w0 = 0.f, w1 = 0.f; const int s = blk * 64 + tid;
                if (tid < 64) {
                    float ssq = 0.f;
#pragma unroll
                    for (int j4 = 0; j4 < 8; ++j4) { const f32x4 a = *(const f32x4*)(SSP + (size_t)s * 32 + 4 * j4); ssq += (a[0] + a[1]) + (a[2] + a[3]); }
                    const float rms = rsqrtf(ssq * (1.0f / D) + EPS); RMSV[s] = rms;
                    float lg[36];
#pragma unroll
                    for (int j4 = 0; j4 < 9; ++j4) { f32x4 a = *(const f32x4*)(LOGP + (size_t)s * 64 + 4 * j4);
#pragma unroll
                        for (int z = 1; z < 4; ++z) a += *(const f32x4*)(LOGP + (size_t)z * S * 64 + (size_t)s * 64 + 4 * j4);
                        lg[4 * j4] = a[0] * rms; lg[4 * j4 + 1] = a[1] * rms; lg[4 * j4 + 2] = a[2] * rms; lg[4 * j4 + 3] = a[3] * rms; }
                    float gl[4]; int gi = 0; float gm;
#pragma unroll
                    for (int j = 0; j < 4; ++j) gl[j] = lg[j] + bg[j];
                    gm = gl[0];
#pragma unroll
                    for (int j = 1; j < 4; ++j) if (gl[j] > gm) { gm = gl[j]; gi = j; }
                    float gs = 0.f;
#pragma unroll
                    for (int j = 0; j < 4; ++j) gs += __expf(gl[j] - gm);
                    const float gwt = 1.f / gs;
                    float v0 = -__builtin_inff(), v1 = -__builtin_inff(); int i0 = 0, i1 = 0;
#pragma unroll
                    for (int j = 0; j < 8; ++j) { const float lv = (gi == 0) ? lg[4 + j] : (gi == 1) ? lg[12 + j] : (gi == 2) ? lg[20 + j] : lg[28 + j]; const float v = lv + be[gi * 8 + j];
                        if (v > v0) { v1 = v0; i1 = i0; v0 = v; i0 = j; } else if (v > v1) { v1 = v; i1 = j; } }
                    const float ee = __expf(v1 - v0), den = 1.f / (1.f + ee);
                    w0 = gwt * den; w1 = gwt * ee * den; e0 = gi * 8 + i0; e1 = gi * 8 + i1;
                    r0 = __hip_atomic_fetch_add(&hist[e0], 1u, __ATOMIC_RELAXED, __HIP_MEMORY_SCOPE_WORKGROUP); r1 = __hip_atomic_fetch_add(&hist[e1], 1u, __ATOMIC_RELAXED, __HIP_MEMORY_SCOPE_WORKGROUP);
                }
                __syncthreads();
                if (tid < 32) { const unsigned c = hist[tid]; base[tid] = c ? __hip_atomic_fetch_add(ctl + CW_CNT + 64 * l + tid, c, __ATOMIC_RELAXED, __HIP_MEMORY_SCOPE_AGENT) : 0u; }
                __syncthreads();
                if (tid < 64) { REC_E[2 * s] = e0; REC_E[2 * s + 1] = e1; REC_R[2 * s] = (int)(base[e0] + r0); REC_R[2 * s + 1] = (int)(base[e1] + r1); REC_W[2 * s] = w0; REC_W[2 * s + 1] = w1; }
                __syncthreads();
            }
            SEAM(15);
        }
        if (IN(16) || IN(17) || IN(18)) {
            FRESH();
            LAS int* pst = (LAS int*)(CTLW + 16);
            if (tid == 0) { int acc = 0; for (int e = 0; e < 32; ++e) { pst[e] = acc; const int c = (int)__hip_atomic_load(ctl + CW_CNT + 64 * l + e, __ATOMIC_RELAXED, __HIP_MEMORY_SCOPE_AGENT); acc += (c + 255) & ~255; } pst[32] = acc; }
            __syncthreads();
            if (tid < 160) { int e = 0; for (int k = 1; k < 32; ++k) if (pst[k] <= tid * 256) e = k; ((LAS int*)(CTLW + 256))[tid] = e; }
            __syncthreads();
        }
        if (IN(16)) for (int rep_ = 0; rep_ < (int)((PROBE_REP >> 16) & 1u) + 1; ++rep_) {
            FRESH();
            const LAS int* pst = (const LAS int*)(CTLW + 16);
            for (int i = bid * NTHR + tid; i < 2 * S; i += G * NTHR) { const int slot = pst[REC_E[i]] + REC_R[i]; TOK[slot] = i >> 1; WSLOT[slot] = REC_W[i]; REC_S[i] = slot; }
            SEAM(16);
        }
        if (IN(17)) for (int rep_ = 0; rep_ < (int)((PROBE_REP >> 17) & 1u) + 1; ++rep_) {
            FRESH();
            pg8::MoeSched Sd{(const LAS int*)(CTLW + 16), (const char*)MOE1F, TOK, (size_t)1024 * D, (size_t)256 * D, 4, G, bid, 1};
            pg8::EpiMoe1 E{HID8, TOK, RMSV};
            pg8::gemm_phase<pg8::EpiMoe1, pg8::MoeSched, true, true>(tid, lds, D / 2, D / 2, D / 2, (const char*)XF8, Sd, E);
            SEAM(17);
        }
        if (IN(18)) for (int rep_ = 0; rep_ < (int)((PROBE_REP >> 18) & 1u) + 1; ++rep_) {
            {   FRESH();
                pg8::MoeSched Sd{(const LAS int*)(CTLW + 16), (const char*)MOE1F, TOK, (size_t)1024 * D, (size_t)256 * D, 4, G, bid, 2};
                pg8::EpiMoe1 E{HID8, TOK, RMSV};
                pg8::gemm_phase<pg8::EpiMoe1, pg8::MoeSched, true, true>(tid, lds, D / 2, D / 2, D / 2, (const char*)XF8, Sd, E); }
            {   FRESH();
                pg8::MoeSched2 Sd{(const LAS int*)(CTLW + 16), (const char*)HID8, (const char*)MOE2F, (size_t)D * 512, (size_t)256 * 512, 8, G, bid, 1};
                pg8::EpiMoe2 E{YS8, WSLOT};
                pg8::gemm_phase<pg8::EpiMoe2, pg8::MoeSched2, false, true>(tid, lds, 256, 256, 256, nullptr, Sd, E); }
            {   FRESH(); GRID_BAR(); }
            {   FRESH();
                pg8::MoeSched2 Sd{(const LAS int*)(CTLW + 16), (const char*)HID8, (const char*)MOE2F, (size_t)D * 512, (size_t)256 * 512, 8, G, bid, 2};
                pg8::EpiMoe2 E{YS8, WSLOT};
                pg8::gemm_phase<pg8::EpiMoe2, pg8::MoeSched2, false, true>(tid, lds, 256, 256, 256, nullptr, Sd, E); }
            {   FRESH(); SEAM(18); }
        }
}

__global__ void __launch_bounds__(NTHR, 2) fwd_kernel(Args args) {
    extern __shared__ __attribute__((aligned(16))) unsigned char lds_raw[];
    LAS unsigned char* lds0 = (LAS unsigned char*)lds_raw;
    {   int t0 = threadIdx.x; asm volatile("" : "+v"(t0));
        for (int u = t0; u < (LDS_BYTES - LDSCTL_OFF) / 4; u += NTHR) ((LAS unsigned*)(lds0 + LDSCTL_OFF))[u] = 0u;
        __syncthreads();
        if (t0 == 0) { LAS unsigned long long* pw = (LAS unsigned long long*)(lds0 + LDSCTL_OFF + 512);
#pragma unroll
            for (int i = 0; i < 50; ++i) pw[i] = (unsigned long long)args.in[i];
            pw[50] = (unsigned long long)args.ws; pw[51] = (unsigned long long)args.out; }
        __syncthreads();
#if !MK_MULTI
        if (t0 == 0) (void)xb_add(&((unsigned*)args.ws)[CW_BAR + XB_XCNT(xb_xcc_id())], 1u);
#endif
    }
    const int ph_lo = args.ph_lo, ph_hi = args.ph_hi;
    int wave_s = __builtin_amdgcn_readfirstlane(threadIdx.x >> 6); asm volatile("" : "+s"(wave_s));
#if MK_MULTI
    if (args.l_lo < NL) layer_body<0>(args.l_lo, wave_s, lds0, ph_lo, ph_hi);
#else
    layer_body<0>(0, wave_s, lds0, ph_lo, ph_hi);
    layer_body<1>(1, wave_s, lds0, ph_lo, ph_hi);
    layer_body<2>(2, wave_s, lds0, ph_lo, ph_hi);
    layer_body<3>(3, wave_s, lds0, ph_lo, ph_hi);
#endif
    if (args.l_hi > NL) {
        FRESH();
        for (int s = gw; s < S; s += NGW) { const int s0 = REC_S[2 * s], s1 = REC_S[2 * s + 1];
#pragma unroll
            for (int j = 0; j < 4; ++j) { float x[8], ya[8], yb[8]; unpack8(*(const u32x4*)(XB + (size_t)s * D + 8 * lane + 512 * j), x);
                unpack8_fp8(*(const u32x2*)(YS8 + (size_t)s0 * D + 8 * lane + 512 * j), ya); unpack8_fp8(*(const u32x2*)(YS8 + (size_t)s1 * D + 8 * lane + 512 * j), yb);
#pragma unroll
                for (int e = 0; e < 8; ++e) x[e] += (ya[e] + yb[e]) * 0.0625f;
                *(f32x4*)(X + (size_t)s * D + 8 * lane + 512 * j) = (f32x4){x[0], x[1], x[2], x[3]};
                *(f32x4*)(X + (size_t)s * D + 8 * lane + 512 * j + 4) = (f32x4){x[4], x[5], x[6], x[7]}; } }
    }
}

extern "C" void kernel_launch(void* const* d_in, const int* in_sizes, int n_in, void* d_out, int out_size, void* d_ws, size_t ws_size, hipStream_t stream) {
    static int grid = 0;
    if (grid == 0) {
        if (n_in != 50 || out_size != S * D || ws_size < WS_END) { fprintf(stderr, "kernel_launch: unexpected shapes (n_in %d, out %d, ws %zu < %zu)\n", n_in, out_size, ws_size, (size_t)WS_END); grid = -1; return; }
        int dev = 0, cus = 0, per_cu = 0;
        if (hipGetDevice(&dev) != hipSuccess || hipDeviceGetAttribute(&cus, hipDeviceAttributeMultiprocessorCount, dev) != hipSuccess) { grid = -1; return; }
        if (hipFuncSetAttribute((const void*)fwd_kernel, hipFuncAttributeMaxDynamicSharedMemorySize, LDS_BYTES) != hipSuccess) { fprintf(stderr, "kernel_launch: hipFuncSetAttribute failed\n"); grid = -1; return; }
        if (hipOccupancyMaxActiveBlocksPerMultiprocessor(&per_cu, (const void*)fwd_kernel, NTHR, LDS_BYTES) != hipSuccess || per_cu < 1) { fprintf(stderr, "kernel_launch: occupancy query says %d\n", per_cu); }
        (void)hipGetLastError();
        grid = cus;
    }
    if (grid < 0) return;
    (void)in_sizes;
    if (hipMemsetAsync((char*)d_ws + WS_CTL, 0, CTL_ZERO_BYTES, stream) != hipSuccess) return;
    Args a{};
    for (int i = 0; i < 50; ++i) a.in[i] = (const float*)d_in[i];
    a.out = (float*)d_out; a.ws = (unsigned char*)d_ws;
#if MK_MULTI
    for (int l = 0; l < NL; ++l)
        for (int ph = 0; ph < NPH; ++ph) { a.l_lo = l; a.l_hi = l + 1; a.ph_lo = ph; a.ph_hi = ph + 1; hipLaunchKernelGGL(fwd_kernel, dim3(grid), dim3(NTHR), LDS_BYTES, stream, a); }
    a.l_lo = NL; a.l_hi = NL + 1; a.ph_lo = 0; a.ph_hi = 0; hipLaunchKernelGGL(fwd_kernel, dim3(grid), dim3(NTHR), LDS_BYTES, stream, a);
#else
    a.l_lo = 0; a.l_hi = NL + 1; a.ph_lo = 0; a.ph_hi = NPH;
    hipLaunchKernelGGL(fwd_kernel, dim3(grid), dim3(NTHR), LDS_BYTES, stream, a);
#endif
    const hipError_t le = hipPeekAtLastError();
    if (le != hipSuccess) fprintf(stderr, "kernel_launch: launch failed: %s\n", hipGetErrorName(le));
}
```

```cpp
#include <hip/hip_runtime.h>
#include <cstdio>
#include <cstdint>

#ifndef MK_MULTI
#define MK_MULTI 0
#endif

#define LAS __attribute__((address_space(3)))
#define GAS __attribute__((address_space(1)))
typedef unsigned short bf16_t;
typedef short bf16x8 __attribute__((ext_vector_type(8)));
typedef float f32x4 __attribute__((ext_vector_type(4)));
typedef float f32x2 __attribute__((ext_vector_type(2)));
typedef float f32x16 __attribute__((ext_vector_type(16)));
typedef unsigned u32x4 __attribute__((ext_vector_type(4)));
typedef unsigned u32x2 __attribute__((ext_vector_type(2)));

constexpr int S = 16384, D = 2048, NL = 4, INW = 3136, INWP = 3200, WINR = 3328;
constexpr int MEMT = 256;
constexpr int NSLOT = 40960;
constexpr float EPS = 1e-6f;
constexpr float LOG2E = 1.4426950408889634f;
constexpr int P_AQ = 0, P_AK = 448, P_AV = 576, P_BA = 704, P_BG = 1216, P_CQ = 1728, P_CKV = 2240, P_CKR = 2496, P_DU = 2560;

constexpr size_t MiB = 1u << 20;
constexpr size_t WS_CTL = 0, CTL_ZERO_BYTES = 1 * MiB;
constexpr size_t WS_ROPE = 1 * MiB;
constexpr size_t WS_H = WS_ROPE + 4 * MiB;
constexpr size_t WS_P = WS_H + 65 * MiB;
constexpr size_t WS_O = WS_P + 104 * MiB;
constexpr size_t WS_QRAW = WS_O + 64 * MiB;
constexpr size_t WS_KVRAW = WS_QRAW + 24 * MiB;
constexpr size_t WS_Q = WS_KVRAW + 32 * MiB;
constexpr size_t WS_KIMG = WS_Q + 24 * MiB;
constexpr size_t WS_VIMG = WS_KIMG + 24 * MiB;
constexpr size_t WS_SWAK = WS_VIMG + 16 * MiB;
constexpr size_t WS_SWAV = WS_SWAK + 4 * MiB;
constexpr size_t WS_ZC = WS_SWAV + 4 * MiB;
constexpr size_t WS_UA = WS_ZC + 16 * MiB;
constexpr size_t WS_EBUF = WS_UA + 20 * MiB;
constexpr size_t WS_YG = WS_EBUF + 4 * MiB;
constexpr size_t WS_QX = WS_YG + 16 * MiB;
constexpr size_t WS_OX = WS_QX + 16 * MiB;
constexpr size_t WS_MEMN = WS_OX + 16 * MiB;
constexpr size_t WS_KMEM = WS_MEMN + 1 * MiB;
constexpr size_t WS_VMEM = WS_KMEM + 1 * MiB;
constexpr size_t WS_XKIMG = WS_VMEM + 1 * MiB;
constexpr size_t WS_XVIMG = WS_XKIMG + 1 * MiB;
constexpr size_t WS_LOG = WS_XVIMG + 1 * MiB;
constexpr size_t WS_REC = WS_LOG + 4 * MiB;
constexpr size_t WS_TOK = WS_REC + 1 * MiB;
constexpr size_t WS_WSLOT = WS_TOK + 1 * MiB;
constexpr size_t WS_HID = WS_WSLOT + 1 * MiB;
constexpr size_t WS_YS = WS_HID + 40 * MiB;
constexpr size_t WS_WIN = WS_YS + 160 * MiB;
constexpr size_t WS_WOUT = WS_WIN + 13 * MiB;
constexpr size_t WS_XWQ = WS_WOUT + 8 * MiB;
constexpr size_t WS_XWK = WS_XWQ + 2 * MiB;
constexpr size_t WS_XWV = WS_XWK + 2 * MiB;
constexpr size_t WS_XWO = WS_XWV + 2 * MiB;
constexpr size_t WS_PW = WS_XWO + 2 * MiB;
constexpr size_t WS_WQB = WS_PW + 1 * MiB;
constexpr size_t WS_WKVB = WS_WQB + 1 * MiB;
constexpr size_t WS_GLU = WS_WKVB + 1 * MiB;
constexpr size_t WS_ROUT = WS_GLU + 1 * MiB;
constexpr size_t WS_MOE1 = WS_ROUT + 1 * MiB;
constexpr size_t WS_MOE2 = WS_MOE1 + 128 * MiB;
constexpr size_t WS_W1G = WS_MOE2 + 64 * MiB;
constexpr size_t WS_BTY = WS_W1G + 16 * MiB;
constexpr size_t WS_PARTO = WS_BTY + 80 * MiB;
constexpr size_t WS_PARTML = WS_PARTO + 32 * MiB;
constexpr size_t WS_XB = WS_PARTML + 1 * MiB;
constexpr size_t WS_QXP = WS_XB + 65 * MiB;
constexpr size_t WS_LOGP = WS_QXP + 64 * MiB;
constexpr size_t WS_SSP = WS_LOGP + 16 * MiB;
constexpr size_t WS_RMSV = WS_SSP + 2 * MiB;
constexpr size_t WS_RMS1 = WS_RMSV + 1 * MiB;
constexpr size_t WS_XF8 = WS_RMS1 + 1 * MiB;
constexpr size_t WS_END = WS_XF8 + 33 * MiB;
constexpr int CW_BAR = 4096;
constexpr int CW_SS = 32768;
constexpr int CW_CNT = 16384;

constexpr int RING_BYTES = 131072;
constexpr int LDSCTL_OFF = RING_BYTES;
constexpr int LDS_BYTES = 147456;
constexpr int NWAVES = 8, NTHR = 512;

__device__ __forceinline__ float bf2f(unsigned b) { return __uint_as_float(b << 16); }
typedef __bf16 bf16x2_t __attribute__((ext_vector_type(2)));
__device__ __forceinline__ unsigned cvt_pk_bf16(float lo, float hi) { const f32x2 v = {lo, hi}; const bf16x2_t b = __builtin_convertvector(v, bf16x2_t); return __builtin_bit_cast(unsigned, b); }
__device__ __forceinline__ float wave_sum(float v) {
#pragma unroll
    for (int o = 1; o < 64; o <<= 1) v += __shfl_xor(v, o);
    return v;
}
__device__ __forceinline__ float fast_exp2(float x) { return __builtin_amdgcn_exp2f(x); }
__device__ __forceinline__ float fast_rcp(float x) { return __builtin_amdgcn_rcpf(x); }
__device__ __forceinline__ float sigmoidf_(float x) { return fast_rcp(1.f + fast_exp2(-x * LOG2E)); }
__device__ __forceinline__ void unpack8(const u32x4 w, float (&f)[8]) {
    f[0] = bf2f(w.x & 0xffffu); f[1] = bf2f(w.x >> 16); f[2] = bf2f(w.y & 0xffffu); f[3] = bf2f(w.y >> 16);
    f[4] = bf2f(w.z & 0xffffu); f[5] = bf2f(w.z >> 16); f[6] = bf2f(w.w & 0xffffu); f[7] = bf2f(w.w >> 16);
}
__device__ __forceinline__ u32x4 pack8(const float (&f)[8]) { u32x4 w; w.x = cvt_pk_bf16(f[0], f[1]); w.y = cvt_pk_bf16(f[2], f[3]); w.z = cvt_pk_bf16(f[4], f[5]); w.w = cvt_pk_bf16(f[6], f[7]); return w; }
__device__ __forceinline__ unsigned pk4_fp8(float a, float b, float c, float d) { int w = __builtin_amdgcn_cvt_pk_fp8_f32(a, b, 0, false); w = __builtin_amdgcn_cvt_pk_fp8_f32(c, d, w, true); return (unsigned)w; }
__device__ __forceinline__ void unpack8_fp8(const u32x2 w, float (&f)[8]) { const f32x2 a = __builtin_amdgcn_cvt_pk_f32_fp8(w.x, false), b = __builtin_amdgcn_cvt_pk_f32_fp8(w.x, true), c = __builtin_amdgcn_cvt_pk_f32_fp8(w.y, false), d = __builtin_amdgcn_cvt_pk_f32_fp8(w.y, true);
    f[0] = a.x; f[1] = a.y; f[2] = b.x; f[3] = b.y; f[4] = c.x; f[5] = c.y; f[6] = d.x; f[7] = d.y; }
#define LDS_WAIT() asm volatile("s_waitcnt lgkmcnt(0)" ::: "memory")
#define VM_WAIT() asm volatile("s_waitcnt vmcnt(0)" ::: "memory")

namespace pg8 {
constexpr int BM = 256, BK = 64, HALF = 128, HTB = HALF * BK * 2, STAGE_BYTES = 8 * HTB, NXCD = 8, WGM = 8;
__host__ __device__ __forceinline__ int lds_byte(int r, int c) { const int st = (r >> 4) * 2 + (c >> 5), rr = r & 15, cc = c & 31, ob = rr * 64 + cc * 2; return st * 1024 + (ob ^ (((ob >> 9) & 1) << 5)); }
__host__ __device__ __forceinline__ void stage_rc(int b, int& R, int& C) { const int st = b / 1024, sb = b % 1024, swz = sb ^ (((sb >> 9) & 1) << 5); R = (st >> 1) * 16 + swz / 64; C = (st & 1) * 32 + (swz % 64) / 2; }
__host__ __device__ __forceinline__ int perm32(int rho) { const int n = rho >> 4, i = rho & 15; return 8 * (i >> 2) + 4 * n + (i & 3); }

struct Unit { int pm, pn, z; const char* a; const char* b; const int* rows; };

struct GSched {
    const char* A; const char* B; size_t aTile, bTile, aZ, bZ; int nM, nN, nZ, G, c;
    __device__ __forceinline__ bool next(int i, Unit& u) const {
        const int nwg = nM * nN; const long L = (long)i * G + c; if (L >= (long)nwg * nZ) return false;
        const int z = (int)(L / nwg); int wgid = (int)(L - (long)z * nwg);
        { const int q = nwg / NXCD, r = nwg % NXCD, xcd = wgid % NXCD, off = wgid / NXCD; wgid = (xcd < r ? xcd * (q + 1) : r * (q + 1) + (xcd - r) * q) + off; }
        const int nig = WGM * nN, gid = wgid / nig, fm = gid * WGM, gsz = (nM - fm) < WGM ? (nM - fm) : WGM;
        u.pm = fm + ((wgid % nig) % gsz); u.pn = (wgid % nig) / gsz; u.z = z;
        u.a = A + (size_t)z * aZ + (size_t)u.pm * aTile; u.b = B + (size_t)z * bZ + (size_t)u.pn * bTile; u.rows = nullptr; return true;
    }
};

template <class Epi, class Sched, bool GATHER = false, bool F8 = false>
__device__ __forceinline__ void gemm_phase(const int tid_in, LAS unsigned char* lds, const int K, const int lda, const int ldb, const char* Abase, const Sched& S, const Epi& E) {
    int tid = tid_in; asm volatile("" : "+v"(tid));
    const int wid = __builtin_amdgcn_readfirstlane(tid >> 6), lane = tid & 63, wr = wid >> 2, wc = wid & 3, fr = lane & 15, fq = lane >> 4;
    const int nt = K / BK;
    unsigned voffA[2], voffB[2]; int rA[2], cA2[2];
#pragma unroll
    for (int i = 0; i < 2; ++i) { int R, C; stage_rc(tid * 16 + i * 8192, R, C); const int Rb = Epi::PERM ? ((R & ~31) + perm32(R & 31)) : R;
        voffA[i] = (unsigned)(R * lda + C) * 2u; voffB[i] = (unsigned)(Rb * ldb + C) * 2u; rA[i] = R; cA2[i] = C * 2; }
    const size_t kstep = (size_t)(BK * 2);
    const size_t hstepA = (size_t)HALF * lda * 2, hstepB = (size_t)HALF * ldb * 2;
    const unsigned ldsw = (unsigned)wid * 1024u;
    const int aoff = lds_byte(wr * 64 + fr, fq * 8), boff = lds_byte(wc * 32 + fr, fq * 8);
#define PG8_SA(b, h) (((b) * 2 + (h)) * HTB)
#define PG8_SB(b, h) ((4 + (b) * 2 + (h)) * HTB)
#define PG8_STAGE(bufoff, gbase, voff) do { _Pragma("unroll") for (int _i = 0; _i < 2; ++_i) \
        __builtin_amdgcn_global_load_lds((const unsigned*)((const char*)(gbase) + (voff)[_i]), (LAS unsigned*)(lds + (bufoff) + ldsw + _i * 8192), 16, 0, 0); } while (0)
#define PG8_LDA(dst, b, h) do { _Pragma("unroll") for (int m = 0; m < 4; ++m) _Pragma("unroll") for (int k = 0; k < 2; ++k) dst[m][k] = *(const LAS bf16x8*)(lds + PG8_SA(b, h) + aoff + m * 2048 + k * 1024); } while (0)
#define PG8_LDB(dst, b, h) do { _Pragma("unroll") for (int n = 0; n < 2; ++n) _Pragma("unroll") for (int k = 0; k < 2; ++k) dst[n][k] = *(const LAS bf16x8*)(lds + PG8_SB(b, h) + boff + n * 2048 + k * 1024); } while (0)
typedef long pg8_i64x2 __attribute__((ext_vector_type(2)));
#define PG8_MMA(ai, bj, At, Bt) do { __builtin_amdgcn_s_setprio(1); _Pragma("unroll") for (int m = 0; m < 4; ++m) _Pragma("unroll") for (int n = 0; n < 2; ++n) _Pragma("unroll") for (int k = 0; k < 2; ++k) { \
        if constexpr (F8) {   \
            const pg8_i64x2 a_ = __builtin_bit_cast(pg8_i64x2, At[m][k]), b_ = __builtin_bit_cast(pg8_i64x2, Bt[n][k]); \
            acc[ai][bj][m][n] = __builtin_amdgcn_mfma_f32_16x16x32_fp8_fp8(b_.x, a_.x, acc[ai][bj][m][n], 0, 0, 0); \
            acc[ai][bj][m][n] = __builtin_amdgcn_mfma_f32_16x16x32_fp8_fp8(b_.y, a_.y, acc[ai][bj][m][n], 0, 0, 0); \
        } else acc[ai][bj][m][n] = __builtin_amdgcn_mfma_f32_16x16x32_bf16(Bt[n][k], At[m][k], acc[ai][bj][m][n], 0, 0, 0); } \
        __builtin_amdgcn_s_setprio(0); } while (0)
#define PG8_WAIT_V(n) asm volatile("s_waitcnt vmcnt(" #n ")" ::: "memory")
#define PG8_WAIT_L(n) asm volatile("s_waitcnt lgkmcnt(" #n ")" ::: "memory")
#define PG8_BAR __builtin_amdgcn_s_barrier()
#define PG8_SCHED __builtin_amdgcn_sched_barrier(0)
    Unit cur, nxt; int ui = 0;
    if (!S.next(0, cur)) return;
    f32x4 acc[2][2][4][2];
#pragma unroll
    for (int a = 0; a < 2; ++a)
#pragma unroll
        for (int b = 0; b < 2; ++b)
#pragma unroll
            for (int m = 0; m < 4; ++m)
#pragma unroll
                for (int n = 0; n < 2; ++n) acc[a][b][m][n] = (f32x4){0.f, 0.f, 0.f, 0.f};
    bf16x8 At[4][2], B0[2][2], B1[2][2];
    unsigned gc0[2], gc1[2], gn0[2], gn1[2];
    const char* cA = GATHER ? Abase : cur.a; const char* cB = cur.b;
    if constexpr (GATHER) {
#pragma unroll
        for (int i = 0; i < 2; ++i) { gc0[i] = (unsigned)cur.rows[rA[i]] * (unsigned)(lda * 2) + (unsigned)cA2[i]; gc1[i] = (unsigned)cur.rows[HALF + rA[i]] * (unsigned)(lda * 2) + (unsigned)cA2[i]; gn0[i] = gc0[i]; gn1[i] = gc1[i]; }
    }
#define PG8_STAGE_A(bufoff, h, ptr, usenext) do { if constexpr (GATHER) { if (usenext) { if ((h) == 0) PG8_STAGE(bufoff, ptr, gn0); else PG8_STAGE(bufoff, ptr, gn1); } else { if ((h) == 0) PG8_STAGE(bufoff, ptr, gc0); else PG8_STAGE(bufoff, ptr, gc1); } } \
        else { PG8_STAGE(bufoff, (ptr) + ((h) ? hstepA : 0), voffA); } } while (0)
    PG8_STAGE(PG8_SB(0, 0), cB, voffB); PG8_STAGE(PG8_SB(0, 1), cB + hstepB, voffB); PG8_STAGE_A(PG8_SA(0, 0), 0, cA, false); PG8_STAGE_A(PG8_SA(0, 1), 1, cA, false);
    if (wr == 1) PG8_BAR;
    PG8_WAIT_V(2); PG8_BAR;
    PG8_STAGE(PG8_SB(1, 0), cB + kstep, voffB); PG8_STAGE_A(PG8_SA(1, 0), 0, cA + kstep, false); PG8_STAGE(PG8_SB(1, 1), cB + hstepB + kstep, voffB);
    PG8_WAIT_V(6); PG8_BAR;
    for (;;) {
        const bool has_next = S.next(ui + 1, nxt);
        const char* nA = GATHER ? Abase : (has_next ? nxt.a : cA); const char* nB = has_next ? nxt.b : cB;
        if constexpr (GATHER) {
            if (has_next) {
#pragma unroll
                for (int i = 0; i < 2; ++i) { gn0[i] = (unsigned)nxt.rows[rA[i]] * (unsigned)(lda * 2) + (unsigned)cA2[i]; gn1[i] = (unsigned)nxt.rows[HALF + rA[i]] * (unsigned)(lda * 2) + (unsigned)cA2[i]; }
            } else {
#pragma unroll
                for (int i = 0; i < 2; ++i) { gn0[i] = gc0[i]; gn1[i] = gc1[i]; }
            }
        }
#pragma unroll 1
        for (int t = 0; t < nt; t += 2) {
            const bool last = (t == nt - 2);
            const char* a1 = cA + (size_t)(t + 1) * kstep;
            const char* a2 = last ? nA : cA + (size_t)(t + 2) * kstep; const char* b2 = last ? nB : cB + (size_t)(t + 2) * kstep;
            const char* a3 = a2 + kstep; const char* b3 = b2 + kstep;
            PG8_LDB(B0, 0, 0); PG8_LDB(B1, 0, 1); PG8_SCHED; PG8_LDA(At, 0, 0); PG8_STAGE_A(PG8_SA(1, 1), 1, a1, false);
            PG8_WAIT_V(8); PG8_WAIT_L(0); PG8_BAR; PG8_MMA(0, 0, At, B0); PG8_MMA(0, 1, At, B1); PG8_BAR; PG8_SCHED;
            PG8_LDA(At, 0, 1); PG8_STAGE(PG8_SB(0, 0), b2, voffB); PG8_STAGE(PG8_SB(0, 1), b2 + hstepB, voffB); PG8_STAGE_A(PG8_SA(0, 0), 0, a2, last);
            PG8_WAIT_V(8); PG8_WAIT_L(0); PG8_BAR; PG8_MMA(1, 0, At, B0); PG8_MMA(1, 1, At, B1); PG8_BAR; PG8_SCHED;
            PG8_LDB(B0, 1, 0); PG8_LDB(B1, 1, 1); PG8_SCHED; PG8_LDA(At, 1, 0); PG8_STAGE_A(PG8_SA(0, 1), 1, a2, last);
            PG8_WAIT_V(8); PG8_WAIT_L(0); PG8_BAR; PG8_MMA(0, 0, At, B0); PG8_MMA(0, 1, At, B1); PG8_BAR; PG8_SCHED;
            PG8_LDA(At, 1, 1); PG8_STAGE(PG8_SB(1, 0), b3, voffB); PG8_STAGE(PG8_SB(1, 1), b3 + hstepB, voffB); PG8_STAGE_A(PG8_SA(1, 0), 0, a3, last);
            PG8_WAIT_V(8); PG8_WAIT_L(0); PG8_BAR; PG8_MMA(1, 0, At, B0); PG8_MMA(1, 1, At, B1); PG8_BAR; PG8_SCHED;
        }
        if (wr == 0) PG8_BAR;
        E(acc, cur, wr, wc, fr, fq);
        if (!has_next) break;
#pragma unroll
        for (int a = 0; a < 2; ++a)
#pragma unroll
            for (int b = 0; b < 2; ++b)
#pragma unroll
                for (int m = 0; m < 4; ++m)
#pragma unroll
                    for (int n = 0; n < 2; ++n) acc[a][b][m][n] = (f32x4){0.f, 0.f, 0.f, 0.f};
        cur = nxt; cA = nA; cB = nB; ++ui;
        if constexpr (GATHER) {
#pragma unroll
            for (int i = 0; i < 2; ++i) { gc0[i] = gn0[i]; gc1[i] = gn1[i]; }
        }
        if (wr == 1) PG8_BAR;
    }
    PG8_WAIT_V(0);
    PG8_BAR;
#undef PG8_STAGE_A
#undef PG8_SA
#undef PG8_SB
#undef PG8_STAGE
#undef PG8_LDA
#undef PG8_LDB
#undef PG8_MMA
#undef PG8_WAIT_V
#undef PG8_WAIT_L
#undef PG8_BAR
#undef PG8_SCHED
}

struct EpiBf16 {
    static constexpr bool PERM = true;
    bf16_t* O; int ldc; int col_off; const float* bias; const float* rowscale;
    __device__ __forceinline__ void operator()(const f32x4 (&acc)[2][2][4][2], const Unit& u, int wr, int wc, int fr, int fq) const {
        const int row0 = u.pm * BM + wr * 64 + fr, c0 = u.pn * BM + wc * 32 + 8 * fq;
        f32x4 bv[2][2];
#pragma unroll
        for (int bj = 0; bj < 2; ++bj)
#pragma unroll
            for (int n = 0; n < 2; ++n) bv[bj][n] = bias ? *(const f32x4*)(bias + c0 + bj * HALF + 4 * n) : (f32x4){0.f, 0.f, 0.f, 0.f};
#pragma unroll
        for (int ai = 0; ai < 2; ++ai)
#pragma unroll
            for (int m = 0; m < 4; ++m) { const int row = row0 + ai * HALF + m * 16; bf16_t* rowp = O + (size_t)row * ldc + col_off + c0; const float rs = rowscale ? rowscale[row] : 1.f;
#pragma unroll
                for (int bj = 0; bj < 2; ++bj) { const f32x4 v0 = acc[ai][bj][m][0] * rs + bv[bj][0], v1 = acc[ai][bj][m][1] * rs + bv[bj][1];
                    u32x4 w; w.x = cvt_pk_bf16(v0[0], v0[1]); w.y = cvt_pk_bf16(v0[2], v0[3]); w.z = cvt_pk_bf16(v1[0], v1[1]); w.w = cvt_pk_bf16(v1[2], v1[3]);
                    *(u32x4*)(rowp + bj * HALF) = w; } }
    }
};
struct EpiResid {
    static constexpr bool PERM = true;
    bf16_t* XBp; int ldc; float* SS; bool dry; unsigned char* XF8p;
    __device__ __forceinline__ void operator()(const f32x4 (&acc)[2][2][4][2], const Unit& u, int wr, int wc, int fr, int fq) const {
        const int row0 = u.pm * BM + wr * 64 + fr, c0 = u.pn * BM + wc * 32 + 8 * fq;
#pragma unroll
        for (int ai = 0; ai < 2; ++ai)
#pragma unroll
            for (int m = 0; m < 4; ++m) { const int row = row0 + ai * HALF + m * 16; bf16_t* rowb = XBp + (size_t)row * ldc + c0; float ss = 0.f;
                u32x4 old[2];
#pragma unroll
                for (int bj = 0; bj < 2; ++bj) old[bj] = *(const u32x4*)(rowb + bj * HALF);
#pragma unroll
                for (int bj = 0; bj < 2; ++bj) { float x[8]; unpack8(old[bj], x);
#pragma unroll
                    for (int j = 0; j < 4; ++j) { x[j] += acc[ai][bj][m][0][j]; x[4 + j] += acc[ai][bj][m][1][j]; }
#pragma unroll
                    for (int j = 0; j < 8; ++j) ss += x[j] * x[j];
                    if (!dry) *(u32x4*)(rowb + bj * HALF) = pack8(x);
                    if (XF8p) *(u32x2*)(XF8p + (size_t)row * ldc + c0 + bj * HALF) = (u32x2){pk4_fp8(x[0], x[1], x[2], x[3]), pk4_fp8(x[4], x[5], x[6], x[7])}; }
                if (SS) { ss += __shfl_xor(ss, 16); ss += __shfl_xor(ss, 32); if (fq == 0) SS[(size_t)row * 32 + u.pn * 4 + wc] = ss; } }
    }
};
struct EpiF32Z {
    static constexpr bool PERM = false;
    float* C; int ldc; size_t zstride;
    __device__ __forceinline__ void operator()(const f32x4 (&acc)[2][2][4][2], const Unit& u, int wr, int wc, int fr, int fq) const {
        const int row0 = u.pm * BM + wr * 64 + fr, col0 = u.pn * BM + wc * 32 + 4 * fq;
#pragma unroll
        for (int ai = 0; ai < 2; ++ai)
#pragma unroll
            for (int m = 0; m < 4; ++m) { float* rowp = C + (size_t)u.z * zstride + (size_t)(row0 + ai * HALF + m * 16) * ldc + col0;
#pragma unroll
                for (int bj = 0; bj < 2; ++bj)
#pragma unroll
                    for (int n = 0; n < 2; ++n) *(f32x4*)(rowp + bj * HALF + n * 16) = acc[ai][bj][m][n]; }
    }
};
template <int NVALID> struct EpiF32Part {
    static constexpr bool PERM = false;
    float* C; int ldc; size_t zstride;
    __device__ __forceinline__ void operator()(const f32x4 (&acc)[2][2][4][2], const Unit& u, int wr, int wc, int fr, int fq) const {
        if (u.pn != 0) return;
        if (NVALID == 64 && wc >= 2) return;
        const int row0 = u.pm * BM + wr * 64 + fr, col0 = wc * 32 + 4 * fq;
#pragma unroll
        for (int ai = 0; ai < 2; ++ai)
#pragma unroll
            for (int m = 0; m < 4; ++m) { float* rowp = C + (size_t)u.z * zstride + (size_t)(row0 + ai * HALF + m * 16) * ldc + col0;
#pragma unroll
                for (int n = 0; n < 2; ++n) *(f32x4*)(rowp + n * 16) = acc[ai][0][m][n]; }
    }
};
struct EpiSsmY {
    static constexpr bool PERM = true;
    bf16_t* YG;
    __device__ __forceinline__ void operator()(const f32x4 (&acc)[2][2][4][2], const Unit& u, int wr, int wc, int fr, int fq) const {
        const int row0 = wr * 64 + fr, c0 = u.pn * BM + wc * 32 + 8 * fq;
#pragma unroll
        for (int ai = 0; ai < 2; ++ai)
#pragma unroll
            for (int m = 0; m < 4; ++m) { const int chunk = row0 + ai * HALF + m * 16;
#pragma unroll
                for (int bj = 0; bj < 2; ++bj) { const int col = c0 + bj * HALF, t = col >> 4, o0 = col & 15;
                    float v[8];
#pragma unroll
                    for (int j = 0; j < 4; ++j) { v[j] = acc[ai][bj][m][0][j]; v[4 + j] = acc[ai][bj][m][1][j]; }
#pragma unroll
                    for (int j = 0; j < 8; ++j) { const float x = v[j], y = 1.5957691216f * (x + 0.044715f * x * x * x); v[j] = x * fast_rcp(1.f + fast_exp2(-y * LOG2E)); }
                    *(u32x4*)(YG + (size_t)(chunk * 64 + t) * 512 + u.z * 16 + o0) = pack8(v); } }
    }
};
struct EpiGlu {
    static constexpr bool PERM = true;
    const bf16_t* YG; const float* bias; bf16_t* O;
    __device__ __forceinline__ void operator()(const f32x4 (&acc)[2][2][4][2], const Unit& u, int wr, int wc, int fr, int fq) const {
        const int row0 = u.pm * BM + wr * 64 + fr, c0 = u.pn * BM + wc * 32 + 8 * fq;
#pragma unroll
        for (int ai = 0; ai < 2; ++ai)
#pragma unroll
            for (int m = 0; m < 4; ++m) { const int row = row0 + ai * HALF + m * 16;
#pragma unroll
                for (int bj = 0; bj < 2; ++bj) { const int col = c0 + bj * HALF;
                    const u32x4 yw = *(const u32x4*)(YG + (size_t)row * 512 + col); float y[8]; unpack8(yw, y);
                    const f32x4 b0 = *(const f32x4*)(bias + col), b1 = *(const f32x4*)(bias + col + 4);
                    float v[8];
#pragma unroll
                    for (int j = 0; j < 4; ++j) { v[j] = y[j] * sigmoidf_(acc[ai][bj][m][0][j] + b0[j]); v[4 + j] = y[4 + j] * sigmoidf_(acc[ai][bj][m][1][j] + b1[j]); }
                    *(u32x4*)(O + (size_t)row * D + 1536 + col) = pack8(v); } }
    }
};
struct EpiMoe1 {
    static constexpr bool PERM = true;
    unsigned char* HID8; const int* TOKp; const float* SS;
    __device__ __forceinline__ void operator()(const f32x4 (&acc)[2][2][4][2], const Unit& u, int wr, int wc, int fr, int fq) const {
        const int row0 = u.z * BM + wr * 64 + fr, c0 = u.pn * HALF + wc * 32 + 8 * fq;
#pragma unroll
        for (int ai = 0; ai < 2; ++ai)
#pragma unroll
            for (int m = 0; m < 4; ++m) { const int row = row0 + ai * HALF + m * 16; float v[8];
                const float rs = SS[TOKp[row]] * (1.0f / 32.0f);
#pragma unroll
                for (int j = 0; j < 4; ++j) { const float g0 = acc[ai][0][m][0][j] * rs, g1 = acc[ai][0][m][1][j] * rs; v[j] = g0 * sigmoidf_(g0) * (acc[ai][1][m][0][j] * rs); v[4 + j] = g1 * sigmoidf_(g1) * (acc[ai][1][m][1][j] * rs); }
                *(u32x2*)(HID8 + (size_t)row * 512 + c0) = (u32x2){pk4_fp8(v[0], v[1], v[2], v[3]), pk4_fp8(v[4], v[5], v[6], v[7])}; }
    }
};
struct EpiMoe2 {
    static constexpr bool PERM = true;
    unsigned char* YS8; const float* W;
    __device__ __forceinline__ void operator()(const f32x4 (&acc)[2][2][4][2], const Unit& u, int wr, int wc, int fr, int fq) const {
        const int row0 = u.z * BM + wr * 64 + fr, c0 = u.pn * BM + wc * 32 + 8 * fq;
#pragma unroll
        for (int ai = 0; ai < 2; ++ai)
#pragma unroll
            for (int m = 0; m < 4; ++m) { const int row = row0 + ai * HALF + m * 16; const float w = W[row] * (16.0f / 32.0f);
#pragma unroll
                for (int bj = 0; bj < 2; ++bj) { const f32x4 v0 = acc[ai][bj][m][0] * w, v1 = acc[ai][bj][m][1] * w;
                    *(u32x2*)(YS8 + (size_t)row * D + c0 + bj * HALF) = (u32x2){pk4_fp8(v0[0], v0[1], v0[2], v0[3]), pk4_fp8(v1[0], v1[1], v1[2], v1[3])}; } }
    }
};
struct EpiBf16Part64 {
    static constexpr bool PERM = true;
    bf16_t* O; size_t zstride; const float* rowscale;
    __device__ __forceinline__ void operator()(const f32x4 (&acc)[2][2][4][2], const Unit& u, int wr, int wc, int fr, int fq) const {
        if (wc >= 2) return;
        const int row0 = u.pm * BM + wr * 64 + fr, c0 = wc * 32 + 8 * fq;
#pragma unroll
        for (int ai = 0; ai < 2; ++ai)
#pragma unroll
            for (int m = 0; m < 4; ++m) { const int row = row0 + ai * HALF + m * 16; const float rs = rowscale[row]; const f32x4 v0 = acc[ai][0][m][0] * rs, v1 = acc[ai][0][m][1] * rs;
                u32x4 w; w.x = cvt_pk_bf16(v0[0], v0[1]); w.y = cvt_pk_bf16(v0[2], v0[3]); w.z = cvt_pk_bf16(v1[0], v1[1]); w.w = cvt_pk_bf16(v1[2], v1[3]);
                *(u32x4*)(O + (size_t)u.z * zstride + (size_t)row * 64 + c0) = w; }
    }
};
struct EpiBf16Z { static constexpr bool PERM = true; bf16_t* O0; int ldc; size_t zstride;
    __device__ __forceinline__ void operator()(const f32x4 (&acc)[2][2][4][2], const Unit& u, int wr, int wc, int fr, int fq) const { EpiBf16 e{O0 + (size_t)u.z * zstride, ldc, 0, nullptr, nullptr}; e(acc, u, wr, wc, fr, fq); } };
struct EpiMem { static constexpr bool PERM = true; bf16_t* K0; bf16_t* V0;
    __device__ __forceinline__ void operator()(const f32x4 (&acc)[2][2][4][2], const Unit& u, int wr, int wc, int fr, int fq) const { EpiBf16 e{((u.z >> 2) ? V0 : K0) + (size_t)(u.z & 3) * 256 * 512, 512, 0, nullptr, nullptr}; e(acc, u, wr, wc, fr, fq); } };
struct MemSched { const char* A; const char* B; int G, c;
    __device__ __forceinline__ bool next(int i, Unit& u) const {
        const long L = (long)i * G + c; if (L >= 16) return false;
        const int pn = (int)L & 1, ks = ((int)L >> 1) & 3, kv = (int)L >> 3;
        u.pm = 0; u.pn = pn; u.z = kv * 4 + ks; u.a = A + (size_t)ks * 1024; u.b = B + (size_t)kv * 512 * D * 2 + (size_t)pn * 256 * D * 2 + (size_t)ks * 1024; u.rows = nullptr; return true; } };
struct MoeSched { const LAS int* pst; const char* B; const int* tok; size_t bE, bTile; int nN, G, c, mode;
    __device__ __forceinline__ bool next(int i, Unit& u) const {
        const int nb = __builtin_amdgcn_readfirstlane(pst[32]) >> 8; const int n1 = nb * nN, n1a = (n1 / G) * G;
        const int cv = (G % NXCD == 0) ? (c % NXCD) * (G / NXCD) + c / NXCD : c;
        const long L = (long)(mode == 2 ? n1a : 0) + (long)i * G + cv; if (L >= (long)(mode == 1 ? n1a : n1)) return false;
        const int b = (int)(L / nN), pn = (int)(L % nN); const int e = __builtin_amdgcn_readfirstlane(pst[240 + b]);
        u.pm = 0; u.pn = pn; u.z = b; u.a = nullptr; u.rows = tok + b * 256; u.b = B + (size_t)e * bE + (size_t)pn * bTile; return true; } };
struct MoeSched2 { const LAS int* pst; const char* A; const char* B; size_t bE, bTile; int nN, G, c, mode;
    __device__ __forceinline__ bool next(int i, Unit& u) const {
        const int nb = __builtin_amdgcn_readfirstlane(pst[32]) >> 8; const int n1 = nb * 4, r1 = n1 % G, bdone = ((n1 / G) * G) / 4, n2a = bdone * nN, n2 = nb * nN;
        const int cv = (G % NXCD == 0) ? (c % NXCD) * (G / NXCD) + c / NXCD : c;
        long L;
        if (mode == 1) { const int nfree = r1 ? G - r1 : 0; const long E = 3L * nfree;
            if (r1 && cv >= r1) L = (i < 3) ? (long)i * nfree + (cv - r1) : E + (long)(i - 3) * G + cv; else L = E + (long)i * G + cv;
            if (L >= n2a) return false; }
        else { L = (long)n2a + (long)i * G + cv; if (L >= n2) return false; }
        const int b = (int)(L / nN), pn = (int)(L % nN); const int e = __builtin_amdgcn_readfirstlane(pst[240 + b]);
        u.pm = 0; u.pn = pn; u.z = b; u.a = A + (size_t)b * 256 * 512; u.rows = nullptr; u.b = B + (size_t)e * bE + (size_t)pn * bTile; return true; } };
}

#define XB_TMO      128
#define XB_XCNT(j)  (256  + 64 * (j))
#define XB_XSUB(j)  (1280 + 64 * (j))
#define XB_XGEN(j)  (2304 + 64 * (j))
#define XB_TOP      3328
#define XB_TOPGEN   3392
#define XCD_BAR_WORDS 3456
#define XB_SPIN_CAP (1u << 22)
__device__ __forceinline__ unsigned xb_ld(unsigned* p)              { return __hip_atomic_load(p, __ATOMIC_RELAXED, __HIP_MEMORY_SCOPE_AGENT); }
__device__ __forceinline__ unsigned xb_add(unsigned* p, unsigned v) { return __hip_atomic_fetch_add(p, v, __ATOMIC_RELAXED, __HIP_MEMORY_SCOPE_AGENT); }
__device__ __forceinline__ unsigned xb_xcc_id() { return (unsigned)__builtin_amdgcn_s_getreg((3 << 11) | 20) & 0xFu; }
#define XB_SPIN(cond, bar) do { unsigned _sp = 0; while (cond) { __builtin_amdgcn_s_sleep(1); \
    if ((++_sp & 255u) == 0u) { if (xb_ld(&(bar)[XB_TMO])) break; if (_sp > XB_SPIN_CAP) { atomicAdd(&(bar)[XB_TMO], 1u); break; } } } } while (0)
struct XcdBarrier { unsigned* bar; unsigned x; volatile LAS unsigned* st; };
__device__ __forceinline__ XcdBarrier xcd_barrier_post(unsigned* bar, volatile LAS unsigned* st) {
    XcdBarrier b; b.bar = bar; b.x = xb_xcc_id(); b.st = st;
    if (threadIdx.x == 0) (void)xb_add(&bar[XB_XCNT(b.x)], 1u);
    return b;
}
__device__ __forceinline__ void xcd_barrier_complete(unsigned* bar, unsigned x, unsigned& nloc, unsigned& nx) {
    const unsigned G = gridDim.x * gridDim.y * gridDim.z;
    unsigned sum, cnt, mine, sp = 0u;
    for (;;) {
        sum = 0u; cnt = 0u; mine = 0u;
#pragma unroll
        for (unsigned j = 0; j < 16; ++j) { const unsigned c = xb_ld(&bar[XB_XCNT(j)]); sum += c; cnt += (c > 0u) ? 1u : 0u; mine = (j == x) ? c : mine; }
        if (sum == G) break;
        __builtin_amdgcn_s_sleep(1);
        if ((++sp & 255u) == 0u) { if (xb_ld(&bar[XB_TMO])) break; if (sp > XB_SPIN_CAP) { atomicAdd(&bar[XB_TMO], 1u); break; } }
    }
    nloc = mine > 0u ? mine : 1u; nx = cnt > 0u ? cnt : 1u;
}
__device__ __forceinline__ void xcd_barrier(const XcdBarrier& b, const int tid_) {
    asm volatile("s_waitcnt vmcnt(0)" ::: "memory");
    __syncthreads();
    if (tid_ == 0) {
        unsigned* bar = b.bar;
        __builtin_amdgcn_s_waitcnt(0);
        unsigned nloc = b.st[0], nx = b.st[1];
        if (nloc == 0u) { xcd_barrier_complete(bar, b.x, nloc, nx); b.st[0] = nloc; b.st[1] = nx; }
        const unsigned old = xb_add(&bar[XB_XSUB(b.x)], 1u);
        const unsigned gen = old / nloc;
        if (old + 1u == (gen + 1u) * nloc) {
            __builtin_amdgcn_fence(__ATOMIC_RELEASE, "agent");
            asm volatile("s_waitcnt vmcnt(0)" ::: "memory");
            const unsigned og = xb_add(&bar[XB_TOP], 1u);
            const unsigned tg = og / nx;
            if (og + 1u == (tg + 1u) * nx) xb_add(&bar[XB_TOPGEN], 1u);
            else XB_SPIN(xb_ld(&bar[XB_TOPGEN]) == tg, bar);
            __builtin_amdgcn_fence(__ATOMIC_ACQUIRE, "agent");
            xb_add(&bar[XB_XGEN(b.x)], 1u);
            asm volatile("s_waitcnt vmcnt(0)" ::: "memory");
        } else {
            XB_SPIN(xb_ld(&bar[XB_XGEN(b.x)]) == gen, bar);
            __builtin_amdgcn_fence(__ATOMIC_ACQUIRE, "agent");
            asm volatile("s_waitcnt vmcnt(0)" ::: "memory");
        }
    }
    __syncthreads();
}

template <int RB> __device__ __forceinline__ int kswz(int row, int c) { return (RB == 256) ? (c ^ (row & 15)) : (c ^ ((row >> 1) & 7)); }
__device__ __forceinline__ int vswz(int d, int c) { return c ^ ((d >> 1) & 7); }
template <int BYTES> __device__ __forceinline__ void dma_tile(const unsigned char* src, LAS unsigned char* dst, int tid, int wid) {
#pragma unroll
    for (int i = 0; i < BYTES / 8192; ++i)
        __builtin_amdgcn_global_load_lds((const unsigned*)(src + (unsigned)(i * 8192 + tid * 16)), (LAS unsigned*)(dst + i * 8192 + wid * 1024), 16, 0, 0);
}
template <int DQK, int DV, int MODE>
__device__ __forceinline__ void attn_tile_compute(const LAS unsigned char* kb, const LAS unsigned char* vb, const int k0, const bool domask, const bf16x8 (&qf)[DQK / 16],
                                                  const int qpos, const LAS float* biasrow, const int lr, const int hi, f32x16 (&o)[DV / 32], float& m_run, float& l_run) {
    constexpr int RB = DQK * 2, NKS = DQK / 16, NDB = DV / 32;
            f32x16 p0, p1;
#pragma unroll
            for (int r = 0; r < 16; ++r) { p0[r] = 0.f; p1[r] = 0.f; }
#pragma unroll
            for (int ks = 0; ks < NKS; ++ks) {
                const int c = 2 * ks + hi;
                const bf16x8 kf0 = *(const LAS bf16x8*)(kb + lr * RB + kswz<RB>(lr, c) * 16);
                const bf16x8 kf1 = *(const LAS bf16x8*)(kb + (lr + 32) * RB + kswz<RB>(lr + 32, c) * 16);
                p0 = __builtin_amdgcn_mfma_f32_32x32x16_bf16(kf0, qf[ks], p0, 0, 0, 0);
                p1 = __builtin_amdgcn_mfma_f32_32x32x16_bf16(kf1, qf[ks], p1, 0, 0, 0);
            }
            if (domask) {
                const float NEG = -__builtin_inff();
#pragma unroll
                for (int r = 0; r < 16; ++r) {
                    const int key0 = k0 + (r & 3) + 8 * (r >> 2) + 4 * hi, key1 = key0 + 32;
                    if (MODE == 0) { if (key0 > qpos) p0[r] = NEG; if (key1 > qpos) p1[r] = NEG; }
                    if (MODE == 1) { const int d0 = qpos - key0, d1 = qpos - key1;
                        p0[r] = ((unsigned)d0 < 128u) ? p0[r] + biasrow[d0 & 127] : NEG;
                        p1[r] = ((unsigned)d1 < 128u) ? p1[r] + biasrow[d1 & 127] : NEG; }
                }
            }
            float mx = p0[0];
#pragma unroll
            for (int r = 1; r < 16; ++r) mx = fmaxf(mx, p0[r]);
#pragma unroll
            for (int r = 0; r < 16; ++r) mx = fmaxf(mx, p1[r]);
            { auto rr = __builtin_amdgcn_permlane32_swap(__float_as_uint(mx), __float_as_uint(mx), false, false); mx = fmaxf(__uint_as_float(rr[0]), __uint_as_float(rr[1])); }
            const float mn = fmaxf(m_run, mx), alpha = fast_exp2(m_run - mn);
            m_run = mn;
            float ps = 0.f;
#pragma unroll
            for (int r = 0; r < 16; ++r) { p0[r] = fast_exp2(p0[r] - mn); p1[r] = fast_exp2(p1[r] - mn); ps += p0[r] + p1[r]; }
            l_run = l_run * alpha + ps;
            if (!__all(alpha == 1.f)) {
#pragma unroll
                for (int db = 0; db < NDB; ++db)
#pragma unroll
                    for (int r = 0; r < 16; ++r) o[db][r] *= alpha;
            }
            bf16x8 pf[4];
#pragma unroll
            for (int s = 0; s < 4; ++s) {
                const int r0 = 8 * (s & 1);
                unsigned a01, a23, b45, b67;
                if (s < 2) { a01 = cvt_pk_bf16(p0[r0 + 0], p0[r0 + 1]); a23 = cvt_pk_bf16(p0[r0 + 2], p0[r0 + 3]); b45 = cvt_pk_bf16(p0[r0 + 4], p0[r0 + 5]); b67 = cvt_pk_bf16(p0[r0 + 6], p0[r0 + 7]); }
                else       { a01 = cvt_pk_bf16(p1[r0 + 0], p1[r0 + 1]); a23 = cvt_pk_bf16(p1[r0 + 2], p1[r0 + 3]); b45 = cvt_pk_bf16(p1[r0 + 4], p1[r0 + 5]); b67 = cvt_pk_bf16(p1[r0 + 6], p1[r0 + 7]); }
                auto s0 = __builtin_amdgcn_permlane32_swap(a01, b45, false, false);
                auto s1 = __builtin_amdgcn_permlane32_swap(a23, b67, false, false);
                u32x4 w; w.x = s0[0]; w.y = s1[0]; w.z = s0[1]; w.w = s1[1];
                pf[s] = __builtin_bit_cast(bf16x8, w);
            }
#pragma unroll
            for (int db = 0; db < NDB; ++db) {
                const int d = 32 * db + lr;
#pragma unroll
                for (int s = 0; s < 4; ++s) {
                    const bf16x8 vf = *(const LAS bf16x8*)(vb + d * 128 + vswz(d, 2 * s + hi) * 16);
                    o[db] = __builtin_amdgcn_mfma_f32_32x32x16_bf16(vf, pf[s], o[db], 0, 0, 0);
                }
            }
        }
template <int DQK, int DV, int MODE>
__device__ __forceinline__ void attn_tiles(const int tid_in, LAS unsigned char* lds, const unsigned char* gK, const unsigned char* gV, int t_lo, int t_hi,
                                           const bf16x8 (&qf)[DQK / 16], int qpos, int wave_q0, const LAS float* biasrow,
                                           f32x16 (&o)[DV / 32], float& m_run, float& l_run) {
    constexpr int KT = 64 * DQK * 2, VT = DV * 128, BUF = KT + VT;
    int tid = tid_in; asm volatile("" : "+v"(tid));
    const int wid = __builtin_amdgcn_readfirstlane(tid >> 6), lane = tid & 63, lr = lane & 31, hi = lane >> 5;
    dma_tile<KT>(gK + (size_t)t_lo * KT, lds, tid, wid); dma_tile<VT>(gV + (size_t)t_lo * VT, lds + KT, tid, wid);
    VM_WAIT(); __syncthreads();
#pragma unroll 1
    for (int t = t_lo; t < t_hi; ++t) {
        const int cur = (t - t_lo) & 1;
        LAS unsigned char* kb = lds + cur * BUF; LAS unsigned char* vb = kb + KT;
        if (t + 1 < t_hi) { LAS unsigned char* nb = lds + (cur ^ 1) * BUF; dma_tile<KT>(gK + (size_t)(t + 1) * KT, nb, tid, wid); dma_tile<VT>(gV + (size_t)(t + 1) * VT, nb + KT, tid, wid); }
        const int k0 = t * 64;
        bool need = true, domask = false;
        if (MODE == 0) { need = (k0 <= wave_q0 + 31); domask = (k0 + 63 > wave_q0); }
        if (MODE == 1) { need = (k0 <= wave_q0 + 31) && (k0 + 63 >= wave_q0 - 127); domask = true; }
        if (need) attn_tile_compute<DQK, DV, MODE>(kb, vb, k0, domask, qf, qpos, biasrow, lr, hi, o, m_run, l_run);
        VM_WAIT(); __syncthreads();
    }
}
#define MLA_KLD(KB, ks, F0, F1) do { const int c_ = 2 * (ks) + hi; \
        F0 = *(const LAS bf16x8*)((KB) + lr * 384 + kswz<384>(lr, c_) * 16); \
        F1 = *(const LAS bf16x8*)((KB) + (lr + 32) * 384 + kswz<384>(lr + 32, c_) * 16); } while (0)
#define MLA_QK(KB, P0, P1) do { _Pragma("unroll") for (int r = 0; r < 16; ++r) { P0[r] = 0.f; P1[r] = 0.f; } \
    bf16x8 ka_[3], kb_[3]; MLA_KLD(KB, 0, ka_[0], kb_[0]); MLA_KLD(KB, 1, ka_[1], kb_[1]); \
    _Pragma("unroll") for (int ks = 0; ks < 12; ++ks) { \
        if (ks + 2 < 12) MLA_KLD(KB, ks + 2, ka_[(ks + 2) % 3], kb_[(ks + 2) % 3]); \
        __builtin_amdgcn_sched_barrier(0); \
        P0 = __builtin_amdgcn_mfma_f32_32x32x16_bf16(ka_[ks % 3], qf[ks], P0, 0, 0, 0); \
        P1 = __builtin_amdgcn_mfma_f32_32x32x16_bf16(kb_[ks % 3], qf[ks], P1, 0, 0, 0); } } while (0)
__device__ __forceinline__ void mla_softmax(f32x16& p0, f32x16& p1, const bool domask, const int k0, const int qpos, const int hi, f32x16 (&o)[4], float& m_run, float& l_run, bf16x8 (&pf)[4]) {
    if (domask) {
        const float NEG = -__builtin_inff();
#pragma unroll
        for (int r = 0; r < 16; ++r) { const int key0 = k0 + (r & 3) + 8 * (r >> 2) + 4 * hi; if (key0 > qpos) p0[r] = NEG; if (key0 + 32 > qpos) p1[r] = NEG; }
    }
    float mx = p0[0];
#pragma unroll
    for (int r = 1; r < 16; ++r) mx = fmaxf(mx, p0[r]);
#pragma unroll
    for (int r = 0; r < 16; ++r) mx = fmaxf(mx, p1[r]);
    { auto rr = __builtin_amdgcn_permlane32_swap(__float_as_uint(mx), __float_as_uint(mx), false, false); mx = fmaxf(__uint_as_float(rr[0]), __uint_as_float(rr[1])); }
    float mn = m_run, alpha = 1.f;
    if (!__all(mx - m_run <= 8.f)) { mn = fmaxf(m_run, mx); alpha = fast_exp2(m_run - mn); m_run = mn;
#pragma unroll
        for (int db = 0; db < 4; ++db)
#pragma unroll
            for (int r = 0; r < 16; ++r) o[db][r] *= alpha; }
    float ps = 0.f;
#pragma unroll
    for (int r = 0; r < 16; ++r) { p0[r] = fast_exp2(p0[r] - mn); p1[r] = fast_exp2(p1[r] - mn); ps += p0[r] + p1[r]; }
    l_run = l_run * alpha + ps;
#pragma unroll
    for (int s = 0; s < 4; ++s) {
        const int r0 = 8 * (s & 1);
        unsigned a01, a23, b45, b67;
        if (s < 2) { a01 = cvt_pk_bf16(p0[r0 + 0], p0[r0 + 1]); a23 = cvt_pk_bf16(p0[r0 + 2], p0[r0 + 3]); b45 = cvt_pk_bf16(p0[r0 + 4], p0[r0 + 5]); b67 = cvt_pk_bf16(p0[r0 + 6], p0[r0 + 7]); }
        else       { a01 = cvt_pk_bf16(p1[r0 + 0], p1[r0 + 1]); a23 = cvt_pk_bf16(p1[r0 + 2], p1[r0 + 3]); b45 = cvt_pk_bf16(p1[r0 + 4], p1[r0 + 5]); b67 = cvt_pk_bf16(p1[r0 + 6], p1[r0 + 7]); }
        auto s0 = __builtin_amdgcn_permlane32_swap(a01, b45, false, false);
        auto s1 = __builtin_amdgcn_permlane32_swap(a23, b67, false, false);
        u32x4 w; w.x = s0[0]; w.y = s1[0]; w.z = s0[1]; w.w = s1[1];
        pf[s] = __builtin_bit_cast(bf16x8, w);
    }
}
__device__ __forceinline__ void mla_pv(const bf16x8 (&pf)[4], const LAS unsigned char* vb, const int lr, const int hi, f32x16 (&o)[4]) {
    bf16x8 vf[2][4];
#pragma unroll
    for (int s = 0; s < 4; ++s) vf[0][s] = *(const LAS bf16x8*)(vb + lr * 128 + vswz(lr, 2 * s + hi) * 16);
#pragma unroll
    for (int db = 0; db < 4; ++db) {
        if (db + 1 < 4) { const int d = 32 * (db + 1) + lr;
#pragma unroll
            for (int s = 0; s < 4; ++s) vf[(db + 1) & 1][s] = *(const LAS bf16x8*)(vb + d * 128 + vswz(d, 2 * s + hi) * 16); }
        __builtin_amdgcn_sched_barrier(0);
#pragma unroll
        for (int s = 0; s < 4; ++s) o[db] = __builtin_amdgcn_mfma_f32_32x32x16_bf16(vf[db & 1][s], pf[s], o[db], 0, 0, 0);
    }
}
typedef long i64x2 __attribute__((ext_vector_type(2)));
__host__ __device__ __forceinline__ int f8pos(int k) { return (k & ~31) | (((k >> 3) & 1) << 4) | (((k >> 4) & 1) << 3) | (k & 7); }
#define F8_KLD(KB, m, F0, F1) do { const int c_ = (2 * (m) + hi) ^ ((lr >> 2) & 3); \
        F0 = *(const LAS i64x2*)((KB) + lr * 192 + c_ * 16); F1 = *(const LAS i64x2*)((KB) + (lr + 32) * 192 + c_ * 16); } while (0)
#define F8_QK(KB, P0, P1) do { _Pragma("unroll") for (int r = 0; r < 16; ++r) { P0[r] = 0.f; P1[r] = 0.f; } \
    i64x2 ka_[3], kb_[3]; F8_KLD(KB, 0, ka_[0], kb_[0]); F8_KLD(KB, 1, ka_[1], kb_[1]); \
    _Pragma("unroll") for (int m = 0; m < 6; ++m) { \
        if (m + 2 < 6) F8_KLD(KB, m + 2, ka_[(m + 2) % 3], kb_[(m + 2) % 3]); \
        __builtin_amdgcn_sched_barrier(0); \
        P0 = __builtin_amdgcn_mfma_f32_32x32x16_fp8_fp8(ka_[m % 3].x, qf[m].x, P0, 0, 0, 0); \
        P1 = __builtin_amdgcn_mfma_f32_32x32x16_fp8_fp8(kb_[m % 3].x, qf[m].x, P1, 0, 0, 0); \
        P0 = __builtin_amdgcn_mfma_f32_32x32x16_fp8_fp8(ka_[m % 3].y, qf[m].y, P0, 0, 0, 0); \
        P1 = __builtin_amdgcn_mfma_f32_32x32x16_fp8_fp8(kb_[m % 3].y, qf[m].y, P1, 0, 0, 0); } } while (0)
__device__ __forceinline__ void f8_softmax(f32x16& p0, f32x16& p1, const bool domask, const int k0, const int qpos, const int hi, f32x16 (&o)[4], float& m_run, float& l_run, long (&pf)[4]) {
    constexpr float C = 0.07216878364870322f * LOG2E;
    if (domask) {
        const float NEG = -__builtin_inff();
#pragma unroll
        for (int r = 0; r < 16; ++r) { const int key0 = k0 + (r & 3) + 8 * (r >> 2) + 4 * hi; if (key0 > qpos) p0[r] = NEG; if (key0 + 32 > qpos) p1[r] = NEG; }
    }
    float mx = p0[0];
#pragma unroll
    for (int r = 1; r < 16; ++r) mx = fmaxf(mx, p0[r]);
#pragma unroll
    for (int r = 0; r < 16; ++r) mx = fmaxf(mx, p1[r]);
    { auto rr = __builtin_amdgcn_permlane32_swap(__float_as_uint(mx), __float_as_uint(mx), false, false); mx = fmaxf(__uint_as_float(rr[0]), __uint_as_float(rr[1])); }
    mx *= C;
    float mn = m_run, alpha = 1.f;
    if (!__all(mx - m_run <= 8.f)) { mn = fmaxf(m_run, mx); alpha = fast_exp2(m_run - mn); m_run = mn;
#pragma unroll
        for (int db = 0; db < 4; ++db)
#pragma unroll
            for (int r = 0; r < 16; ++r) o[db][r] *= alpha; }
    float ps = 0.f;
#pragma unroll
    for (int r = 0; r < 16; ++r) { p0[r] = fast_exp2(p0[r] * C - mn); p1[r] = fast_exp2(p1[r] * C - mn); ps += p0[r] + p1[r]; }
    l_run = l_run * alpha + ps;
#pragma unroll
    for (int s = 0; s < 4; ++s) {
        const int r0 = 8 * (s & 1);
        unsigned a, b;
        if (s < 2) { a = pk4_fp8(p0[r0 + 0], p0[r0 + 1], p0[r0 + 2], p0[r0 + 3]); b = pk4_fp8(p0[r0 + 4], p0[r0 + 5], p0[r0 + 6], p0[r0 + 7]); }
        else       { a = pk4_fp8(p1[r0 + 0], p1[r0 + 1], p1[r0 + 2], p1[r0 + 3]); b = pk4_fp8(p1[r0 + 4], p1[r0 + 5], p1[r0 + 6], p1[r0 + 7]); }
        auto sw = __builtin_amdgcn_permlane32_swap(a, b, false, false);
        pf[s] = (long)(((unsigned long long)sw[1] << 32) | (unsigned long long)sw[0]);
    }
}
__device__ __forceinline__ void f8_pv(const long (&pf)[4], const LAS unsigned char* vb, const int lr, const int hi, f32x16 (&o)[4]) {
    i64x2 vf[2][2];
#pragma unroll
    for (int m = 0; m < 2; ++m) vf[0][m] = *(const LAS i64x2*)(vb + lr * 64 + (((2 * m + hi) ^ ((lr >> 2) & 3)) << 4));
#pragma unroll
    for (int db = 0; db < 4; ++db) {
        if (db + 1 < 4) { const int d = 32 * (db + 1) + lr;
#pragma unroll
            for (int m = 0; m < 2; ++m) vf[(db + 1) & 1][m] = *(const LAS i64x2*)(vb + d * 64 + (((2 * m + hi) ^ ((d >> 2) & 3)) << 4)); }
        __builtin_amdgcn_sched_barrier(0);
#pragma unroll
        for (int m = 0; m < 2; ++m) { o[db] = __builtin_amdgcn_mfma_f32_32x32x16_fp8_fp8(vf[db & 1][m].x, pf[2 * m], o[db], 0, 0, 0);
                                      o[db] = __builtin_amdgcn_mfma_f32_32x32x16_fp8_fp8(vf[db & 1][m].y, pf[2 * m + 1], o[db], 0, 0, 0); }
    }
}
__device__ __forceinline__ void attn_mla_f8(const int tid_in, LAS unsigned char* lds, const unsigned char* gK, const unsigned char* gV, const int t_lo, const int t_hi,
                                            const i64x2 (&qf)[6], const int qpos, const int wave_q0, f32x16 (&o)[4], float& m_run, float& l_run) {
    constexpr int KT = 12288, VT = 8192;
    int tid = tid_in; asm volatile("" : "+v"(tid));
    const int wid = __builtin_amdgcn_readfirstlane(tid >> 6), lane = tid & 63, lr0 = lane & 31, hi = lane >> 5;
    const bool halfB = wid >= 4;
    LAS unsigned char* KB0 = lds; LAS unsigned char* VB0 = lds + 2 * KT;
#define F8_DMA(T, KDST, VDST) do { const unsigned char* ks_ = gK + (size_t)(T) * KT; \
        __builtin_amdgcn_global_load_lds((const unsigned*)(ks_ + (unsigned)(tid * 16)), (LAS unsigned*)((KDST) + wid * 1024), 16, 0, 0); \
        if (wid < 4) __builtin_amdgcn_global_load_lds((const unsigned*)(ks_ + 8192 + (unsigned)(tid * 16)), (LAS unsigned*)((KDST) + 8192 + wid * 1024), 16, 0, 0); \
        __builtin_amdgcn_global_load_lds((const unsigned*)(gV + (size_t)(T) * VT + (unsigned)(tid * 16)), (LAS unsigned*)((VDST) + wid * 1024), 16, 0, 0); } while (0)
    F8_DMA(t_lo, KB0, VB0);
    VM_WAIT(); __syncthreads();
    if (!halfB) {
        int vcur = 0;
#pragma unroll 1
        for (int t = t_lo; t <= t_hi; ++t) {
            const int j = t - t_lo, vnext = (vcur == 2) ? 0 : vcur + 1;
            if (t + 1 < t_hi) F8_DMA(t + 1, KB0 + ((j + 1) & 1) * KT, VB0 + vnext * VT);
            const int k0 = t * 64;
            int lr = lr0; asm volatile("" : "+v"(lr));
            if ((t < t_hi) && (k0 <= wave_q0 + 31)) { f32x16 p0, p1; long pf[4]; const LAS unsigned char* kb = KB0 + (j & 1) * KT;
                F8_QK(kb, p0, p1); f8_softmax(p0, p1, k0 + 63 > wave_q0, k0, qpos, hi, o, m_run, l_run, pf); f8_pv(pf, VB0 + vcur * VT, lr, hi, o); }
            vcur = vnext;
            VM_WAIT(); __syncthreads();
        }
    } else {
        long pf[4] = {0, 0, 0, 0};
        int vcur = 0, vprev = 2;
#pragma unroll 1
        for (int t = t_lo; t <= t_hi; ++t) {
            const int j = t - t_lo, vnext = (vcur == 2) ? 0 : vcur + 1;
            if (t + 1 < t_hi) F8_DMA(t + 1, KB0 + ((j + 1) & 1) * KT, VB0 + vnext * VT);
            const int k0 = t * 64;
            int lr = lr0; asm volatile("" : "+v"(lr));
            if ((j > 0) && (k0 - 64 <= wave_q0 + 31)) f8_pv(pf, VB0 + vprev * VT, lr, hi, o);
            if ((t < t_hi) && (k0 <= wave_q0 + 31)) { f32x16 p0, p1; const LAS unsigned char* kb = KB0 + (j & 1) * KT;
                F8_QK(kb, p0, p1); f8_softmax(p0, p1, k0 + 63 > wave_q0, k0, qpos, hi, o, m_run, l_run, pf); }
            vprev = vcur; vcur = vnext;
            VM_WAIT(); __syncthreads();
        }
    }
#undef F8_DMA
}
__device__ __forceinline__ void attn_mla_stag(const int tid_in, LAS unsigned char* lds, const unsigned char* gK, const unsigned char* gV, const int t_lo, const int t_hi,
                                              const bf16x8 (&qf)[12], const int qpos, const int wave_q0, f32x16 (&o)[4], float& m_run, float& l_run) {
    constexpr int KT = 24576, VT = 16384;
    int tid = tid_in; asm volatile("" : "+v"(tid));
    const int wid = __builtin_amdgcn_readfirstlane(tid >> 6), lane = tid & 63, lr0 = lane & 31, hi = lane >> 5;
    const bool halfB = wid >= 4;
    LAS unsigned char* KB0 = lds; LAS unsigned char* VB0 = lds + 2 * KT;
    dma_tile<KT>(gK + (size_t)t_lo * KT, KB0, tid, wid); dma_tile<VT>(gV + (size_t)t_lo * VT, VB0, tid, wid);
    VM_WAIT(); __syncthreads();
    if (!halfB) {
        int vcur = 0;
#pragma unroll 1
        for (int t = t_lo; t <= t_hi; ++t) {
            const int j = t - t_lo, vnext = (vcur == 2) ? 0 : vcur + 1;
            if (t + 1 < t_hi) { dma_tile<KT>(gK + (size_t)(t + 1) * KT, KB0 + ((j + 1) & 1) * KT, tid, wid); dma_tile<VT>(gV + (size_t)(t + 1) * VT, VB0 + vnext * VT, tid, wid); }
            const int k0 = t * 64;
            int lr = lr0; asm volatile("" : "+v"(lr));
            if ((t < t_hi) && (k0 <= wave_q0 + 31)) { f32x16 p0, p1; bf16x8 pf[4]; const LAS unsigned char* kb = KB0 + (j & 1) * KT;
                MLA_QK(kb, p0, p1); mla_softmax(p0, p1, k0 + 63 > wave_q0, k0, qpos, hi, o, m_run, l_run, pf); mla_pv(pf, VB0 + vcur * VT, lr, hi, o); }
            vcur = vnext;
            VM_WAIT(); __syncthreads();
        }
    } else {
        bf16x8 pf[4];
#pragma unroll
        for (int s = 0; s < 4; ++s) pf[s] = (bf16x8){0, 0, 0, 0, 0, 0, 0, 0};
        int vcur = 0, vprev = 2;
#pragma unroll 1
        for (int t = t_lo; t <= t_hi; ++t) {
            const int j = t - t_lo, vnext = (vcur == 2) ? 0 : vcur + 1;
            if (t + 1 < t_hi) { dma_tile<KT>(gK + (size_t)(t + 1) * KT, KB0 + ((j + 1) & 1) * KT, tid, wid); dma_tile<VT>(gV + (size_t)(t + 1) * VT, VB0 + vnext * VT, tid, wid); }
            const int k0 = t * 64;
            int lr = lr0; asm volatile("" : "+v"(lr));
            if ((j > 0) && (k0 - 64 <= wave_q0 + 31)) mla_pv(pf, VB0 + vprev * VT, lr, hi, o);
            if ((t < t_hi) && (k0 <= wave_q0 + 31)) { f32x16 p0, p1; const LAS unsigned char* kb = KB0 + (j & 1) * KT;
                MLA_QK(kb, p0, p1); mla_softmax(p0, p1, k0 + 63 > wave_q0, k0, qpos, hi, o, m_run, l_run, pf); }
            vprev = vcur; vcur = vnext;
            VM_WAIT(); __syncthreads();
        }
    }
}
template <int DQK> __device__ __forceinline__ void load_q_norm(const bf16_t* qrow, const float* gain, float scale, int hi, bf16x8 (&qf)[DQK / 16]) {
    float x[DQK / 16][8]; float ss = 0.f;
#pragma unroll
    for (int ks = 0; ks < DQK / 16; ++ks) { const u32x4 w = *(const u32x4*)(qrow + 16 * ks + 8 * hi); unpack8(w, x[ks]);
#pragma unroll
        for (int j = 0; j < 8; ++j) ss += x[ks][j] * x[ks][j]; }
    { auto rr = __builtin_amdgcn_permlane32_swap(__float_as_uint(ss), __float_as_uint(ss), false, false); ss = __uint_as_float(rr[0]) + __uint_as_float(rr[1]); }
    const float rs = rsqrtf(ss * (1.0f / DQK) + EPS) * scale;
#pragma unroll
    for (int ks = 0; ks < DQK / 16; ++ks) { float y[8];
#pragma unroll
        for (int j = 0; j < 8; ++j) y[j] = x[ks][j] * rs * gain[16 * ks + 8 * hi + j];
        qf[ks] = __builtin_bit_cast(bf16x8, pack8(y)); }
}
template <int DQK> __device__ __forceinline__ void load_q_norm_bf16x2(const bf16_t* qa, const bf16_t* qb_, const float* gain, float scale, int hi, bf16x8 (&qf)[DQK / 16]) {
    float x[DQK / 16][8]; float ss = 0.f;
#pragma unroll
    for (int ks = 0; ks < DQK / 16; ++ks) { float a[8], b[8]; unpack8(*(const u32x4*)(qa + 16 * ks + 8 * hi), a); unpack8(*(const u32x4*)(qb_ + 16 * ks + 8 * hi), b);
#pragma unroll
        for (int j = 0; j < 8; ++j) { x[ks][j] = a[j] + b[j]; ss += x[ks][j] * x[ks][j]; } }
    { auto rr = __builtin_amdgcn_permlane32_swap(__float_as_uint(ss), __float_as_uint(ss), false, false); ss = __uint_as_float(rr[0]) + __uint_as_float(rr[1]); }
    const float rs = rsqrtf(ss * (1.0f / DQK) + EPS) * scale;
#pragma unroll
    for (int ks = 0; ks < DQK / 16; ++ks) { float y[8];
#pragma unroll
        for (int j = 0; j < 8; ++j) y[j] = x[ks][j] * rs * gain[16 * ks + 8 * hi + j];
        qf[ks] = __builtin_bit_cast(bf16x8, pack8(y)); }
}
template <int DQK> __device__ __forceinline__ void load_q_norm_bf16x4(const bf16_t* q0, const size_t zs, const float* gain, float scale, int hi, bf16x8 (&qf)[DQK / 16]) {
    float x[DQK / 16][8]; float ss = 0.f;
#pragma unroll
    for (int ks = 0; ks < DQK / 16; ++ks) {
#pragma unroll
        for (int j = 0; j < 8; ++j) x[ks][j] = 0.f;
#pragma unroll
        for (int z = 0; z < 4; ++z) { float a[8]; unpack8(*(const u32x4*)(q0 + z * zs + 16 * ks + 8 * hi), a);
#pragma unroll
            for (int j = 0; j < 8; ++j) x[ks][j] += a[j]; }
#pragma unroll
        for (int j = 0; j < 8; ++j) ss += x[ks][j] * x[ks][j]; }
    { auto rr = __builtin_amdgcn_permlane32_swap(__float_as_uint(ss), __float_as_uint(ss), false, false); ss = __uint_as_float(rr[0]) + __uint_as_float(rr[1]); }
    const float rs = rsqrtf(ss * (1.0f / DQK) + EPS) * scale;
#pragma unroll
    for (int ks = 0; ks < DQK / 16; ++ks) { float y[8];
#pragma unroll
        for (int j = 0; j < 8; ++j) y[j] = x[ks][j] * rs * gain[16 * ks + 8 * hi + j];
        qf[ks] = __builtin_bit_cast(bf16x8, pack8(y)); }
}
template <int DV> __device__ __forceinline__ void store_o(bf16_t* orow, const f32x16 (&o)[DV / 32], float inv_l, int hi) {
#pragma unroll
    for (int db = 0; db < DV / 32; ++db)
#pragma unroll
        for (int r4 = 0; r4 < 4; ++r4) { u32x2 w; w.x = cvt_pk_bf16(o[db][4 * r4] * inv_l, o[db][4 * r4 + 1] * inv_l); w.y = cvt_pk_bf16(o[db][4 * r4 + 2] * inv_l, o[db][4 * r4 + 3] * inv_l);
            *(u32x2*)(orow + 32 * db + 8 * r4 + 4 * hi) = w; }
}

struct Args { const float* in[50]; float* out; unsigned char* ws; int l_lo, l_hi, ph_lo, ph_hi; };
enum { I_X = 0, I_MEM, I_RELB, I_LNMIX, I_WIN, I_SWAQG, I_SWAKG, I_SINK, I_DWW, I_DWB, I_CLNG, I_CLNB, I_PWW, I_PWB, I_QAG, I_KVAG, I_WQB, I_WKVB, I_QNN, I_QNR, I_KNN, I_KNR,
       I_ARE, I_AIM, I_LOGDT, I_BRE, I_BIM, I_CRE, I_CIM, I_SSMD, I_GLUW, I_GLUB, I_MIXG, I_WOUT, I_LNX, I_MEMG, I_XWQ, I_XWK, I_XWV, I_XQG, I_XKG, I_XWO, I_LNMOE, I_WG, I_BG, I_WE, I_BE, I_MG, I_MU, I_MD };
constexpr int NPH = 19;

__constant__ unsigned char T5_BUCKET[128] = {0,1,2,3,4,5,6,7,8,9,10,11,12,13,14,15,16,16,16,17,17,18,18,18,19,19,19,20,20,20,20,21,21,21,21,22,22,22,22,22,23,23,23,23,23,23,24,24,24,24,24,24,25,25,25,25,25,25,25,26,26,26,26,26,26,26,26,27,27,27,27,27,27,27,27,27,27,28,28,28,28,28,28,28,28,28,28,29,29,29,29,29,29,29,29,29,29,29,29,30,30,30,30,30,30,30,30,30,30,30,30,30,30,31,31,31,31,31,31,31,31,31,31,31,31,31,31,31};

__device__ __forceinline__ void tr_item(const float* W, int ldw, int k0, int n0, bf16_t* WT, int ldt, int drow0, const float* kgain, LAS float* scr, int lane) {
    float tv[32];
#pragma unroll
    for (int i = 0; i < 32; ++i) { const int kk = 2 * i + (lane >> 5); tv[i] = W[(size_t)(k0 + kk) * ldw + n0 + (lane & 31)]; }
#pragma unroll
    for (int i = 0; i < 32; ++i) { const int kk = 2 * i + (lane >> 5); float v = tv[i]; if (kgain) v *= kgain[k0 + kk]; scr[kk * 33 + (lane & 31)] = v; }
    LDS_WAIT();
    const int c = lane & 7;
#pragma unroll
    for (int j = 0; j < 4; ++j) { const int n = (lane >> 3) + 8 * j; const LAS float* s = scr + (8 * c) * 33 + n;
        u32x4 o; o.x = cvt_pk_bf16(s[0 * 33], s[1 * 33]); o.y = cvt_pk_bf16(s[2 * 33], s[3 * 33]); o.z = cvt_pk_bf16(s[4 * 33], s[5 * 33]); o.w = cvt_pk_bf16(s[6 * 33], s[7 * 33]);
        *(u32x4*)(WT + (size_t)(drow0 + n) * ldt + k0 + 8 * c) = o; }
    LDS_WAIT();
}
struct TrD { const float* src; const float* kg; unsigned char* dst; int ldw, ldtB, f8; };
__device__ __forceinline__ void tr_load(const TrD& d, int lane, float (&tv)[32], f32x4 (&kq)[2]) {
#pragma unroll
    for (int i = 0; i < 32; ++i) { const int kk = 2 * i + (lane >> 5); tv[i] = d.src[(size_t)kk * d.ldw + (lane & 31)]; }
    if (d.kg) { kq[0] = *(const f32x4*)(d.kg + 8 * (lane & 7)); kq[1] = *(const f32x4*)(d.kg + 8 * (lane & 7) + 4); }
    else { kq[0] = (f32x4){1.f, 1.f, 1.f, 1.f}; kq[1] = kq[0]; }
}
__device__ __forceinline__ void tr_fin(const TrD& d, int lane, const float (&tv)[32], const f32x4 (&kq)[2], LAS float* scr) {
#pragma unroll
    for (int i = 0; i < 32; ++i) { const int kk = 2 * i + (lane >> 5); scr[kk * 33 + (lane & 31)] = tv[i]; }
    LDS_WAIT();
    const int c = lane & 7;
    if (d.f8) {
#pragma unroll
        for (int j = 0; j < 4; ++j) { const int n = (lane >> 3) + 8 * j; const LAS float* s = scr + (8 * c) * 33 + n;
            *(u32x2*)(d.dst + (size_t)n * d.ldtB + 8 * c) = (u32x2){pk4_fp8(s[0 * 33] * 32.0f * kq[0].x, s[1 * 33] * 32.0f * kq[0].y, s[2 * 33] * 32.0f * kq[0].z, s[3 * 33] * 32.0f * kq[0].w),
                                                                    pk4_fp8(s[4 * 33] * 32.0f * kq[1].x, s[5 * 33] * 32.0f * kq[1].y, s[6 * 33] * 32.0f * kq[1].z, s[7 * 33] * 32.0f * kq[1].w)}; }
    } else {
#pragma unroll
        for (int j = 0; j < 4; ++j) { const int n = (lane >> 3) + 8 * j; const LAS float* s = scr + (8 * c) * 33 + n;
            u32x4 o; o.x = cvt_pk_bf16(s[0 * 33] * kq[0].x, s[1 * 33] * kq[0].y); o.y = cvt_pk_bf16(s[2 * 33] * kq[0].z, s[3 * 33] * kq[0].w); o.z = cvt_pk_bf16(s[4 * 33] * kq[1].x, s[5 * 33] * kq[1].y); o.w = cvt_pk_bf16(s[6 * 33] * kq[1].z, s[7 * 33] * kq[1].w);
            *(u32x4*)(d.dst + (size_t)n * d.ldtB + 16 * c) = o; }
    }
    LDS_WAIT();
}
__device__ __forceinline__ void tr_item8(const float* W, int ldw, int k0, int n0, unsigned char* WT8, int ldt, int drow0, const float* kgain, LAS float* scr, int lane) {
    float tv[32];
#pragma unroll
    for (int i = 0; i < 32; ++i) { const int kk = 2 * i + (lane >> 5); tv[i] = W[(size_t)(k0 + kk) * ldw + n0 + (lane & 31)]; }
#pragma unroll
    for (int i = 0; i < 32; ++i) { const int kk = 2 * i + (lane >> 5); float v = tv[i] * 32.0f; if (kgain) v *= kgain[k0 + kk]; scr[kk * 33 + (lane & 31)] = v; }
    LDS_WAIT();
    const int c = lane & 7;
#pragma unroll
    for (int j = 0; j < 4; ++j) { const int n = (lane >> 3) + 8 * j; const LAS float* s = scr + (8 * c) * 33 + n;
        *(u32x2*)(WT8 + (size_t)(drow0 + n) * ldt + k0 + 8 * c) = (u32x2){pk4_fp8(s[0 * 33], s[1 * 33], s[2 * 33], s[3 * 33]), pk4_fp8(s[4 * 33], s[5 * 33], s[6 * 33], s[7 * 33])}; }
    LDS_WAIT();
}
__device__ __forceinline__ void rms_row_store(const f32x4 (&v)[8], const float* gain, bf16_t* orow, int lane) {
    float ss = 0.f;
#pragma unroll
    for (int j = 0; j < 8; ++j) ss += (v[j].x * v[j].x + v[j].y * v[j].y) + (v[j].z * v[j].z + v[j].w * v[j].w);
    const float rs = rsqrtf(wave_sum(ss) * (1.0f / D) + EPS);
#pragma unroll
    for (int j = 0; j < 8; ++j) { const f32x4 g = *(const f32x4*)(gain + 4 * lane + 256 * j); u32x2 w; w.x = cvt_pk_bf16(v[j].x * rs * g.x, v[j].y * rs * g.y); w.y = cvt_pk_bf16(v[j].z * rs * g.z, v[j].w * rs * g.w);
        *(u32x2*)(orow + 4 * lane + 256 * j) = w; }
}
__device__ __forceinline__ f32x2 cmul(f32x2 a, f32x2 b) { return (f32x2){a.x * b.x - a.y * b.y, a.x * b.y + a.y * b.x}; }
__device__ __forceinline__ void sincos_rev(float x, float& s, float& c) { float r = x * 0.15915494309189535f; r -= rintf(r); s = __builtin_amdgcn_sinf(r); c = __builtin_amdgcn_cosf(r); }

#define X ((float*)out_)
#define ROPE ((float*)(ws + WS_ROPE))
#define H ((bf16_t*)(ws + WS_H))
#define P ((bf16_t*)(ws + WS_P))
#define O ((bf16_t*)(ws + WS_O))
#define QRAW ((bf16_t*)(ws + WS_QRAW))
#define KVRAW ((bf16_t*)(ws + WS_KVRAW))
#define Q ((bf16_t*)(ws + WS_Q))
#define KIMG ((unsigned char*)(ws + WS_KIMG))
#define VIMG ((unsigned char*)(ws + WS_VIMG))
#define SWAK ((unsigned char*)(ws + WS_SWAK))
#define SWAV ((unsigned char*)(ws + WS_SWAV))
#define ZC ((bf16_t*)(ws + WS_ZC))
#define UA ((bf16_t*)(ws + WS_UA))
#define EBUF ((float*)(ws + WS_EBUF))
#define YG ((bf16_t*)(ws + WS_YG))
#define QX ((bf16_t*)(ws + WS_QX))
#define OX ((bf16_t*)(ws + WS_OX))
#define MEMN ((bf16_t*)(ws + WS_MEMN))
#define KMEM ((bf16_t*)(ws + WS_KMEM))
#define VMEM ((bf16_t*)(ws + WS_VMEM))
#define XKIMG ((unsigned char*)(ws + WS_XKIMG))
#define XVIMG ((unsigned char*)(ws + WS_XVIMG))
#define LOGI ((float*)(ws + WS_LOG))
#define TOK ((int*)(ws + WS_TOK))
#define WSLOT ((float*)(ws + WS_WSLOT))
#define HID ((bf16_t*)(ws + WS_HID))
#define YS8 ((unsigned char*)(ws + WS_YS))
#define WIN ((bf16_t*)(ws + WS_WIN))
#define WOUT ((bf16_t*)(ws + WS_WOUT))
#define XWQ ((bf16_t*)(ws + WS_XWQ))
#define XWK ((bf16_t*)(ws + WS_XWK))
#define XWV ((bf16_t*)(ws + WS_XWV))
#define XWO ((bf16_t*)(ws + WS_XWO))
#define PW ((bf16_t*)(ws + WS_PW))
#define WQB ((bf16_t*)(ws + WS_WQB))
#define WKVB ((bf16_t*)(ws + WS_WKVB))
#define GLU ((bf16_t*)(ws + WS_GLU))
#define ROUT ((bf16_t*)(ws + WS_ROUT))
#define MOE1 ((bf16_t*)(ws + WS_MOE1))
#define MOE2 ((bf16_t*)(ws + WS_MOE2))
#define W1G ((bf16_t*)(ws + WS_W1G))
#define BTY ((bf16_t*)(ws + WS_BTY))
#define PARTO ((float*)(ws + WS_PARTO))
#define XB ((bf16_t*)(ws + WS_XB))
#define QXP ((float*)(ws + WS_QXP))
#define LOGP ((float*)(ws + WS_LOGP))
#define SSP ((float*)(ws + WS_SSP))
#define RMSV ((float*)(ws + WS_RMSV))
#define RMS1 ((float*)(ws + WS_RMS1))
#define XF8 ((unsigned char*)(ws + WS_XF8))
#define KCG ((float*)(ws + WS_H + 16 * MiB))
#define PQ7 ((bf16_t*)(ws + WS_H))
#define HID8 ((unsigned char*)(ws + WS_HID))
#define MOE1F ((unsigned char*)(ws + WS_MOE1))
#define MOE2F ((unsigned char*)(ws + WS_MOE2))
#define PARTML ((float*)(ws + WS_PARTML))
#define REC_E ((int*)(ws + WS_REC))
#define REC_R (REC_E + 2 * S)
#define REC_W ((float*)(REC_E + 4 * S))
#define REC_S (REC_E + 6 * S)
__device__ __forceinline__ unsigned long long ldp(const LAS unsigned* pt, int i) { unsigned lo = pt[2 * i], hi = pt[2 * i + 1]; lo = __builtin_amdgcn_readfirstlane(lo); hi = __builtin_amdgcn_readfirstlane(hi); return ((unsigned long long)hi << 32) | lo; }
#define INP(i) ((const float*)(const GAS float*)ldp(PT, (i)))
#define FRESH() int tid = (wave_s << 6) + (int)__builtin_amdgcn_mbcnt_hi(~0u, __builtin_amdgcn_mbcnt_lo(~0u, 0u)), G = gridDim.x, bid = blockIdx.x; unsigned lo_ = 0u; asm volatile("" : "+v"(tid), "+s"(G), "+s"(bid), "+s"(lo_)); LAS unsigned char* lds = lds0; const LAS unsigned* PT = (const LAS unsigned*)(lds0 + lo_ + LDSCTL_OFF + 512); volatile LAS unsigned* CTLW = (volatile LAS unsigned*)(lds0 + lo_ + LDSCTL_OFF); (void)CTLW; const int NGW = G * NWAVES; (void)NGW; const int lane = tid & 63, wave = __builtin_amdgcn_readfirstlane(tid >> 6), gw = bid * NWAVES + wave; unsigned char* ws = (unsigned char*)(GAS unsigned char*)ldp(PT, 50); float* out_ = (float*)(GAS float*)ldp(PT, 51); unsigned* ctl = (unsigned*)ws; (void)lane; (void)wave; (void)gw; (void)ws; (void)out_; (void)ctl
#if !MK_MULTI
#define GRID_BAR() do { XcdBarrier bar_; bar_.bar = ctl + CW_BAR; bar_.x = xb_xcc_id(); bar_.st = CTLW; xcd_barrier(bar_, tid); } while (0)
#else
#define GRID_BAR() do { } while (0)
#endif

#ifndef PROBE_REP
#define PROBE_REP 0u
#endif
#ifndef PHASE_MASK
#define PHASE_MASK 0xFFFFFFFFu
#endif
#define IN(k) ((((PHASE_MASK) >> (k)) & 1u) && ({ int a_ = ph_lo, b_ = ph_hi; asm volatile("" : "+s"(a_), "+s"(b_)); (a_ <= (k) && (k) < b_); }))
#define SEAM(k) do { if (IN((k) + 1) || ((k) == NPH - 1 && IN(0) && IN(NPH - 1))) GRID_BAR(); } while (0)


__device__ __forceinline__ void norm_groups(const LAS unsigned* PT, unsigned char* ws, const int l, const int s0, const int sstride, const int glo, const int ghi, const int lane) {
    const float* mg = INP(I_MIXG) + l * D;
    for (int s = s0; s < S; s += sstride) {
#pragma unroll
        for (int grp = 0; grp < 4; ++grp) { if (grp < glo || grp >= ghi) continue; bf16_t* p = O + (size_t)s * D + grp * 512 + 8 * lane; float x[8];
                    if (grp == 2 && s >= S / 2) {
                        const int h = lane >> 4, d0 = (lane & 15) * 8, qb = s >> 8, row = s & 255;
                        const size_t sa = ((size_t)(h * 32 + (qb - 32)) * 2 + 0) * 256 + row, sb = sa + 256;
                        const f32x2 mla = *(const f32x2*)(PARTML + sa * 2), mlb = *(const f32x2*)(PARTML + sb * 2);
                        const float mm = fmaxf(mla.x, mlb.x), fa = fast_exp2(mla.x - mm), fb = fast_exp2(mlb.x - mm), inv = fast_rcp(mla.y * fa + mlb.y * fb);
                        const f32x4 a0 = *(const f32x4*)(PARTO + sa * 128 + d0), a1 = *(const f32x4*)(PARTO + sa * 128 + d0 + 4), b0 = *(const f32x4*)(PARTO + sb * 128 + d0), b1 = *(const f32x4*)(PARTO + sb * 128 + d0 + 4);
#pragma unroll
                        for (int j = 0; j < 4; ++j) { x[j] = (a0[j] * fa + b0[j] * fb) * inv; x[4 + j] = (a1[j] * fa + b1[j] * fb) * inv; }
                    } else unpack8(*(const u32x4*)p, x);
                    float ss = 0.f;
#pragma unroll
                    for (int j = 0; j < 8; ++j) ss += x[j] * x[j];
                    const float rs = rsqrtf(wave_sum(ss) * (1.f / 512.f) + EPS); const float* gn = mg + grp * 512 + 8 * lane;
#pragma unroll
                    for (int j = 0; j < 8; ++j) x[j] = x[j] * rs * gn[j];
                    *(u32x4*)p = pack8(x); }
            }
}

template <int DUMMY> __device__ __forceinline__ void layer_body(const int l, const int wave_s, LAS unsigned char* lds0, const int ph_lo, const int ph_hi) {
        if (IN(0)) {
            FRESH();
            LAS float* scr = (LAS float*)(lds + wave * 16384);
            for (int rep_ = 0; rep_ < (int)(PROBE_REP & 1u) + 1; ++rep_) {
                const float* w_in = INP(I_WIN) + (size_t)l * D * INW; const float* w_out = INP(I_WOUT) + (size_t)l * D * D;
                const float* xwq = INP(I_XWQ) + (size_t)l * D * 512; const float* xwk = INP(I_XWK) + (size_t)l * D * 512; const float* xwv = INP(I_XWV) + (size_t)l * D * 512;
                const float* xwo = INP(I_XWO) + (size_t)l * 512 * D; const float* pww = INP(I_PWW) + (size_t)l * 512 * 512;
                const float* wqb = INP(I_WQB) + (size_t)l * 512 * 768; const float* wkvb = INP(I_WKVB) + (size_t)l * 256 * 1024; const float* gluw = INP(I_GLUW) + (size_t)l * 512 * 512;
                const float* mg = INP(I_MG) + (size_t)l * 32 * D * 512; const float* mu = INP(I_MU) + (size_t)l * 32 * D * 512; const float* md = INP(I_MD) + (size_t)l * 32 * 512 * D;
                const float* qag = INP(I_QAG) + l * 512; const float* kvag = INP(I_KVAG) + l * 256; const float* lnx = INP(I_LNX) + l * D; const float* lnmix = INP(I_LNMIX) + l * D; const float* lnm = INP(I_LNMOE) + l * D;
                constexpr int N_IN = 32 * 98, N_OUT = 32 * 64, N_XQ = 32 * 16, N_XO = 8 * 64, N_PW = 8 * 16, N_QB = 8 * 24, N_KVB = 4 * 32, N_GLU = 8 * 16, N_MG = 32 * 512, N_MD = 32 * 512;
                constexpr int NITEMS = N_IN + N_OUT + 3 * N_XQ + N_XO + N_PW + N_QB + N_KVB + N_GLU + 2 * N_MG + N_MD;
                auto decode = [&](int r) -> TrD {
                    const float* W; int ldw, k0, n0, drow0, ldt; unsigned char* base; const float* kgn = nullptr; int f8 = 0;
                    if (r < N_MG) { const int e = r >> 9, rr = r & 511, kb = rr >> 4, nb = rr & 15; n0 = 32 * nb; k0 = 64 * kb; W = mg + (size_t)e * D * 512; ldw = 512; base = MOE1F + (size_t)e * 1024 * D; ldt = D; drow0 = (n0 >> 7) * 256 + (n0 & 127); kgn = lnm; f8 = 1; }
                    else if ((r -= N_MG) < N_MG) { const int e = r >> 9, rr = r & 511, kb = rr >> 4, nb = rr & 15; n0 = 32 * nb; k0 = 64 * kb; W = mu + (size_t)e * D * 512; ldw = 512; base = MOE1F + (size_t)e * 1024 * D; ldt = D; drow0 = (n0 >> 7) * 256 + 128 + (n0 & 127); kgn = lnm; f8 = 1; }
                    else if ((r -= N_MG) < N_MD) { const int e = r >> 9, rr = r & 511, kb = rr >> 6, nb = rr & 63; n0 = 32 * nb; k0 = 64 * kb; W = md + (size_t)e * 512 * D; ldw = D; base = MOE2F + (size_t)e * D * 512; ldt = 512; drow0 = n0; f8 = 1; }
                    else if ((r -= N_MD) < N_IN) { const int kb = r / 98, nb = r % 98; n0 = 32 * nb; k0 = 64 * kb; W = w_in; ldw = INW; base = (unsigned char*)WIN; ldt = D; drow0 = (n0 < 448) ? n0 : (n0 < 512 ? 3072 + (n0 - 448) : n0 - 64); kgn = lnmix; }
                    else if ((r -= N_IN) < N_OUT) { const int kb = r >> 6, nb = r & 63; n0 = 32 * nb; k0 = 64 * kb; W = w_out; ldw = D; base = (unsigned char*)WOUT; ldt = D; drow0 = n0; }
                    else if ((r -= N_OUT) < N_XQ) { const int kb = r >> 4, nb = r & 15; n0 = 32 * nb; k0 = 64 * kb; W = xwq; ldw = 512; base = (unsigned char*)XWQ; ldt = D; drow0 = n0; kgn = lnx; }
                    else if ((r -= N_XQ) < N_XQ) { const int kb = r >> 4, nb = r & 15; n0 = 32 * nb; k0 = 64 * kb; W = xwk; ldw = 512; base = (unsigned char*)XWK; ldt = D; drow0 = n0; }
                    else if ((r -= N_XQ) < N_XQ) { const int kb = r >> 4, nb = r & 15; n0 = 32 * nb; k0 = 64 * kb; W = xwv; ldw = 512; base = (unsigned char*)XWV; ldt = D; drow0 = n0; }
                    else if ((r -= N_XQ) < N_XO) { const int kb = r >> 6, nb = r & 63; n0 = 32 * nb; k0 = 64 * kb; W = xwo; ldw = D; base = (unsigned char*)XWO; ldt = 512; drow0 = n0; }
                    else if ((r -= N_XO) < N_PW) { const int kb = r >> 4, nb = r & 15; n0 = 32 * nb; k0 = 64 * kb; W = pww; ldw = 512; base = (unsigned char*)PW; ldt = 512; drow0 = n0; }
                    else if ((r -= N_PW) < N_QB) { const int kb = r / 24, nb = r % 24; n0 = 32 * nb; k0 = 64 * kb; W = wqb; ldw = 768; base = (unsigned char*)WQB; ldt = 512; drow0 = n0; kgn = qag; }
                    else if ((r -= N_QB) < N_KVB) { const int kb = r >> 5, nb = r & 31; n0 = 32 * nb; k0 = 64 * kb; W = wkvb; ldw = 1024; base = (unsigned char*)WKVB; ldt = 256; drow0 = n0; kgn = kvag; }
                    else { r -= N_KVB; const int kb = r >> 4, nb = r & 15; n0 = 32 * nb; k0 = 64 * kb; W = gluw; ldw = 512; base = (unsigned char*)GLU; ldt = 512; drow0 = n0; }
                    TrD d; d.src = W + (size_t)k0 * ldw + n0; d.ldw = ldw; d.kg = kgn ? kgn + k0 : nullptr; d.f8 = f8; d.ldtB = f8 ? ldt : 2 * ldt; d.dst = base + (size_t)drow0 * d.ldtB + (f8 ? k0 : 2 * k0);
                    return d; };
#pragma unroll 1
                for (int it = gw; it < NITEMS; it += 2 * NGW) {
                    const int it2 = it + NGW; const bool two = it2 < NITEMS;
                    const TrD d0 = decode(it); TrD d1 = d0; float ta[32], tb[32]; f32x4 ka[2], kb2[2];
                    tr_load(d0, lane, ta, ka);
                    if (two) { d1 = decode(it2); tr_load(d1, lane, tb, kb2); }
                    tr_fin(d0, lane, ta, ka, scr);
                    if (two) tr_fin(d1, lane, tb, kb2, scr);
                }
                if (bid == 0 && tid < 256) { *(u32x4*)(XB + (size_t)S * D + 8 * tid) = (u32x4){0u, 0u, 0u, 0u}; *(u32x2*)(XF8 + (size_t)S * D + 8 * tid) = (u32x2){0u, 0u}; }
                for (int i = bid * NTHR + tid; i < (WINR - INW) * D / 8; i += G * NTHR) *(u32x4*)(WIN + (size_t)INW * D + (size_t)i * 8) = (u32x4){0u, 0u, 0u, 0u};
                const float* wgp = INP(I_WG) + (size_t)l * D * 4; const float* wep = INP(I_WE) + (size_t)l * D * 32;
                for (int i = bid * NTHR + tid; i < 256 * D / 2; i += G * NTHR) { const int n = i / (D / 2), k = (i % (D / 2)) * 2; float a = 0.f, b = 0.f;
                    if (n < 4) { a = wgp[(size_t)k * 4 + n] * lnm[k]; b = wgp[(size_t)(k + 1) * 4 + n] * lnm[k + 1]; } else if (n < 36) { a = wep[(size_t)k * 32 + n - 4] * lnm[k]; b = wep[(size_t)(k + 1) * 32 + n - 4] * lnm[k + 1]; }
                    *(unsigned*)(ROUT + (size_t)n * D + k) = cvt_pk_bf16(a, b); }
            }
            __syncthreads();
            for (int rep_ = 0; rep_ < (int)((PROBE_REP >> 19) & 1u) + 1; ++rep_)
            for (int task = bid; task < 256; task += G) {
                FRESH();
                const int g = task >> 3, part = task & 7;
                LAS f32x2* LP = (LAS f32x2*)lds;
                LAS f32x2* BB = (LAS f32x2*)(lds + 36864);
                LAS f32x2* CC = (LAS f32x2*)(lds + 45056);
                LAS float* KC = (LAS float*)(lds + 53248);
                const float* are = INP(I_ARE) + (size_t)(l * 32 + g) * 64; const float* aim = INP(I_AIM) + (size_t)(l * 32 + g) * 64;
                const float dt = __expf(INP(I_LOGDT)[l * 32 + g]);
                const float* bre = INP(I_BRE) + (size_t)(l * 32 + g) * 1024; const float* bim = INP(I_BIM) + (size_t)(l * 32 + g) * 1024;
                const float* cre = INP(I_CRE) + (size_t)(l * 32 + g) * 1024; const float* cim = INP(I_CIM) + (size_t)(l * 32 + g) * 1024;
                const float* dsk = INP(I_SSMD) + l * 512 + g * 16;
                if (tid < 64) { const int p = tid; float s, c; sincos_rev(aim[p] * dt, s, c); const float mag = fast_exp2(are[p] * dt * LOG2E); const f32x2 lb = (f32x2){mag * c, mag * s};
                    f32x2 cur = (f32x2){1.f, 0.f}; for (int j = 0; j <= 64; ++j) { LP[p * 65 + j] = cur; cur = cmul(cur, lb); } }
                for (int i = tid; i < 1024; i += NTHR) { const int p = i >> 4, ii = i & 15; float s, c; sincos_rev(aim[p] * dt, s, c); const float mag = fast_exp2(are[p] * dt * LOG2E);
                    const float nr = mag * c - 1.f, ni = mag * s, lr_ = are[p], li = aim[p], den = fast_rcp(lr_ * lr_ + li * li);
                    const f32x2 coef = (f32x2){(nr * lr_ + ni * li) * den, (ni * lr_ - nr * li) * den};
                    BB[p * 16 + ii] = cmul(coef, (f32x2){bre[p * 16 + ii], bim[p * 16 + ii]});
                    CC[i] = (f32x2){cre[i], cim[i]}; }
                __syncthreads();
                {   const int j = part * 8 + (tid >> 6), o = (tid >> 2) & 15, i0 = (tid & 3) * 4; float acc[4] = {0.f, 0.f, 0.f, 0.f};
                    for (int p = 0; p < 64; ++p) { const f32x2 u = cmul(CC[o * 64 + p], LP[p * 65 + j]);
#pragma unroll
                        for (int m = 0; m < 4; ++m) { const f32x2 bb = BB[p * 16 + i0 + m]; acc[m] += u.x * bb.x - u.y * bb.y; } }
#pragma unroll
                    for (int m = 0; m < 4; ++m) if (j == 0 && o == i0 + m) acc[m] += dsk[o];
                    *(f32x4*)(KCG + (size_t)g * 16384 + (j * 16 + o) * 16 + i0) = (f32x4){acc[0], acc[1], acc[2], acc[3]}; }
                for (int ch = tid; ch < 32 * 128; ch += NTHR) { const int n = part * 32 + ch / 128, kc = (ch % 128) * 8, tau = kc >> 4, i0 = kc & 15; float v[8];
                    if (n < 128) { const int p = n & 63; const f32x2 lp = LP[p * 65 + 63 - tau];
#pragma unroll
                        for (int j = 0; j < 8; ++j) { const f32x2 t2 = cmul(lp, BB[p * 16 + i0 + j]); v[j] = (n < 64) ? t2.x : t2.y; } }
                    else {
#pragma unroll
                        for (int j = 0; j < 8; ++j) v[j] = 0.f; }
                    *(u32x4*)(W1G + ((size_t)g * 256 + n) * 1024 + kc) = pack8(v); }
                __syncthreads();
            }
            if (l == 0) { FRESH(); for (int i = bid * NTHR + tid; i < S * 32; i += G * NTHR) { const int pos = i >> 5, f = i & 31; const float inv = fast_exp2(-(float)f * (13.287712379549449f / 32.0f));
                    double tr = (double)pos * (double)inv * 0.15915494309189535; tr -= rint(tr); const float rf = (float)tr;
                    ROPE[2 * i] = __builtin_amdgcn_cosf(rf); ROPE[2 * i + 1] = __builtin_amdgcn_sinf(rf); } }
            for (int rep3_ = (int)((PROBE_REP >> 21) & 1u); rep3_ >= 0; --rep3_)
            {   FRESH(); const float* xin = INP(I_X);
                for (int s = gw; s < S; s += NGW) { float x[4][8];
                    if (l == 0) {
#pragma unroll
                        for (int j = 0; j < 4; ++j) { const f32x4 a = *(const f32x4*)(xin + (size_t)s * D + 8 * lane + 512 * j), b = *(const f32x4*)(xin + (size_t)s * D + 8 * lane + 512 * j + 4);
                            x[j][0] = a[0]; x[j][1] = a[1]; x[j][2] = a[2]; x[j][3] = a[3]; x[j][4] = b[0]; x[j][5] = b[1]; x[j][6] = b[2]; x[j][7] = b[3]; } }
                    else { const int s0 = REC_S[2 * s], s1 = REC_S[2 * s + 1];
#pragma unroll
                        for (int j = 0; j < 4; ++j) { float ya[8], yb[8]; unpack8(*(const u32x4*)(XB + (size_t)s * D + 8 * lane + 512 * j), x[j]);
                            unpack8_fp8(*(const u32x2*)(YS8 + (size_t)s0 * D + 8 * lane + 512 * j), ya); unpack8_fp8(*(const u32x2*)(YS8 + (size_t)s1 * D + 8 * lane + 512 * j), yb);
#pragma unroll
                            for (int e = 0; e < 8; ++e) x[j][e] += (ya[e] + yb[e]) * 0.0625f; } }
                    float ss = 0.f;
#pragma unroll
                    for (int j = 0; j < 4; ++j)
#pragma unroll
                        for (int e = 0; e < 8; ++e) ss += x[j][e] * x[j][e];
                    ss = wave_sum(ss);
                    if (rep3_ == 0) {
#pragma unroll
                        for (int j = 0; j < 4; ++j) *(u32x4*)(XB + (size_t)s * D + 8 * lane + 512 * j) = pack8(x[j]);
                        if (lane == 0) RMS1[s] = rsqrtf(ss * (1.0f / D) + EPS); } }
                const float* mgain = INP(I_MEMG) + l * D; const float* mem = INP(I_MEM);
                for (int s = gw; s < MEMT; s += NGW) { f32x4 v[8];
#pragma unroll
                    for (int j = 0; j < 8; ++j) v[j] = *(const f32x4*)(mem + (size_t)s * D + 4 * lane + 256 * j);
                    rms_row_store(v, mgain, MEMN + (size_t)s * D, lane); }
            }
            SEAM(0);
        }
        if (IN(1)) for (int rep_ = 0; rep_ < (int)((PROBE_REP >> 1) & 1u) + 1; ++rep_) {
            FRESH();
            {
                for (int task = bid; task < 256; task += G) {
                    FRESH();
                    const int g = task >> 3, part = task & 7;
                    LAS f32x2* LP = (LAS f32x2*)lds;
                    LAS f32x2* CC = (LAS f32x2*)(lds + 45056);
                    LAS float* KC = (LAS float*)(lds + 53248);
                    const float* are = INP(I_ARE) + (size_t)(l * 32 + g) * 64; const float* aim = INP(I_AIM) + (size_t)(l * 32 + g) * 64;
                    const float dt = __expf(INP(I_LOGDT)[l * 32 + g]);
                    const float* cre = INP(I_CRE) + (size_t)(l * 32 + g) * 1024; const float* cim = INP(I_CIM) + (size_t)(l * 32 + g) * 1024;
                    if (tid < 64) { const int p = tid; float s_, c_; sincos_rev(aim[p] * dt, s_, c_); const float mag = fast_exp2(are[p] * dt * LOG2E); const f32x2 lb = (f32x2){mag * c_, mag * s_};
                        f32x2 cur = (f32x2){1.f, 0.f}; for (int j = 0; j <= 64; ++j) { LP[p * 65 + j] = cur; cur = cmul(cur, lb); } }
                    for (int i = tid; i < 1024; i += NTHR) CC[i] = (f32x2){cre[i], cim[i]};
#pragma unroll
                    for (int k_ = 0; k_ < 8; ++k_) { const int i = tid + k_ * NTHR; *(LAS f32x4*)(KC + 4 * i) = *(const f32x4*)(KCG + (size_t)g * 16384 + 4 * i); }
                    __syncthreads();
                    for (int ch = tid; ch < 128 * 144; ch += NTHR) { const int rr = part * 128 + ch / 144, kc = (ch % 144) * 8, t = rr >> 4, o = rr & 15; float v[8];
                        if (kc < 1024) { const int tau = kc >> 4, i0 = kc & 15;
#pragma unroll
                            for (int j = 0; j < 8; ++j) v[j] = (tau <= t) ? KC[((t - tau) * 16 + o) * 16 + i0 + j] : 0.f; }
                        else if (kc < 1152) { const bool im = kc >= 1088; const int p0 = (kc - (im ? 1088 : 1024));
#pragma unroll
                            for (int j = 0; j < 8; ++j) { const f32x2 t2 = cmul(CC[o * 64 + p0 + j], LP[(p0 + j) * 65 + t + 1]); v[j] = im ? -t2.y : t2.x; } }
                        else {
#pragma unroll
                            for (int j = 0; j < 8; ++j) v[j] = 0.f; }
                        *(u32x4*)(BTY + ((size_t)g * 1024 + rr) * 1280 + kc) = pack8(v); }
                    __syncthreads();
                } }
            __syncthreads();
            pg8::GSched Sd{(const char*)XB, (const char*)WIN, (size_t)256 * D * 2, (size_t)256 * D * 2, 0, 0, S / 256, 12, 1, G, bid};
            pg8::EpiBf16 E{P, INWP, 0, nullptr, RMS1};
            for (int r2_ = 0; r2_ < (int)((PROBE_REP >> 23) & 1u) + 1; ++r2_)
            pg8::gemm_phase<pg8::EpiBf16, pg8::GSched>(tid, lds, D, D, D, nullptr, Sd, E);
            for (int r3_ = 0; r3_ < (int)((PROBE_REP >> 22) & 1u) * 4 + 1; ++r3_)
            {
                pg8::GSched St{(const char*)XB, (const char*)(WIN + (size_t)3072 * D), (size_t)256 * D * 2, 0, (size_t)512 * 2, (size_t)512 * 2, S / 256, 1, 4, G, bid};
                pg8::EpiBf16Part64 Et{PQ7, (size_t)S * 64, RMS1};
                pg8::gemm_phase<pg8::EpiBf16Part64, pg8::GSched>(tid, lds, 512, D, D, nullptr, St, Et); }
            SEAM(1);
        }
        if (IN(2)) for (int rep_ = 0; rep_ < (int)((PROBE_REP >> 2) & 1u) + 1; ++rep_) {
            FRESH();
            {   pg8::GSched Sd{(const char*)(P + P_CQ), (const char*)WQB, (size_t)256 * INWP * 2, (size_t)256 * 512 * 2, 0, 0, S / 256, 3, 1, G, bid};
                pg8::EpiBf16 E{QRAW, 768, 0, nullptr, nullptr};
                pg8::gemm_phase<pg8::EpiBf16, pg8::GSched>(tid, lds, 512, INWP, 512, nullptr, Sd, E); }
            {   FRESH(); pg8::GSched Sd{(const char*)(P + P_CKV), (const char*)WKVB, (size_t)256 * INWP * 2, (size_t)256 * 256 * 2, 0, 0, S / 256, 4, 1, G, bid};
                pg8::EpiBf16 E{KVRAW, 1024, 0, nullptr, nullptr};
                pg8::gemm_phase<pg8::EpiBf16, pg8::GSched>(tid, lds, 256, INWP, 256, nullptr, Sd, E); }
            __syncthreads();
            for (int rep2_ = 0; rep2_ < (int)((PROBE_REP >> 20) & 1u) + 1; ++rep2_)
            for (int tile = bid; tile < S / 64; tile += G) {
                FRESH();
                const int t0 = tile * 64;
                LAS bf16_t* Z = (LAS bf16_t*)lds;
                LAS bf16_t* DW = (LAS bf16_t*)(lds + 98304);
                const float* dww = INP(I_DWW) + (size_t)l * 31 * 512;
                u32x4 tmp_[8], kraw_[2], vraw_[2];
#pragma unroll
                for (int k_ = 0; k_ < 8; ++k_) { const int i = tid + k_ * NTHR; const int half = i & 1, g = (i >> 1) & 31, tau = i >> 6; tmp_[k_] = *(const u32x4*)(P + (size_t)(t0 + tau) * INWP + P_DU + g * 16 + 8 * half); }
#pragma unroll
                for (int kh = 0; kh < 2; ++kh) { const int s_ = t0 + wave * 8 + (lane >> 3), c_ = lane & 7; kraw_[kh] = *(const u32x4*)(P + (size_t)s_ * INWP + P_AK + kh * 64 + 8 * c_); vraw_[kh] = *(const u32x4*)(P + (size_t)s_ * INWP + P_AV + kh * 64 + 8 * c_); }
#pragma unroll
                for (int hb = 0; hb < 2; ++hb) { u32x4 aw_[6], gw_[6];
#pragma unroll
                    for (int i1 = 0; i1 < 6; ++i1) { const int i = tid + (hb * 6 + i1) * NTHR, rr = (i < 94 * 64) ? (i >> 6) : 93, c8 = (i & 63) * 8, s = t0 - 30 + rr, sc = s < 0 ? 0 : s;
                        aw_[i1] = *(const u32x4*)(P + (size_t)sc * INWP + P_BA + c8); gw_[i1] = *(const u32x4*)(P + (size_t)sc * INWP + P_BG + c8); }
#pragma unroll
                    for (int i1 = 0; i1 < 6; ++i1) { const int i = tid + (hb * 6 + i1) * NTHR, rr = i >> 6, c8 = (i & 63) * 8, s = t0 - 30 + rr; float z[8], a[8], g[8]; unpack8(aw_[i1], a); unpack8(gw_[i1], g);
#pragma unroll
                        for (int j = 0; j < 8; ++j) z[j] = (s >= 0) ? a[j] * sigmoidf_(g[j]) : 0.f;
                        if (i < 94 * 64) *(LAS u32x4*)(Z + rr * 512 + c8) = pack8(z); } }
                for (int i = tid; i < 31 * 64; i += NTHR) { const int w = i >> 6, c8 = (i & 63) * 8; float v[8];
#pragma unroll
                    for (int j = 0; j < 8; ++j) v[j] = dww[w * 512 + c8 + j];
                    *(LAS u32x4*)(DW + w * 512 + c8) = pack8(v); }
                __syncthreads();
                {   const int c8 = lane * 8; const float* dwb = INP(I_DWB) + l * 512 + c8; const float* lg = INP(I_CLNG) + l * 512 + c8; const float* lb = INP(I_CLNB) + l * 512 + c8;
                    for (int g4 = 0; g4 < 2; ++g4) {
                        const int tb = wave * 8 + 4 * g4; float a4[4][8], zw[4][8];
#pragma unroll
                        for (int q = 0; q < 4; ++q)
#pragma unroll
                            for (int j = 0; j < 8; ++j) a4[q][j] = dwb[j];
#pragma unroll
                        for (int q = 0; q < 3; ++q) unpack8(*(const LAS u32x4*)(Z + (tb + q) * 512 + c8), zw[q]);
#pragma unroll 1
                        for (int w0 = 0; w0 < 32; w0 += 4) {
#pragma unroll
                            for (int i = 0; i < 4; ++i) { const int w = w0 + i; if (w < 31) { float k[8]; unpack8(*(const LAS u32x4*)(Z + (tb + 3 + w) * 512 + c8), zw[(i + 3) & 3]); unpack8(*(const LAS u32x4*)(DW + w * 512 + c8), k);
#pragma unroll
                                for (int q = 0; q < 4; ++q)
#pragma unroll
                                    for (int j = 0; j < 8; ++j) a4[q][j] += zw[(i + q) & 3][j] * k[j]; } } }
#pragma unroll
                    for (int q = 0; q < 4; ++q) { const int tau = tb + q; float acc[8];
#pragma unroll
                        for (int j = 0; j < 8; ++j) acc[j] = a4[q][j];
                        float sm = 0.f;
#pragma unroll
                        for (int j = 0; j < 8; ++j) sm += acc[j];
                        const float mean = wave_sum(sm) * (1.f / 512.f); float sq = 0.f;
#pragma unroll
                        for (int j = 0; j < 8; ++j) { acc[j] -= mean; sq += acc[j] * acc[j]; }
                        const float rstd = rsqrtf(wave_sum(sq) * (1.f / 512.f) + EPS); float y[8];
#pragma unroll
                        for (int j = 0; j < 8; ++j) { const float v = acc[j] * rstd * lg[j] + lb[j]; y[j] = v * sigmoidf_(v); }
                        *(u32x4*)(ZC + (size_t)(t0 + tau) * 512 + c8) = pack8(y); } } }
                __syncthreads();
                {
#pragma unroll
                for (int k_ = 0; k_ < 8; ++k_) { const int i = tid + k_ * NTHR; const int half = i & 1, g = (i >> 1) & 31, tau = i >> 6;
                    *(u32x4*)(UA + ((size_t)g * 256 + tile) * 1280 + tau * 16 + 8 * half) = tmp_[k_]; } }
                {   LAS bf16_t* vt = (LAS bf16_t*)(lds + wave * 1024);
                    const int j = lane >> 3, c = lane & 7, r = wave * 8 + j, s = t0 + r; const float* kg = INP(I_SWAKG) + l * 64 + 8 * c;
#pragma unroll
                    for (int kh = 0; kh < 2; ++kh) {
                        float x[8]; unpack8(kraw_[kh], x); float ss = 0.f;
#pragma unroll
                        for (int e = 0; e < 8; ++e) ss += x[e] * x[e];
                        ss += __shfl_xor(ss, 1); ss += __shfl_xor(ss, 2); ss += __shfl_xor(ss, 4);
                        const float rs = rsqrtf(ss * (1.f / 64.f) + EPS);
#pragma unroll
                        for (int e = 0; e < 8; ++e) x[e] = x[e] * rs * kg[e];
                        *(u32x4*)(SWAK + ((size_t)kh * 256 + tile) * 8192 + r * 128 + kswz<128>(r, c) * 16) = pack8(x);
                        *(LAS u32x4*)(vt + j * 64 + 8 * c) = vraw_[kh];
                        LDS_WAIT();
                        { const int d = lane; float v[8];
#pragma unroll
                            for (int jj = 0; jj < 8; ++jj) v[jj] = bf2f(vt[jj * 64 + d]);
                            *(u32x4*)(SWAV + ((size_t)kh * 256 + tile) * 8192 + d * 128 + vswz(d, wave) * 16) = pack8(v); }
                        LDS_WAIT();
                    } }
                __syncthreads();
            }
            SEAM(2);
        }
        if (IN(3)) for (int rep_ = 0; rep_ < (int)((PROBE_REP >> 3) & 1u) + 1; ++rep_) {
            FRESH();
            {   pg8::GSched Sd{(const char*)ZC, (const char*)PW, (size_t)256 * 512 * 2, (size_t)256 * 512 * 2, 0, 0, S / 256, 2, 1, G, (bid + G / 2) % G};
                pg8::EpiBf16 E{O, D, 512, INP(I_PWB) + l * 512, nullptr};
                pg8::gemm_phase<pg8::EpiBf16, pg8::GSched>(tid, lds, 512, 512, 512, nullptr, Sd, E); }
            {   pg8::GSched Sd{(const char*)UA, (const char*)W1G, 0, 0, (size_t)256 * 1280 * 2, (size_t)256 * 1024 * 2, 1, 1, 32, G, (bid + 128) % G};
                pg8::EpiF32Part<128> E{EBUF, 128, (size_t)256 * 128};
                pg8::gemm_phase<pg8::EpiF32Part<128>, pg8::GSched>(tid, lds, 1024, 1280, 1024, nullptr, Sd, E); }
            {   FRESH(); pg8::MemSched Sm{(const char*)MEMN, (const char*)XWK, G, (bid + G - 160) % G};
                pg8::EpiMem Em{KMEM, VMEM};
                pg8::gemm_phase<pg8::EpiMem, pg8::MemSched>(tid, lds, 512, D, D, nullptr, Sm, Em); }
            __syncthreads();
            for (int tile = bid; tile < S / 64; tile += G) {
                FRESH();
                const int t0 = tile * 64; constexpr float QSCALE = 0.07216878364870322f * LOG2E;
                LAS bf16_t* vt = (LAS bf16_t*)(lds + wave * 8192);
                const float* qnn = INP(I_QNN) + l * 128; const float* qnr = INP(I_QNR) + l * 64; const float* knn = INP(I_KNN) + l * 128; const float* knr = INP(I_KNR) + l * 64;
                for (int j2 = 0; j2 < 8; j2 += 2) {
                    u32x2 wkv_[2]; float xkr_[2], cs_[2], sn_[2]; unsigned wqn_[2][4], wkn_[2][4], wv_[2][4]; float xqr_[2][4];
#pragma unroll
                    for (int u = 0; u < 2; ++u) { const int s = t0 + wave * 8 + j2 + u;
                        wkv_[u] = *(const u32x2*)(P + (size_t)s * INWP + P_CKV + 4 * lane);
                        xkr_[u] = bf2f(P[(size_t)s * INWP + P_CKR + lane]);
                        cs_[u] = ROPE[((size_t)s * 32 + (lane & 31)) * 2]; sn_[u] = ROPE[((size_t)s * 32 + (lane & 31)) * 2 + 1];
#pragma unroll
                        for (int h = 0; h < 4; ++h) { wqn_[u][h] = *(const unsigned*)(QRAW + (size_t)s * 768 + h * 192 + 2 * lane); xqr_[u][h] = bf2f(QRAW[(size_t)s * 768 + h * 192 + 128 + lane]);
                            wkn_[u][h] = *(const unsigned*)(KVRAW + (size_t)s * 1024 + h * 256 + 2 * lane); wv_[u][h] = *(const unsigned*)(KVRAW + (size_t)s * 1024 + h * 256 + 128 + 2 * lane); } }
#pragma unroll
                    for (int u = 0; u < 2; ++u) {
                    const int j = j2 + u, r = wave * 8 + j, s = t0 + r;
                    const u32x2 wkv = wkv_[u]; const float xkr = xkr_[u], cs = cs_[u], sn = sn_[u];
                    unsigned wqn[4], wkn[4], wv[4]; float xqr[4];
#pragma unroll
                    for (int h = 0; h < 4; ++h) { wqn[h] = wqn_[u][h]; wkn[h] = wkn_[u][h]; wv[h] = wv_[u][h]; xqr[h] = xqr_[u][h]; }
                    float ps[14];
                    { const float a = bf2f(wkv.x & 0xffffu), b = bf2f(wkv.x >> 16), c = bf2f(wkv.y & 0xffffu), d = bf2f(wkv.y >> 16); ps[0] = a * a + b * b + c * c + d * d; }
                    ps[1] = xkr * xkr;
#pragma unroll
                    for (int h = 0; h < 4; ++h) { const float a = bf2f(wqn[h] & 0xffffu), b = bf2f(wqn[h] >> 16), c = bf2f(wkn[h] & 0xffffu), d = bf2f(wkn[h] >> 16);
                        ps[2 + 3 * h] = a * a + b * b; ps[3 + 3 * h] = xqr[h] * xqr[h]; ps[4 + 3 * h] = c * c + d * d; }
#pragma unroll
                    for (int o = 1; o < 64; o <<= 1)
#pragma unroll
                        for (int k = 0; k < 14; ++k) ps[k] += __shfl_xor(ps[k], o);
                    const float rkv = rsqrtf(ps[0] * (1.f / 256.f) + EPS);
                    float kr; { const float y = xkr * rsqrtf(ps[1] * (1.f / 64.f) + EPS) * knr[lane]; const float pr = __shfl_xor(y, 32);
                        kr = (lane < 32) ? (y * cs - pr * sn) : (pr * sn + y * cs); }
#pragma unroll
                    for (int h = 0; h < 4; ++h) {
                        { const float a = bf2f(wqn[h] & 0xffffu), b = bf2f(wqn[h] >> 16);
                          const float rs = rsqrtf(ps[2 + 3 * h] * (1.f / 128.f) + EPS);
                          *(unsigned short*)((unsigned char*)Q + ((size_t)h * S + s) * 192 + f8pos(2 * lane)) = (unsigned short)(pk4_fp8(a * rs * qnn[2 * lane], b * rs * qnn[2 * lane + 1], 0.f, 0.f) & 0xffffu); }
                        { const float y = xqr[h] * rsqrtf(ps[3 + 3 * h] * (1.f / 64.f) + EPS) * qnr[lane]; const float pr = __shfl_xor(y, 32);
                          const float qr = ((lane < 32) ? (y * cs - pr * sn) : (pr * sn + y * cs));
                          ((unsigned char*)Q)[((size_t)h * S + s) * 192 + f8pos(128 + lane)] = (unsigned char)(pk4_fp8(qr, 0.f, 0.f, 0.f) & 0xffu); }
                        { const float a = bf2f(wkn[h] & 0xffffu), b = bf2f(wkn[h] >> 16);
                          const float rs = rsqrtf(ps[4 + 3 * h] * (1.f / 128.f) + EPS);
                          unsigned char* kimg = KIMG + ((size_t)h * 256 + tile) * 12288 + r * 192; const int pn_ = f8pos(2 * lane), pr_ = f8pos(128 + lane), sw_ = (r >> 2) & 3;
                          *(unsigned short*)(kimg + (((pn_ >> 4) ^ sw_) << 4) + (pn_ & 15)) = (unsigned short)(pk4_fp8(a * rs * knn[2 * lane], b * rs * knn[2 * lane + 1], 0.f, 0.f) & 0xffffu);
                          kimg[(((pr_ >> 4) ^ sw_) << 4) + (pr_ & 15)] = (unsigned char)(pk4_fp8(kr, 0.f, 0.f, 0.f) & 0xffu); }
                        *(LAS unsigned short*)((LAS unsigned char*)vt + (h * 8 + j) * 128 + 2 * lane) = (unsigned short)(pk4_fp8(bf2f(wv[h] & 0xffffu) * rkv, bf2f(wv[h] >> 16) * rkv, 0.f, 0.f) & 0xffffu);
                    }
                                    }
                }
                LDS_WAIT();
                for (int h = 0; h < 4; ++h)
                    for (int dd = 0; dd < 2; ++dd) { const int d = lane + 64 * dd; const LAS unsigned char* v8 = (const LAS unsigned char*)vt; unsigned lo = 0u, hi4 = 0u;
#pragma unroll
                        for (int jj = 0; jj < 4; ++jj) { lo |= (unsigned)v8[(h * 8 + jj) * 128 + d] << (8 * jj); hi4 |= (unsigned)v8[(h * 8 + 4 + jj) * 128 + d] << (8 * jj); }
                        const int off_ = 32 * (wave >> 2) + 8 * (((wave & 1) << 1) | ((wave >> 1) & 1));
                        *(u32x2*)(VIMG + ((size_t)h * 256 + tile) * 8192 + d * 64 + ((((off_ >> 4) ^ ((d >> 2) & 3))) << 4) + (off_ & 15)) = (u32x2){lo, hi4}; }
                LDS_WAIT();
            }
            __syncthreads();
            __syncthreads();
            {   FRESH(); LAS float* tab = (LAS float*)(lds + 98304);
                const float* relb = INP(I_RELB);
                for (int i = tid; i < 1024; i += NTHR) { const int h = i >> 7, dist = i & 127; tab[i] = relb[T5_BUCKET[dist] * 8 + h] * LOG2E; }
                __syncthreads();
                const int lr = lane & 31, hi = lane >> 5;
                for (int it = bid; it < 128; it += G) {
                    const int kh = it & 1, qb = it >> 1, q0 = qb * 256, wq0 = q0 + 32 * wave, qpos = wq0 + lr;
                    const int t_lo = (4 * qb - 2) < 0 ? 0 : (4 * qb - 2), t_hi = 4 * qb + 4;
                    __syncthreads();
                    for (int t = t_lo; t < t_hi; ++t) { dma_tile<8192>(SWAK + ((size_t)kh * 256 + t) * 8192, lds + (t - t_lo) * 16384, tid, wave); dma_tile<8192>(SWAV + ((size_t)kh * 256 + t) * 8192, lds + (t - t_lo) * 16384 + 8192, tid, wave); }
                    VM_WAIT(); __syncthreads();
#pragma unroll 1
                    for (int g = 0; g < 4; ++g) { const int h = 4 * kh + g;
                        bf16x8 qf[4];
                        if (h < 7) load_q_norm<64>(P + (size_t)qpos * INWP + P_AQ + h * 64, INP(I_SWAQG) + l * 64, 0.125f * LOG2E, hi, qf);
                        else load_q_norm_bf16x4<64>(PQ7 + (size_t)qpos * 64, (size_t)S * 64, INP(I_SWAQG) + l * 64, 0.125f * LOG2E, hi, qf);
                        f32x16 o[2];
#pragma unroll
                        for (int db = 0; db < 2; ++db)
#pragma unroll
                            for (int r = 0; r < 16; ++r) o[db][r] = 0.f;
                        float m_run = -1e30f, l_run = 0.f;
#pragma unroll 1
                        for (int t = t_lo; t < t_hi; ++t) { const int k0 = t * 64;
                            if ((k0 <= wq0 + 31) && (k0 + 63 >= wq0 - 127)) attn_tile_compute<64, 64, 1>(lds + (t - t_lo) * 16384, lds + (t - t_lo) * 16384 + 8192, k0, true, qf, qpos, tab + h * 128, lr, hi, o, m_run, l_run); }
                        { auto rr = __builtin_amdgcn_permlane32_swap(__float_as_uint(l_run), __float_as_uint(l_run), false, false); l_run = __uint_as_float(rr[0]) + __uint_as_float(rr[1]); }
                        l_run += fast_exp2(INP(I_SINK)[l * 8 + h] * LOG2E - m_run);
                        store_o<64>(O + (size_t)qpos * D + h * 64, o, fast_rcp(l_run), hi);
                    }
                }
            }
            SEAM(3);
        }
        if (IN(4)) for (int rep_ = 0; rep_ < (int)((PROBE_REP >> 4) & 1u) + 1; ++rep_) {
            FRESH();
            for (int task = bid; task < 64; task += G) {
                FRESH();
                LAS f32x2* SE = (LAS f32x2*)lds;
                const int sl = tid & 31, seg = tid >> 5, st = task * 32 + sl, g = st >> 6, p = st & 63;
                const float dt = __expf(INP(I_LOGDT)[l * 32 + g]); const float are = INP(I_ARE)[(size_t)(l * 32 + g) * 64 + p], aim = INP(I_AIM)[(size_t)(l * 32 + g) * 64 + p];
                float s_, c_; sincos_rev(aim * dt, s_, c_); const float mag = fast_exp2(are * dt * LOG2E); f32x2 lt = (f32x2){mag * c_, mag * s_};
#pragma unroll
                for (int k = 0; k < 6; ++k) lt = cmul(lt, lt);
                f32x2 e[16];
#pragma unroll
                for (int k = 0; k < 16; ++k) { const size_t off = ((size_t)g * 256 + seg * 16 + k) * 128 + p; e[k] = (f32x2){EBUF[off], EBUF[off + 64]}; }
                f32x2 acc = (f32x2){0.f, 0.f};
#pragma unroll
                for (int k = 0; k < 16; ++k) { const f32x2 t = cmul(lt, acc); acc = (f32x2){t.x + e[k].x, t.y + e[k].y}; }
                SE[sl * 16 + seg] = acc;
                f32x2 l16 = lt;
#pragma unroll
                for (int k = 0; k < 4; ++k) l16 = cmul(l16, l16);
                __syncthreads();
                f32x2 carry = (f32x2){0.f, 0.f};
                for (int k = 0; k < seg; ++k) { const f32x2 t = cmul(l16, carry); const f32x2 se = SE[sl * 16 + k]; carry = (f32x2){t.x + se.x, t.y + se.y}; }
#pragma unroll
                for (int k = 0; k < 16; ++k) { const int c = seg * 16 + k; bf16_t* dst = UA + ((size_t)g * 256 + c) * 1280 + 1024 + p;
                    dst[0] = (bf16_t)(cvt_pk_bf16(carry.x, 0.f) & 0xffffu); dst[64] = (bf16_t)(cvt_pk_bf16(carry.y, 0.f) & 0xffffu);
                    const f32x2 t = cmul(lt, carry); carry = (f32x2){t.x + e[k].x, t.y + e[k].y}; }
                __syncthreads();
            }
            {   FRESH(); const int lr = lane & 31, hi = lane >> 5;
                for (int it = bid; it < 256; it += G) {
                    const int xcd_ = it & 7, il_ = ((xcd_ & 1) << 5) | (it >> 3), h = xcd_ >> 1, j = il_ >> 1, part = il_ & 1;
                    for (int sub = 0; sub <= part; ++sub) {
                        const bool fin = (sub == 1);
                        const int qb = fin ? j : 63 - j;
                        const int t_lo = fin ? 0 : (part ? 130 : 0), t_hi = fin ? 4 * j + 4 : (part ? 4 * (64 - j) : 130);
                        const int q0 = qb * 256, wq0 = q0 + 32 * wave, qpos = wq0 + lr;
                        i64x2 qf[6];
#pragma unroll
                        for (int m = 0; m < 6; ++m) qf[m] = *(const i64x2*)((const unsigned char*)Q + ((size_t)h * S + qpos) * 192 + 32 * m + 16 * hi);
                        f32x16 o[4];
#pragma unroll
                        for (int db = 0; db < 4; ++db)
#pragma unroll
                            for (int r = 0; r < 16; ++r) o[db][r] = 0.f;
                        float m_run = -1e30f, l_run = 0.f;
                        attn_mla_f8(tid, lds, KIMG + (size_t)h * 256 * 12288, VIMG + (size_t)h * 256 * 8192, t_lo, t_hi, qf, qpos, wq0, o, m_run, l_run);
                        { auto rr = __builtin_amdgcn_permlane32_swap(__float_as_uint(l_run), __float_as_uint(l_run), false, false); l_run = __uint_as_float(rr[0]) + __uint_as_float(rr[1]); }
                        int tz = tid; asm volatile("" : "+v"(tz));
                        const int lr2 = tz & 31, hi2 = (tz >> 5) & 1, row2 = q0 + (tz >> 6) * 32 + lr2;
                        if (fin) store_o<128>(O + (size_t)row2 * D + 1024 + h * 128, o, fast_rcp(l_run), hi2);
                        else {
                            const size_t slot = ((size_t)(h * 32 + (qb - 32)) * 2 + part) * 256 + (tz >> 6) * 32 + lr2;
                            float* po = PARTO + slot * 128;
#pragma unroll
                            for (int db = 0; db < 4; ++db)
#pragma unroll
                                for (int r4 = 0; r4 < 4; ++r4) *(f32x4*)(po + 32 * db + 8 * r4 + 4 * hi2) = (f32x4){o[db][4 * r4], o[db][4 * r4 + 1], o[db][4 * r4 + 2], o[db][4 * r4 + 3]};
                            if (hi2 == 0) *(f32x2*)(PARTML + slot * 2) = (f32x2){m_run, l_run};
                        }
                    }
                }
            }
            SEAM(4);
        }
        if (IN(5)) for (int rep_ = 0; rep_ < (int)((PROBE_REP >> 5) & 1u) + 1; ++rep_) {
            FRESH();
            pg8::GSched Sd{(const char*)UA, (const char*)BTY, 0, (size_t)256 * 1280 * 2, (size_t)256 * 1280 * 2, (size_t)1024 * 1280 * 2, 1, 4, 32, G, bid};
            pg8::EpiSsmY E{YG};
            pg8::gemm_phase<pg8::EpiSsmY, pg8::GSched>(tid, lds, 1152, 1280, 1280, nullptr, Sd, E);
            if (G == 256 && bid >= 128) { FRESH(); norm_groups(PT, ws, l, (bid - 128) * NWAVES + wave, 128 * NWAVES, 0, 3, lane); }
            SEAM(5);
        }
        if (IN(6)) for (int rep_ = 0; rep_ < (int)((PROBE_REP >> 6) & 1u) + 1; ++rep_) {
            FRESH();
            pg8::GSched Sd{(const char*)YG, (const char*)GLU, (size_t)256 * 512 * 2, (size_t)256 * 512 * 2, 0, 0, S / 256, 2, 1, G, bid};
            pg8::EpiGlu E{YG, INP(I_GLUB) + l * 512, O};
            pg8::gemm_phase<pg8::EpiGlu, pg8::GSched>(tid, lds, 512, 512, 512, nullptr, Sd, E);
            __syncthreads();
            for (int it = (bid + 32) % G; it < 32; it += G) {
                FRESH();
                const int tile = it >> 3, w8 = it & 7, r = w8 * 8 + wave, mrow = tile * 64 + r;
                LAS bf16_t* vt = (LAS bf16_t*)lds; const float* kg = INP(I_XKG) + l * 128;
                unsigned wk[4]; float ps[4];
#pragma unroll
                for (int h = 0; h < 4; ++h) { float a = 0.f, b = 0.f, va = 0.f, vb = 0.f;
#pragma unroll
                    for (int z = 0; z < 4; ++z) { const unsigned k2 = *(const unsigned*)(KMEM + (size_t)z * 256 * 512 + (size_t)mrow * 512 + h * 128 + 2 * lane), v2 = *(const unsigned*)(VMEM + (size_t)z * 256 * 512 + (size_t)mrow * 512 + h * 128 + 2 * lane);
                        a += bf2f(k2 & 0xffffu); b += bf2f(k2 >> 16); va += bf2f(v2 & 0xffffu); vb += bf2f(v2 >> 16); }
                    wk[h] = cvt_pk_bf16(a, b); a = bf2f(wk[h] & 0xffffu); b = bf2f(wk[h] >> 16); ps[h] = a * a + b * b;
                    *(LAS unsigned*)(vt + (h * 8 + wave) * 128 + 2 * lane) = cvt_pk_bf16(va, vb); }
#pragma unroll
                for (int o = 1; o < 64; o <<= 1)
#pragma unroll
                    for (int h = 0; h < 4; ++h) ps[h] += __shfl_xor(ps[h], o);
#pragma unroll
                for (int h = 0; h < 4; ++h) { const float a = bf2f(wk[h] & 0xffffu), b = bf2f(wk[h] >> 16), rs = rsqrtf(ps[h] * (1.f / 128.f) + EPS);
                    *(unsigned*)(XKIMG + ((size_t)h * 4 + tile) * 16384 + r * 256 + kswz<256>(r, lane >> 2) * 16 + (lane & 3) * 4) = cvt_pk_bf16(a * rs * kg[2 * lane], b * rs * kg[2 * lane + 1]); }
                __syncthreads();
                {   const int h = tid >> 7, d = tid & 127; float v[8];
#pragma unroll
                    for (int jj = 0; jj < 8; ++jj) v[jj] = bf2f(vt[(h * 8 + jj) * 128 + d]);
                    *(u32x4*)(XVIMG + ((size_t)h * 4 + tile) * 16384 + d * 128 + vswz(d, w8) * 16) = pack8(v); }
                __syncthreads();
            }
            SEAM(6);
        }
        if (IN(7)) for (int rep_ = 0; rep_ < (int)((PROBE_REP >> 7) & 1u) + 1; ++rep_) {
            FRESH();
            norm_groups(PT, ws, l, gw, NGW, (G == 256) ? 3 : 0, 4, lane);
            SEAM(7);
        }
        if (IN(8)) for (int rep_ = 0; rep_ < (int)((PROBE_REP >> 8) & 1u) + 1; ++rep_) {
            FRESH();
            pg8::GSched Sd{(const char*)O, (const char*)WOUT, (size_t)256 * D * 2, (size_t)256 * D * 2, 0, 0, S / 256, D / 256, 1, G, bid};
            pg8::EpiResid E{XB, D, nullptr, (((PROBE_REP >> 8) & 1u) != 0u) && rep_ == 0, nullptr};
            pg8::gemm_phase<pg8::EpiResid, pg8::GSched>(tid, lds, D, D, D, nullptr, Sd, E);
            SEAM(8);
        }
        if (IN(10)) for (int rep_ = 0; rep_ < (int)((PROBE_REP >> 10) & 1u) + 1; ++rep_) {
            FRESH();
            pg8::GSched Sd{(const char*)XB, (const char*)XWQ, (size_t)256 * D * 2, (size_t)256 * D * 2, (size_t)1024 * 2, (size_t)1024 * 2, S / 256, 2, 2, G, bid};
            pg8::EpiBf16Z E{(bf16_t*)QXP, 512, (size_t)S * 512};
            pg8::gemm_phase<pg8::EpiBf16Z, pg8::GSched>(tid, lds, 1024, D, D, nullptr, Sd, E);
            SEAM(10);
        }
        if (IN(11)) for (int rep_ = 0; rep_ < (int)((PROBE_REP >> 11) & 1u) + 1; ++rep_) {
            FRESH();
            const int lr = lane & 31, hi = lane >> 5;
            for (int it = bid; it < 256; it += G) {
                const int h = it & 3, qb = it >> 2, wq0 = qb * 256 + 32 * wave, qpos = wq0 + lr;
                bf16x8 qf[8]; load_q_norm_bf16x2<128>((const bf16_t*)QXP + (size_t)qpos * 512 + h * 128, (const bf16_t*)QXP + (size_t)S * 512 + (size_t)qpos * 512 + h * 128, INP(I_XQG) + l * 128, 0.08838834764831845f * LOG2E, hi, qf);
                f32x16 o[4];
#pragma unroll
                for (int db = 0; db < 4; ++db)
#pragma unroll
                    for (int r = 0; r < 16; ++r) o[db][r] = 0.f;
                float m_run = -1e30f, l_run = 0.f;
                attn_tiles<128, 128, 2>(tid, lds, XKIMG + (size_t)h * 4 * 16384, XVIMG + (size_t)h * 4 * 16384, 0, 4, qf, qpos, wq0, nullptr, o, m_run, l_run);
                { auto rr = __builtin_amdgcn_permlane32_swap(__float_as_uint(l_run), __float_as_uint(l_run), false, false); l_run = __uint_as_float(rr[0]) + __uint_as_float(rr[1]); }
                store_o<128>(OX + (size_t)qpos * 512 + h * 128, o, fast_rcp(l_run), hi);
            }
            SEAM(11);
        }
        if (IN(12)) for (int rep_ = 0; rep_ < (int)((PROBE_REP >> 12) & 1u) + 1; ++rep_) {
            FRESH();
            pg8::GSched Sd{(const char*)OX, (const char*)XWO, (size_t)256 * 512 * 2, (size_t)256 * 512 * 2, 0, 0, S / 256, D / 256, 1, G, bid};
            pg8::EpiResid E{XB, D, SSP, (((PROBE_REP >> 12) & 1u) != 0u) && rep_ == 0, XF8};
            pg8::gemm_phase<pg8::EpiResid, pg8::GSched>(tid, lds, 512, 512, 512, nullptr, Sd, E);
            SEAM(12);
        }
        if (IN(14)) for (int rep_ = 0; rep_ < (int)((PROBE_REP >> 14) & 1u) + 1; ++rep_) {
            FRESH();
            pg8::GSched Sd{(const char*)XB, (const char*)ROUT, (size_t)256 * D * 2, 0, (size_t)512 * 2, (size_t)512 * 2, S / 256, 1, 4, G, bid};
            pg8::EpiF32Part<64> E{LOGP, 64, (size_t)S * 64};
            pg8::gemm_phase<pg8::EpiF32Part<64>, pg8::GSched>(tid, lds, 512, D, D, nullptr, Sd, E);
            SEAM(14);
        }
        if (IN(15)) for (int rep_ = 0; rep_ < (int)((PROBE_REP >> 15) & 1u) + 1; ++rep_) {
            FRESH();
            for (int i = bid * NTHR + tid; i < NSLOT; i += G * NTHR) { TOK[i] = S; WSLOT[i] = 0.f; }
            if (bid == 0 && tid == 0) RMSV[S] = 0.f;
            LAS unsigned* hist = (LAS unsigned*)lds; LAS unsigned* base = hist + 32;
            const float* bg = INP(I_BG) + l * 4; const float* be = INP(I_BE) + l * 32;
            for (int blk = bid; blk < S / 64; blk += G) {
                if (tid < 64) hist[tid] = 0u;
                __syncthreads();
                int e0 = 0, e1 = 0; unsigned r0 = 0, r1 = 0; float w0 = 0.f, w1 = 0.f; const int s = blk * 64 + tid;
                if (tid < 64) {
                    float ssq = 0.f;
#pragma unroll
                    for (int j4 = 0; j4 < 8; ++j4) { const f32x4 a = *(const f32x4*)(SSP + (size_t)s * 32 + 4 * j4); ssq += (a[0] + a[1]) + (a[2] + a[3]); }
                    const float rms = rsqrtf(ssq * (1.0f / D) + EPS); RMSV[s] = rms;
                    float lg[36];
#pragma unroll
                    for (int j4 = 0; j4 < 9; ++j4) { f32x4 a = *(const f32x4*)(LOGP + (size_t)s * 64 + 4 * j4);
#pragma unroll
                        for (int z = 1; z < 4; ++z) a += *(const f32x4*)(LOGP + (size_t)z * S * 64 + (size_t)s * 64 + 4 * j4);
                        lg[4 * j4] = a[0] * rms; lg[4 * j4 + 1] = a[1] * rms; lg[4 * j4 + 2] = a[2] * rms; lg[4 * j4 + 3] = a[3] * rms; }
                    float gl[4]; int gi = 0; float gm;
#pragma unroll
                    for (int j = 0; j < 4; ++j) gl[j] = lg[j] + bg[j];
                    gm = gl[0];
#pragma unroll
                    for (int j = 1; j < 4; ++j) if (gl[j] > gm) { gm = gl[j]; gi = j; }
                    float gs = 0.f;
#pragma unroll
                    for (int j = 0; j < 4; ++j) gs += __expf(gl[j] - gm);
                    const float gwt = 1.f / gs;
                    float v0 = -__builtin_inff(), v1 = -__builtin_inff(); int i0 = 0, i1 = 0;
#pragma unroll
                    for (int j = 0; j < 8; ++j) { const float lv = (gi == 0) ? lg[4 + j] : (gi == 1) ? lg[12 + j] : (gi == 2) ? lg[20 + j] : lg[28 + j]; const float v = lv + be[gi * 8 + j];
                        if (v > v0) { v1 = v0; i1 = i0; v0 = v; i0 = j; } else if (v > v1) { v1 = v; i1 = j; } }
                    const float ee = __expf(v1 - v0), den = 1.f / (1.f + ee);
                    w0 = gwt * den; w1 = gwt * ee * den; e0 = gi * 8 + i0; e1 = gi * 8 + i1;
                    r0 = __hip_atomic_fetch_add(&hist[e0], 1u, __ATOMIC_RELAXED, __HIP_MEMORY_SCOPE_WORKGROUP); r1 = __hip_atomic_fetch_add(&hist[e1], 1u, __ATOMIC_RELAXED, __HIP_MEMORY_SCOPE_WORKGROUP);
                }
                __syncthreads();
                if (tid < 32) { const unsigned c = hist[tid]; base[tid] = c ? __hip_atomic_fetch_add(ctl + CW_CNT + 64 * l + tid, c, __ATOMIC_RELAXED, __HIP_MEMORY_SCOPE_AGENT) : 0u; }
                __syncthreads();
                if (tid < 64) { REC_E[2 * s] = e0; REC_E[2 * s + 1] = e1; REC_R[2 * s] = (int)(base[e0] + r0); REC_R[2 * s + 1] = (int)(base[e1] + r1); REC_W[2 * s] = w0; REC_W[2 * s + 1] = w1; }
                __syncthreads();
            }
            SEAM(15);
        }
        if (IN(16) || IN(17) || IN(18)) {
            FRESH();
            LAS int* pst = (LAS int*)(CTLW + 16);
            if (tid == 0) { int acc = 0; for (int e = 0; e < 32; ++e) { pst[e] = acc; const int c = (int)__hip_atomic_load(ctl + CW_CNT + 64 * l + e, __ATOMIC_RELAXED, __HIP_MEMORY_SCOPE_AGENT); acc += (c + 255) & ~255; } pst[32] = acc; }
            __syncthreads();
            if (tid < 160) { int e = 0; for (int k = 1; k < 32; ++k) if (pst[k] <= tid * 256) e = k; ((LAS int*)(CTLW + 256))[tid] = e; }
            __syncthreads();
        }
        if (IN(16)) for (int rep_ = 0; rep_ < (int)((PROBE_REP >> 16) & 1u) + 1; ++rep_) {
            FRESH();
            const LAS int* pst = (const LAS int*)(CTLW + 16);
            for (int i = bid * NTHR + tid; i < 2 * S; i += G * NTHR) { const int slot = pst[REC_E[i]] + REC_R[i]; TOK[slot] = i >> 1; WSLOT[slot] = REC_W[i]; REC_S[i] = slot; }
            SEAM(16);
        }
        if (IN(17)) for (int rep_ = 0; rep_ < (int)((PROBE_REP >> 17) & 1u) + 1; ++rep_) {
            FRESH();
            pg8::MoeSched Sd{(const LAS int*)(CTLW + 16), (const char*)MOE1F, TOK, (size_t)1024 * D, (size_t)256 * D, 4, G, bid, 1};
            pg8::EpiMoe1 E{HID8, TOK, RMSV};
            pg8::gemm_phase<pg8::EpiMoe1, pg8::MoeSched, true, true>(tid, lds, D / 2, D / 2, D / 2, (const char*)XF8, Sd, E);
            SEAM(17);
        }
        if (IN(18)) for (int rep_ = 0; rep_ < (int)((PROBE_REP >> 18) & 1u) + 1; ++rep_) {
            {   FRESH();
                pg8::MoeSched Sd{(const LAS int*)(CTLW + 16), (const char*)MOE1F, TOK, (size_t)1024 * D, (size_t)256 * D, 4, G, bid, 2};
                pg8::EpiMoe1 E{HID8, TOK, RMSV};
                pg8::gemm_phase<pg8::EpiMoe1, pg8::MoeSched, true, true>(tid, lds, D / 2, D / 2, D / 2, (const char*)XF8, Sd, E); }
            {   FRESH();
                pg8::MoeSched2 Sd{(const LAS int*)(CTLW + 16), (const char*)HID8, (const char*)MOE2F, (size_t)D * 512, (size_t)256 * 512, 8, G, bid, 1};
                pg8::EpiMoe2 E{YS8, WSLOT};
                pg8::gemm_phase<pg8::EpiMoe2, pg8::MoeSched2, false, true>(tid, lds, 256, 256, 256, nullptr, Sd, E); }
            {   FRESH(); GRID_BAR(); }
            {   FRESH();
                pg8::MoeSched2 Sd{(const LAS int*)(CTLW + 16), (const char*)HID8, (const char*)MOE2F, (size_t)D * 512, (size_t)256 * 512, 8, G, bid, 2};
                pg8::EpiMoe2 E{YS8, WSLOT};
                pg8::gemm_phase<pg8::EpiMoe2, pg8::MoeSched2, false, true>(tid, lds, 256, 256, 256, nullptr, Sd, E); }
            {   FRESH(); SEAM(18); }
        }
}

__global__ void __launch_bounds__(NTHR, 2) fwd_kernel(Args args) {
    extern __shared__ __attribute__((aligned(16))) unsigned char lds_raw[];
    LAS unsigned char* lds0 = (LAS unsigned char*)lds_raw;
    {   int t0 = threadIdx.x; asm volatile("" : "+v"(t0));
        for (int u = t0; u < (LDS_BYTES - LDSCTL_OFF) / 4; u += NTHR) ((LAS unsigned*)(lds0 + LDSCTL_OFF))[u] = 0u;
        __syncthreads();
        if (t0 == 0) { LAS unsigned long long* pw = (LAS unsigned long long*)(lds0 + LDSCTL_OFF + 512);
#pragma unroll
            for (int i = 0; i < 50; ++i) pw[i] = (unsigned long long)args.in[i];
            pw[50] = (unsigned long long)args.ws; pw[51] = (unsigned long long)args.out; }
        __syncthreads();
#if !MK_MULTI
        if (t0 == 0) (void)xb_add(&((unsigned*)args.ws)[CW_BAR + XB_XCNT(xb_xcc_id())], 1u);
#endif
    }
    const int ph_lo = args.ph_lo, ph_hi = args.ph_hi;
    int wave_s = __builtin_amdgcn_readfirstlane(threadIdx.x >> 6); asm volatile("" : "+s"(wave_s));
#if MK_MULTI
    if (args.l_lo < NL) layer_body<0>(args.l_lo, wave_s, lds0, ph_lo, ph_hi);
#else
    layer_body<0>(0, wave_s, lds0, ph_lo, ph_hi);
    layer_body<1>(1, wave_s, lds0, ph_lo, ph_hi);
    layer_body<2>(2, wave_s, lds0, ph_lo, ph_hi);
    layer_body<3>(3, wave_s, lds0, ph_lo, ph_hi);
#endif
    if (args.l_hi > NL) {
        FRESH();
        for (int s = gw; s < S; s += NGW) { const int s0 = REC_S[2 * s], s1 = REC_S[2 * s + 1];
#pragma unroll
            for (int j = 0; j < 4; ++j) { float x[8], ya[8], yb[8]; unpack8(*(const u32x4*)(XB + (size_t)s * D + 8 * lane + 512 * j), x);
                unpack8_fp8(*(const u32x2*)(YS8 + (size_t)s0 * D + 8 * lane + 512 * j), ya); unpack8_fp8(*(const u32x2*)(YS8 + (size_t)s1 * D + 8 * lane + 512 * j), yb);
#pragma unroll
                for (int e = 0; e < 8; ++e) x[e] += (ya[e] + yb[e]) * 0.0625f;
                *(f32x4*)(X + (size_t)s * D + 8 * lane + 512 * j) = (f32x4){x[0], x[1], x[2], x[3]};
                *(f32x4*)(X + (size_t)s * D + 8 * lane + 512 * j + 4) = (f32x4){x[4], x[5], x[6], x[7]}; } }
    }
}

extern "C" void kernel_launch(void* const* d_in, const int* in_sizes, int n_in, void* d_out, int out_size, void* d_ws, size_t ws_size, hipStream_t stream) {
    static int grid = 0;
    if (grid == 0) {
        if (n_in != 50 || out_size != S * D || ws_size < WS_END) { fprintf(stderr, "kernel_launch: unexpected shapes (n_in %d, out %d, ws %zu < %zu)\n", n_in, out_size, ws_size, (size_t)WS_END); grid = -1; return; }
        int dev = 0, cus = 0, per_cu = 0;
        if (hipGetDevice(&dev) != hipSuccess || hipDeviceGetAttribute(&cus, hipDeviceAttributeMultiprocessorCount, dev) != hipSuccess) { grid = -1; return; }
        if (hipFuncSetAttribute((const void*)fwd_kernel, hipFuncAttributeMaxDynamicSharedMemorySize, LDS_BYTES) != hipSuccess) { fprintf(stderr, "kernel_launch: hipFuncSetAttribute failed\n"); grid = -1; return; }
        if (hipOccupancyMaxActiveBlocksPerMultiprocessor(&per_cu, (const void*)fwd_kernel, NTHR, LDS_BYTES) != hipSuccess || per_cu < 1) { fprintf(stderr, "kernel_launch: occupancy query says %d\n", per_cu); }
        (void)hipGetLastError();
        grid = cus;
    }
    if (grid < 0) return;
    (void)in_sizes;
    if (hipMemsetAsync((char*)d_ws + WS_CTL, 0, CTL_ZERO_BYTES, stream) != hipSuccess) return;
    Args a{};
    for (int i = 0; i < 50; ++i) a.in[i] = (const float*)d_in[i];
    a.out = (float*)d_out; a.ws = (unsigned char*)d_ws;
#if MK_MULTI
    for (int l = 0; l < NL; ++l)
        for (int ph = 0; ph < NPH; ++ph) { a.l_lo = l; a.l_hi = l + 1; a.ph_lo = ph; a.ph_hi = ph + 1; hipLaunchKernelGGL(fwd_kernel, dim3(grid), dim3(NTHR), LDS_BYTES, stream, a); }
    a.l_lo = NL; a.l_hi = NL + 1; a.ph_lo = 0; a.ph_hi = 0; hipLaunchKernelGGL(fwd_kernel, dim3(grid), dim3(NTHR), LDS_BYTES, stream, a);
#else
    a.l_lo = 0; a.l_hi = NL + 1; a.ph_lo = 0; a.ph_hi = NPH;
    hipLaunchKernelGGL(fwd_kernel, dim3(grid), dim3(NTHR), LDS_BYTES, stream, a);
#endif
    const hipError_t le = hipPeekAtLastError();
    if (le != hipSuccess) fprintf(stderr, "kernel_launch: launch failed: %s\n", hipGetErrorName(le));
}
```
